# Optimizing an MI355X kernel written in HIP

```python
import math
import jax, jax.numpy as jnp
from jax import lax
import numpy as np

D_MODEL = 4096
BATCH = 2
SEQ = 4096
DEPTH = 4

N_MIXERS = 2
EPS = 1e-5

SSM_EXPAND = 2
D_INNER = SSM_EXPAND * D_MODEL
SSM_HEADDIM = 64
SSM_HEADS = D_INNER // SSM_HEADDIM
SSM_GROUPS = 8
HEADS_PER_GROUP = SSM_HEADS // SSM_GROUPS
SSM_STATE = 128
SSM_CONV = 4
CONV_DIM = D_INNER + 2 * SSM_GROUPS * SSM_STATE
CHUNK = 128
DT_MIN = 1e-3
DT_MAX = 1e-1

DIFF_HEAD_DIM = 128
DIFF_HEADS = D_MODEL // (2 * DIFF_HEAD_DIM)
Q_BLOCK = 128
ATTN_SCALE = DIFF_HEAD_DIM ** -0.5
ROPE_THETA = 10000.0

D_FF = 256 * ((8 * D_MODEL // 3 + 255) // 256)
FFN_CONV = 3

kernel_name = "hybrid_ssd_diffattn_convffn_trunk"


def rmsnorm(x, w):
    xf = x.astype(jnp.float32)
    y = xf * lax.rsqrt(jnp.mean(xf * xf, axis=-1, keepdims=True) + EPS)
    return (y * w.astype(jnp.float32)).astype(x.dtype)


def causal_dwconv(x, w, b):
    k_width = w.shape[0]
    length = x.shape[1]
    xp = jnp.pad(x, ((0, 0), (k_width - 1, 0), (0, 0)))
    return b + sum(w[k] * xp[:, k:k + length] for k in range(k_width))


def gated_group_rmsnorm(y, z, w):
    b, l, _ = y.shape
    g = (y.astype(jnp.float32) * jax.nn.silu(z.astype(jnp.float32))).reshape(b, l, SSM_GROUPS, -1)
    g = g * lax.rsqrt(jnp.mean(g * g, axis=-1, keepdims=True) + EPS)
    return (g.reshape(b, l, D_INNER) * w.astype(jnp.float32)).astype(y.dtype)


def ssd_chunked(x, a, bm, cm):
    b, l, g, h, p = x.shape
    n = bm.shape[-1]
    c = l // CHUNK
    x = x.reshape(b, c, CHUNK, g, h, p)
    bm = bm.reshape(b, c, CHUNK, g, n)
    cm = cm.reshape(b, c, CHUNK, g, n)
    a = a.reshape(b, c, CHUNK, g, h).transpose(0, 3, 4, 1, 2)
    a_cs = jnp.cumsum(a, axis=-1)
    causal = jnp.tri(CHUNK, dtype=bool)
    seg = a_cs[..., :, None] - a_cs[..., None, :]
    decay_in = jnp.exp(jnp.where(causal, seg, -jnp.inf))
    cb = jnp.einsum("bclgn,bcsgn->bcgls", cm, bm)
    y_diag = jnp.einsum("bcgls,bghcls,bcsghp->bclghp", cb, decay_in, x)
    decay_states = jnp.exp(a_cs[..., -1:] - a_cs)
    states = jnp.einsum("bcsgn,bghcs,bcsghp->bcghpn", bm, decay_states, x)
    chunk_cs = jnp.cumsum(jnp.pad(a_cs[..., -1], ((0, 0), (0, 0), (0, 0), (1, 0))), axis=-1)
    decay_chunk = jnp.exp(jnp.where(jnp.tri(c + 1, dtype=bool),
                                    chunk_cs[..., :, None] - chunk_cs[..., None, :], -jnp.inf))
    states = jnp.concatenate([jnp.zeros_like(states[:, :1]), states], axis=1)
    states = jnp.einsum("bghzc,bcghpn->bzghpn", decay_chunk, states)[:, :-1]
    y_off = jnp.einsum("bclgn,bcghpn,bghcl->bclghp", cm, states, jnp.exp(a_cs))
    return (y_diag + y_off).reshape(b, l, g, h, p)


def mamba2_mixer(u, w_in, conv_w, conv_b, dt_bias, a_log, d_skip, norm_w, w_out):
    b, l, _ = u.shape
    zxbcdt = u @ w_in
    z = zxbcdt[..., :D_INNER]
    xbc = zxbcdt[..., D_INNER:D_INNER + CONV_DIM]
    dt = zxbcdt[..., D_INNER + CONV_DIM:]
    xbc = jax.nn.silu(causal_dwconv(xbc, conv_w, conv_b))
    xs = xbc[..., :D_INNER].reshape(b, l, SSM_GROUPS, HEADS_PER_GROUP, SSM_HEADDIM)
    bm = xbc[..., D_INNER:D_INNER + SSM_GROUPS * SSM_STATE].reshape(b, l, SSM_GROUPS, SSM_STATE)
    cm = xbc[..., D_INNER + SSM_GROUPS * SSM_STATE:].reshape(b, l, SSM_GROUPS, SSM_STATE)
    dt = jax.nn.softplus(dt.astype(jnp.float32) + dt_bias.astype(jnp.float32))
    dt = dt.reshape(b, l, SSM_GROUPS, HEADS_PER_GROUP)
    a = -jnp.exp(a_log.astype(jnp.float32)).reshape(SSM_GROUPS, HEADS_PER_GROUP)
    xf = xs.astype(jnp.float32)
    y = ssd_chunked(xf * dt[..., None], dt * a, bm.astype(jnp.float32), cm.astype(jnp.float32))
    y = y + d_skip.astype(jnp.float32).reshape(SSM_GROUPS, HEADS_PER_GROUP)[:, :, None] * xf
    y = y.reshape(b, l, D_INNER).astype(u.dtype)
    return gated_group_rmsnorm(y, z, norm_w) @ w_out


def rotary_tables(positions):
    inv_freq = 1.0 / (ROPE_THETA ** (jnp.arange(0, DIFF_HEAD_DIM, 2, dtype=jnp.float32) / DIFF_HEAD_DIM))
    freqs = positions.astype(jnp.float32)[..., None] * inv_freq
    emb = jnp.concatenate([freqs, freqs], axis=-1)
    return jnp.cos(emb), jnp.sin(emb)


def apply_rope(t, cos, sin):
    c = cos[:, :, None, None, :]
    s = sin[:, :, None, None, :]
    half = DIFF_HEAD_DIM // 2
    tf = t.astype(jnp.float32)
    rot = jnp.concatenate([-tf[..., half:], tf[..., :half]], axis=-1)
    return (tf * c + rot * s).astype(t.dtype)


def diff_attention(u, cos, sin, w_qkv, lq1, lk1, lq2, lk2, subln_w, w_o, lambda_init):
    b, l, _ = u.shape
    qkv = u @ w_qkv
    q = qkv[..., :D_MODEL].reshape(b, l, DIFF_HEADS, 2, DIFF_HEAD_DIM)
    k = qkv[..., D_MODEL:2 * D_MODEL].reshape(b, l, DIFF_HEADS, 2, DIFF_HEAD_DIM)
    v = qkv[..., 2 * D_MODEL:].reshape(b, l, DIFF_HEADS, 2 * DIFF_HEAD_DIM)
    q = apply_rope(q, cos, sin)
    k = apply_rope(k, cos, sin)
    lam = (jnp.exp(jnp.sum(lq1.astype(jnp.float32) * lk1.astype(jnp.float32)))
           - jnp.exp(jnp.sum(lq2.astype(jnp.float32) * lk2.astype(jnp.float32))) + lambda_init)
    k = k.transpose(0, 2, 3, 1, 4)
    v = v.transpose(0, 2, 1, 3)
    n_blk = l // Q_BLOCK
    qb = q.reshape(b, n_blk, Q_BLOCK, DIFF_HEADS, 2, DIFF_HEAD_DIM).transpose(1, 0, 3, 4, 2, 5)
    k_pos = jnp.arange(l)

    def one_block(args):
        q_blk, blk = args
        s = jnp.einsum("bhcqd,bhckd->bhcqk", q_blk, k).astype(jnp.float32) * ATTN_SCALE
        q_pos = blk * Q_BLOCK + jnp.arange(Q_BLOCK)
        s = jnp.where(k_pos[None, :] <= q_pos[:, None], s, -jnp.inf)
        p = jax.nn.softmax(s, axis=-1)
        attn = p[:, :, 0] - lam * p[:, :, 1]
        return jnp.einsum("bhqk,bhkv->bhqv", attn.astype(v.dtype), v)

    o = lax.map(one_block, (qb, jnp.arange(n_blk)))
    o = rmsnorm(o, subln_w) * (1.0 - lambda_init)
    o = o.transpose(1, 0, 3, 2, 4).reshape(b, l, DIFF_HEADS * 2 * DIFF_HEAD_DIM)
    return o @ w_o


def conv_ffn(u, w_up, conv_w, conv_b, w_down):
    h = causal_dwconv(u @ w_up, conv_w, conv_b)
    return (jax.nn.silu(h[..., :D_FF]) * h[..., D_FF:]) @ w_down


def setup_inputs(seed: int = 0) -> dict:
    key = jax.random.key(seed)
    keys = list(jax.random.split(key, 96))
    kit = iter(keys)

    def nrm(shape, scale):
        return jax.random.normal(next(kit), shape, jnp.float32) * scale

    def gain(n):
        return 1.0 + nrm((n,), 0.02)

    inputs = {}
    inputs["x"] = nrm((BATCH, SEQ, D_MODEL), 1.0)
    inputs["positions"] = (jnp.arange(SEQ, dtype=jnp.int32)[None, :]
                           + jax.random.randint(next(kit), (BATCH, 1), 0, 1024, dtype=jnp.int32))
    for i in range(DEPTH):
        p = f"l{i}_"
        inputs[p + "norm_mix"] = gain(D_MODEL)
        if i % N_MIXERS == 0:
            inputs[p + "m_w_in"] = nrm((D_MODEL, 2 * D_INNER + 2 * SSM_GROUPS * SSM_STATE + SSM_HEADS), D_MODEL ** -0.5)
            inputs[p + "m_conv_w"] = nrm((SSM_CONV, CONV_DIM), SSM_CONV ** -0.5)
            inputs[p + "m_conv_b"] = nrm((CONV_DIM,), 0.02)
            dt = jnp.exp(jax.random.uniform(next(kit), (SSM_HEADS,), jnp.float32)
                         * (math.log(DT_MAX) - math.log(DT_MIN)) + math.log(DT_MIN))
            inputs[p + "m_dt_bias"] = dt + jnp.log(-jnp.expm1(-dt))
            inputs[p + "m_a_log"] = jnp.log(jax.random.uniform(next(kit), (SSM_HEADS,), jnp.float32, 1.0, 16.0))
            inputs[p + "m_d"] = 1.0 + nrm((SSM_HEADS,), 0.1)
            inputs[p + "m_norm"] = gain(D_INNER)
            inputs[p + "m_w_out"] = nrm((D_INNER, D_MODEL), D_INNER ** -0.5)
        else:
            inputs[p + "a_w_qkv"] = nrm((D_MODEL, 3 * D_MODEL), D_MODEL ** -0.5)
            inputs[p + "a_lq1"] = nrm((DIFF_HEAD_DIM,), 0.1)
            inputs[p + "a_lk1"] = nrm((DIFF_HEAD_DIM,), 0.1)
            inputs[p + "a_lq2"] = nrm((DIFF_HEAD_DIM,), 0.1)
            inputs[p + "a_lk2"] = nrm((DIFF_HEAD_DIM,), 0.1)
            inputs[p + "a_subln"] = gain(2 * DIFF_HEAD_DIM)
            inputs[p + "a_w_o"] = nrm((D_MODEL, D_MODEL), D_MODEL ** -0.5)
        inputs[p + "norm_ffn"] = gain(D_MODEL)
        inputs[p + "f_w_up"] = nrm((D_MODEL, 2 * D_FF), D_MODEL ** -0.5)
        inputs[p + "f_conv_w"] = nrm((FFN_CONV, 2 * D_FF), FFN_CONV ** -0.5)
        inputs[p + "f_conv_b"] = nrm((2 * D_FF,), 0.02)
        inputs[p + "f_w_down"] = nrm((D_FF, D_MODEL), D_FF ** -0.5)
    inputs["final_norm"] = gain(D_MODEL)
    return inputs


def reference(x, positions,
              l0_norm_mix, l0_m_w_in, l0_m_conv_w, l0_m_conv_b, l0_m_dt_bias, l0_m_a_log, l0_m_d, l0_m_norm, l0_m_w_out,
              l0_norm_ffn, l0_f_w_up, l0_f_conv_w, l0_f_conv_b, l0_f_w_down,
              l1_norm_mix, l1_a_w_qkv, l1_a_lq1, l1_a_lk1, l1_a_lq2, l1_a_lk2, l1_a_subln, l1_a_w_o,
              l1_norm_ffn, l1_f_w_up, l1_f_conv_w, l1_f_conv_b, l1_f_w_down,
              l2_norm_mix, l2_m_w_in, l2_m_conv_w, l2_m_conv_b, l2_m_dt_bias, l2_m_a_log, l2_m_d, l2_m_norm, l2_m_w_out,
              l2_norm_ffn, l2_f_w_up, l2_f_conv_w, l2_f_conv_b, l2_f_w_down,
              l3_norm_mix, l3_a_w_qkv, l3_a_lq1, l3_a_lk1, l3_a_lq2, l3_a_lk2, l3_a_subln, l3_a_w_o,
              l3_norm_ffn, l3_f_w_up, l3_f_conv_w, l3_f_conv_b, l3_f_w_down,
              final_norm):
    norm_mix = [l0_norm_mix, l1_norm_mix, l2_norm_mix, l3_norm_mix]
    norm_ffn = [l0_norm_ffn, l1_norm_ffn, l2_norm_ffn, l3_norm_ffn]
    mixer_params = [
        (l0_m_w_in, l0_m_conv_w, l0_m_conv_b, l0_m_dt_bias, l0_m_a_log, l0_m_d, l0_m_norm, l0_m_w_out),
        (l1_a_w_qkv, l1_a_lq1, l1_a_lk1, l1_a_lq2, l1_a_lk2, l1_a_subln, l1_a_w_o),
        (l2_m_w_in, l2_m_conv_w, l2_m_conv_b, l2_m_dt_bias, l2_m_a_log, l2_m_d, l2_m_norm, l2_m_w_out),
        (l3_a_w_qkv, l3_a_lq1, l3_a_lk1, l3_a_lq2, l3_a_lk2, l3_a_subln, l3_a_w_o),
    ]
    ffn_params = [
        (l0_f_w_up, l0_f_conv_w, l0_f_conv_b, l0_f_w_down),
        (l1_f_w_up, l1_f_conv_w, l1_f_conv_b, l1_f_w_down),
        (l2_f_w_up, l2_f_conv_w, l2_f_conv_b, l2_f_w_down),
        (l3_f_w_up, l3_f_conv_w, l3_f_conv_b, l3_f_w_down),
    ]
    cos, sin = rotary_tables(positions)
    for i in range(DEPTH):
        u = rmsnorm(x, norm_mix[i])
        if i % N_MIXERS == 0:
            x = x + mamba2_mixer(u, *mixer_params[i])
        else:
            lambda_init = 0.8 - 0.6 * math.exp(-0.3 * i)
            x = x + diff_attention(u, cos, sin, *mixer_params[i], lambda_init)
        x = x + conv_ffn(rmsnorm(x, norm_ffn[i]), *ffn_params[i])
    return rmsnorm(x, final_norm)
```

```cpp
#include <hip/hip_runtime.h>
#include <cstdio>
#include <cstdint>
namespace pg8 {
#define PG8_LAS __attribute__((address_space(3)))
typedef unsigned short bf16_t;
typedef short bf16x8 __attribute__((ext_vector_type(8)));
typedef float f32x4 __attribute__((ext_vector_type(4)));
typedef unsigned u32x4 __attribute__((ext_vector_type(4)));
constexpr int BM = 256, BK = 64, HALF = 128, HTB = HALF * BK * 2  , STAGE_BYTES = 8 * HTB, NXCD = 8, WGM = 8;

__host__ __device__ __forceinline__ int lds_byte(int r, int c) { const int st = (r >> 4) * 2 + (c >> 5), rr = r & 15, cc = c & 31, ob = rr * 64 + cc * 2; return st * 1024 + (ob ^ (((ob >> 9) & 1) << 5)); }
__host__ __device__ __forceinline__ void stage_rc(int b, int& R, int& C) { const int st = b / 1024, sb = b % 1024, swz = sb ^ (((sb >> 9) & 1) << 5); R = (st >> 1) * 16 + swz / 64; C = (st & 1) * 32 + (swz % 64) / 2; }
__host__ __device__ __forceinline__ int perm32(int rho) { const int n = rho >> 4, i = rho & 15; return 8 * (i >> 2) + 4 * n + (i & 3); }

struct Unit { int pm, pn; };
struct Gemm { const bf16_t* A; const bf16_t* Bt; int M, N, K; int ld = 0; };

struct StaticOrder {
    int nM, nN, nwg, G, c;
    __host__ __device__ void init(int M, int N, int G_, int c_) { nM = M / BM; nN = N / BM; nwg = nM * nN; G = G_; c = c_; }
    __host__ __device__ bool next(int i, Unit& u) const {
        const long L = (long)i * G + c; if (L >= nwg) return false;
        int wgid = (int)L; { const int q = nwg / NXCD, r = nwg % NXCD, xcd = wgid % NXCD, off = wgid / NXCD; wgid = (xcd < r ? xcd * (q + 1) : r * (q + 1) + (xcd - r) * q) + off; }
        const int nig = WGM * nN, gid = wgid / nig, fm = gid * WGM, gsz = (nM - fm) < WGM ? (nM - fm) : WGM;
        u.pm = fm + ((wgid % nig) % gsz); u.pn = (wgid % nig) / gsz; return true;
    }
    __device__ __forceinline__ void a_ready(const Unit&) const {}
    __device__ __forceinline__ void done(const Unit&) const {}
};

typedef float f32x2c __attribute__((ext_vector_type(2))); typedef __bf16 bf16x2c __attribute__((ext_vector_type(2)));
__device__ __forceinline__ unsigned cvt_pk_bf16(float lo, float hi) { const f32x2c v = {lo, hi}; return __builtin_bit_cast(unsigned, __builtin_convertvector(v, bf16x2c)); }
typedef float f32x2 __attribute__((ext_vector_type(2)));
__device__ __forceinline__ f32x2 gelu_pk(f32x2 v) {
    const f32x2 av = __builtin_elementwise_abs(v), d = av * 0.2316418882f + 1.0f;
    f32x2 t; t.x = __builtin_amdgcn_rcpf(d.x); t.y = __builtin_amdgcn_rcpf(d.y);
    f32x2 q = t * 0.5307027145f + (-0.7265760135f); q = q * t + 0.7107068705f; q = q * t + (-0.142248368f); q = q * t + 0.127414796f; q = q * t;
    const f32x2 s = (v * v) * (-0.72134752044f);
    f32x2 e; e.x = __builtin_amdgcn_exp2f(s.x); e.y = __builtin_amdgcn_exp2f(s.y);
    const f32x2 m = v * (q * e), r = v - m;
    f32x2 o; o.x = v.x < 0.f ? m.x : r.x; o.y = v.y < 0.f ? m.y : r.y; return o;
}

template <int ACT  > struct EpiBf16 {
    static constexpr bool PERM = true, AFTER_DRAIN = false; static_assert(ACT == 0 || ACT == 1, "EpiBf16: ACT is 0 (none) or 1 (gelu_pk)");
    bf16_t* O; int ldc; const float* bias; int split_cols; size_t split_stride; float scale0;
    __device__ __forceinline__ void operator()(const f32x4 (&acc)[2][2][4][2], const Unit& u, int wr, int wc, int fr, int fq) const {
        const int row0 = u.pm * BM + wr * 64 + fr; int colt = u.pn * BM; bf16_t* base = O;
        float sc = 1.f; if (split_cols) { const int t = colt / split_cols; base += (size_t)t * split_stride; colt -= t * split_cols; if (t == 0) sc = scale0; }
        const int col0 = colt + wc * 32 + 8 * fq, bcol0 = u.pn * BM + wc * 32 + 8 * fq;
        f32x4 bv[2][2];
#pragma unroll
        for (int bj = 0; bj < 2; ++bj)
#pragma unroll
            for (int n = 0; n < 2; ++n) bv[bj][n] = bias ? *(const f32x4*)(bias + bcol0 + bj * HALF + 4 * n) : (f32x4){0.f, 0.f, 0.f, 0.f};
#pragma unroll
        for (int ai = 0; ai < 2; ++ai)
#pragma unroll
            for (int m = 0; m < 4; ++m) { bf16_t* rowp = base + (size_t)(row0 + ai * HALF + m * 16) * ldc + col0;
#pragma unroll
                for (int bj = 0; bj < 2; ++bj) { f32x4 v0 = acc[ai][bj][m][0] + bv[bj][0], v1 = acc[ai][bj][m][1] + bv[bj][1];
                    if (ACT == 1) { f32x2 a = gelu_pk((f32x2){v0[0], v0[1]}), b = gelu_pk((f32x2){v0[2], v0[3]}), c = gelu_pk((f32x2){v1[0], v1[1]}), d = gelu_pk((f32x2){v1[2], v1[3]});
                        v0 = (f32x4){a.x, a.y, b.x, b.y}; v1 = (f32x4){c.x, c.y, d.x, d.y}; }
                    v0 = v0 * sc; v1 = v1 * sc; u32x4 w; w.x = cvt_pk_bf16(v0[0], v0[1]); w.y = cvt_pk_bf16(v0[2], v0[3]); w.z = cvt_pk_bf16(v1[0], v1[1]); w.w = cvt_pk_bf16(v1[2], v1[3]);
                    *(u32x4*)(rowp + bj * HALF) = w; } }
    }
};


struct EpiRes {
    static constexpr bool PERM = false, AFTER_DRAIN = false;
    const float* base; float* out; int ldc;
    __device__ __forceinline__ void operator()(const f32x4 (&acc)[2][2][4][2], const Unit& u, int wr, int wc, int fr, int fq) const {
        const int col0 = u.pn * BM + wc * 32 + 4 * fq;
#pragma unroll
        for (int ai = 0; ai < 2; ++ai)
#pragma unroll
            for (int m = 0; m < 4; ++m) { const size_t off = (size_t)(u.pm * BM + ai * HALF + wr * 64 + m * 16 + fr) * ldc + col0;
#pragma unroll
                for (int bj = 0; bj < 2; ++bj)
#pragma unroll
                    for (int n = 0; n < 2; ++n) { const f32x4 bs = *(const f32x4*)(base + off + bj * HALF + n * 16); *(f32x4*)(out + off + bj * HALF + n * 16) = bs + acc[ai][bj][m][n]; }
                if (m & 1) asm volatile("" ::: "memory"); }
    }
};
struct EpiHeadMajor {
    static constexpr bool PERM = true, AFTER_DRAIN = false;
    bf16_t* O; size_t gstride; const float* cs; const float* sn; const unsigned long long* ss; const PG8_LAS float* tab; int pm0, ntab;
    __device__ __forceinline__ void operator()(const f32x4 (&acc)[2][2][4][2], const Unit& u, int wr, int wc, int fr, int fq) const {
        const int row0 = u.pm * BM + wr * 64 + fr, col0 = wc * 32 + 8 * fq; const bool rope = u.pn < 32, intab = (unsigned)(u.pm - pm0) < (unsigned)ntab;
#pragma unroll
        for (int ai = 0; ai < 2; ++ai)
#pragma unroll
            for (int m = 0; m < 4; ++m) { const int row = row0 + ai * HALF + m * 16;
                const float rs = intab ? tab[row - pm0 * BM] : 1.0f / sqrtf((float)ss[row] * (1.0f / (4096.0f * 16777216.0f)) + 1e-5f);
                f32x4 c4 = {1.f, 1.f, 1.f, 1.f}, s4 = {0.f, 0.f, 0.f, 0.f};
                if (rope) { c4 = *(const f32x4*)(cs + (size_t)row * 64 + 16 * wc + 4 * fq); s4 = *(const f32x4*)(sn + (size_t)row * 64 + 16 * wc + 4 * fq); }
#pragma unroll
                for (int bj = 0; bj < 2; ++bj) { bf16_t* rowp = O + (size_t)(u.pn * 2 + bj) * gstride + (size_t)row * 128 + col0;
                    const f32x4 v0 = acc[ai][bj][m][0] * rs, v1 = acc[ai][bj][m][1] * rs;
                    const f32x4 r0 = {v0[0] * c4[0] - v0[1] * s4[0], v0[1] * c4[0] + v0[0] * s4[0], v0[2] * c4[1] - v0[3] * s4[1], v0[3] * c4[1] + v0[2] * s4[1]};
                    const f32x4 r1 = {v1[0] * c4[2] - v1[1] * s4[2], v1[1] * c4[2] + v1[0] * s4[2], v1[2] * c4[3] - v1[3] * s4[3], v1[3] * c4[3] + v1[2] * s4[3]};
                    u32x4 w; w.x = cvt_pk_bf16(r0[0], r0[1]); w.y = cvt_pk_bf16(r0[2], r0[3]); w.z = cvt_pk_bf16(r1[0], r1[1]); w.w = cvt_pk_bf16(r1[2], r1[3]);
                    *(u32x4*)rowp = w; } }
    }
};
struct EpiBf16S {
    static constexpr bool PERM = true, AFTER_DRAIN = false;
    bf16_t* O; int ldc; const unsigned long long* ss; const PG8_LAS float* tab; int pm0, ntab;
    __device__ __forceinline__ void operator()(const f32x4 (&acc)[2][2][4][2], const Unit& u, int wr, int wc, int fr, int fq) const {
        const int row0 = u.pm * BM + wr * 64 + fr, col0 = u.pn * BM + wc * 32 + 8 * fq; const bool intab = (unsigned)(u.pm - pm0) < (unsigned)ntab;
#pragma unroll
        for (int ai = 0; ai < 2; ++ai)
#pragma unroll
            for (int m = 0; m < 4; ++m) { const int row = row0 + ai * HALF + m * 16;
                const float rs = intab ? tab[row - pm0 * BM] : 1.0f / sqrtf((float)ss[row] * (1.0f / (4096.0f * 16777216.0f)) + 1e-5f);
                bf16_t* rowp = O + (size_t)row * ldc + col0;
#pragma unroll
                for (int bj = 0; bj < 2; ++bj) { const f32x4 v0 = acc[ai][bj][m][0] * rs, v1 = acc[ai][bj][m][1] * rs;
                    u32x4 w; w.x = cvt_pk_bf16(v0[0], v0[1]); w.y = cvt_pk_bf16(v0[2], v0[3]); w.z = cvt_pk_bf16(v1[0], v1[1]); w.w = cvt_pk_bf16(v1[2], v1[3]);
                    *(u32x4*)(rowp + bj * HALF) = w; } }
    }
};
template <int C, bool BC> __device__ __forceinline__ float eg_dpp(float x) { return __int_as_float(__builtin_amdgcn_update_dpp(0, __float_as_int(x), C, 0xf, 0xf, BC)); }
#define EG_DPP(x, c, bc) eg_dpp<c, bc>(x)
#define EG_SHR1(x) EG_DPP(x, 0x111, true)
#define EG_SHR2(x) EG_DPP(x, 0x112, true)
#define EG_MIR(x) EG_DPP(x, 0x140, false)
#define EG_SWP(x) EG_DPP(x, 0xB1, false)
struct EpiGate {
    static constexpr bool PERM = true, AFTER_DRAIN = false;
    bf16_t* GA; bf16_t* HB; const float* cw; const float* cb; int nup, dff; const unsigned long long* ss; PG8_LAS unsigned char* side;
    __device__ __forceinline__ void prefetch(const Unit& nx, int par, int wid, int lane) const {
        const float* base = (wid < 3 ? cw + (size_t)wid * nup : wid < 6 ? cw + (size_t)(wid - 3) * nup + dff : wid == 6 ? cb : cb + dff) + nx.pn * 128 + lane;
        PG8_LAS unsigned char* d = side + par * 4096 + wid * 512;
        __builtin_amdgcn_global_load_lds((const unsigned*)base, (PG8_LAS unsigned*)d, 4, 0, 0);
        __builtin_amdgcn_global_load_lds((const unsigned*)(base + 64), (PG8_LAS unsigned*)(d + 256), 4, 0, 0);
        __builtin_amdgcn_global_load_lds((const unsigned*)(ss + (size_t)nx.pm * BM) + wid * 64 + lane, (PG8_LAS unsigned*)(side + 8192 + par * 2048 + wid * 256), 4, 0, 0);
    }
    __device__ __forceinline__ void run(const f32x4 (&acc)[2][2][4][2], const Unit& u, int par, int wr, int wc, int fr, int fq) const {
        typedef unsigned u32x2 __attribute__((ext_vector_type(2)));
        const int ch0 = u.pn * 128 + wc * 32 + 8 * fq;
        float rsv[2][4]; { const PG8_LAS unsigned long long* sl = (const PG8_LAS unsigned long long*)(side + 8192 + par * 2048) + wr * 64 + fr;
#pragma unroll
            for (int ai = 0; ai < 2; ++ai)
#pragma unroll
                for (int m = 0; m < 4; ++m) rsv[ai][m] = __builtin_amdgcn_rsqf((float)sl[ai * 128 + m * 16] * (1.0f / (4096.0f * 16777216.0f)) + 1e-5f); }
        const bool f0 = fr == 0, f01 = fr < 2;
#pragma unroll
        for (int n = 0; n < 2; ++n) { const int ch = ch0 + 4 * n;
            const PG8_LAS f32x4* wp = (const PG8_LAS f32x4*)(side + par * 4096) + (wc * 8 + 2 * fq + n);
            const f32x4 wg0 = wp[0], wg1 = wp[32], wg2 = wp[64], wv0 = wp[96], wv1 = wp[128], wv2 = wp[160], bg = wp[192], bv = wp[224];
#pragma unroll
            for (int ai = 0; ai < 2; ++ai) { f32x4 pg1 = {0.f, 0.f, 0.f, 0.f}, pg2 = pg1, pv1 = pg1, pv2 = pg1;
#pragma unroll
                for (int m = 0; m < 4; ++m) { const int row = u.pm * BM + ai * HALF + wr * 64 + m * 16 + fr;
                    const float rs = rsv[ai][m];
                    const f32x4 g = acc[ai][0][m][n] * rs, v = acc[ai][1][m][n] * rs; f32x4 g1, g2, v1, v2, o;
#pragma unroll
                    for (int e = 0; e < 4; ++e) { g1[e] = EG_SHR1(g[e]); g2[e] = EG_SHR2(g[e]); v1[e] = EG_SHR1(v[e]); v2[e] = EG_SHR2(v[e]); }
#pragma unroll
                    for (int e = 0; e < 4; ++e) { const float tg1 = f0 ? pg1[e] : g1[e], tg2 = f01 ? pg2[e] : g2[e], tv1 = f0 ? pv1[e] : v1[e], tv2 = f01 ? pv2[e] : v2[e];
                        const float a = bg[e] + wg0[e] * tg2 + wg1[e] * tg1 + wg2[e] * g[e], b = bv[e] + wv0[e] * tv2 + wv1[e] * tv1 + wv2[e] * v[e];
                        o[e] = a * __builtin_amdgcn_rcpf(1.f + __expf(-a)) * b; }
                    if (m > 0 || !f01) { u32x2 w; w.x = cvt_pk_bf16(o[0], o[1]); w.y = cvt_pk_bf16(o[2], o[3]); *(u32x2*)(GA + (size_t)row * dff + ch) = w; }
                    if ((m == 0 && f01) || (m == 3 && fr >= 14)) { const int j = (m == 0) ? fr : fr - 12;
                        bf16_t* hp = HB + (size_t)(((row >> 6) * 4 + j) * 2) * dff + ch;
                        u32x2 wg_; wg_.x = cvt_pk_bf16(g[0], g[1]); wg_.y = cvt_pk_bf16(g[2], g[3]); *(u32x2*)hp = wg_;
                        u32x2 wv_; wv_.x = cvt_pk_bf16(v[0], v[1]); wv_.y = cvt_pk_bf16(v[2], v[3]); *(u32x2*)(hp + dff) = wv_; }
#pragma unroll
                    for (int e = 0; e < 4; ++e) { pg1[e] = EG_MIR(g[e]); pg2[e] = EG_SWP(pg1[e]); pv1[e] = EG_MIR(v[e]); pv2[e] = EG_SWP(pv1[e]); }
                } } }
    }
};
#undef EG_SHR1
#undef EG_SHR2
#undef EG_MIR
#undef EG_SWP
#undef EG_DPP
template <class T> struct epi_pf { static constexpr bool v = false; };
template <> struct epi_pf<EpiGate> { static constexpr bool v = true; };
struct EpiResN {
    static constexpr bool PERM = false, AFTER_DRAIN = false;
    const float* base; float* out; bf16_t* xb; unsigned long long* ss; int ldc;
    __device__ __forceinline__ void operator()(const f32x4 (&acc)[2][2][4][2], const Unit& u, int wr, int wc, int fr, int fq) const {
        const int col0 = u.pn * BM + wc * 32 + 4 * fq;
        int l = threadIdx.x; asm volatile("" : "+v"(l)); l &= 63;
        typedef unsigned u32x2 __attribute__((ext_vector_type(2)));
        const size_t off0 = (size_t)(u.pm * BM + wr * 64 + fr) * ldc + col0;
        const int ucol = (fq & 1) ? 12 + 4 * fq : 4 * fq;
        f32x4 bsA[2][2][2], bsB[2][2][2];
#define ERN_LOAD(dst, b_) do { _Pragma("unroll") for (int mm = 0; mm < 2; ++mm) _Pragma("unroll") for (int bj = 0; bj < 2; ++bj) _Pragma("unroll") for (int n = 0; n < 2; ++n) \
            dst[mm][bj][n] = *(const f32x4*)(base + off0 + (size_t)(((b_) >> 1) * HALF + (((b_) & 1) * 2 + mm) * 16) * ldc + bj * HALF + n * 16); } while (0)
#define ERN_DO(src, b_) do { _Pragma("unroll") for (int mm = 0; mm < 2; ++mm) { const int ai = (b_) >> 1, m = ((b_) & 1) * 2 + mm; const int row = u.pm * BM + ai * HALF + wr * 64 + m * 16 + fr; \
            const size_t off = off0 + (size_t)(ai * HALF + m * 16) * ldc; float q = 0.f; \
            _Pragma("unroll") for (int bj = 0; bj < 2; ++bj) { const f32x4 o0 = src[mm][bj][0] + acc[ai][bj][m][0], o1 = src[mm][bj][1] + acc[ai][bj][m][1]; \
                *(f32x4*)(out + off + bj * HALF) = o0; *(f32x4*)(out + off + bj * HALF + 16) = o1; \
                q += ((o0[0] * o0[0] + o0[1] * o0[1]) + (o0[2] * o0[2] + o0[3] * o0[3])) + ((o1[0] * o1[0] + o1[1] * o1[1]) + (o1[2] * o1[2] + o1[3] * o1[3])); \
                  \
                const auto r0 = __builtin_amdgcn_permlane16_swap(cvt_pk_bf16(o0[0], o0[1]), cvt_pk_bf16(o1[0], o1[1]), false, false); \
                const auto r1 = __builtin_amdgcn_permlane16_swap(cvt_pk_bf16(o0[2], o0[3]), cvt_pk_bf16(o1[2], o1[3]), false, false); \
                u32x4 w; w.x = r0[0]; w.y = r1[0]; w.z = r0[1]; w.w = r1[1]; \
                *(u32x4*)(xb + off - 4 * fq + ucol + bj * HALF) = w; } \
            q += __builtin_bit_cast(float, __builtin_amdgcn_ds_bpermute((l ^ 16) << 2, __builtin_bit_cast(int, q))); \
            q += __builtin_bit_cast(float, __builtin_amdgcn_ds_bpermute((l ^ 32) << 2, __builtin_bit_cast(int, q))); \
            if (fq == 0) atomicAdd(ss + row, (unsigned long long)__float2ll_rn(q * 16777216.0f)); } } while (0)
        ERN_LOAD(bsA, 0); ERN_LOAD(bsB, 1); asm volatile("" ::: "memory");
        ERN_DO(bsA, 0); asm volatile("" ::: "memory"); ERN_LOAD(bsA, 2); asm volatile("" ::: "memory");
        ERN_DO(bsB, 1); asm volatile("" ::: "memory"); ERN_LOAD(bsB, 3); asm volatile("" ::: "memory");
        ERN_DO(bsA, 2); asm volatile("" ::: "memory");
        ERN_DO(bsB, 3);
#undef ERN_LOAD
#undef ERN_DO
    }
};
struct EpiPart {
    static constexpr bool PERM = false, AFTER_DRAIN = false;
    float* P;
    __device__ __forceinline__ void operator()(const f32x4 (&acc)[2][2][4][2], const Unit& u, int wr, int wc, int fr, int fq) const {
#pragma unroll
        for (int ai = 0; ai < 2; ++ai)
#pragma unroll
            for (int m = 0; m < 4; ++m) { float* rowp = P + (size_t)(u.pm * BM + ai * HALF + wr * 64 + m * 16 + fr) * 128 + wc * 32 + 4 * fq;
#pragma unroll
                for (int n = 0; n < 2; ++n) *(f32x4*)(rowp + n * 16) = acc[ai][0][m][n]; }
    }
};
struct OneUnit {
    int pm, valid;
    __device__ __forceinline__ bool next(int i, Unit& u) const { if (i != 0 || !valid) return false; u.pm = pm; u.pn = 0; return true; }
    __device__ __forceinline__ void a_ready(const Unit&) const {}
    __device__ __forceinline__ void done(const Unit&) const {}
};
struct EpiNull {
    static constexpr bool PERM = true, AFTER_DRAIN = false;
    __device__ __forceinline__ void operator()(const f32x4 (&acc)[2][2][4][2], const Unit& u, int wr, int wc, int fr, int fq) const {
        float s = 0.f;
#pragma unroll
        for (int ai = 0; ai < 2; ++ai)
#pragma unroll
            for (int bj = 0; bj < 2; ++bj)
#pragma unroll
                for (int m = 0; m < 4; ++m)
#pragma unroll
                    for (int n = 0; n < 2; ++n) s += acc[ai][bj][m][n][0] + acc[ai][bj][m][n][1] + acc[ai][bj][m][n][2] + acc[ai][bj][m][n][3];
        if (s == 1.2345e-30f) asm volatile("s_nop 0" ::: "memory");
    }
};
template <class Epi, class Sched, bool ALIGN_EPI = false, bool SP2 = false>
__device__ __forceinline__ void gemm_phase(PG8_LAS unsigned char* lds, const Gemm g, const Sched& S, const Epi& E) {
    int tid_l_ = threadIdx.x; asm volatile("" : "+v"(tid_l_)); const int tid = tid_l_, wid = __builtin_amdgcn_readfirstlane(tid >> 6), lane = tid & 63, wr = wid >> 2, wc = wid & 3, fr = lane & 15, fq = lane >> 4;
    const int nt = g.K / BK, K = g.ld ? g.ld : g.K;
    unsigned voffA[2], voffB[2];
#pragma unroll
    for (int i = 0; i < 2; ++i) { int R, C; stage_rc(tid * 16 + i * 8192, R, C); const int Rb = Epi::PERM ? ((R & ~31) + perm32(R & 31)) : R;
        voffA[i] = (unsigned)(R * K + C) * 2u; voffB[i] = (unsigned)(Rb * K + C) * 2u; }
    const size_t kstep = (size_t)(BK * 2);
    const size_t hstep = (size_t)HALF * K * 2;
    const size_t tstep = 2 * hstep;
    const unsigned ldsw = (unsigned)wid * 1024u;
    const int aoff = lds_byte(wr * 64 + fr, fq * 8), boff = lds_byte(wc * 32 + fr, fq * 8);
#define PG8_SA(b, h) (((b) * 2 + (h)) * HTB)
#define PG8_SB(b, h) ((4 + (b) * 2 + (h)) * HTB)
#define PG8_STAGE(bufoff, gbase, voff) do { _Pragma("unroll") for (int _i = 0; _i < 2; ++_i) \
        __builtin_amdgcn_global_load_lds((const unsigned*)((const char*)(gbase) + (voff)[_i]), (PG8_LAS unsigned*)(lds + (bufoff) + ldsw + _i * 8192), 16, 0, 0); } while (0)
#define PG8_LDA(dst, b, h) do { _Pragma("unroll") for (int m = 0; m < 4; ++m) _Pragma("unroll") for (int k = 0; k < 2; ++k) dst[m][k] = *(const PG8_LAS bf16x8*)(lds + PG8_SA(b, h) + aoff + m * 2048 + k * 1024); } while (0)
#define PG8_LDB(dst, b, h) do { _Pragma("unroll") for (int n = 0; n < 2; ++n) _Pragma("unroll") for (int k = 0; k < 2; ++k) dst[n][k] = *(const PG8_LAS bf16x8*)(lds + PG8_SB(b, h) + boff + n * 2048 + k * 1024); } while (0)
#define PG8_MMA(ai, bj, At, Bt) do { __builtin_amdgcn_s_setprio(1); _Pragma("unroll") for (int m = 0; m < 4; ++m) _Pragma("unroll") for (int n = 0; n < 2; ++n) _Pragma("unroll") for (int k = 0; k < 2; ++k) \
        acc[ai][bj][m][n] = __builtin_amdgcn_mfma_f32_16x16x32_bf16(Bt[n][k], At[m][k], acc[ai][bj][m][n], 0, 0, 0); __builtin_amdgcn_s_setprio(0); } while (0)
#define PG8_WAIT_V(n) asm volatile("s_waitcnt vmcnt(" #n ")" ::: "memory")
#define PG8_WAIT_L(n) asm volatile("s_waitcnt lgkmcnt(" #n ")" ::: "memory")
#define PG8_BAR __builtin_amdgcn_s_barrier()
#define PG8_SCHED __builtin_amdgcn_sched_barrier(0)
    Unit cur, nxt; int ui = 0;
    if (!S.next(0, cur)) return;
    f32x4 acc[2][2][4][2];
#pragma unroll
    for (int a = 0; a < 2; ++a)
#pragma unroll
        for (int b = 0; b < 2; ++b)
#pragma unroll
            for (int m = 0; m < 4; ++m)
#pragma unroll
                for (int n = 0; n < 2; ++n) acc[a][b][m][n] = (f32x4){0.f, 0.f, 0.f, 0.f};
    bf16x8 At[4][2], B0[2][2], B1[2][2];
    const char* cA = (const char*)g.A + (size_t)cur.pm * tstep; const char* cB = (const char*)g.Bt + (size_t)cur.pn * tstep;
    if constexpr (epi_pf<Epi>::v) E.prefetch(cur, 0, wid, lane);
    S.a_ready(cur);
    if constexpr (SP2) {
        PG8_STAGE(PG8_SB(0, 0), cB, voffB); PG8_STAGE(PG8_SB(0, 1), cB + hstep, voffB); PG8_STAGE(PG8_SA(0, 0), cA, voffA); PG8_STAGE(PG8_SA(0, 1), cA + hstep, voffA);
        if (wr == 1) PG8_BAR;
        PG8_WAIT_V(2); PG8_BAR;
        PG8_STAGE(PG8_SB(1, 0), cB + kstep, voffB); PG8_STAGE(PG8_SA(1, 0), cA + kstep, voffA); PG8_STAGE(PG8_SB(1, 1), cB + hstep + kstep, voffB);
        PG8_WAIT_V(6); PG8_BAR;
    } else {
        PG8_STAGE(PG8_SB(0, 0), cB, voffB); PG8_STAGE(PG8_SA(0, 0), cA, voffA); PG8_STAGE(PG8_SB(0, 1), cB + hstep, voffB); PG8_STAGE(PG8_SA(0, 1), cA + hstep, voffA);
        if (wr == 1) PG8_BAR;
        PG8_WAIT_V(4); PG8_BAR;
        PG8_STAGE(PG8_SB(1, 0), cB + kstep, voffB); PG8_STAGE(PG8_SA(1, 0), cA + kstep, voffA); PG8_STAGE(PG8_SB(1, 1), cB + hstep + kstep, voffB);
        PG8_WAIT_V(6); PG8_BAR;
    }
    for (;;) {
        const bool has_next = S.next(ui + 1, nxt);
        const char* nA = has_next ? (const char*)g.A + (size_t)nxt.pm * tstep : cA; const char* nB = has_next ? (const char*)g.Bt + (size_t)nxt.pn * tstep : cB;
        for (int t = 0; t < nt; t += 2) {
            const bool last = (t == nt - 2);
            const char* a1 = cA + (size_t)(t + 1) * kstep;
            const char* a2 = last ? nA : cA + (size_t)(t + 2) * kstep; const char* b2 = last ? nB : cB + (size_t)(t + 2) * kstep;
            const char* a3 = a2 + kstep; const char* b3 = b2 + kstep;
            if (last && has_next) S.a_ready(nxt);
            if constexpr (SP2) {
            PG8_LDB(B0, 0, 0); PG8_LDB(B1, 0, 1); PG8_SCHED; PG8_LDA(At, 0, 0); PG8_STAGE(PG8_SA(1, 1), a1 + hstep, voffA);
            PG8_WAIT_V(8); PG8_WAIT_L(0); PG8_BAR; PG8_MMA(0, 0, At, B0); PG8_MMA(0, 1, At, B1); PG8_BAR; PG8_SCHED;
            PG8_LDA(At, 0, 1); PG8_STAGE(PG8_SB(0, 0), b2, voffB); PG8_STAGE(PG8_SB(0, 1), b2 + hstep, voffB); PG8_STAGE(PG8_SA(0, 0), a2, voffA);
            PG8_WAIT_V(8); PG8_WAIT_L(0); PG8_BAR; PG8_MMA(1, 0, At, B0); PG8_MMA(1, 1, At, B1); PG8_BAR; PG8_SCHED;
            PG8_LDB(B0, 1, 0); PG8_LDB(B1, 1, 1); PG8_SCHED; PG8_LDA(At, 1, 0); PG8_STAGE(PG8_SA(0, 1), a2 + hstep, voffA);
            PG8_WAIT_V(8); PG8_WAIT_L(0); PG8_BAR; PG8_MMA(0, 0, At, B0); PG8_MMA(0, 1, At, B1); PG8_BAR; PG8_SCHED;
            PG8_LDA(At, 1, 1); PG8_STAGE(PG8_SB(1, 0), b3, voffB); PG8_STAGE(PG8_SB(1, 1), b3 + hstep, voffB); PG8_STAGE(PG8_SA(1, 0), a3, voffA);
            PG8_WAIT_V(8); PG8_WAIT_L(0); PG8_BAR; PG8_MMA(1, 0, At, B0); PG8_MMA(1, 1, At, B1); PG8_BAR; PG8_SCHED;
            } else {
            PG8_LDB(B0, 0, 0); PG8_SCHED; PG8_LDA(At, 0, 0); PG8_STAGE(PG8_SA(1, 1), a1 + hstep, voffA);
            PG8_WAIT_L(8); PG8_BAR; PG8_WAIT_L(0); PG8_MMA(0, 0, At, B0); PG8_BAR; PG8_SCHED;
            PG8_LDB(B1, 0, 1); PG8_STAGE(PG8_SB(0, 0), b2, voffB);
            PG8_BAR; PG8_WAIT_L(0); PG8_MMA(0, 1, At, B1); PG8_BAR;
            PG8_LDA(At, 0, 1); PG8_STAGE(PG8_SA(0, 0), a2, voffA);
            PG8_BAR; PG8_WAIT_L(0); PG8_MMA(1, 0, At, B0); PG8_BAR; PG8_SCHED;
            PG8_STAGE(PG8_SB(0, 1), b2 + hstep, voffB);
            PG8_WAIT_V(6); PG8_BAR; PG8_MMA(1, 1, At, B1); PG8_BAR;
            PG8_LDB(B0, 1, 0); PG8_SCHED; PG8_LDA(At, 1, 0); PG8_STAGE(PG8_SA(0, 1), a2 + hstep, voffA);
            PG8_WAIT_L(8); PG8_BAR; PG8_WAIT_L(0); PG8_MMA(0, 0, At, B0); PG8_BAR; PG8_SCHED;
            PG8_LDB(B1, 1, 1); PG8_STAGE(PG8_SB(1, 0), b3, voffB);
            PG8_BAR; PG8_WAIT_L(0); PG8_MMA(0, 1, At, B1); PG8_BAR;
            PG8_LDA(At, 1, 1); PG8_STAGE(PG8_SA(1, 0), a3, voffA);
            PG8_BAR; PG8_WAIT_L(0); PG8_MMA(1, 0, At, B0); PG8_BAR; PG8_SCHED;
            PG8_STAGE(PG8_SB(1, 1), b3 + hstep, voffB);
            PG8_WAIT_V(6); PG8_BAR; PG8_MMA(1, 1, At, B1); PG8_BAR;
            }
        }
        if constexpr (ALIGN_EPI) { if (wr == 0) PG8_BAR; }
        if constexpr (epi_pf<Epi>::v) { if (has_next) E.prefetch(nxt, (ui + 1) & 1, wid, lane); E.run(acc, cur, ui & 1, wr, wc, fr, fq); S.done(cur); } else
        if constexpr (!Epi::AFTER_DRAIN) { E(acc, cur, wr, wc, fr, fq); S.done(cur); }
        if (!has_next) break;
#pragma unroll
        for (int a = 0; a < 2; ++a)
#pragma unroll
            for (int b = 0; b < 2; ++b)
#pragma unroll
                for (int m = 0; m < 4; ++m)
#pragma unroll
                    for (int n = 0; n < 2; ++n) acc[a][b][m][n] = (f32x4){0.f, 0.f, 0.f, 0.f};
        cur = nxt; cA = nA; cB = nB; ++ui;
        if constexpr (ALIGN_EPI) { if (wr == 1) PG8_BAR; }
    }
    PG8_WAIT_V(0);
    if constexpr (!ALIGN_EPI) { if (wr == 0) PG8_BAR; }
    PG8_BAR;
    if constexpr (Epi::AFTER_DRAIN) { E.fused(acc, cur, wr, wc, fr, fq, lds, wid, lane); S.done(cur); }
#undef PG8_SA
#undef PG8_SB
#undef PG8_STAGE
#undef PG8_LDA
#undef PG8_LDB
#undef PG8_MMA
#undef PG8_WAIT_V
#undef PG8_WAIT_L
#undef PG8_BAR
#undef PG8_SCHED
}
}

#ifndef PG8_SP2
#define PG8_SP2 true
#endif
#ifndef PG8_ALIGN
#define PG8_ALIGN true
#endif

namespace att {
constexpr int D = 128;
constexpr float SCALE = 0.08838834764831845f;
constexpr float THR = 8.f;
constexpr bool WSKIP = false;
constexpr int NW = 8, QBLK = 32, KVBLK = 64, QB = NW * QBLK;
constexpr int SHM_V = KVBLK * D * 2, SHM_K = KVBLK * D * 2;
constexpr int LDS_BYTES = 2 * SHM_V + 2 * SHM_K + NW * 64 * 4;
typedef unsigned short bf16;
typedef short bf16x8 __attribute__((ext_vector_type(8)));
typedef short s16x4 __attribute__((ext_vector_type(4)));
typedef float f32x16 __attribute__((ext_vector_type(16)));
typedef float f32x4 __attribute__((ext_vector_type(4)));
typedef unsigned u32x4 __attribute__((ext_vector_type(4)));
template <class A, class Bt> struct same_t { static constexpr bool v = false; };
template <class A> struct same_t<A, A> { static constexpr bool v = true; };

#define KSWZ(row, colB) ((row) * 256 + ((colB) ^ (((row) & 7) << 4)))
#define SBAR() __builtin_amdgcn_sched_barrier(0)
__device__ __forceinline__ int v_st(int k, int c) { const int kk = (k & ~0xC) | ((k & 4) << 1) | ((k & 8) >> 1); return ((kk >> 3) * 4 + (c >> 5)) * 512 + ((kk & 7) * 32 + (c & 31)) * 2; }
__device__ __forceinline__ int v_rd_base(int lane) { return ((lane & 3) << 3) | (((lane >> 2) & 3) << 6) | (((lane >> 4) & 1) << 5) | (((lane >> 5) & 1) << 8); }
constexpr int v_rd_off(int d0, int ks, int half) { return d0 * 512 + ks * 4096 + half * 2048; }
__device__ __forceinline__ int crow(int r, int hi) { return (r & 3) + 8 * (r >> 2) + 4 * hi; }
typedef float f32x2a __attribute__((ext_vector_type(2))); typedef __bf16 bf16x2a __attribute__((ext_vector_type(2)));
__device__ __forceinline__ unsigned cvtpk(float lo, float hi) { const f32x2a v = {lo, hi}; return __builtin_bit_cast(unsigned, __builtin_convertvector(v, bf16x2a)); }
__device__ __forceinline__ bf16x8 pack8(f32x4 a, f32x4 b) {
    u32x4 w = {cvtpk(a[0], a[1]), cvtpk(a[2], a[3]), cvtpk(b[0], b[1]), cvtpk(b[2], b[3])};
    return *reinterpret_cast<bf16x8*>(&w);
}
template <class T> __device__ __forceinline__ bf16x8 load8(const T* p) {
    if constexpr (same_t<T, float>::v) { return pack8(*(const f32x4*)p, *(const f32x4*)(p + 4)); }
    else { return *reinterpret_cast<const bf16x8*>(p); }
}
__device__ __forceinline__ void mask_tile(f32x16& p0, f32x16& p1, int dq, unsigned W) {
    const float NEG = -__builtin_inff();
#pragma unroll
    for (int r = 0; r < 16; ++r) {
        const int c = (r & 3) + 8 * (r >> 2);
        if ((unsigned)(dq - c) >= W) p0[r] = NEG;
        if ((unsigned)(dq - c - 32) >= W) p1[r] = NEG;
    }
}
__device__ __forceinline__ void partialSM(f32x16& p0, f32x16& p1, float& m_reg, float& mn, float& alpha) {
    float pmax = p0[0]; for (int r = 1; r < 16; ++r) pmax = fmaxf(pmax, p0[r]); for (int r = 0; r < 16; ++r) pmax = fmaxf(pmax, p1[r]);
    { auto rr = __builtin_amdgcn_permlane32_swap(__float_as_uint(pmax), __float_as_uint(pmax), false, false);
      pmax = fmaxf(__uint_as_float(rr[0]), __uint_as_float(rr[1])); }
    constexpr float C2 = 1.4426950408889634f * SCALE;
    if (__builtin_expect(__all((pmax - m_reg) * SCALE <= THR), 1)) { mn = m_reg; alpha = 1.f; }
    else { mn = fmaxf(m_reg, pmax); alpha = __builtin_amdgcn_exp2f((m_reg - mn) * C2); m_reg = mn; }
    const float mnL = -mn * C2;
    for (int r = 0; r < 16; ++r) p0[r] = fmaf(p0[r], C2, mnL); for (int r = 0; r < 16; ++r) p1[r] = fmaf(p1[r], C2, mnL);
    for (int r = 0; r < 16; ++r) p0[r] = __builtin_amdgcn_exp2f(p0[r]);
}
__device__ __forceinline__ void finishSM(f32x16& p0, f32x16& p1, float alpha, float& l_reg, bf16x8& pa0, bf16x8& pa1, bf16x8& pa2, bf16x8& pa3) {
    for (int r = 0; r < 16; ++r) p1[r] = __builtin_amdgcn_exp2f(p1[r]);
    float ps = 0; for (int r = 0; r < 16; ++r) ps += p0[r]; for (int r = 0; r < 16; ++r) ps += p1[r];
    { auto rr = __builtin_amdgcn_permlane32_swap(__float_as_uint(ps), __float_as_uint(ps), false, false);
      ps = __uint_as_float(rr[0]) + __uint_as_float(rr[1]); }
    l_reg = l_reg * alpha + ps;
#define PK4(P, B_, OUT) do { unsigned a0 = cvtpk(P[B_+0], P[B_+1]), a1 = cvtpk(P[B_+2], P[B_+3]);                          \
        unsigned b0 = cvtpk(P[B_+4], P[B_+5]), b1 = cvtpk(P[B_+6], P[B_+7]);                                             \
        auto r0 = __builtin_amdgcn_permlane32_swap(a0, b0, false, false); auto r1 = __builtin_amdgcn_permlane32_swap(a1, b1, false, false); \
        u32x4 w = {r0[0], r1[0], r0[1], r1[1]}; OUT = *reinterpret_cast<bf16x8*>(&w); } while (0)
    PK4(p0, 0, pa0); PK4(p0, 8, pa1); PK4(p1, 0, pa2); PK4(p1, 8, pa3);
#undef PK4
}
template <int KB, bool SK>
__device__ __forceinline__ void qkt(f32x16& p0, f32x16& p1, const char* K_lds, int r32, int hi, const bf16x8* qr, bool act) {
    if (SK && !act) { const float NEG = -__builtin_inff();
#pragma unroll
        for (int r = 0; r < 16; ++r) { p0[r] = NEG; p1[r] = NEG; } return; }
    p0 = f32x16{}; p1 = f32x16{};
    const char* kb[4];
#pragma unroll
    for (int dd = 0; dd < 4; ++dd) kb[dd] = K_lds + KB * SHM_K + KSWZ(r32, (dd * 16 + hi * 8) * 2);
#pragma unroll
    for (int d0 = 0; d0 < 8; ++d0) { const char* a = kb[d0 & 3] + (d0 >> 2) * 128;
        bf16x8 b0 = *reinterpret_cast<const bf16x8*>(a);
        bf16x8 b1 = *reinterpret_cast<const bf16x8*>(a + 32 * 256);
        p0 = __builtin_amdgcn_mfma_f32_32x32x16_bf16(b0, qr[d0], p0, 0, 0, 0);
        p1 = __builtin_amdgcn_mfma_f32_32x32x16_bf16(b1, qr[d0], p1, 0, 0, 0); }
}
template <int VB, bool SK>
__device__ __forceinline__ void pv_tile(f32x16* o, int vb0, bf16x8 pa0, bf16x8 pa1, bf16x8 pa2, bf16x8 pa3, bool act) {
    if (SK && !act) return;
#define TRRD(dst, off) asm volatile("ds_read_b64_tr_b16 %0, %1 offset:%2" : "=&v"(dst) : "v"(vb0), "i"(off) : "memory")
#define PV_D0(d0) do { s16x4 l0, l1, l2, l3, h0, h1, h2, h3; constexpr int b_ = VB * SHM_V + v_rd_off(d0, 0, 0);     \
        TRRD(l0, b_); TRRD(h0, b_ + 2048); TRRD(l1, b_ + 4096); TRRD(h1, b_ + 6144); TRRD(l2, b_ + 8192); TRRD(h2, b_ + 10240); TRRD(l3, b_ + 12288); TRRD(h3, b_ + 14336); \
        asm volatile("s_waitcnt lgkmcnt(0)" ::: "memory"); SBAR();                 \
        o[d0] = __builtin_amdgcn_mfma_f32_32x32x16_bf16(pa0, (bf16x8){l0[0], l0[1], l0[2], l0[3], h0[0], h0[1], h0[2], h0[3]}, o[d0], 0, 0, 0);   \
        o[d0] = __builtin_amdgcn_mfma_f32_32x32x16_bf16(pa1, (bf16x8){l1[0], l1[1], l1[2], l1[3], h1[0], h1[1], h1[2], h1[3]}, o[d0], 0, 0, 0);   \
        o[d0] = __builtin_amdgcn_mfma_f32_32x32x16_bf16(pa2, (bf16x8){l2[0], l2[1], l2[2], l2[3], h2[0], h2[1], h2[2], h2[3]}, o[d0], 0, 0, 0);   \
        o[d0] = __builtin_amdgcn_mfma_f32_32x32x16_bf16(pa3, (bf16x8){l3[0], l3[1], l3[2], l3[3], h3[0], h3[1], h3[2], h3[3]}, o[d0], 0, 0, 0); } while (0)
    PV_D0(0); PV_D0(1); PV_D0(2); PV_D0(3);
#undef PV_D0
#undef TRRD
}

template <class TIn, class TOut> struct BlockRef { const TIn* Q; const TIn* K; const TIn* V; TOut* O; int P0; };
template <class TIn> struct Seam {
    bf16x8 qr[8];
    bf16x8 st_v0, st_v1, st_k0, st_k1; f32x4 sf0, sf1, sf2, sf3;
    f32x4 tq[16];
};
__device__ __forceinline__ int swa_jlo(int P0, int W) { const int lowk = P0 - W + 1; return lowk > 0 ? lowk / KVBLK : 0; }
#define ROW(p, k0, rr) ((p) + (size_t)((k0) + (rr)) * D + sc)
#define VMW() asm volatile("s_waitcnt vmcnt(0)" ::: "memory")
#define VMWN(n) asm volatile("s_waitcnt vmcnt(%0)" :: "i"(n) : "memory")
#define SLOAD_H(Kp, Vp, k0) do { S.st_v0 = load8<TIn>(ROW(Vp, k0, sr)); S.st_v1 = load8<TIn>(ROW(Vp, k0, 32 + sr));              \
                         S.st_k0 = load8<TIn>(ROW(Kp, k0, sr)); S.st_k1 = load8<TIn>(ROW(Kp, k0, 32 + sr)); } while (0)
#define SWRITE_HK(bf) do { *(bf16x8*)(K_lds + (bf) * SHM_K + kws) = S.st_k0; *(bf16x8*)(K_lds + (bf) * SHM_K + kws + 32 * 256) = S.st_k1; } while (0)
#define SWRITE_HV(bf) do { *(bf16x8*)(V_lds + (bf) * SHM_V + vst0) = S.st_v0; *(bf16x8*)(V_lds + (bf) * SHM_V + vst1) = S.st_v1; } while (0)
#define SWRITE_H(bf) do { SWRITE_HV(bf); SWRITE_HK(bf); } while (0)
#define SLOAD_F(p, k0) do { S.sf0 = *(const f32x4*)ROW(p, k0, sr); S.sf1 = *(const f32x4*)(ROW(p, k0, sr) + 4);                \
                            S.sf2 = *(const f32x4*)ROW(p, k0, 32 + sr); S.sf3 = *(const f32x4*)(ROW(p, k0, 32 + sr) + 4); } while (0)
#define SWRITE_KF(bf) do { *(bf16x8*)(K_lds + (bf) * SHM_K + kws) = pack8(S.sf0, S.sf1); *(bf16x8*)(K_lds + (bf) * SHM_K + kws + 32 * 256) = pack8(S.sf2, S.sf3); } while (0)
#define SWRITE_VF(bf) do { *(bf16x8*)(V_lds + (bf) * SHM_V + vst0) = pack8(S.sf0, S.sf1); *(bf16x8*)(V_lds + (bf) * SHM_V + vst1) = pack8(S.sf2, S.sf3); } while (0)
template <class TIn, class TOut>
__device__ __forceinline__ void causal_swa_prime(const BlockRef<TIn, TOut>& cur, int W, char* lds, Seam<TIn>& S) {
    constexpr bool F32 = same_t<TIn, float>::v;
    int tid_l_ = threadIdx.x; asm volatile("" : "+v"(tid_l_)); const int tid = tid_l_, wid = __builtin_amdgcn_readfirstlane(tid >> 6), lane = tid & 63, r32 = lane & 31, hi = lane >> 5;
    const int sr = tid >> 4, sc = (tid & 15) * 8, kws = KSWZ(sr, sc * 2); char* K_lds = lds + 2 * SHM_V;
    const int kb0 = swa_jlo(cur.P0, W) * KVBLK;
    for (int d0 = 0; d0 < 8; ++d0) S.qr[d0] = load8<TIn>(cur.Q + (size_t)(wid * QBLK + r32) * D + d0 * 16 + hi * 8);
    if constexpr (F32) { SLOAD_F((const float*)cur.K, kb0); VMW(); SWRITE_KF(0); SBAR(); SLOAD_F((const float*)cur.V, kb0); }
    else { SLOAD_H(cur.K, cur.V, kb0); VMW(); SWRITE_HK(0); }
    __syncthreads();
}
template <class TIn, class TOut>
__device__ __forceinline__ void causal_swa_block(const BlockRef<TIn, TOut>& cur, const BlockRef<TIn, TOut>& nxt, int skv, int W, char* lds, Seam<TIn>& S) {
    constexpr bool F32 = same_t<TIn, float>::v;
    int tid_l_ = threadIdx.x; asm volatile("" : "+v"(tid_l_)); const int tid = tid_l_, wid = __builtin_amdgcn_readfirstlane(tid >> 6), lane = tid & 63, r32 = lane & 31, hi = lane >> 5;
    const int j_lo = swa_jlo(cur.P0, W);
    int j_hi = (cur.P0 + QB - 1) / KVBLK + 1; if (j_hi > skv / KVBLK) j_hi = skv / KVBLK;
    const int NT = j_hi - j_lo;
    const int kbn = swa_jlo(nxt.P0, W) * KVBLK;
    const int qlo = cur.P0 + wid * QBLK, qm = qlo + r32 - 4 * hi;
    char* V_lds = lds; char* K_lds = lds + 2 * SHM_V;
    float* ws = (float*)(lds + 2 * SHM_V + 2 * SHM_K) + wid * 64; float* li_l = ws, * al_l = ws + 32;
    float m_reg = -1e30f, l_reg = 0; f32x16 o[4] = {};
    const int sr = tid >> 4, sc = (tid & 15) * 8, vst0 = v_st(sr, sc), vst1 = v_st(32 + sr, sc), kws = KSWZ(sr, sc * 2);
    const int vb0 = (int)(uintptr_t)V_lds + v_rd_base(lane);
    const TIn* Kh = cur.K; const TIn* Vh = cur.V;
#define RESC(a) do { if (__any((a) < 1.f)) { if (hi == 0) al_l[r32] = (a); asm volatile("s_waitcnt lgkmcnt(0)" ::: "memory");              \
                     for (int d_ = 0; d_ < 4; ++d_) for (int r = 0; r < 16; ++r) o[d_][r] *= al_l[crow(r, hi)]; } } while (0)
#define KBASE(t) ((j_lo + (t)) * KVBLK)
#define ACT(t) (KBASE(t) <= qlo + QBLK - 1 && KBASE(t) + KVBLK - 1 >= qlo - W + 1)
#define MASKT(P0_, P1_, t) do { const int kb_ = KBASE(t); if ((!SK || ACT(t)) && (kb_ + KVBLK - 1 > qlo || kb_ <= qlo + QBLK - 1 - W)) mask_tile(P0_, P1_, qm - kb_, (unsigned)W); } while (0)
    constexpr int NQL = F32 ? 16 : 8;
    constexpr bool SK = WSKIP && !F32;
#define SEAM_K0() do { VMWN(NQL); if constexpr (F32) { SWRITE_KF(0); SBAR(); SLOAD_F((const float*)nxt.V, kbn); } else { SWRITE_HK(0); } SBAR(); } while (0)
    f32x16 pA0, pA1, pB0, pB1; float mnA, mnB, alA, alB; bf16x8 pa0, pa1, pa2, pa3;
    if constexpr (F32) { VMW(); SWRITE_VF(0); SBAR(); } else { SWRITE_HV(0); SBAR(); }
    if (NT > 1) { if constexpr (F32) SLOAD_F((const float*)Kh, KBASE(1)); else SLOAD_H(Kh, Vh, KBASE(1)); }
    SBAR(); qkt<0, SK>(pA0, pA1, K_lds, r32, hi, S.qr, ACT(0));
    if constexpr (F32) { if (NT > 1) { VMW(); SWRITE_KF(1); SBAR(); SLOAD_F((const float*)Vh, KBASE(1)); } }
    MASKT(pA0, pA1, 0); partialSM(pA0, pA1, m_reg, mnA, alA);
    if (NT > 1) { VMW(); if constexpr (F32) { SWRITE_VF(1); SBAR(); if (NT > 2) SLOAD_F((const float*)Kh, KBASE(2)); } else SWRITE_H(1); }
    __syncthreads();
#define HALF_STEP(PX0, PX1, mnX, alX, PY0, PY1, alY, t, KB, VB, SB) do {                                                      \
        SBAR(); qkt<KB, SK>(PX0, PX1, K_lds, r32, hi, S.qr, ACT(t));                                             \
        finishSM(PY0, PY1, alY, l_reg, pa0, pa1, pa2, pa3); SBAR();                                                           \
        if ((t) + 1 < NT) { if constexpr (F32) { VMW(); SWRITE_KF(SB); SBAR(); SLOAD_F((const float*)Vh, KBASE((t) + 1)); }  \
                            else { SLOAD_H(Kh, Vh, KBASE((t) + 1)); } SBAR(); }                                               \
        pv_tile<VB, SK>(o, vb0, pa0, pa1, pa2, pa3, ACT((t) - 1)); MASKT(PX0, PX1, (t)); partialSM(PX0, PX1, m_reg, mnX, alX);                                        \
        __syncthreads();                                                                                                      \
        if ((t) + 1 < NT) { VMW(); if constexpr (F32) { SWRITE_VF(SB); SBAR(); if ((t) + 2 < NT) SLOAD_F((const float*)Kh, KBASE((t) + 2)); } \
                            else { SWRITE_H(SB); } }                                                                          \
        RESC(alX); __syncthreads(); } while (0)
    for (int t = 1; t + 1 < NT; t += 2) {
        HALF_STEP(pB0, pB1, mnB, alB, pA0, pA1, alA, t, 1, 0, 0);
        HALF_STEP(pA0, pA1, mnA, alA, pB0, pB1, alB, t + 1, 0, 1, 1);
    }
    const bool even = (NT & 1) == 0;
    if (even) { SBAR(); qkt<1, SK>(pB0, pB1, K_lds, r32, hi, S.qr, ACT(NT - 1)); SBAR(); }
#define QROW(e) (nxt.Q + (size_t)(wid * QBLK + r32) * D + ((e) >> 1) * 16 + hi * 8 + ((e) & 1) * 4)
    if constexpr (F32) { SLOAD_F((const float*)nxt.K, kbn); SBAR();
#pragma unroll
        for (int e = 0; e < 8; ++e) S.tq[e] = *(const f32x4*)QROW(e); }
    else { SLOAD_H(nxt.K, nxt.V, kbn); SBAR();
#pragma unroll
        for (int d0 = 0; d0 < 8; ++d0) S.qr[d0] = load8<TIn>(nxt.Q + (size_t)(wid * QBLK + r32) * D + d0 * 16 + hi * 8); }
    SBAR();
    finishSM(pA0, pA1, alA, l_reg, pa0, pa1, pa2, pa3); SBAR();
    if constexpr (F32) {
#pragma unroll
        for (int e = 8; e < 16; ++e) S.tq[e] = *(const f32x4*)QROW(e); SBAR(); }
#undef QROW
    pv_tile<0, SK>(o, vb0, pa0, pa1, pa2, pa3, ACT(even ? NT - 2 : NT - 1));
    if (even) { MASKT(pB0, pB1, NT - 1); partialSM(pB0, pB1, m_reg, mnB, alB); __syncthreads(); RESC(alB);
        finishSM(pB0, pB1, alB, l_reg, pa0, pa1, pa2, pa3); SBAR(); pv_tile<1, SK>(o, vb0, pa0, pa1, pa2, pa3, ACT(NT - 1)); }
    SBAR(); SEAM_K0();
    if (hi == 0) li_l[r32] = l_reg; asm volatile("s_waitcnt lgkmcnt(0)" ::: "memory");
    float rli[16];
#pragma unroll
    for (int r = 0; r < 16; ++r) rli[r] = __builtin_amdgcn_rcpf(li_l[crow(r, hi)]);
    TOut* Ow = cur.O + (size_t)(wid * QBLK) * D;
#pragma unroll
    for (int r = 0; r < 16; ++r) { const int orow = crow(r, hi);
#pragma unroll
        for (int d0 = 0; d0 < 4; ++d0) { const float v = o[d0][r] * rli[r];
            if constexpr (same_t<TOut, float>::v) { Ow[(size_t)orow * D + d0 * 32 + r32] = v; }
            else { const float vn = __shfl_xor(v, 1);
                   if ((r32 & 1) == 0) *(unsigned*)(Ow + (size_t)orow * D + d0 * 32 + r32) = cvtpk(v, vn); } } }
    if constexpr (F32) {
#pragma unroll
        for (int d0 = 0; d0 < 8; ++d0) S.qr[d0] = pack8(S.tq[2 * d0], S.tq[2 * d0 + 1]); }
    __syncthreads();
#undef RESC
#undef KBASE
#undef ACT
#undef MASKT
#undef SEAM_K0
#undef HALF_STEP
}
#undef ROW
#undef VMW
#undef VMWN
#undef SLOAD_H
#undef SWRITE_HK
#undef SWRITE_HV
#undef SWRITE_H
#undef SLOAD_F
#undef SWRITE_KF
#undef SWRITE_VF
}

namespace mk {
constexpr int NWAVES = 8, NTHR = 512;
constexpr int BATCH = 2, SEQ = 4096, M = BATCH * SEQ, DM = 4096;
constexpr int DI = 8192, NHEAD = 128, HDIM = 64, NGRP = 8, NST = 128, CONVD = 10240, NCHUNK = 32;
constexpr int NZX = 18560, NZXP = 18688, ZX_XBC = 8192, ZX_DT = 18432, NZXM = 18432;
constexpr int DFF = 11008, NUP = 22016;
constexpr int NQKV = 12288, AH = 16;
constexpr float EPS = 1e-5f;

constexpr size_t MiB = 1u << 20;
constexpr size_t WS_CTL = 0, CTL_ZERO_BYTES = 1 * MiB;
constexpr size_t WS_ROPE = 2 * MiB;
constexpr size_t WS_W = 8 * MiB;
constexpr size_t WL_MAMBA = 468 * MiB, WL_ATTN = 386 * MiB;
constexpr size_t W_IN = 0, W_OUT = 146 * MiB, W_UP_M = 210 * MiB, W_DOWN_M = 382 * MiB;
constexpr size_t W_QKV = 0, W_O = 96 * MiB, W_UP_A = 128 * MiB, W_DOWN_A = 300 * MiB;
constexpr size_t WS_XR = 1716 * MiB;
constexpr size_t WS_U = 1844 * MiB;
constexpr size_t WS_BIG = 1908 * MiB;
constexpr size_t WS_ACT2 = 2252 * MiB;
constexpr size_t WS_XT = 2424 * MiB;
constexpr size_t WS_Y = 2552 * MiB;
constexpr size_t WS_BN = 2680 * MiB, WS_BT = 2696 * MiB, WS_CN = 2712 * MiB, WS_DTF = 2728 * MiB;
constexpr size_t WS_PART = 2732 * MiB;
constexpr size_t WS_END = 2764 * MiB;
constexpr int CW_TMO = 0, CW_CODE = 1, CW_BAR = 4096;
constexpr int CW_SS = 65536;
static_assert((CW_SS + 9 * M * 2) * 4 <= (int)CTL_ZERO_BYTES, "norm statistics inside the memset region");

constexpr int RING_OFF = 0, RING_BYTES = 131072 + 16384;
constexpr int TAB_OFF = 131072, TAB_TILES = 16;
constexpr int LDSCTL_OFF = RING_BYTES, MISC_OFF = LDSCTL_OFF + 320;
constexpr int SIDE_OFF = RING_BYTES + 1024, LDS_BYTES = SIDE_OFF + 12288;
static_assert(MISC_OFF + 128 <= LDS_BYTES, "LDS map");

#define GAS __attribute__((address_space(1)))
#define LAS __attribute__((address_space(3)))
typedef unsigned short bf16;
typedef unsigned v4u __attribute__((ext_vector_type(4)));
typedef unsigned v2u __attribute__((ext_vector_type(2)));
typedef float f32x4 __attribute__((ext_vector_type(4)));
typedef float f32x2 __attribute__((ext_vector_type(2)));
typedef float f32x16 __attribute__((ext_vector_type(16)));
typedef short bf16x8 __attribute__((ext_vector_type(8)));
typedef GAS unsigned gu32;
#define RLX_AGENT __ATOMIC_RELAXED, __HIP_MEMORY_SCOPE_AGENT
#define LDS_WAIT() asm volatile("s_waitcnt lgkmcnt(0)" ::: "memory")
#define VM_WAIT() asm volatile("s_waitcnt vmcnt(0)" ::: "memory")
__device__ __forceinline__ unsigned f2bf(float f) { unsigned u = __builtin_bit_cast(unsigned, f); return (u + 0x7fffu + ((u >> 16) & 1u)) >> 16; }
typedef __bf16 bf16x2_t __attribute__((ext_vector_type(2)));
__device__ __forceinline__ unsigned pk2(float lo, float hi) { const f32x2 v = {lo, hi}; return __builtin_bit_cast(unsigned, __builtin_convertvector(v, bf16x2_t)); }
__device__ __forceinline__ float bf_lo(unsigned w) { return __builtin_bit_cast(float, w << 16); }
__device__ __forceinline__ float bf_hi(unsigned w) { return __builtin_bit_cast(float, w & 0xffff0000u); }
__device__ __forceinline__ float bf1(bf16 h) { return __builtin_bit_cast(float, (unsigned)h << 16); }
__device__ __forceinline__ float silu_f(float a) { return a * __builtin_amdgcn_rcpf(1.f + __expf(-a)); }

#define XB_TMO      128
#define XB_XCNT(j)  (256  + 64 * (j))
#define XB_XSUB(j)  (1280 + 64 * (j))
#define XB_XGEN(j)  (2304 + 64 * (j))
#define XB_TOP      3328
#define XB_TOPGEN   3392
#define XCD_BAR_WORDS 3456
#define XB_SPIN_CAP (1u << 18)
__device__ __forceinline__ unsigned xb_ld(unsigned* p)              { return __hip_atomic_load(p, __ATOMIC_RELAXED, __HIP_MEMORY_SCOPE_AGENT); }
__device__ __forceinline__ unsigned xb_add(unsigned* p, unsigned v) { return __hip_atomic_fetch_add(p, v, __ATOMIC_RELAXED, __HIP_MEMORY_SCOPE_AGENT); }
__device__ __forceinline__ unsigned xb_xcc_id() { return (unsigned)__builtin_amdgcn_s_getreg((3 << 11) | 20) & 0xFu; }
#define XB_SPIN(cond, bar) do { unsigned _sp = 0; while (cond) { __builtin_amdgcn_s_sleep(1); \
    if ((++_sp & 255u) == 0u) { if (xb_ld(&(bar)[XB_TMO])) break; if (_sp > XB_SPIN_CAP) { atomicAdd(&(bar)[XB_TMO], 1u); break; } } } } while (0)
struct XcdBarrier { unsigned* bar; unsigned x; volatile LAS unsigned* st; };
__device__ __forceinline__ XcdBarrier xcd_barrier_post(unsigned* bar, volatile LAS unsigned* st) {
    XcdBarrier b; b.bar = bar; b.x = xb_xcc_id(); b.st = st;
    if (threadIdx.x == 0) (void)xb_add(&bar[XB_XCNT(b.x)], 1u);
    return b;
}
__device__ __forceinline__ void xcd_barrier_complete(unsigned* bar, unsigned x, unsigned& nloc, unsigned& nx) {
    const unsigned G = gridDim.x * gridDim.y * gridDim.z;
    unsigned sum, cnt, mine, sp = 0u;
    for (;;) {
        sum = 0u; cnt = 0u; mine = 0u;
#pragma unroll
        for (unsigned j = 0; j < 16; ++j) { const unsigned c = xb_ld(&bar[XB_XCNT(j)]); sum += c; cnt += (c > 0u) ? 1u : 0u; mine = (j == x) ? c : mine; }
        if (sum == G) break;
        __builtin_amdgcn_s_sleep(1);
        if ((++sp & 255u) == 0u) { if (xb_ld(&bar[XB_TMO])) break; if (sp > XB_SPIN_CAP) { atomicAdd(&bar[XB_TMO], 1u); break; } }
    }
    nloc = mine > 0u ? mine : 1u; nx = cnt > 0u ? cnt : 1u;
}
__device__ __forceinline__ void xcd_barrier(const XcdBarrier& b) {
    asm volatile("s_waitcnt vmcnt(0)" ::: "memory");
    __syncthreads();
    if (threadIdx.x == 0) {
        unsigned long long bar_l_ = (unsigned long long)b.bar; asm volatile("" : "+s"(bar_l_));
        unsigned* bar = (unsigned*)bar_l_;
        __builtin_amdgcn_s_waitcnt(0);
        unsigned bx_l_ = b.x; asm volatile("" : "+s"(bx_l_));
        unsigned nloc = b.st[0], nx = b.st[1];
        if (nloc == 0u) { xcd_barrier_complete(bar, bx_l_, nloc, nx); b.st[0] = nloc; b.st[1] = nx; }
        const unsigned old = xb_add(&bar[XB_XSUB(bx_l_)], 1u);
        const unsigned gen = old / nloc;
        if (old + 1u == (gen + 1u) * nloc) {
            __builtin_amdgcn_fence(__ATOMIC_RELEASE, "agent");
            asm volatile("s_waitcnt vmcnt(0)" ::: "memory");
            const unsigned og = xb_add(&bar[XB_TOP], 1u);
            const unsigned tg = og / nx;
            if (og + 1u == (tg + 1u) * nx) xb_add(&bar[XB_TOPGEN], 1u);
            else XB_SPIN(xb_ld(&bar[XB_TOPGEN]) == tg, bar);
            __builtin_amdgcn_fence(__ATOMIC_ACQUIRE, "agent");
            xb_add(&bar[XB_XGEN(bx_l_)], 1u);
            asm volatile("s_waitcnt vmcnt(0)" ::: "memory");
        } else {
            XB_SPIN(xb_ld(&bar[XB_XGEN(bx_l_)]) == gen, bar);
            __builtin_amdgcn_fence(__ATOMIC_ACQUIRE, "agent");
            asm volatile("s_waitcnt vmcnt(0)" ::: "memory");
        }
    }
    __syncthreads();
}

struct Frame {
    LAS unsigned char* lds;
    unsigned char* ws;
    int tid, lane, wave;
    int vcu, G, bx;
};

__device__ __forceinline__ void relaunder(Frame& F, unsigned char* ws0) { int t = threadIdx.x; asm volatile("" : "+v"(t)); F.tid = t; F.lane = t & 63; F.wave = __builtin_amdgcn_readfirstlane(t >> 6);
    unsigned long long w = (unsigned long long)ws0; asm volatile("" : "+s"(w)); F.ws = (unsigned char*)w;
    int g = gridDim.x; asm volatile("" : "+s"(g)); F.G = g; int bx = blockIdx.x; asm volatile("" : "+s"(bx)); F.bx = bx; F.vcu = (g % 8 == 0) ? (bx % 8) * (g / 8) + bx / 8 : bx; }
__device__ __forceinline__ float wave_sum(float v) {
    int l = threadIdx.x; asm volatile("" : "+v"(l)); l &= 63;
#pragma unroll
    for (int o = 1; o < 64; o <<= 1) v += __builtin_bit_cast(float, __builtin_amdgcn_ds_bpermute((l ^ o) << 2, __builtin_bit_cast(int, v)));
    return v;
}

__device__ __forceinline__ void p0_matrix(Frame& F, const float* W, int K, int N, int NP, bf16* WT, int& prefix, int perm_limit = 0, const float* gain = nullptr, int gv_tiles = 0) {
    const int nnt = NP / 256, nkt = K / 128, ntiles = nkt * nnt, G = F.G, w = F.wave, lane = F.lane;
    int t = (F.vcu - prefix) % G; if (t < 0) t += G;
    prefix = (prefix + ntiles) % G;
    LAS unsigned char* L = F.lds;
    f32x4 v[16];
#define P0_TILE(tt, kt_, nt_) const int blk_ = (tt) / (16 * nnt), rem_ = (tt) - blk_ * 16 * nnt, bh_ = (nkt - 16 * blk_) < 16 ? (nkt - 16 * blk_) : 16, nt_ = rem_ / bh_, kt_ = 16 * blk_ + (rem_ - nt_ * bh_)
#define P0_LOAD(tt) do { P0_TILE(tt, kt_, nt_); const int n_ = nt_ * 256 + 4 * lane; \
        const GAS float* s_ = (const GAS float*)W + (size_t)(kt_ * 128 + 16 * w) * N + n_; \
        if (n_ < N) { _Pragma("unroll") for (int jj = 0; jj < 16; ++jj) v[jj] = *(const GAS f32x4*)(s_ + (size_t)jj * N); \
            if (gain) { _Pragma("unroll") for (int jj = 0; jj < 16; ++jj) v[jj] = v[jj] * gain[kt_ * 128 + 16 * w + jj]; } } \
        else { _Pragma("unroll") for (int jj = 0; jj < 16; ++jj) v[jj] = (f32x4){0.f, 0.f, 0.f, 0.f}; } } while (0)
    if (t < ntiles) P0_LOAD(t);
    while (t < ntiles) {
#pragma unroll
        for (int i = 0; i < 4; ++i)
#pragma unroll
            for (int h = 0; h < 2; ++h) {
                v4u o; o.x = pk2(v[8 * h + 0][i], v[8 * h + 1][i]); o.y = pk2(v[8 * h + 2][i], v[8 * h + 3][i]); o.z = pk2(v[8 * h + 4][i], v[8 * h + 5][i]); o.w = pk2(v[8 * h + 6][i], v[8 * h + 7][i]);
                *(LAS v4u*)(L + (4 * lane + i) * 256 + (((2 * w + h) ^ (lane & 15)) << 4)) = o;
            }
        P0_TILE(t, kt, nt); const int tn = t + G;
        if (tn < ntiles) P0_LOAD(tn);
        __syncthreads();
        const int nb = gv_tiles ? ((nt < gv_tiles ? 2 * nt : 2 * (nt - gv_tiles)) * 256 + (nt < gv_tiles ? 0 : 128)) : nt * 256;
        GAS bf16* dst = (GAS bf16*)WT + kt * 128 + 8 * (lane & 15);
        const bool perm = nt * 256 < perm_limit;
#pragma unroll
        for (int jj = 0; jj < 8; ++jj) { const int r = w * 32 + jj * 4 + (lane >> 4);
            const v4u o = *(LAS const v4u*)(L + r * 256 + (((lane & 15) ^ ((r >> 2) & 15)) << 4));
            const int d = r & 127, ro = perm ? ((r & 128) | (d < 64 ? 2 * d : 2 * (d - 64) + 1)) : r;
            const int rr = gv_tiles ? ((ro >> 7) * 256 + (ro & 127)) : ro;
            *(GAS v4u*)(dst + (size_t)(nb + rr) * K) = o; }
        __syncthreads();
        t = tn;
    }
#undef P0_LOAD
#undef P0_TILE
}

__device__ __forceinline__ void rms_row_bf16(const float* xrow, const float* w, bf16* orow, int lane) {
    const GAS f32x4* xr = (const GAS f32x4*)xrow + lane; const GAS f32x4* wr = (const GAS f32x4*)w + lane;
    f32x4 v[16]; float s = 0.f;
#pragma unroll
    for (int j = 0; j < 16; ++j) { v[j] = xr[64 * j]; s += (v[j].x * v[j].x + v[j].y * v[j].y) + (v[j].z * v[j].z + v[j].w * v[j].w); }
    const float rstd = 1.0f / sqrtf(wave_sum(s) * (1.f / DM) + EPS);
    GAS v2u* o8 = (GAS v2u*)orow + lane;
#pragma unroll
    for (int j = 0; j < 16; ++j) { const f32x4 g = wr[64 * j]; v2u o; o.x = pk2(v[j].x * rstd * g.x, v[j].y * rstd * g.y); o.y = pk2(v[j].z * rstd * g.z, v[j].w * rstd * g.w); o8[64 * j] = o; }
}
__device__ __forceinline__ void rms_row_f32(const float* xrow, const float* w, float* orow, int lane) {
    const GAS f32x4* xr = (const GAS f32x4*)xrow + lane; const GAS f32x4* wr = (const GAS f32x4*)w + lane;
    f32x4 v[16]; float s = 0.f;
#pragma unroll
    for (int j = 0; j < 16; ++j) { v[j] = xr[64 * j]; s += (v[j].x * v[j].x + v[j].y * v[j].y) + (v[j].z * v[j].z + v[j].w * v[j].w); }
    const float rstd = 1.0f / sqrtf(wave_sum(s) * (1.f / DM) + EPS);
    GAS f32x4* o = (GAS f32x4*)orow + lane;
#pragma unroll
    for (int j = 0; j < 16; ++j) { const f32x4 g = wr[64 * j]; o[64 * j] = v[j] * rstd * g; }
}
__device__ __forceinline__ void x_row_prep(const float* xrow, bf16* orow, unsigned long long* ssq, int lane) {
    const GAS f32x4* xr = (const GAS f32x4*)xrow + lane;
    f32x4 v[16]; float s = 0.f;
#pragma unroll
    for (int j = 0; j < 16; ++j) { v[j] = xr[64 * j]; s += (v[j].x * v[j].x + v[j].y * v[j].y) + (v[j].z * v[j].z + v[j].w * v[j].w); }
    s = wave_sum(s);
    GAS v2u* o8 = (GAS v2u*)orow + lane;
#pragma unroll
    for (int j = 0; j < 16; ++j) { v2u o; o.x = pk2(v[j].x, v[j].y); o.y = pk2(v[j].z, v[j].w); o8[64 * j] = o; }
    if (lane == 0) *ssq = (unsigned long long)__float2ll_rn(s * 16777216.0f);
}
__device__ __forceinline__ void rmsnorm_phase(Frame& F, const float* x, const float* w, bf16* U) {
    const int gw = F.vcu * NWAVES + F.wave, NGW = F.G * NWAVES;
    for (int m = gw; m < M; m += NGW) rms_row_bf16(x + (size_t)m * DM, w, U + (size_t)m * DM, F.lane);
}

template <class Sched>
__device__ __forceinline__ void rstd_table(Frame& F, const Sched& S, const unsigned long long* ss, int& pm0, int& ntab) {
    int lo = 1 << 30, hi = -1; pg8::Unit u;
    for (int i = 0; S.next(i, u); ++i) { lo = u.pm < lo ? u.pm : lo; hi = u.pm > hi ? u.pm : hi; }
    if (hi < 0) { pm0 = 0; ntab = 0; return; }
    pm0 = lo; ntab = (hi - lo + 1) < TAB_TILES ? (hi - lo + 1) : TAB_TILES;
    LAS float* tab = (LAS float*)(F.lds + TAB_OFF);
    for (int r = F.tid; r < ntab * 256; r += NTHR) tab[r] = 1.0f / sqrtf((float)ss[pm0 * 256 + r] * (1.0f / (4096.0f * 16777216.0f)) + 1e-5f);
    __syncthreads();
}

__device__ __forceinline__ void llc_touch(Frame& F, const void* p, size_t bytes) {
    const GAS v4u* q = (const GAS v4u*)p; const size_t n16 = bytes / 16, st = (size_t)F.G * NTHR; unsigned acc = 0u;
    for (size_t i = (size_t)F.vcu * NTHR + F.tid; i + 3 * st < n16; i += 4 * st) { const v4u a = q[i], b = q[i + st], c = q[i + 2 * st], d = q[i + 3 * st]; acc += (a.x ^ b.y) + (c.z ^ d.w); }
    if (acc == 0x12345677u) ((unsigned*)(F.ws + WS_CTL))[300] = acc;
}
__device__ __forceinline__ void unpack8(const v4u w, float (&o)[8]) { o[0] = bf_lo(w.x); o[1] = bf_hi(w.x); o[2] = bf_lo(w.y); o[3] = bf_hi(w.y); o[4] = bf_lo(w.z); o[5] = bf_hi(w.z); o[6] = bf_lo(w.w); o[7] = bf_hi(w.w); }
__device__ __forceinline__ void ffn_gate_phase(Frame& F, const bf16* H, const float* cw, const float* cb, bf16* GA) {
    constexpr int R = 32, NCHK = DFF / 8, NRB = M / R;
    const int total = NCHK * NRB;
    for (int it = F.vcu * NTHR + F.tid; it < total; it += F.G * NTHR) {
        const int ch = it % NCHK, rb = it / NCHK, c0 = ch * 8, t0 = rb * R;
        float wg[3][8], wv[3][8], bg[8], bv[8];
#pragma unroll
        for (int k = 0; k < 3; ++k) {
            const f32x4 a0 = *(const GAS f32x4*)(cw + (size_t)k * NUP + c0), a1 = *(const GAS f32x4*)(cw + (size_t)k * NUP + c0 + 4);
            const f32x4 b0 = *(const GAS f32x4*)(cw + (size_t)k * NUP + DFF + c0), b1 = *(const GAS f32x4*)(cw + (size_t)k * NUP + DFF + c0 + 4);
#pragma unroll
            for (int j = 0; j < 4; ++j) { wg[k][j] = a0[j]; wg[k][4 + j] = a1[j]; wv[k][j] = b0[j]; wv[k][4 + j] = b1[j]; }
        }
        { const f32x4 a0 = *(const GAS f32x4*)(cb + c0), a1 = *(const GAS f32x4*)(cb + c0 + 4), b0 = *(const GAS f32x4*)(cb + DFF + c0), b1 = *(const GAS f32x4*)(cb + DFF + c0 + 4);
#pragma unroll
          for (int j = 0; j < 4; ++j) { bg[j] = a0[j]; bg[4 + j] = a1[j]; bv[j] = b0[j]; bv[4 + j] = b1[j]; } }
        float g2[8], g1[8], v2[8], v1[8];
        if ((t0 & (SEQ - 1)) == 0) {
#pragma unroll
            for (int j = 0; j < 8; ++j) { g2[j] = 0.f; g1[j] = 0.f; v2[j] = 0.f; v1[j] = 0.f; }
        } else {
            const GAS bf16* r2 = (const GAS bf16*)H + (size_t)(t0 - 2) * NUP + c0; const GAS bf16* r1 = r2 + NUP;
            unpack8(*(const GAS v4u*)r2, g2); unpack8(*(const GAS v4u*)(r2 + DFF), v2); unpack8(*(const GAS v4u*)r1, g1); unpack8(*(const GAS v4u*)(r1 + DFF), v1);
        }
        const GAS bf16* hp = (const GAS bf16*)H + (size_t)t0 * NUP + c0; GAS bf16* op = (GAS bf16*)GA + (size_t)t0 * DFF + c0;
#pragma unroll 8
        for (int r = 0; r < R; ++r) {
            float g0[8], v0[8], o[8];
            unpack8(*(const GAS v4u*)(hp + (size_t)r * NUP), g0); unpack8(*(const GAS v4u*)(hp + (size_t)r * NUP + DFF), v0);
#pragma unroll
            for (int j = 0; j < 8; ++j) {
                const float a = bg[j] + wg[0][j] * g2[j] + wg[1][j] * g1[j] + wg[2][j] * g0[j];
                const float b = bv[j] + wv[0][j] * v2[j] + wv[1][j] * v1[j] + wv[2][j] * v0[j];
                o[j] = silu_f(a) * b; g2[j] = g1[j]; g1[j] = g0[j]; v2[j] = v1[j]; v1[j] = v0[j];
            }
            v4u w; w.x = pk2(o[0], o[1]); w.y = pk2(o[2], o[3]); w.z = pk2(o[4], o[5]); w.w = pk2(o[6], o[7]);
            *(GAS v4u*)(op + (size_t)r * DFF) = w;
        }
    }
}

__device__ __forceinline__ void ffn_fix_phase(Frame& F, const bf16* HB, const float* cw, const float* cb, bf16* GA) {
    constexpr int NCHK = DFF / 8, NSPAN = M / 64;
    for (int it = F.vcu * NTHR + F.tid; it < NCHK * NSPAN; it += F.G * NTHR) {
        const int ch = it % NCHK, s = it / NCHK, c0 = ch * 8, t0 = s * 64;
        float wg[3][8], wv[3][8], bg[8], bv[8];
#pragma unroll
        for (int k = 0; k < 3; ++k) {
            const f32x4 a0 = *(const GAS f32x4*)(cw + (size_t)k * NUP + c0), a1 = *(const GAS f32x4*)(cw + (size_t)k * NUP + c0 + 4);
            const f32x4 b0 = *(const GAS f32x4*)(cw + (size_t)k * NUP + DFF + c0), b1 = *(const GAS f32x4*)(cw + (size_t)k * NUP + DFF + c0 + 4);
#pragma unroll
            for (int j = 0; j < 4; ++j) { wg[k][j] = a0[j]; wg[k][4 + j] = a1[j]; wv[k][j] = b0[j]; wv[k][4 + j] = b1[j]; }
        }
        { const f32x4 a0 = *(const GAS f32x4*)(cb + c0), a1 = *(const GAS f32x4*)(cb + c0 + 4), b0 = *(const GAS f32x4*)(cb + DFF + c0), b1 = *(const GAS f32x4*)(cb + DFF + c0 + 4);
#pragma unroll
          for (int j = 0; j < 4; ++j) { bg[j] = a0[j]; bg[4 + j] = a1[j]; bv[j] = b0[j]; bv[4 + j] = b1[j]; } }
        float g2[8], g1[8], v2[8], v1[8];
        if ((t0 & (SEQ - 1)) == 0) {
#pragma unroll
            for (int j = 0; j < 8; ++j) { g2[j] = 0.f; g1[j] = 0.f; v2[j] = 0.f; v1[j] = 0.f; }
        } else {
            const GAS bf16* pr = (const GAS bf16*)HB + (size_t)(((s - 1) * 4 + 2) * 2) * DFF + c0;
            unpack8(*(const GAS v4u*)pr, g2); unpack8(*(const GAS v4u*)(pr + DFF), v2); unpack8(*(const GAS v4u*)(pr + 2 * DFF), g1); unpack8(*(const GAS v4u*)(pr + 3 * DFF), v1);
        }
        const GAS bf16* cp = (const GAS bf16*)HB + (size_t)((s * 4) * 2) * DFF + c0; GAS bf16* op = (GAS bf16*)GA + (size_t)t0 * DFF + c0;
#pragma unroll
        for (int r = 0; r < 2; ++r) {
            float g0[8], v0[8], o[8];
            unpack8(*(const GAS v4u*)(cp + (size_t)(2 * r) * DFF), g0); unpack8(*(const GAS v4u*)(cp + (size_t)(2 * r + 1) * DFF), v0);
#pragma unroll
            for (int j = 0; j < 8; ++j) {
                const float a = bg[j] + wg[0][j] * g2[j] + wg[1][j] * g1[j] + wg[2][j] * g0[j];
                const float b = bv[j] + wv[0][j] * v2[j] + wv[1][j] * v1[j] + wv[2][j] * v0[j];
                o[j] = silu_f(a) * b; g2[j] = g1[j]; g1[j] = g0[j]; v2[j] = v1[j]; v1[j] = v0[j];
            }
            v4u w; w.x = pk2(o[0], o[1]); w.y = pk2(o[2], o[3]); w.z = pk2(o[4], o[5]); w.w = pk2(o[6], o[7]);
            *(GAS v4u*)(op + (size_t)r * DFF) = w;
        }
    }
}

__device__ __forceinline__ void ssd_prep_phase(Frame& F, const bf16* ZX, const float* cw, const float* cb, const float* dt_bias, bf16* XT, bf16* Bn, bf16* BT, bf16* Cn, float* DTF, const float* part, const unsigned long long* ssq) {
    const int gw = F.vcu * NWAVES + F.wave, NGW = F.G * NWAVES, lane = F.lane, c8 = lane & 7, rg = lane >> 3;
    for (int it = gw; it < 64 * 160; it += NGW) {
        const int cg = it % 160, bc = it / 160;
        const int ch0 = cg * 64 + 8 * c8, m0 = bc * 128;
        const GAS bf16* src = (const GAS bf16*)ZX + (size_t)(m0 + 16 * rg - 3) * NZXP + ZX_XBC + ch0;
        v4u raw[19];
        const bool hist = (rg != 0) || ((bc & 31) != 0);
#pragma unroll
        for (int jj = 0; jj < 19; ++jj) raw[jj] = (jj >= 3 || hist) ? *(const GAS v4u*)(src + (size_t)jj * NZXP) : (v4u){0u, 0u, 0u, 0u};
        float wt[4][8], bb[8];
#pragma unroll
        for (int k = 0; k < 4; ++k) { const f32x4 a = *(const GAS f32x4*)(cw + (size_t)k * CONVD + ch0), b = *(const GAS f32x4*)(cw + (size_t)k * CONVD + ch0 + 4);
#pragma unroll
            for (int e = 0; e < 4; ++e) { wt[k][e] = a[e]; wt[k][4 + e] = b[e]; } }
        { const f32x4 a = *(const GAS f32x4*)(cb + ch0), b = *(const GAS f32x4*)(cb + ch0 + 4);
#pragma unroll
          for (int e = 0; e < 4; ++e) { bb[e] = a[e]; bb[4 + e] = b[e]; } }
        GAS bf16* tdst = nullptr; GAS bf16* ndst = nullptr;
        if (cg < 128) { tdst = (GAS bf16*)XT + ((size_t)(bc * 128 + cg) * 64 + 8 * c8) * 128 + 16 * rg; }
        else if (cg < 144) { const int g = (cg - 128) >> 1, n0 = ((cg - 128) & 1) * 64 + 8 * c8; tdst = (GAS bf16*)BT + ((size_t)(bc * 8 + g) * 128 + n0) * 128 + 16 * rg; ndst = (GAS bf16*)Bn + ((size_t)(bc * 8 + g) * 128 + 16 * rg) * 128 + n0; }
        else { const int g = (cg - 144) >> 1, n0 = ((cg - 144) & 1) * 64 + 8 * c8; ndst = (GAS bf16*)Cn + ((size_t)(bc * 8 + g) * 128 + 16 * rg) * 128 + n0; }
#pragma unroll
        for (int hf = 0; hf < 2; ++hf) {
            unsigned nw[8][4];
#pragma unroll
            for (int ep = 0; ep < 4; ++ep) {
                float oa[8], ob[8];
                float a3 = bf_lo(raw[8 * hf][ep]), a2 = bf_lo(raw[8 * hf + 1][ep]), a1 = bf_lo(raw[8 * hf + 2][ep]), b3 = bf_hi(raw[8 * hf][ep]), b2 = bf_hi(raw[8 * hf + 1][ep]), b1 = bf_hi(raw[8 * hf + 2][ep]);
#pragma unroll
                for (int r = 0; r < 8; ++r) { const float a0 = bf_lo(raw[8 * hf + 3 + r][ep]), b0 = bf_hi(raw[8 * hf + 3 + r][ep]);
                    oa[r] = silu_f(bb[2 * ep] + wt[0][2 * ep] * a3 + wt[1][2 * ep] * a2 + wt[2][2 * ep] * a1 + wt[3][2 * ep] * a0);
                    ob[r] = silu_f(bb[2 * ep + 1] + wt[0][2 * ep + 1] * b3 + wt[1][2 * ep + 1] * b2 + wt[2][2 * ep + 1] * b1 + wt[3][2 * ep + 1] * b0);
                    a3 = a2; a2 = a1; a1 = a0; b3 = b2; b2 = b1; b1 = b0; }
                if (tdst) {
                    v4u t0; t0.x = pk2(oa[0], oa[1]); t0.y = pk2(oa[2], oa[3]); t0.z = pk2(oa[4], oa[5]); t0.w = pk2(oa[6], oa[7]);
                    *(GAS v4u*)(tdst + (size_t)(2 * ep) * 128 + 8 * hf) = t0;
                    t0.x = pk2(ob[0], ob[1]); t0.y = pk2(ob[2], ob[3]); t0.z = pk2(ob[4], ob[5]); t0.w = pk2(ob[6], ob[7]);
                    *(GAS v4u*)(tdst + (size_t)(2 * ep + 1) * 128 + 8 * hf) = t0;
                }
                if (ndst) {
#pragma unroll
                    for (int r = 0; r < 8; ++r) nw[r][ep] = pk2(oa[r], ob[r]);
                }
            }
            if (ndst) {
#pragma unroll
                for (int r = 0; r < 8; ++r) { v4u o; o.x = nw[r][0]; o.y = nw[r][1]; o.z = nw[r][2]; o.w = nw[r][3]; *(GAS v4u*)(ndst + (size_t)(8 * hf + r) * 128) = o; }
            }
        }
    }
    for (int i = F.vcu * NTHR + F.tid; i < M * NHEAD; i += F.G * NTHR) {
        const int h = i & 127, m = i >> 7;
        float raw;
        if (part) { float s = 0.f;
#pragma unroll
            for (int ks = 0; ks < 8; ++ks) s += ((const GAS float*)part)[((size_t)ks * M + m) * 128 + h];
            raw = s * (1.0f / sqrtf((float)ssq[m] * (1.0f / (4096.0f * 16777216.0f)) + 1e-5f)) + dt_bias[h]; }
        else raw = bf1(((const GAS bf16*)ZX)[(size_t)m * NZXP + ZX_DT + h]) + dt_bias[h];
        const float sp = raw > 20.f ? raw : log1pf(__expf(raw));
        ((GAS float*)DTF)[(size_t)((m >> 12) * NHEAD + h) * SEQ + (m & (SEQ - 1))] = sp;
    }
}

#define LDS_BAR() do { asm volatile("s_waitcnt lgkmcnt(0)" ::: "memory"); __builtin_amdgcn_s_barrier(); asm volatile("" ::: "memory"); } while (0)
__device__ __forceinline__ int swz(int r, int q) { return r * 256 + ((q ^ (r & 15)) << 4); }
__device__ __forceinline__ bf16x8 ldfrag(LAS const unsigned char* base, int row, int q) { return *(LAS const bf16x8*)(base + swz(row, q)); }
__device__ __forceinline__ void ssd_phase(Frame& F, const bf16* XT, const bf16* Bn, const bf16* BT, const bf16* Cn, const float* DTF, const float* a_log, const float* d_skip, bf16* Y, const bf16* ZXz) {
    constexpr int SC = 0, SB = 32768, SBT = 65536, SXT = 98304, SS = 114688, SM = 131072;
    LAS unsigned char* L = F.lds;
    LAS float* dtv = (LAS float*)(L + SM); LAS float* acs = dtv + 128; LAS float* w2 = dtv + 256;
    const int tid = F.tid, wave = F.wave, lane = F.lane, c = lane & 31, hi = lane >> 5;
    const int lb = wave >> 1, pb = wave & 1, nb = wave >> 1, sb0 = 2 * (wave & 1);
    for (int id = F.vcu; id < BATCH * NHEAD; id += F.G) {
        const int b = id >> 7, h = id & 127, g = h >> 4;
        const float A = -__expf(a_log[h]), Dh = d_skip[h];
        for (int i = tid; i < 1024; i += NTHR) *(LAS v4u*)(L + SS + i * 16) = (v4u){0u, 0u, 0u, 0u};
        f32x16 sacc;
#pragma unroll
        for (int r = 0; r < 16; ++r) sacc[r] = 0.f;
        v4u stC[4], stB[4], stBT[4], stX[2]; f32x2 stdt;
#define SSD_LOAD(cc_) do { const int cidx_ = b * NCHUNK + (cc_); \
            const GAS v4u* pc_ = (const GAS v4u*)(Cn + (size_t)(cidx_ * 8 + g) * 16384); const GAS v4u* pb_ = (const GAS v4u*)(Bn + (size_t)(cidx_ * 8 + g) * 16384); \
            const GAS v4u* pt_ = (const GAS v4u*)(BT + (size_t)(cidx_ * 8 + g) * 16384); const GAS v4u* px_ = (const GAS v4u*)(XT + (size_t)(cidx_ * 128 + h) * 8192); \
            _Pragma("unroll") for (int j_ = 0; j_ < 4; ++j_) { stC[j_] = pc_[tid + 512 * j_]; stB[j_] = pb_[tid + 512 * j_]; stBT[j_] = pt_[tid + 512 * j_]; } \
            _Pragma("unroll") for (int j_ = 0; j_ < 2; ++j_) stX[j_] = px_[tid + 512 * j_]; \
            stdt = *(const GAS f32x2*)(DTF + (size_t)(b * NHEAD + h) * SEQ + (cc_) * 128 + 2 * lane); } while (0)
        SSD_LOAD(0);
        for (int cc = 0; cc < NCHUNK; ++cc) {
#pragma unroll
            for (int j = 0; j < 4; ++j) { const int i = tid + 512 * j, o = swz(i >> 4, i & 15); *(LAS v4u*)(L + SC + o) = stC[j]; *(LAS v4u*)(L + SB + o) = stB[j]; *(LAS v4u*)(L + SBT + o) = stBT[j]; }
#pragma unroll
            for (int j = 0; j < 2; ++j) { const int i = tid + 512 * j; *(LAS v4u*)(L + SXT + swz(i >> 4, i & 15)) = stX[j]; }
            if (wave == 0) {
                const float a0 = stdt.x * A, a1 = stdt.y * A; float p = a0 + a1;
#pragma unroll
                for (int o = 1; o < 64; o <<= 1) { const float t = __shfl_up(p, o); if (lane >= o) p += t; }
                const float tot = __shfl(p, 63);
                acs[2 * lane] = p - a1; acs[2 * lane + 1] = p; dtv[2 * lane] = stdt.x; dtv[2 * lane + 1] = stdt.y;
                w2[2 * lane] = stdt.x * __expf(tot - (p - a1)); w2[2 * lane + 1] = stdt.y * __expf(tot - p);
            }
            LDS_BAR();
            if (cc + 1 < NCHUNK) SSD_LOAD(cc + 1);
            bf16x8 cf[8];
#pragma unroll
            for (int ks = 0; ks < 8; ++ks) cf[ks] = ldfrag(L + SC, 32 * lb + c, 2 * ks + hi);
            f32x16 yacc;
#pragma unroll
            for (int r = 0; r < 16; ++r) yacc[r] = 0.f;
#pragma unroll
            for (int ks = 0; ks < 8; ++ks) yacc = __builtin_amdgcn_mfma_f32_32x32x16_bf16(ldfrag(L + SS, 32 * pb + c, 2 * ks + hi), cf[ks], yacc, 0, 0, 0);
            const float acl = acs[32 * lb + c]; const float el = __expf(acl);
#pragma unroll
            for (int r = 0; r < 16; ++r) yacc[r] *= el;
            f32x16 cb0, cb1;
#pragma unroll
            for (int r = 0; r < 16; ++r) { cb0[r] = 0.f; cb1[r] = 0.f; }
            if (sb0 <= lb) {
#pragma unroll
                for (int ks = 0; ks < 8; ++ks) cb0 = __builtin_amdgcn_mfma_f32_32x32x16_bf16(ldfrag(L + SB, 32 * sb0 + c, 2 * ks + hi), cf[ks], cb0, 0, 0, 0);
            }
            if (sb0 + 1 <= lb) {
#pragma unroll
                for (int ks = 0; ks < 8; ++ks) cb1 = __builtin_amdgcn_mfma_f32_32x32x16_bf16(ldfrag(L + SB, 32 * (sb0 + 1) + c, 2 * ks + hi), cf[ks], cb1, 0, 0, 0);
            }
            v2u zc[4];
            { const GAS bf16* pz = (const GAS bf16*)ZXz + (size_t)(b * SEQ + cc * 128 + 32 * lb + c) * NZXP + h * 64 + 32 * pb + 4 * hi;
#pragma unroll
              for (int q = 0; q < 4; ++q) zc[q] = *(const GAS v2u*)(pz + 8 * q); }
            const int lrow = 32 * lb + c;
#pragma unroll
            for (int q = 0; q < 4; ++q) {
                const int s0a = 32 * sb0 + 8 * q + 4 * hi, s0b = s0a + 32;
                const f32x4 aa = *(LAS const f32x4*)(acs + s0a), da = *(LAS const f32x4*)(dtv + s0a), ab = *(LAS const f32x4*)(acs + s0b), db = *(LAS const f32x4*)(dtv + s0b);
#pragma unroll
                for (int j = 0; j < 4; ++j) {
                    cb0[4 * q + j] = (s0a + j <= lrow) ? cb0[4 * q + j] * __expf(acl - aa[j]) * da[j] : 0.f;
                    cb1[4 * q + j] = (s0b + j <= lrow) ? cb1[4 * q + j] * __expf(acl - ab[j]) * db[j] : 0.f;
                }
            }
            LDS_BAR();
#pragma unroll
            for (int q = 0; q < 4; ++q) {
                v2u wa, wb; wa.x = pk2(cb0[4 * q], cb0[4 * q + 1]); wa.y = pk2(cb0[4 * q + 2], cb0[4 * q + 3]); wb.x = pk2(cb1[4 * q], cb1[4 * q + 1]); wb.y = pk2(cb1[4 * q + 2], cb1[4 * q + 3]);
                *(LAS v2u*)(L + SB + swz(lrow, 4 * sb0 + q) + 8 * hi) = wa; *(LAS v2u*)(L + SB + swz(lrow, 4 * (sb0 + 1) + q) + 8 * hi) = wb;
            }
            LDS_BAR();
            const int nks = 2 * (lb + 1);
            for (int ks = 0; ks < nks; ++ks) yacc = __builtin_amdgcn_mfma_f32_32x32x16_bf16(ldfrag(L + SXT, 32 * pb + c, 2 * ks + hi), ldfrag(L + SB, lrow, 2 * ks + hi), yacc, 0, 0, 0);
            {
                GAS bf16* yrow = (GAS bf16*)Y + (size_t)(b * SEQ + cc * 128 + lrow) * DI + h * 64 + 32 * pb + 4 * hi;
#pragma unroll
                for (int q = 0; q < 4; ++q) {
                    float yv[4];
#pragma unroll
                    for (int j = 0; j < 4; ++j) { const int p = 32 * pb + 8 * q + 4 * hi + j; const float xv = bf1(*(LAS const bf16*)(L + SXT + swz(p, lrow >> 3) + (lrow & 7) * 2)); const unsigned zw = j < 2 ? zc[q].x : zc[q].y; const float zf = (j & 1) ? bf_hi(zw) : bf_lo(zw); yv[j] = (yacc[4 * q + j] + Dh * xv) * silu_f(zf); }
                    v2u w; w.x = pk2(yv[0], yv[1]); w.y = pk2(yv[2], yv[3]); *(GAS v2u*)(yrow + 8 * q) = w;
                }
            }
            {
                const float etot = __expf(acs[127]);
#pragma unroll
                for (int r = 0; r < 16; ++r) sacc[r] *= etot;
#pragma unroll
                for (int ks = 0; ks < 8; ++ks) {
                    const bf16x8 xa = ldfrag(L + SXT, 32 * pb + c, 2 * ks + hi);
                    const f32x4 wA = *(LAS const f32x4*)(w2 + 16 * ks + 8 * hi), wB = *(LAS const f32x4*)(w2 + 16 * ks + 8 * hi + 4);
                    const v4u xu = __builtin_bit_cast(v4u, xa);
                    v4u xs; xs.x = pk2(bf_lo(xu.x) * wA[0], bf_hi(xu.x) * wA[1]); xs.y = pk2(bf_lo(xu.y) * wA[2], bf_hi(xu.y) * wA[3]);
                    xs.z = pk2(bf_lo(xu.z) * wB[0], bf_hi(xu.z) * wB[1]); xs.w = pk2(bf_lo(xu.w) * wB[2], bf_hi(xu.w) * wB[3]);
                    sacc = __builtin_amdgcn_mfma_f32_32x32x16_bf16(ldfrag(L + SBT, 32 * nb + c, 2 * ks + hi), __builtin_bit_cast(bf16x8, xs), sacc, 0, 0, 0);
                }
                const int prow = 32 * pb + c;
#pragma unroll
                for (int q = 0; q < 4; ++q) { v2u w; w.x = pk2(sacc[4 * q], sacc[4 * q + 1]); w.y = pk2(sacc[4 * q + 2], sacc[4 * q + 3]); *(LAS v2u*)(L + SS + swz(prow, 4 * nb + q) + 8 * hi) = w; }
            }
            LDS_BAR();
        }
#undef SSD_LOAD
    }
}

__device__ __forceinline__ void gated_norm_phase(Frame& F, const bf16* Y, const bf16* ZX, const float* nw, bf16* G) {
    const int gw = F.vcu * NWAVES + F.wave, NGW = F.G * NWAVES, lane = F.lane;
    constexpr int UN = 8;
    for (int it0 = gw; it0 < M * NGRP; it0 += UN * NGW) {
        v4u yr[UN][2];
#pragma unroll
        for (int u = 0; u < UN; ++u) { const int it = it0 + u * NGW, m = it >> 3, g = it & 7;
#pragma unroll
            for (int j = 0; j < 2; ++j) { const int col = g * 1024 + j * 512 + lane * 8;
                if (it < M * NGRP) { yr[u][j] = *(const GAS v4u*)((const GAS bf16*)Y + (size_t)m * DI + col); } } }
#pragma unroll
        for (int u = 0; u < UN; ++u) { const int it = it0 + u * NGW, m = it >> 3, g = it & 7;
            if (it >= M * NGRP) break;
            float gv[16]; float ss = 0.f;
#pragma unroll
            for (int j = 0; j < 2; ++j) { float yv[8]; unpack8(yr[u][j], yv);
#pragma unroll
                for (int e = 0; e < 8; ++e) { const float t = yv[e]; gv[8 * j + e] = t; ss += t * t; } }
            const float rstd = 1.0f / sqrtf(wave_sum(ss) * (1.f / 1024.f) + EPS);
#pragma unroll
            for (int j = 0; j < 2; ++j) {
                const int col = g * 1024 + j * 512 + lane * 8;
                const f32x4 wa = *(const GAS f32x4*)(nw + col), wb = *(const GAS f32x4*)(nw + col + 4);
                v4u o; o.x = pk2(gv[8 * j] * rstd * wa[0], gv[8 * j + 1] * rstd * wa[1]); o.y = pk2(gv[8 * j + 2] * rstd * wa[2], gv[8 * j + 3] * rstd * wa[3]);
                o.z = pk2(gv[8 * j + 4] * rstd * wb[0], gv[8 * j + 5] * rstd * wb[1]); o.w = pk2(gv[8 * j + 6] * rstd * wb[2], gv[8 * j + 7] * rstd * wb[3]);
                *(GAS v4u*)((GAS bf16*)G + (size_t)m * DI + col) = o;
            }
        }
    }
}

__device__ __forceinline__ void rope_table_phase(Frame& F, const int* positions, float* cs, float* sn) {
    for (int i = F.vcu * NTHR + F.tid; i < M * 64; i += F.G * NTHR) {
        const int d = i & 63, m = i >> 6;
        const float inv = 1.0f / powf(10000.0f, (float)(2 * d) * (1.0f / 128.0f));
        const float ang = (float)positions[m] * inv;
        const float k = rintf(ang * 0.15915494309189535f);
        float r = fmaf(-k, 6.28125f, ang); r = fmaf(-k, 1.9353071795864769e-3f, r);
        const float rev = r * 0.15915494309189535f;
        cs[i] = __builtin_amdgcn_cosf(rev); sn[i] = __builtin_amdgcn_sinf(rev);
    }
}
__device__ __forceinline__ void rope_phase(Frame& F, bf16* QKVH, const float* cs, const float* sn) {
    const int total = 64 * M * 8;
    for (int i = F.vcu * NTHR + F.tid; i < total; i += F.G * NTHR) {
        const int d8 = i & 7, m = (i >> 3) & (M - 1), cg = i >> 16;
        GAS bf16* row = (GAS bf16*)QKVH + ((size_t)cg * M + m) * 128 + d8 * 8;
        float a[8], b[8];
        unpack8(*(const GAS v4u*)row, a); unpack8(*(const GAS v4u*)(row + 64), b);
        const f32x4 c0 = *(const GAS f32x4*)(cs + (size_t)m * 64 + d8 * 8), c1 = *(const GAS f32x4*)(cs + (size_t)m * 64 + d8 * 8 + 4);
        const f32x4 s0 = *(const GAS f32x4*)(sn + (size_t)m * 64 + d8 * 8), s1 = *(const GAS f32x4*)(sn + (size_t)m * 64 + d8 * 8 + 4);
        float oa[8], ob[8];
#pragma unroll
        for (int j = 0; j < 8; ++j) { const float cc = j < 4 ? c0[j & 3] : c1[j & 3], ss = j < 4 ? s0[j & 3] : s1[j & 3]; oa[j] = a[j] * cc - b[j] * ss; ob[j] = b[j] * cc + a[j] * ss; }
        v4u wa, wb; wa.x = pk2(oa[0], oa[1]); wa.y = pk2(oa[2], oa[3]); wa.z = pk2(oa[4], oa[5]); wa.w = pk2(oa[6], oa[7]);
        wb.x = pk2(ob[0], ob[1]); wb.y = pk2(ob[2], ob[3]); wb.z = pk2(ob[4], ob[5]); wb.w = pk2(ob[6], ob[7]);
        *(GAS v4u*)row = wa; *(GAS v4u*)(row + 64) = wb;
    }
}
typedef att::BlockRef<att::bf16, float> AttRef;
__device__ __forceinline__ AttRef att_ref(const bf16* QKVH, float* OP, int L, int pass) {
    const int combo = L >> 3, x = L & 7;
    const int vh = combo & 1, c = (combo >> 1) & 1, h = (combo >> 2) & 15, b = combo >> 6;
    const int qb = pass ? 15 - x : x;
    const size_t GS = (size_t)M * 128;
    AttRef r;
    r.Q = QKVH + (size_t)(2 * h + c) * GS + (size_t)(b * SEQ + qb * 256) * 128;
    r.K = QKVH + (size_t)(32 + 2 * h + c) * GS + (size_t)(b * SEQ) * 128;
    r.V = QKVH + (size_t)(64 + 2 * h + vh) * GS + (size_t)(b * SEQ) * 128;
    r.O = OP + (size_t)((2 * h + c) * 2 + vh) * GS + (size_t)(b * SEQ + qb * 256) * 128;
    r.P0 = qb * 256;
    return r;
}
__device__ __forceinline__ void attn_phase(Frame& F, const bf16* QKVH, float* OP, char* lds) {
    constexpr int TOTAL = 1024;
    int L = F.vcu; if (L >= TOTAL) return;
    const int stride = F.G; int pass = 0;
    AttRef cur = att_ref(QKVH, OP, L, 0);
    att::Seam<att::bf16> S;
    att::causal_swa_prime<att::bf16, float>(cur, SEQ, lds, S);
    for (;;) {
        const bool more_pass = pass == 0, more_item = L + stride < TOTAL, last = !more_pass && !more_item;
        int passn = pass + 1, Ln = L;
        if (!more_pass) { passn = 0; Ln = more_item ? L + stride : L; }
        const AttRef nxt = last ? cur : att_ref(QKVH, OP, Ln, passn);
        att::causal_swa_block<att::bf16, float>(cur, nxt, SEQ, SEQ, lds, S);
        if (last) break;
        cur = nxt; pass = passn; L = Ln;
    }
}
namespace att2 {
using att::bf16x8; using att::s16x4; using att::f32x16; using att::f32x4;
constexpr int QROWS = 128, KT = 64, K_BYTES = 16384, V_BYTES = 32768;
constexpr int OFF_K = 0, OFF_V = 2 * K_BYTES, OFF_P = OFF_V + 2 * V_BYTES, OFF_AL = OFF_P + 2 * 4 * 4096, OFF_LL = OFF_AL + 2 * 4 * 32 * 4, LDS_NEED = OFF_LL + 4 * 32 * 4;
__device__ __forceinline__ int v_st2(int k, int c) { const int kk = (k & ~0xC) | ((k & 4) << 1) | ((k & 8) >> 1); return ((kk >> 3) * 8 + (c >> 5)) * 512 + ((kk & 7) * 32 + (c & 31)) * 2; }
struct Blk { const unsigned short* Q; const unsigned short* K; const unsigned short* V0; const unsigned short* V1; float* O; int P0; unsigned short* AO; const float* subln; float lam, post; };
typedef att::u32x4 u4;

template <int PAR>
__device__ __forceinline__ void stageK(const Blk& B, char* lds, int t, int NT, int tid, u4 (&stK)[4]) {
    if (t + 1 < NT) {
#pragma unroll
        for (int j = 0; j < 4; ++j) { const int id = tid + 256 * j, key = id >> 4, col = (id & 15) * 8; *(u4*)(lds + OFF_K + (PAR ^ 1) * K_BYTES + KSWZ(key, col * 2)) = stK[j]; }
    }
    if (t + 2 < NT) {
#pragma unroll
        for (int j = 0; j < 4; ++j) { const int id = tid + 256 * j, key = id >> 4, col = (id & 15) * 8; stK[j] = *(const __attribute__((address_space(1))) u4*)(B.K + (size_t)((t + 2) * KT + key) * 128 + col); }
    }
}
template <int PAR>
__device__ __forceinline__ void stageV(const Blk& B, char* lds, int t, int NT, int tid, u4 (&stV)[8]) {
    if (t < NT) {
#pragma unroll
        for (int j = 0; j < 8; ++j) { const int id = tid + 256 * j, key = id >> 5, col = (id & 31) * 8; *(u4*)(lds + OFF_V + PAR * V_BYTES + v_st2(key, col)) = stV[j]; }
    }
    if (t + 1 < NT) {
#pragma unroll
        for (int j = 0; j < 8; ++j) { const int id = tid + 256 * j, key = id >> 5, col = (id & 31) * 8;
            stV[j] = *(const __attribute__((address_space(1))) u4*)((col < 128 ? B.V0 + col : B.V1 + (col - 128)) + (size_t)((t + 1) * KT + key) * 128); }
    }
}
template <int PAR>
__device__ __forceinline__ void step_prod(const Blk& B, char* lds, int t, int NT, int tid, int wid, int lane, int r32, int hi, const bf16x8 (&qr)[8], float& m_reg, float& l_reg, u4 (&stV)[8]) {
    stageV<PAR>(B, lds, t, NT, tid, stV);
    if (t < NT) {
        f32x16 p0, p1; float mn, al; bf16x8 pa0, pa1, pa2, pa3;
        __builtin_amdgcn_s_setprio(2);
        att::qkt<PAR, false>(p0, p1, lds + OFF_K, r32, hi, qr, true);
        __builtin_amdgcn_s_setprio(0);
        const int kb = t * KT, qlo = B.P0 + wid * 32;
        if (kb + KT - 1 > qlo) att::mask_tile(p0, p1, qlo + r32 - 4 * hi - kb, (unsigned)0x7fffffff);
        att::partialSM(p0, p1, m_reg, mn, al);
        att::finishSM(p0, p1, al, l_reg, pa0, pa1, pa2, pa3);
        char* pb = lds + OFF_P + (PAR * 4 + wid) * 4096 + lane * 16;
        *(bf16x8*)(pb) = pa0; *(bf16x8*)(pb + 1024) = pa1; *(bf16x8*)(pb + 2048) = pa2; *(bf16x8*)(pb + 3072) = pa3;
        if (hi == 0) ((float*)(lds + OFF_AL))[(PAR * 4 + wid) * 32 + r32] = al;
    }
    __syncthreads();
}
template <int PAR>
__device__ __forceinline__ void step_cons(const Blk& B, char* lds, int t, int NT, int tid, int p, int lane, int r32, int hi, f32x16 (&o)[8], u4 (&stK)[4]) {
    stageK<PAR>(B, lds, t, NT, tid - 256, stK);
    if (t >= 1) {
        constexpr int UP = PAR ^ 1;
        const float* alp = (const float*)(lds + OFF_AL) + (UP * 4 + p) * 32;
        const float a = alp[r32];
        if (__any(a < 1.f)) {
#pragma unroll
            for (int r = 0; r < 16; ++r) { const float ar = alp[att::crow(r, hi)];
#pragma unroll
                for (int d = 0; d < 8; ++d) o[d][r] *= ar; }
        }
        const char* pb = lds + OFF_P + (UP * 4 + p) * 4096 + lane * 16;
        const bf16x8 pa0 = *(const bf16x8*)(pb), pa1 = *(const bf16x8*)(pb + 1024), pa2 = *(const bf16x8*)(pb + 2048), pa3 = *(const bf16x8*)(pb + 3072);
        const int vb0 = (int)(uintptr_t)(lds + OFF_V) + att::v_rd_base(lane);
#define A2_TRRD(dst, off) asm volatile("ds_read_b64_tr_b16 %0, %1 offset:%2" : "=&v"(dst) : "v"(vb0), "i"(off) : "memory")
#define A2_LDG(L, H, ks, dh) do { constexpr int b_ = UP * V_BYTES + (ks) * 8192 + (dh) * 2048; \
        A2_TRRD(L[0], b_); A2_TRRD(H[0], b_ + 4096); A2_TRRD(L[1], b_ + 512); A2_TRRD(H[1], b_ + 512 + 4096); A2_TRRD(L[2], b_ + 1024); A2_TRRD(H[2], b_ + 1024 + 4096); A2_TRRD(L[3], b_ + 1536); A2_TRRD(H[3], b_ + 1536 + 4096); } while (0)
#define A2_MMA(L, H, pa, dh) do { _Pragma("unroll") for (int d = 0; d < 4; ++d) \
        o[4 * (dh) + d] = __builtin_amdgcn_mfma_f32_32x32x16_bf16(pa, (bf16x8){L[d][0], L[d][1], L[d][2], L[d][3], H[d][0], H[d][1], H[d][2], H[d][3]}, o[4 * (dh) + d], 0, 0, 0); } while (0)
#define A2_W8() do { asm volatile("s_waitcnt lgkmcnt(8)" ::: "memory"); SBAR(); } while (0)
        {
            s16x4 La[4], Ha[4], Lb[4], Hb[4];
            asm volatile("s_waitcnt lgkmcnt(0)" ::: "memory"); SBAR();
            A2_LDG(La, Ha, 0, 0); A2_LDG(Lb, Hb, 0, 1);
            A2_W8(); A2_MMA(La, Ha, pa0, 0); SBAR(); A2_LDG(La, Ha, 1, 0);
            A2_W8(); A2_MMA(Lb, Hb, pa0, 1); SBAR(); A2_LDG(Lb, Hb, 1, 1);
            A2_W8(); A2_MMA(La, Ha, pa1, 0); SBAR(); A2_LDG(La, Ha, 2, 0);
            A2_W8(); A2_MMA(Lb, Hb, pa1, 1); SBAR(); A2_LDG(Lb, Hb, 2, 1);
            A2_W8(); A2_MMA(La, Ha, pa2, 0); SBAR(); A2_LDG(La, Ha, 3, 0);
            A2_W8(); A2_MMA(Lb, Hb, pa2, 1); SBAR(); A2_LDG(Lb, Hb, 3, 1);
            A2_W8(); A2_MMA(La, Ha, pa3, 0); SBAR();
            asm volatile("s_waitcnt lgkmcnt(0)" ::: "memory"); SBAR(); A2_MMA(Lb, Hb, pa3, 1); SBAR();
        }
#undef A2_W8
#undef A2_MMA
#undef A2_LDG
#undef A2_TRRD
    }
    __syncthreads();
}

template <int MODE>
__device__ __forceinline__ void block(const Blk& B, char* lds) {
    int tl = threadIdx.x; asm volatile("" : "+v"(tl));
    const int tid = tl, wid = __builtin_amdgcn_readfirstlane(tid >> 6), lane = tid & 63, r32 = lane & 31, hi = lane >> 5;
    const int NT = (B.P0 + QROWS - 1) / KT + 1;
    if (wid < 4) {
        bf16x8 qr[8]; float m_reg = -1e30f, l_reg = 0.f; u4 stV[8];
#pragma unroll
        for (int j = 0; j < 8; ++j) { const int id = tid + 256 * j, key = id >> 5, col = (id & 31) * 8; stV[j] = *(const __attribute__((address_space(1))) u4*)((col < 128 ? B.V0 + col : B.V1 + (col - 128)) + (size_t)key * 128); }
#pragma unroll
        for (int d0 = 0; d0 < 8; ++d0) qr[d0] = *(const __attribute__((address_space(1))) bf16x8*)(B.Q + (size_t)(wid * 32 + r32) * 128 + d0 * 16 + hi * 8);
        __syncthreads();
        for (int t = 0; t <= NT; t += 2) {
            step_prod<0>(B, lds, t, NT, tid, wid, lane, r32, hi, qr, m_reg, l_reg, stV);
            if (t + 1 <= NT) step_prod<1>(B, lds, t + 1, NT, tid, wid, lane, r32, hi, qr, m_reg, l_reg, stV);
        }
        if (hi == 0) ((float*)(lds + OFF_LL))[wid * 32 + r32] = l_reg;
        __syncthreads();
    } else {
        f32x16 o[8]; const int p = wid - 4; u4 stK[4];
#pragma unroll
        for (int j = 0; j < 4; ++j) { const int id = (tid - 256) + 256 * j, key = id >> 4, col = (id & 15) * 8; const u4 k0 = *(const __attribute__((address_space(1))) u4*)(B.K + (size_t)key * 128 + col); *(u4*)(lds + OFF_K + KSWZ(key, col * 2)) = k0; }
        if (NT > 1) {
#pragma unroll
            for (int j = 0; j < 4; ++j) { const int id = (tid - 256) + 256 * j, key = id >> 4, col = (id & 15) * 8; stK[j] = *(const __attribute__((address_space(1))) u4*)(B.K + (size_t)(KT + key) * 128 + col); }
        }
#pragma unroll
        for (int d = 0; d < 8; ++d)
#pragma unroll
            for (int r = 0; r < 16; ++r) o[d][r] = 0.f;
        __syncthreads();
        for (int t = 0; t <= NT; t += 2) {
            step_cons<0>(B, lds, t, NT, tid, p, lane, r32, hi, o, stK);
            if (t + 1 <= NT) step_cons<1>(B, lds, t + 1, NT, tid, p, lane, r32, hi, o, stK);
        }
        __syncthreads();
        const float* llp = (const float*)(lds + OFF_LL) + p * 32;
        float* Ow = B.O + (size_t)(p * 32) * 256;
        if constexpr (MODE == 0) {
#pragma unroll
            for (int r = 0; r < 16; ++r) { const int orow = att::crow(r, hi); const float rl = __builtin_amdgcn_rcpf(llp[orow]);
#pragma unroll
                for (int d = 0; d < 8; ++d) ((__attribute__((address_space(1))) float*)Ow)[(size_t)orow * 256 + d * 32 + r32] = o[d][r] * rl; }
        } else {
            asm volatile("s_waitcnt vmcnt(0)" ::: "memory");
            int ll_ = threadIdx.x; asm volatile("" : "+v"(ll_)); ll_ &= 63;
            f32x4 sw0 = {B.subln[r32], B.subln[32 + r32], B.subln[64 + r32], B.subln[96 + r32]}, sw1 = {B.subln[128 + r32], B.subln[160 + r32], B.subln[192 + r32], B.subln[224 + r32]};
#pragma unroll
            for (int r = 0; r < 16; ++r) { const int orow = att::crow(r, hi); const float rl = __builtin_amdgcn_rcpf(llp[orow]) * B.lam; float q = 0.f; float dv[8];
#pragma unroll
                for (int d = 0; d < 8; ++d) { const float o0 = ((const __attribute__((address_space(1))) float*)Ow)[(size_t)orow * 256 + d * 32 + r32]; dv[d] = o0 - o[d][r] * rl; q += dv[d] * dv[d]; }
#pragma unroll
                for (int sft = 1; sft < 32; sft <<= 1) q += __builtin_bit_cast(float, __builtin_amdgcn_ds_bpermute((ll_ ^ sft) << 2, __builtin_bit_cast(int, q)));
                const float rs = B.post / sqrtf(q * (1.f / 256.f) + 1e-5f);
                __attribute__((address_space(1))) unsigned short* arow = (__attribute__((address_space(1))) unsigned short*)B.AO + (size_t)(p * 32 + orow) * 4096 + r32;
#pragma unroll
                for (int d = 0; d < 8; ++d) { const float v = dv[d] * rs * (d < 4 ? sw0[d & 3] : sw1[d & 3]);
                    const float vn = __builtin_bit_cast(float, __builtin_amdgcn_update_dpp(0, __builtin_bit_cast(int, v), 0xB1, 0xf, 0xf, true));
                    if ((r32 & 1) == 0) *(__attribute__((address_space(1))) unsigned*)(arow + d * 32) = att::cvtpk(v, vn); }
            }
        }
    }
    __syncthreads();
}
}

__device__ __forceinline__ att2::Blk att2_ref(const bf16* QKVH, float* OP2, bf16* AO, const float* subln, float lam, float post, int L, int c, int pass) {
    const int bh = L >> 4, y = L & 15; const int h = bh & 15, b = bh >> 4; const int qb = pass ? 31 - y : y;
    const size_t GS = (size_t)M * 128;
    att2::Blk r;
    r.Q = QKVH + (size_t)(2 * h + c) * GS + (size_t)(b * SEQ + qb * 128) * 128;
    r.K = QKVH + (size_t)(32 + 2 * h + c) * GS + (size_t)(b * SEQ) * 128;
    r.V0 = QKVH + (size_t)(64 + 2 * h) * GS + (size_t)(b * SEQ) * 128;
    r.V1 = QKVH + (size_t)(65 + 2 * h) * GS + (size_t)(b * SEQ) * 128;
    r.O = OP2 + (size_t)h * M * 256 + (size_t)(b * SEQ + qb * 128) * 256;
    r.P0 = qb * 128;
    r.AO = AO + (size_t)(b * SEQ + qb * 128) * DM + h * 256; r.subln = subln; r.lam = lam; r.post = post;
    return r;
}
__device__ __forceinline__ void attn2_phase(Frame& F, const bf16* QKVH, float* OP2, char* lds, const float* lq1, const float* lk1, const float* lq2, const float* lk2, const float* subln, float lambda_init, bf16* AO) {
    const int lane = F.lane;
    const float d1 = wave_sum(lq1[lane] * lk1[lane] + lq1[lane + 64] * lk1[lane + 64]), d2 = wave_sum(lq2[lane] * lk2[lane] + lq2[lane + 64] * lk2[lane + 64]);
    const float lam = expf(d1) - expf(d2) + lambda_init, post = 1.0f - lambda_init;
    for (int L = F.vcu; L < 512; L += F.G) {
#pragma unroll 1
        for (int pass = 0; pass < 2; ++pass) {
            { const att2::Blk B = att2_ref(QKVH, OP2, AO, subln, lam, post, L, 0, pass); att2::block<0>(B, lds); }
            { const att2::Blk B = att2_ref(QKVH, OP2, AO, subln, lam, post, L, 1, pass); att2::block<1>(B, lds); }
        }
    }
}
__device__ __forceinline__ void attn_combine_phase(Frame& F, const float* OP, const float* lq1, const float* lk1, const float* lq2, const float* lk2, const float* subln, float lambda_init, bf16* AO) {
    const int gw = F.vcu * NWAVES + F.wave, NGW = F.G * NWAVES, lane = F.lane;
    const float d1 = wave_sum(lq1[lane] * lk1[lane] + lq1[lane + 64] * lk1[lane + 64]), d2 = wave_sum(lq2[lane] * lk2[lane] + lq2[lane + 64] * lk2[lane + 64]);
    const float lam = expf(d1) - expf(d2) + lambda_init, post = 1.0f - lambda_init;
    const int vh = lane >> 5, d = (lane & 31) * 4;
    const f32x4 sw = *(const GAS f32x4*)(subln + vh * 128 + d);
    const size_t GS = (size_t)M * 128;
    constexpr int UN = 8;
    for (int it0 = gw; it0 < M * AH; it0 += UN * NGW) {
        f32x4 o1[UN], o2[UN];
#pragma unroll
        for (int u = 0; u < UN; ++u) { const int it = it0 + u * NGW, m = it >> 4, h = it & 15;
            if (it < M * AH) { o1[u] = *(const GAS f32x4*)(OP + (size_t)(2 * h) * M * 256 + (size_t)m * 256 + vh * 128 + d); o2[u] = *(const GAS f32x4*)(OP + (size_t)(2 * h + 1) * M * 256 + (size_t)m * 256 + vh * 128 + d); } }
#pragma unroll
        for (int u = 0; u < UN; ++u) { const int it = it0 + u * NGW, m = it >> 4, h = it & 15;
            if (it >= M * AH) break;
            const f32x4 o = o1[u] - lam * o2[u];
            const float ss = wave_sum((o.x * o.x + o.y * o.y) + (o.z * o.z + o.w * o.w));
            const float rs = post / sqrtf(ss * (1.f / 256.f) + EPS);
            v2u w; w.x = pk2(o.x * rs * sw.x, o.y * rs * sw.y); w.y = pk2(o.z * rs * sw.z, o.w * rs * sw.w);
            *(GAS v2u*)((GAS bf16*)AO + (size_t)m * DM + h * 256 + vh * 128 + d) = w;
        }
    }
}


struct Args { const float* in[57]; float* out; unsigned char* ws; };
__global__ void __launch_bounds__(NTHR, 2) trunk_fwd(Args args) {
    extern __shared__ __attribute__((aligned(16))) unsigned char lds[];
    Frame F;
    F.lds = (LAS unsigned char*)lds;
    F.tid = threadIdx.x; F.lane = F.tid & 63; F.wave = __builtin_amdgcn_readfirstlane(F.tid >> 6);
    gu32* ctl = (gu32*)(args.ws + WS_CTL);
    for (int u = F.tid; u < (LDS_BYTES - LDSCTL_OFF) / 4; u += NTHR) ((LAS unsigned*)(F.lds + LDSCTL_OFF))[u] = 0u;
    __syncthreads();
    volatile LAS unsigned* MISC = (volatile LAS unsigned*)(F.lds + MISC_OFF);
    XcdBarrier bar = xcd_barrier_post((unsigned*)(ctl + CW_BAR), MISC + 8);
#define GRID_BAR() do { xcd_barrier(bar); relaunder(F, args.ws); } while (0)

#define XR ((float*)(F.ws + WS_XR))
#define U ((bf16*)(F.ws + WS_U))
#define BIG ((bf16*)(F.ws + WS_BIG))
#define ACT2 ((bf16*)(F.ws + WS_ACT2))
#define XT ((bf16*)(F.ws + WS_XT))
#define Yb ((bf16*)(F.ws + WS_Y))
#define Bn ((bf16*)(F.ws + WS_BN))
#define BT ((bf16*)(F.ws + WS_BT))
#define Cn ((bf16*)(F.ws + WS_CN))
#define DTF ((float*)(F.ws + WS_DTF))
#define PART ((float*)(F.ws + WS_PART))
#define OP ((float*)(F.ws + WS_XT))
#define SSQ(k) ((unsigned long long*)((unsigned*)(F.ws + WS_CTL) + CW_SS) + (k) * M)
#define ropec ((float*)(F.ws + WS_ROPE))
#define ropes ((float*)(F.ws + WS_ROPE) + (size_t)M * 64)
    relaunder(F, args.ws);

    {
        int p0_prefix = 0;
#pragma unroll 1
        for (int layer = 0; layer < 4; ++layer) {
            const bool mamba = (layer & 1) == 0;
            const int ib = layer == 0 ? 2 : layer == 1 ? 16 : layer == 2 ? 29 : 43;
            const size_t wlo = WS_W + (layer == 0 ? 0 : layer == 1 ? WL_MAMBA : layer == 2 ? WL_MAMBA + WL_ATTN : 2 * WL_MAMBA + WL_ATTN);
            if (mamba) {
                p0_matrix(F, args.in[ib + 1], DM, NZX, NZXP, (bf16*)(F.ws + wlo + W_IN), p0_prefix, 0, args.in[ib + 0]);
                p0_matrix(F, args.in[ib + 8], DI, DM, DM, (bf16*)(F.ws + wlo + W_OUT), p0_prefix);
                p0_matrix(F, args.in[ib + 10], DM, NUP, NUP, (bf16*)(F.ws + wlo + W_UP_M), p0_prefix, 0, args.in[ib + 9], DFF / 256);
                p0_matrix(F, args.in[ib + 13], DFF, DM, DM, (bf16*)(F.ws + wlo + W_DOWN_M), p0_prefix);
            } else {
                p0_matrix(F, args.in[ib + 1], DM, NQKV, NQKV, (bf16*)(F.ws + wlo + W_QKV), p0_prefix, 2 * DM, args.in[ib + 0]);
                p0_matrix(F, args.in[ib + 7], DM, DM, DM, (bf16*)(F.ws + wlo + W_O), p0_prefix);
                p0_matrix(F, args.in[ib + 9], DM, NUP, NUP, (bf16*)(F.ws + wlo + W_UP_A), p0_prefix, 0, args.in[ib + 8], DFF / 256);
                p0_matrix(F, args.in[ib + 12], DFF, DM, DM, (bf16*)(F.ws + wlo + W_DOWN_A), p0_prefix);
            }
        }
        rope_table_phase(F, (const int*)args.in[1], ropec, ropes);
        { const int gw = F.vcu * NWAVES + F.wave, NGW = F.G * NWAVES;
          for (int m = gw; m < M; m += NGW) x_row_prep(args.in[0] + (size_t)m * DM, U + (size_t)m * DM, SSQ(0) + m, F.lane); }
        GRID_BAR();
    }

    {
        constexpr int layer = 0;
        constexpr bool mamba = (layer & 1) == 0;
        constexpr int ib = layer == 0 ? 2 : layer == 1 ? 16 : layer == 2 ? 29 : 43;
        constexpr size_t wlo = WS_W + (layer == 0 ? 0 : layer == 1 ? WL_MAMBA : layer == 2 ? WL_MAMBA + WL_ATTN : 2 * WL_MAMBA + WL_ATTN);
        const float* xin = layer == 0 ? args.in[0] : XR;
        if constexpr (mamba) {
            const bool splitdt = F.G == 256;
            if (splitdt) {
                { pg8::Gemm g{U, (const bf16*)(F.ws + wlo + W_IN), M, NZXM, DM}; pg8::StaticOrder S; S.init(M, NZXM, F.G, F.bx);
                  int pm0, ntab; rstd_table(F, S, SSQ(2 * layer), pm0, ntab);
                  pg8::EpiBf16S E{BIG, NZXP, SSQ(2 * layer), (const LAS float*)(F.lds + TAB_OFF), pm0, ntab};
                  pg8::gemm_phase<pg8::EpiBf16S, pg8::StaticOrder, PG8_ALIGN, PG8_SP2>(F.lds + RING_OFF, g, S, E); }
                { const int ks = F.vcu & 7; pg8::Gemm g{U + ks * 512, (const bf16*)(F.ws + wlo + W_IN) + (size_t)NZXM * DM + ks * 512, M, 256, 512, DM};
                  pg8::OneUnit S{F.vcu >> 3, 1}; pg8::EpiPart E{PART + (size_t)ks * M * 128};
                  pg8::gemm_phase<pg8::EpiPart, pg8::OneUnit, false, PG8_SP2>(F.lds + RING_OFF, g, S, E); }
            } else {
                { pg8::Gemm g{U, (const bf16*)(F.ws + wlo + W_IN), M, NZXP, DM}; pg8::StaticOrder S; S.init(M, NZXP, F.G, F.bx);
                  int pm0, ntab; rstd_table(F, S, SSQ(2 * layer), pm0, ntab);
                  pg8::EpiBf16S E{BIG, NZXP, SSQ(2 * layer), (const LAS float*)(F.lds + TAB_OFF), pm0, ntab};
                  pg8::gemm_phase<pg8::EpiBf16S, pg8::StaticOrder, PG8_ALIGN, PG8_SP2>(F.lds + RING_OFF, g, S, E); }
            }
            GRID_BAR();
            ssd_prep_phase(F, BIG, args.in[ib + 2], args.in[ib + 3], args.in[ib + 4], XT, Bn, BT, Cn, DTF, splitdt ? PART : nullptr, SSQ(2 * layer));
            GRID_BAR();
            ssd_phase(F, XT, Bn, BT, Cn, DTF, args.in[ib + 5], args.in[ib + 6], Yb, BIG);
            GRID_BAR();
            gated_norm_phase(F, Yb, BIG, args.in[ib + 7], ACT2);
            GRID_BAR();
            { pg8::Gemm g{ACT2, (const bf16*)(F.ws + wlo + W_OUT), M, DM, DI}; pg8::StaticOrder S; S.init(M, DM, F.G, F.bx);
              pg8::EpiResN E{xin, XR, U, SSQ(2 * layer + 1), DM};
              pg8::gemm_phase<pg8::EpiResN, pg8::StaticOrder, PG8_ALIGN, PG8_SP2>(F.lds + RING_OFF, g, S, E); }
            GRID_BAR();
        } else {
            { pg8::Gemm g{U, (const bf16*)(F.ws + wlo + W_QKV), M, NQKV, DM}; pg8::StaticOrder S; S.init(M, NQKV, F.G, F.bx);
              int pm0, ntab; rstd_table(F, S, SSQ(2 * layer), pm0, ntab);
              pg8::EpiHeadMajor E{BIG, (size_t)M * 128, ropec, ropes, SSQ(2 * layer), (const LAS float*)(F.lds + TAB_OFF), pm0, ntab};
              pg8::gemm_phase<pg8::EpiHeadMajor, pg8::StaticOrder, PG8_ALIGN, PG8_SP2>(F.lds + RING_OFF, g, S, E); }
            GRID_BAR();
            attn2_phase(F, BIG, OP, (char*)lds + RING_OFF, args.in[ib + 2], args.in[ib + 3], args.in[ib + 4], args.in[ib + 5], args.in[ib + 6], 0.8f - 0.6f * expf(-0.3f * (float)layer), ACT2);
            GRID_BAR();
            { pg8::Gemm g{ACT2, (const bf16*)(F.ws + wlo + W_O), M, DM, DM}; pg8::StaticOrder S; S.init(M, DM, F.G, F.bx);
              pg8::EpiResN E{xin, XR, U, SSQ(2 * layer + 1), DM};
              pg8::gemm_phase<pg8::EpiResN, pg8::StaticOrder, PG8_ALIGN, PG8_SP2>(F.lds + RING_OFF, g, S, E); }
            GRID_BAR();
        }
        constexpr int fb = mamba ? ib + 9 : ib + 8;
        { pg8::Gemm g{U, (const bf16*)(F.ws + wlo + (mamba ? W_UP_M : W_UP_A)), M, NUP, DM}; pg8::StaticOrder S; S.init(M, NUP, F.G, F.bx);

          { pg8::EpiGate E{ACT2, BIG, args.in[fb + 2], args.in[fb + 3], NUP, DFF, SSQ(2 * layer + 1), F.lds + SIDE_OFF};
          pg8::gemm_phase<pg8::EpiGate, pg8::StaticOrder, PG8_ALIGN, PG8_SP2>(F.lds + RING_OFF, g, S, E); } }
        GRID_BAR();
        ffn_fix_phase(F, BIG, args.in[fb + 2], args.in[fb + 3], ACT2);
        GRID_BAR();
        { pg8::Gemm g{ACT2, (const bf16*)(F.ws + wlo + (mamba ? W_DOWN_M : W_DOWN_A)), M, DM, DFF}; pg8::StaticOrder S; S.init(M, DM, F.G, F.bx);
          pg8::EpiResN E{XR, XR, U, SSQ(2 * layer + 2), DM};
          pg8::gemm_phase<pg8::EpiResN, pg8::StaticOrder, PG8_ALIGN, PG8_SP2>(F.lds + RING_OFF, g, S, E); }
        GRID_BAR();
    }
    {
        constexpr int layer = 1;
        constexpr bool mamba = (layer & 1) == 0;
        constexpr int ib = layer == 0 ? 2 : layer == 1 ? 16 : layer == 2 ? 29 : 43;
        constexpr size_t wlo = WS_W + (layer == 0 ? 0 : layer == 1 ? WL_MAMBA : layer == 2 ? WL_MAMBA + WL_ATTN : 2 * WL_MAMBA + WL_ATTN);
        const float* xin = layer == 0 ? args.in[0] : XR;
        if constexpr (mamba) {
            const bool splitdt = F.G == 256;
            if (splitdt) {
                { pg8::Gemm g{U, (const bf16*)(F.ws + wlo + W_IN), M, NZXM, DM}; pg8::StaticOrder S; S.init(M, NZXM, F.G, F.bx);
                  int pm0, ntab; rstd_table(F, S, SSQ(2 * layer), pm0, ntab);
                  pg8::EpiBf16S E{BIG, NZXP, SSQ(2 * layer), (const LAS float*)(F.lds + TAB_OFF), pm0, ntab};
                  pg8::gemm_phase<pg8::EpiBf16S, pg8::StaticOrder, PG8_ALIGN, PG8_SP2>(F.lds + RING_OFF, g, S, E); }
                { const int ks = F.vcu & 7; pg8::Gemm g{U + ks * 512, (const bf16*)(F.ws + wlo + W_IN) + (size_t)NZXM * DM + ks * 512, M, 256, 512, DM};
                  pg8::OneUnit S{F.vcu >> 3, 1}; pg8::EpiPart E{PART + (size_t)ks * M * 128};
                  pg8::gemm_phase<pg8::EpiPart, pg8::OneUnit, false, PG8_SP2>(F.lds + RING_OFF, g, S, E); }
            } else {
                { pg8::Gemm g{U, (const bf16*)(F.ws + wlo + W_IN), M, NZXP, DM}; pg8::StaticOrder S; S.init(M, NZXP, F.G, F.bx);
                  int pm0, ntab; rstd_table(F, S, SSQ(2 * layer), pm0, ntab);
                  pg8::EpiBf16S E{BIG, NZXP, SSQ(2 * layer), (const LAS float*)(F.lds + TAB_OFF), pm0, ntab};
                  pg8::gemm_phase<pg8::EpiBf16S, pg8::StaticOrder, PG8_ALIGN, PG8_SP2>(F.lds + RING_OFF, g, S, E); }
            }
            GRID_BAR();
            ssd_prep_phase(F, BIG, args.in[ib + 2], args.in[ib + 3], args.in[ib + 4], XT, Bn, BT, Cn, DTF, splitdt ? PART : nullptr, SSQ(2 * layer));
            GRID_BAR();
            ssd_phase(F, XT, Bn, BT, Cn, DTF, args.in[ib + 5], args.in[ib + 6], Yb, BIG);
            GRID_BAR();
            gated_norm_phase(F, Yb, BIG, args.in[ib + 7], ACT2);
            GRID_BAR();
            { pg8::Gemm g{ACT2, (const bf16*)(F.ws + wlo + W_OUT), M, DM, DI}; pg8::StaticOrder S; S.init(M, DM, F.G, F.bx);
              pg8::EpiResN E{xin, XR, U, SSQ(2 * layer + 1), DM};
              pg8::gemm_phase<pg8::EpiResN, pg8::StaticOrder, PG8_ALIGN, PG8_SP2>(F.lds + RING_OFF, g, S, E); }
            GRID_BAR();
        } else {
            { pg8::Gemm g{U, (const bf16*)(F.ws + wlo + W_QKV), M, NQKV, DM}; pg8::StaticOrder S; S.init(M, NQKV, F.G, F.bx);
              int pm0, ntab; rstd_table(F, S, SSQ(2 * layer), pm0, ntab);
              pg8::EpiHeadMajor E{BIG, (size_t)M * 128, ropec, ropes, SSQ(2 * layer), (const LAS float*)(F.lds + TAB_OFF), pm0, ntab};
              pg8::gemm_phase<pg8::EpiHeadMajor, pg8::StaticOrder, PG8_ALIGN, PG8_SP2>(F.lds + RING_OFF, g, S, E); }
            GRID_BAR();
            attn2_phase(F, BIG, OP, (char*)lds + RING_OFF, args.in[ib + 2], args.in[ib + 3], args.in[ib + 4], args.in[ib + 5], args.in[ib + 6], 0.8f - 0.6f * expf(-0.3f * (float)layer), ACT2);
            GRID_BAR();
            { pg8::Gemm g{ACT2, (const bf16*)(F.ws + wlo + W_O), M, DM, DM}; pg8::StaticOrder S; S.init(M, DM, F.G, F.bx);
              pg8::EpiResN E{xin, XR, U, SSQ(2 * layer + 1), DM};
              pg8::gemm_phase<pg8::EpiResN, pg8::StaticOrder, PG8_ALIGN, PG8_SP2>(F.lds + RING_OFF, g, S, E); }
            GRID_BAR();
        }
        constexpr int fb = mamba ? ib + 9 : ib + 8;
        { pg8::Gemm g{U, (const bf16*)(F.ws + wlo + (mamba ? W_UP_M : W_UP_A)), M, NUP, DM}; pg8::StaticOrder S; S.init(M, NUP, F.G, F.bx);

          { pg8::EpiGate E{ACT2, BIG, args.in[fb + 2], args.in[fb + 3], NUP, DFF, SSQ(2 * layer + 1), F.lds + SIDE_OFF};
          pg8::gemm_phase<pg8::EpiGate, pg8::StaticOrder, PG8_ALIGN, PG8_SP2>(F.lds + RING_OFF, g, S, E); } }
        GRID_BAR();
        ffn_fix_phase(F, BIG, args.in[fb + 2], args.in[fb + 3], ACT2);
        GRID_BAR();
        { pg8::Gemm g{ACT2, (const bf16*)(F.ws + wlo + (mamba ? W_DOWN_M : W_DOWN_A)), M, DM, DFF}; pg8::StaticOrder S; S.init(M, DM, F.G, F.bx);
          pg8::EpiResN E{XR, XR, U, SSQ(2 * layer + 2), DM};
          pg8::gemm_phase<pg8::EpiResN, pg8::StaticOrder, PG8_ALIGN, PG8_SP2>(F.lds + RING_OFF, g, S, E); }
        GRID_BAR();
    }
    {
        constexpr int layer = 2;
        constexpr bool mamba = (layer & 1) == 0;
        constexpr int ib = layer == 0 ? 2 : layer == 1 ? 16 : layer == 2 ? 29 : 43;
        constexpr size_t wlo = WS_W + (layer == 0 ? 0 : layer == 1 ? WL_MAMBA : layer == 2 ? WL_MAMBA + WL_ATTN : 2 * WL_MAMBA + WL_ATTN);
        const float* xin = layer == 0 ? args.in[0] : XR;
        if constexpr (mamba) {
            const bool splitdt = F.G == 256;
            if (splitdt) {
                { pg8::Gemm g{U, (const bf16*)(F.ws + wlo + W_IN), M, NZXM, DM}; pg8::StaticOrder S; S.init(M, NZXM, F.G, F.bx);
                  int pm0, ntab; rstd_table(F, S, SSQ(2 * layer), pm0, ntab);
                  pg8::EpiBf16S E{BIG, NZXP, SSQ(2 * layer), (const LAS float*)(F.lds + TAB_OFF), pm0, ntab};
                  pg8::gemm_phase<pg8::EpiBf16S, pg8::StaticOrder, PG8_ALIGN, PG8_SP2>(F.lds + RING_OFF, g, S, E); }
                { const int ks = F.vcu & 7; pg8::Gemm g{U + ks * 512, (const bf16*)(F.ws + wlo + W_IN) + (size_t)NZXM * DM + ks * 512, M, 256, 512, DM};
                  pg8::OneUnit S{F.vcu >> 3, 1}; pg8::EpiPart E{PART + (size_t)ks * M * 128};
                  pg8::gemm_phase<pg8::EpiPart, pg8::OneUnit, false, PG8_SP2>(F.lds + RING_OFF, g, S, E); }
            } else {
                { pg8::Gemm g{U, (const bf16*)(F.ws + wlo + W_IN), M, NZXP, DM}; pg8::StaticOrder S; S.init(M, NZXP, F.G, F.bx);
                  int pm0, ntab; rstd_table(F, S, SSQ(2 * layer), pm0, ntab);
                  pg8::EpiBf16S E{BIG, NZXP, SSQ(2 * layer), (const LAS float*)(F.lds + TAB_OFF), pm0, ntab};
                  pg8::gemm_phase<pg8::EpiBf16S, pg8::StaticOrder, PG8_ALIGN, PG8_SP2>(F.lds + RING_OFF, g, S, E); }
            }
            GRID_BAR();
            ssd_prep_phase(F, BIG, args.in[ib + 2], args.in[ib + 3], args.in[ib + 4], XT, Bn, BT, Cn, DTF, splitdt ? PART : nullptr, SSQ(2 * layer));
            GRID_BAR();
            ssd_phase(F, XT, Bn, BT, Cn, DTF, args.in[ib + 5], args.in[ib + 6], Yb, BIG);
            GRID_BAR();
            gated_norm_phase(F, Yb, BIG, args.in[ib + 7], ACT2);
            GRID_BAR();
            { pg8::Gemm g{ACT2, (const bf16*)(F.ws + wlo + W_OUT), M, DM, DI}; pg8::StaticOrder S; S.init(M, DM, F.G, F.bx);
              pg8::EpiResN E{xin, XR, U, SSQ(2 * layer + 1), DM};
              pg8::gemm_phase<pg8::EpiResN, pg8::StaticOrder, PG8_ALIGN, PG8_SP2>(F.lds + RING_OFF, g, S, E); }
            GRID_BAR();
        } else {
            { pg8::Gemm g{U, (const bf16*)(F.ws + wlo + W_QKV), M, NQKV, DM}; pg8::StaticOrder S; S.init(M, NQKV, F.G, F.bx);
              int pm0, ntab; rstd_table(F, S, SSQ(2 * layer), pm0, ntab);
              pg8::EpiHeadMajor E{BIG, (size_t)M * 128, ropec, ropes, SSQ(2 * layer), (const LAS float*)(F.lds + TAB_OFF), pm0, ntab};
              pg8::gemm_phase<pg8::EpiHeadMajor, pg8::StaticOrder, PG8_ALIGN, PG8_SP2>(F.lds + RING_OFF, g, S, E); }
            GRID_BAR();
            attn2_phase(F, BIG, OP, (char*)lds + RING_OFF, args.in[ib + 2], args.in[ib + 3], args.in[ib + 4], args.in[ib + 5], args.in[ib + 6], 0.8f - 0.6f * expf(-0.3f * (float)layer), ACT2);
            GRID_BAR();
            { pg8::Gemm g{ACT2, (const bf16*)(F.ws + wlo + W_O), M, DM, DM}; pg8::StaticOrder S; S.init(M, DM, F.G, F.bx);
              pg8::EpiResN E{xin, XR, U, SSQ(2 * layer + 1), DM};
              pg8::gemm_phase<pg8::EpiResN, pg8::StaticOrder, PG8_ALIGN, PG8_SP2>(F.lds + RING_OFF, g, S, E); }
            GRID_BAR();
        }
        constexpr int fb = mamba ? ib + 9 : ib + 8;
        { pg8::Gemm g{U, (const bf16*)(F.ws + wlo + (mamba ? W_UP_M : W_UP_A)), M, NUP, DM}; pg8::StaticOrder S; S.init(M, NUP, F.G, F.bx);

          { pg8::EpiGate E{ACT2, BIG, args.in[fb + 2], args.in[fb + 3], NUP, DFF, SSQ(2 * layer + 1), F.lds + SIDE_OFF};
          pg8::gemm_phase<pg8::EpiGate, pg8::StaticOrder, PG8_ALIGN, PG8_SP2>(F.lds + RING_OFF, g, S, E); } }
        GRID_BAR();
        ffn_fix_phase(F, BIG, args.in[fb + 2], args.in[fb + 3], ACT2);
        GRID_BAR();
        { pg8::Gemm g{ACT2, (const bf16*)(F.ws + wlo + (mamba ? W_DOWN_M : W_DOWN_A)), M, DM, DFF}; pg8::StaticOrder S; S.init(M, DM, F.G, F.bx);
          pg8::EpiResN E{XR, XR, U, SSQ(2 * layer + 2), DM};
          pg8::gemm_phase<pg8::EpiResN, pg8::StaticOrder, PG8_ALIGN, PG8_SP2>(F.lds + RING_OFF, g, S, E); }
        GRID_BAR();
    }
    {
        constexpr int layer = 3;
        constexpr bool mamba = (layer & 1) == 0;
        constexpr int ib = layer == 0 ? 2 : layer == 1 ? 16 : layer == 2 ? 29 : 43;
        constexpr size_t wlo = WS_W + (layer == 0 ? 0 : layer == 1 ? WL_MAMBA : layer == 2 ? WL_MAMBA + WL_ATTN : 2 * WL_MAMBA + WL_ATTN);
        const float* xin = layer == 0 ? args.in[0] : XR;
        if constexpr (mamba) {
            const bool splitdt = F.G == 256;
            if (splitdt) {
                { pg8::Gemm g{U, (const bf16*)(F.ws + wlo + W_IN), M, NZXM, DM}; pg8::StaticOrder S; S.init(M, NZXM, F.G, F.bx);
                  int pm0, ntab; rstd_table(F, S, SSQ(2 * layer), pm0, ntab);
                  pg8::EpiBf16S E{BIG, NZXP, SSQ(2 * layer), (const LAS float*)(F.lds + TAB_OFF), pm0, ntab};
                  pg8::gemm_phase<pg8::EpiBf16S, pg8::StaticOrder, PG8_ALIGN, PG8_SP2>(F.lds + RING_OFF, g, S, E); }
                { const int ks = F.vcu & 7; pg8::Gemm g{U + ks * 512, (const bf16*)(F.ws + wlo + W_IN) + (size_t)NZXM * DM + ks * 512, M, 256, 512, DM};
                  pg8::OneUnit S{F.vcu >> 3, 1}; pg8::EpiPart E{PART + (size_t)ks * M * 128};
                  pg8::gemm_phase<pg8::EpiPart, pg8::OneUnit, false, PG8_SP2>(F.lds + RING_OFF, g, S, E); }
            } else {
                { pg8::Gemm g{U, (const bf16*)(F.ws + wlo + W_IN), M, NZXP, DM}; pg8::StaticOrder S; S.init(M, NZXP, F.G, F.bx);
                  int pm0, ntab; rstd_table(F, S, SSQ(2 * layer), pm0, ntab);
                  pg8::EpiBf16S E{BIG, NZXP, SSQ(2 * layer), (const LAS float*)(F.lds + TAB_OFF), pm0, ntab};
                  pg8::gemm_phase<pg8::EpiBf16S, pg8::StaticOrder, PG8_ALIGN, PG8_SP2>(F.lds + RING_OFF, g, S, E); }
            }
            GRID_BAR();
            ssd_prep_phase(F, BIG, args.in[ib + 2], args.in[ib + 3], args.in[ib + 4], XT, Bn, BT, Cn, DTF, splitdt ? PART : nullptr, SSQ(2 * layer));
            GRID_BAR();
            ssd_phase(F, XT, Bn, BT, Cn, DTF, args.in[ib + 5], args.in[ib + 6], Yb, BIG);
            GRID_BAR();
            gated_norm_phase(F, Yb, BIG, args.in[ib + 7], ACT2);
            GRID_BAR();
            { pg8::Gemm g{ACT2, (const bf16*)(F.ws + wlo + W_OUT), M, DM, DI}; pg8::StaticOrder S; S.init(M, DM, F.G, F.bx);
              pg8::EpiResN E{xin, XR, U, SSQ(2 * layer + 1), DM};
              pg8::gemm_phase<pg8::EpiResN, pg8::StaticOrder, PG8_ALIGN, PG8_SP2>(F.lds + RING_OFF, g, S, E); }
            GRID_BAR();
        } else {
            { pg8::Gemm g{U, (const bf16*)(F.ws + wlo + W_QKV), M, NQKV, DM}; pg8::StaticOrder S; S.init(M, NQKV, F.G, F.bx);
              int pm0, ntab; rstd_table(F, S, SSQ(2 * layer), pm0, ntab);
              pg8::EpiHeadMajor E{BIG, (size_t)M * 128, ropec, ropes, SSQ(2 * layer), (const LAS float*)(F.lds + TAB_OFF), pm0, ntab};
              pg8::gemm_phase<pg8::EpiHeadMajor, pg8::StaticOrder, PG8_ALIGN, PG8_SP2>(F.lds + RING_OFF, g, S, E); }
            GRID_BAR();
            attn2_phase(F, BIG, OP, (char*)lds + RING_OFF, args.in[ib + 2], args.in[ib + 3], args.in[ib + 4], args.in[ib + 5], args.in[ib + 6], 0.8f - 0.6f * expf(-0.3f * (float)layer), ACT2);
            GRID_BAR();
            { pg8::Gemm g{ACT2, (const bf16*)(F.ws + wlo + W_O), M, DM, DM}; pg8::StaticOrder S; S.init(M, DM, F.G, F.bx);
              pg8::EpiResN E{xin, XR, U, SSQ(2 * layer + 1), DM};
              pg8::gemm_phase<pg8::EpiResN, pg8::StaticOrder, PG8_ALIGN, PG8_SP2>(F.lds + RING_OFF, g, S, E); }
            GRID_BAR();
        }
        constexpr int fb = mamba ? ib + 9 : ib + 8;
        { pg8::Gemm g{U, (const bf16*)(F.ws + wlo + (mamba ? W_UP_M : W_UP_A)), M, NUP, DM}; pg8::StaticOrder S; S.init(M, NUP, F.G, F.bx);

          { pg8::EpiGate E{ACT2, BIG, args.in[fb + 2], args.in[fb + 3], NUP, DFF, SSQ(2 * layer + 1), F.lds + SIDE_OFF};
          pg8::gemm_phase<pg8::EpiGate, pg8::StaticOrder, PG8_ALIGN, PG8_SP2>(F.lds + RING_OFF, g, S, E); } }
        GRID_BAR();
        ffn_fix_phase(F, BIG, args.in[fb + 2], args.in[fb + 3], ACT2);
        GRID_BAR();
        { pg8::Gemm g{ACT2, (const bf16*)(F.ws + wlo + (mamba ? W_DOWN_M : W_DOWN_A)), M, DM, DFF}; pg8::StaticOrder S; S.init(M, DM, F.G, F.bx);
          pg8::EpiResN E{XR, XR, U, SSQ(2 * layer + 2), DM};
          pg8::gemm_phase<pg8::EpiResN, pg8::StaticOrder, PG8_ALIGN, PG8_SP2>(F.lds + RING_OFF, g, S, E); }
        GRID_BAR();
    }
    {
        const int gw = F.vcu * NWAVES + F.wave, NGW = F.G * NWAVES;
        for (int m = gw; m < M; m += NGW) rms_row_f32(XR + (size_t)m * DM, args.in[56], args.out + (size_t)m * DM, F.lane);
    }
#undef GRID_BAR
#undef XR
#undef U
#undef BIG
#undef ACT2
#undef XT
#undef Yb
#undef Bn
#undef BT
#undef Cn
#undef DTF
#undef PART
#undef OP
#undef SSQ
#undef ropec
#undef ropes
}
}

extern "C" void kernel_launch(void* const* d_in, const int* in_sizes, int n_in, void* d_out, int out_size, void* d_ws, size_t ws_size, hipStream_t stream) {
    using namespace mk;
    static int grid = 0;
    if (grid == 0) {
        if (n_in != 57 || out_size != M * DM || ws_size < WS_END) { fprintf(stderr, "kernel_launch: built for 57 inputs, out of %d floats, >= %zu bytes of workspace; got n_in %d, out %d, ws %zu; nothing launched\n", M * DM, (size_t)WS_END, n_in, out_size, ws_size); grid = -1; return; }
        int dev = 0, cus = 0, per_cu = 0;
        if (hipGetDevice(&dev) != hipSuccess || hipDeviceGetAttribute(&cus, hipDeviceAttributeMultiprocessorCount, dev) != hipSuccess) { fprintf(stderr, "kernel_launch: device query failed\n"); grid = -1; return; }
        if (hipFuncSetAttribute((const void*)trunk_fwd, hipFuncAttributeMaxDynamicSharedMemorySize, LDS_BYTES) != hipSuccess) { fprintf(stderr, "kernel_launch: hipFuncSetAttribute failed\n"); grid = -1; return; }
        if (hipOccupancyMaxActiveBlocksPerMultiprocessor(&per_cu, (const void*)trunk_fwd, NTHR, LDS_BYTES) != hipSuccess || per_cu < 1)
            fprintf(stderr, "kernel_launch: note: occupancy query reports %d workgroups per CU\n", per_cu);
        (void)hipGetLastError();
        grid = cus;
    }
    if (grid < 0) return;
    if (hipMemsetAsync((char*)d_ws + WS_CTL, 0, CTL_ZERO_BYTES, stream) != hipSuccess) { fprintf(stderr, "kernel_launch: memset failed\n"); return; }
    Args a{};
    for (int i = 0; i < 57; ++i) a.in[i] = (const float*)d_in[i];
    a.out = (float*)d_out; a.ws = (unsigned char*)d_ws;
    hipLaunchKernelGGL(trunk_fwd, dim3(grid), dim3(NTHR), LDS_BYTES, stream, a);
    const hipError_t le = hipPeekAtLastError();
    if (le != hipSuccess) fprintf(stderr, "kernel_launch: launch failed: %s\n", hipGetErrorName(le));
}
```

```cpp
#include <hip/hip_runtime.h>
#include <cstdio>
#include <cstdint>
namespace pg8 {
#define PG8_LAS __attribute__((address_space(3)))
typedef unsigned short bf16_t;
typedef short bf16x8 __attribute__((ext_vector_type(8)));
typedef float f32x4 __attribute__((ext_vector_type(4)));
typedef unsigned u32x4 __attribute__((ext_vector_type(4)));
constexpr int BM = 256, BK = 64, HALF = 128, HTB = HALF * BK * 2  , STAGE_BYTES = 8 * HTB, NXCD = 8, WGM = 8;

__host__ __device__ __forceinline__ int lds_byte(int r, int c) { const int st = (r >> 4) * 2 + (c >> 5), rr = r & 15, cc = c & 31, ob = rr * 64 + cc * 2; return st * 1024 + (ob ^ (((ob >> 9) & 1) << 5)); }
__host__ __device__ __forceinline__ void stage_rc(int b, int& R, int& C) { const int st = b / 1024, sb = b % 1024, swz = sb ^ (((sb >> 9) & 1) << 5); R = (st >> 1) * 16 + swz / 64; C = (st & 1) * 32 + (swz % 64) / 2; }
__host__ __device__ __forceinline__ int perm32(int rho) { const int n = rho >> 4, i = rho & 15; return 8 * (i >> 2) + 4 * n + (i & 3); }

struct Unit { int pm, pn; };
struct Gemm { const bf16_t* A; const bf16_t* Bt; int M, N, K; int ld = 0; };

struct StaticOrder {
    int nM, nN, nwg, G, c;
    __host__ __device__ void init(int M, int N, int G_, int c_) { nM = M / BM; nN = N / BM; nwg = nM * nN; G = G_; c = c_; }
    __host__ __device__ bool next(int i, Unit& u) const {
        const long L = (long)i * G + c; if (L >= nwg) return false;
        int wgid = (int)L; { const int q = nwg / NXCD, r = nwg % NXCD, xcd = wgid % NXCD, off = wgid / NXCD; wgid = (xcd < r ? xcd * (q + 1) : r * (q + 1) + (xcd - r) * q) + off; }
        const int nig = WGM * nN, gid = wgid / nig, fm = gid * WGM, gsz = (nM - fm) < WGM ? (nM - fm) : WGM;
        u.pm = fm + ((wgid % nig) % gsz); u.pn = (wgid % nig) / gsz; return true;
    }
    __device__ __forceinline__ void a_ready(const Unit&) const {}
    __device__ __forceinline__ void done(const Unit&) const {}
};

typedef float f32x2c __attribute__((ext_vector_type(2))); typedef __bf16 bf16x2c __attribute__((ext_vector_type(2)));
__device__ __forceinline__ unsigned cvt_pk_bf16(float lo, float hi) { const f32x2c v = {lo, hi}; return __builtin_bit_cast(unsigned, __builtin_convertvector(v, bf16x2c)); }
typedef float f32x2 __attribute__((ext_vector_type(2)));
__device__ __forceinline__ f32x2 gelu_pk(f32x2 v) {
    const f32x2 av = __builtin_elementwise_abs(v), d = av * 0.2316418882f + 1.0f;
    f32x2 t; t.x = __builtin_amdgcn_rcpf(d.x); t.y = __builtin_amdgcn_rcpf(d.y);
    f32x2 q = t * 0.5307027145f + (-0.7265760135f); q = q * t + 0.7107068705f; q = q * t + (-0.142248368f); q = q * t + 0.127414796f; q = q * t;
    const f32x2 s = (v * v) * (-0.72134752044f);
    f32x2 e; e.x = __builtin_amdgcn_exp2f(s.x); e.y = __builtin_amdgcn_exp2f(s.y);
    const f32x2 m = v * (q * e), r = v - m;
    f32x2 o; o.x = v.x < 0.f ? m.x : r.x; o.y = v.y < 0.f ? m.y : r.y; return o;
}

template <int ACT  > struct EpiBf16 {
    static constexpr bool PERM = true, AFTER_DRAIN = false; static_assert(ACT == 0 || ACT == 1, "EpiBf16: ACT is 0 (none) or 1 (gelu_pk)");
    bf16_t* O; int ldc; const float* bias; int split_cols; size_t split_stride; float scale0;
    __device__ __forceinline__ void operator()(const f32x4 (&acc)[2][2][4][2], const Unit& u, int wr, int wc, int fr, int fq) const {
        const int row0 = u.pm * BM + wr * 64 + fr; int colt = u.pn * BM; bf16_t* base = O;
        float sc = 1.f; if (split_cols) { const int t = colt / split_cols; base += (size_t)t * split_stride; colt -= t * split_cols; if (t == 0) sc = scale0; }
        const int col0 = colt + wc * 32 + 8 * fq, bcol0 = u.pn * BM + wc * 32 + 8 * fq;
        f32x4 bv[2][2];
#pragma unroll
        for (int bj = 0; bj < 2; ++bj)
#pragma unroll
            for (int n = 0; n < 2; ++n) bv[bj][n] = bias ? *(const f32x4*)(bias + bcol0 + bj * HALF + 4 * n) : (f32x4){0.f, 0.f, 0.f, 0.f};
#pragma unroll
        for (int ai = 0; ai < 2; ++ai)
#pragma unroll
            for (int m = 0; m < 4; ++m) { bf16_t* rowp = base + (size_t)(row0 + ai * HALF + m * 16) * ldc + col0;
#pragma unroll
                for (int bj = 0; bj < 2; ++bj) { f32x4 v0 = acc[ai][bj][m][0] + bv[bj][0], v1 = acc[ai][bj][m][1] + bv[bj][1];
                    if (ACT == 1) { f32x2 a = gelu_pk((f32x2){v0[0], v0[1]}), b = gelu_pk((f32x2){v0[2], v0[3]}), c = gelu_pk((f32x2){v1[0], v1[1]}), d = gelu_pk((f32x2){v1[2], v1[3]});
                        v0 = (f32x4){a.x, a.y, b.x, b.y}; v1 = (f32x4){c.x, c.y, d.x, d.y}; }
                    v0 = v0 * sc; v1 = v1 * sc; u32x4 w; w.x = cvt_pk_bf16(v0[0], v0[1]); w.y = cvt_pk_bf16(v0[2], v0[3]); w.z = cvt_pk_bf16(v1[0], v1[1]); w.w = cvt_pk_bf16(v1[2], v1[3]);
                    *(u32x4*)(rowp + bj * HALF) = w; } }
    }
};


struct EpiRes {
    static constexpr bool PERM = false, AFTER_DRAIN = false;
    const float* base; float* out; int ldc;
    __device__ __forceinline__ void operator()(const f32x4 (&acc)[2][2][4][2], const Unit& u, int wr, int wc, int fr, int fq) const {
        const int col0 = u.pn * BM + wc * 32 + 4 * fq;
#pragma unroll
        for (int ai = 0; ai < 2; ++ai)
#pragma unroll
            for (int m = 0; m < 4; ++m) { const size_t off = (size_t)(u.pm * BM + ai * HALF + wr * 64 + m * 16 + fr) * ldc + col0;
#pragma unroll
                for (int bj = 0; bj < 2; ++bj)
#pragma unroll
                    for (int n = 0; n < 2; ++n) { const f32x4 bs = *(const f32x4*)(base + off + bj * HALF + n * 16); *(f32x4*)(out + off + bj * HALF + n * 16) = bs + acc[ai][bj][m][n]; }
                if (m & 1) asm volatile("" ::: "memory"); }
    }
};
struct EpiHeadMajor {
    static constexpr bool PERM = true, AFTER_DRAIN = false;
    bf16_t* O; size_t gstride; const float* cs; const float* sn; const unsigned long long* ss; const PG8_LAS float* tab; int pm0, ntab;
    __device__ __forceinline__ void operator()(const f32x4 (&acc)[2][2][4][2], const Unit& u, int wr, int wc, int fr, int fq) const {
        const int row0 = u.pm * BM + wr * 64 + fr, col0 = wc * 32 + 8 * fq; const bool rope = u.pn < 32, intab = (unsigned)(u.pm - pm0) < (unsigned)ntab;
#pragma unroll
        for (int ai = 0; ai < 2; ++ai)
#pragma unroll
            for (int m = 0; m < 4; ++m) { const int row = row0 + ai * HALF + m * 16;
                const float rs = intab ? tab[row - pm0 * BM] : 1.0f / sqrtf((float)ss[row] * (1.0f / (4096.0f * 16777216.0f)) + 1e-5f);
                f32x4 c4 = {1.f, 1.f, 1.f, 1.f}, s4 = {0.f, 0.f, 0.f, 0.f};
                if (rope) { c4 = *(const f32x4*)(cs + (size_t)row * 64 + 16 * wc + 4 * fq); s4 = *(const f32x4*)(sn + (size_t)row * 64 + 16 * wc + 4 * fq); }
#pragma unroll
                for (int bj = 0; bj < 2; ++bj) { bf16_t* rowp = O + (size_t)(u.pn * 2 + bj) * gstride + (size_t)row * 128 + col0;
                    const f32x4 v0 = acc[ai][bj][m][0] * rs, v1 = acc[ai][bj][m][1] * rs;
                    const f32x4 r0 = {v0[0] * c4[0] - v0[1] * s4[0], v0[1] * c4[0] + v0[0] * s4[0], v0[2] * c4[1] - v0[3] * s4[1], v0[3] * c4[1] + v0[2] * s4[1]};
                    const f32x4 r1 = {v1[0] * c4[2] - v1[1] * s4[2], v1[1] * c4[2] + v1[0] * s4[2], v1[2] * c4[3] - v1[3] * s4[3], v1[3] * c4[3] + v1[2] * s4[3]};
                    u32x4 w; w.x = cvt_pk_bf16(r0[0], r0[1]); w.y = cvt_pk_bf16(r0[2], r0[3]); w.z = cvt_pk_bf16(r1[0], r1[1]); w.w = cvt_pk_bf16(r1[2], r1[3]);
                    *(u32x4*)rowp = w; } }
    }
};
struct EpiBf16S {
    static constexpr bool PERM = true, AFTER_DRAIN = false;
    bf16_t* O; int ldc; const unsigned long long* ss; const PG8_LAS float* tab; int pm0, ntab;
    __device__ __forceinline__ void operator()(const f32x4 (&acc)[2][2][4][2], const Unit& u, int wr, int wc, int fr, int fq) const {
        const int row0 = u.pm * BM + wr * 64 + fr, col0 = u.pn * BM + wc * 32 + 8 * fq; const bool intab = (unsigned)(u.pm - pm0) < (unsigned)ntab;
#pragma unroll
        for (int ai = 0; ai < 2; ++ai)
#pragma unroll
            for (int m = 0; m < 4; ++m) { const int row = row0 + ai * HALF + m * 16;
                const float rs = intab ? tab[row - pm0 * BM] : 1.0f / sqrtf((float)ss[row] * (1.0f / (4096.0f * 16777216.0f)) + 1e-5f);
                bf16_t* rowp = O + (size_t)row * ldc + col0;
#pragma unroll
                for (int bj = 0; bj < 2; ++bj) { const f32x4 v0 = acc[ai][bj][m][0] * rs, v1 = acc[ai][bj][m][1] * rs;
                    u32x4 w; w.x = cvt_pk_bf16(v0[0], v0[1]); w.y = cvt_pk_bf16(v0[2], v0[3]); w.z = cvt_pk_bf16(v1[0], v1[1]); w.w = cvt_pk_bf16(v1[2], v1[3]);
                    *(u32x4*)(rowp + bj * HALF) = w; } }
    }
};
template <int C, bool BC> __device__ __forceinline__ float eg_dpp(float x) { return __int_as_float(__builtin_amdgcn_update_dpp(0, __float_as_int(x), C, 0xf, 0xf, BC)); }
#define EG_DPP(x, c, bc) eg_dpp<c, bc>(x)
#define EG_SHR1(x) EG_DPP(x, 0x111, true)
#define EG_SHR2(x) EG_DPP(x, 0x112, true)
#define EG_MIR(x) EG_DPP(x, 0x140, false)
#define EG_SWP(x) EG_DPP(x, 0xB1, false)
struct EpiGate {
    static constexpr bool PERM = true, AFTER_DRAIN = false;
    bf16_t* GA; bf16_t* HB; const float* cw; const float* cb; int nup, dff; const unsigned long long* ss; PG8_LAS unsigned char* side;
    __device__ __forceinline__ void prefetch(const Unit& nx, int par, int wid, int lane) const {
        const float* base = (wid < 3 ? cw + (size_t)wid * nup : wid < 6 ? cw + (size_t)(wid - 3) * nup + dff : wid == 6 ? cb : cb + dff) + nx.pn * 128 + lane;
        PG8_LAS unsigned char* d = side + par * 4096 + wid * 512;
        __builtin_amdgcn_global_load_lds((const unsigned*)base, (PG8_LAS unsigned*)d, 4, 0, 0);
        __builtin_amdgcn_global_load_lds((const unsigned*)(base + 64), (PG8_LAS unsigned*)(d + 256), 4, 0, 0);
        __builtin_amdgcn_global_load_lds((const unsigned*)(ss + (size_t)nx.pm * BM) + wid * 64 + lane, (PG8_LAS unsigned*)(side + 8192 + par * 2048 + wid * 256), 4, 0, 0);
    }
    __device__ __forceinline__ void run(const f32x4 (&acc)[2][2][4][2], const Unit& u, int par, int wr, int wc, int fr, int fq) const {
        typedef unsigned u32x2 __attribute__((ext_vector_type(2)));
        const int ch0 = u.pn * 128 + wc * 32 + 8 * fq;
        float rsv[2][4]; { const PG8_LAS unsigned long long* sl = (const PG8_LAS unsigned long long*)(side + 8192 + par * 2048) + wr * 64 + fr;
#pragma unroll
            for (int ai = 0; ai < 2; ++ai)
#pragma unroll
                for (int m = 0; m < 4; ++m) rsv[ai][m] = __builtin_amdgcn_rsqf((float)sl[ai * 128 + m * 16] * (1.0f / (4096.0f * 16777216.0f)) + 1e-5f); }
        const bool f0 = fr == 0, f01 = fr < 2;
#pragma unroll
        for (int n = 0; n < 2; ++n) { const int ch = ch0 + 4 * n;
            const PG8_LAS f32x4* wp = (const PG8_LAS f32x4*)(side + par * 4096) + (wc * 8 + 2 * fq + n);
            const f32x4 wg0 = wp[0], wg1 = wp[32], wg2 = wp[64], wv0 = wp[96], wv1 = wp[128], wv2 = wp[160], bg = wp[192], bv = wp[224];
#pragma unroll
            for (int ai = 0; ai < 2; ++ai) { f32x4 pg1 = {0.f, 0.f, 0.f, 0.f}, pg2 = pg1, pv1 = pg1, pv2 = pg1;
#pragma unroll
                for (int m = 0; m < 4; ++m) { const int row = u.pm * BM + ai * HALF + wr * 64 + m * 16 + fr;
                    const float rs = rsv[ai][m];
                    const f32x4 g = acc[ai][0][m][n] * rs, v = acc[ai][1][m][n] * rs; f32x4 g1, g2, v1, v2, o;
#pragma unroll
                    for (int e = 0; e < 4; ++e) { g1[e] = EG_SHR1(g[e]); g2[e] = EG_SHR2(g[e]); v1[e] = EG_SHR1(v[e]); v2[e] = EG_SHR2(v[e]); }
#pragma unroll
                    for (int e = 0; e < 4; ++e) { const float tg1 = f0 ? pg1[e] : g1[e], tg2 = f01 ? pg2[e] : g2[e], tv1 = f0 ? pv1[e] : v1[e], tv2 = f01 ? pv2[e] : v2[e];
                        const float a = bg[e] + wg0[e] * tg2 + wg1[e] * tg1 + wg2[e] * g[e], b = bv[e] + wv0[e] * tv2 + wv1[e] * tv1 + wv2[e] * v[e];
                        o[e] = a * __builtin_amdgcn_rcpf(1.f + __expf(-a)) * b; }
                    if (m > 0 || !f01) { u32x2 w; w.x = cvt_pk_bf16(o[0], o[1]); w.y = cvt_pk_bf16(o[2], o[3]); *(u32x2*)(GA + (size_t)row * dff + ch) = w; }
                    if ((m == 0 && f01) || (m == 3 && fr >= 14)) { const int j = (m == 0) ? fr : fr - 12;
                        bf16_t* hp = HB + (size_t)(((row >> 6) * 4 + j) * 2) * dff + ch;
                        u32x2 wg_; wg_.x = cvt_pk_bf16(g[0], g[1]); wg_.y = cvt_pk_bf16(g[2], g[3]); *(u32x2*)hp = wg_;
                        u32x2 wv_; wv_.x = cvt_pk_bf16(v[0], v[1]); wv_.y = cvt_pk_bf16(v[2], v[3]); *(u32x2*)(hp + dff) = wv_; }
#pragma unroll
                    for (int e = 0; e < 4; ++e) { pg1[e] = EG_MIR(g[e]); pg2[e] = EG_SWP(pg1[e]); pv1[e] = EG_MIR(v[e]); pv2[e] = EG_SWP(pv1[e]); }
                } } }
    }
};
#undef EG_SHR1
#undef EG_SHR2
#undef EG_MIR
#undef EG_SWP
#undef EG_DPP
template <class T> struct epi_pf { static constexpr bool v = false; };
template <> struct epi_pf<EpiGate> { static constexpr bool v = true; };
struct EpiResN {
    static constexpr bool PERM = false, AFTER_DRAIN = false;
    const float* base; float* out; bf16_t* xb; unsigned long long* ss; int ldc;
    __device__ __forceinline__ void operator()(const f32x4 (&acc)[2][2][4][2], const Unit& u, int wr, int wc, int fr, int fq) const {
        const int col0 = u.pn * BM + wc * 32 + 4 * fq;
        int l = threadIdx.x; asm volatile("" : "+v"(l)); l &= 63;
        typedef unsigned u32x2 __attribute__((ext_vector_type(2)));
        const size_t off0 = (size_t)(u.pm * BM + wr * 64 + fr) * ldc + col0;
        const int ucol = (fq & 1) ? 12 + 4 * fq : 4 * fq;
        f32x4 bsA[2][2][2], bsB[2][2][2];
#define ERN_LOAD(dst, b_) do { _Pragma("unroll") for (int mm = 0; mm < 2; ++mm) _Pragma("unroll") for (int bj = 0; bj < 2; ++bj) _Pragma("unroll") for (int n = 0; n < 2; ++n) \
            dst[mm][bj][n] = *(const f32x4*)(base + off0 + (size_t)(((b_) >> 1) * HALF + (((b_) & 1) * 2 + mm) * 16) * ldc + bj * HALF + n * 16); } while (0)
#define ERN_DO(src, b_) do { _Pragma("unroll") for (int mm = 0; mm < 2; ++mm) { const int ai = (b_) >> 1, m = ((b_) & 1) * 2 + mm; const int row = u.pm * BM + ai * HALF + wr * 64 + m * 16 + fr; \
            const size_t off = off0 + (size_t)(ai * HALF + m * 16) * ldc; float q = 0.f; \
            _Pragma("unroll") for (int bj = 0; bj < 2; ++bj) { const f32x4 o0 = src[mm][bj][0] + acc[ai][bj][m][0], o1 = src[mm][bj][1] + acc[ai][bj][m][1]; \
                *(f32x4*)(out + off + bj * HALF) = o0; *(f32x4*)(out + off + bj * HALF + 16) = o1; \
                q += ((o0[0] * o0[0] + o0[1] * o0[1]) + (o0[2] * o0[2] + o0[3] * o0[3])) + ((o1[0] * o1[0] + o1[1] * o1[1]) + (o1[2] * o1[2] + o1[3] * o1[3])); \
                  \
                const auto r0 = __builtin_amdgcn_permlane16_swap(cvt_pk_bf16(o0[0], o0[1]), cvt_pk_bf16(o1[0], o1[1]), false, false); \
                const auto r1 = __builtin_amdgcn_permlane16_swap(cvt_pk_bf16(o0[2], o0[3]), cvt_pk_bf16(o1[2], o1[3]), false, false); \
                u32x4 w; w.x = r0[0]; w.y = r1[0]; w.z = r0[1]; w.w = r1[1]; \
                *(u32x4*)(xb + off - 4 * fq + ucol + bj * HALF) = w; } \
            q += __builtin_bit_cast(float, __builtin_amdgcn_ds_bpermute((l ^ 16) << 2, __builtin_bit_cast(int, q))); \
            q += __builtin_bit_cast(float, __builtin_amdgcn_ds_bpermute((l ^ 32) << 2, __builtin_bit_cast(int, q))); \
            if (fq == 0) atomicAdd(ss + row, (unsigned long long)__float2ll_rn(q * 16777216.0f)); } } while (0)
        ERN_LOAD(bsA, 0); ERN_LOAD(bsB, 1); asm volatile("" ::: "memory");
        ERN_DO(bsA, 0); asm volatile("" ::: "memory"); ERN_LOAD(bsA, 2); asm volatile("" ::: "memory");
        ERN_DO(bsB, 1); asm volatile("" ::: "memory"); ERN_LOAD(bsB, 3); asm volatile("" ::: "memory");
        ERN_DO(bsA, 2); asm volatile("" ::: "memory");
        ERN_DO(bsB, 3);
#undef ERN_LOAD
#undef ERN_DO
    }
};
struct EpiPart {
    static constexpr bool PERM = false, AFTER_DRAIN = false;
    float* P;
    __device__ __forceinline__ void operator()(const f32x4 (&acc)[2][2][4][2], const Unit& u, int wr, int wc, int fr, int fq) const {
#pragma unroll
        for (int ai = 0; ai < 2; ++ai)
#pragma unroll
            for (int m = 0; m < 4; ++m) { float* rowp = P + (size_t)(u.pm * BM + ai * HALF + wr * 64 + m * 16 + fr) * 128 + wc * 32 + 4 * fq;
#pragma unroll
                for (int n = 0; n < 2; ++n) *(f32x4*)(rowp + n * 16) = acc[ai][0][m][n]; }
    }
};
struct OneUnit {
    int pm, valid;
    __device__ __forceinline__ bool next(int i, Unit& u) const { if (i != 0 || !valid) return false; u.pm = pm; u.pn = 0; return true; }
    __device__ __forceinline__ void a_ready(const Unit&) const {}
    __device__ __forceinline__ void done(const Unit&) const {}
};
struct EpiNull {
    static constexpr bool PERM = true, AFTER_DRAIN = false;
    __device__ __forceinline__ void operator()(const f32x4 (&acc)[2][2][4][2], const Unit& u, int wr, int wc, int fr, int fq) const {
        float s = 0.f;
#pragma unroll
        for (int ai = 0; ai < 2; ++ai)
#pragma unroll
            for (int bj = 0; bj < 2; ++bj)
#pragma unroll
                for (int m = 0; m < 4; ++m)
#pragma unroll
                    for (int n = 0; n < 2; ++n) s += acc[ai][bj][m][n][0] + acc[ai][bj][m][n][1] + acc[ai][bj][m][n][2] + acc[ai][bj][m][n][3];
        if (s == 1.2345e-30f) asm volatile("s_nop 0" ::: "memory");
    }
};
template <class Epi, class Sched, bool ALIGN_EPI = false, bool SP2 = false>
__device__ __forceinline__ void gemm_phase(PG8_LAS unsigned char* lds, const Gemm g, const Sched& S, const Epi& E) {
    int tid_l_ = threadIdx.x; asm volatile("" : "+v"(tid_l_)); const int tid = tid_l_, wid = __builtin_amdgcn_readfirstlane(tid >> 6), lane = tid & 63, wr = wid >> 2, wc = wid & 3, fr = lane & 15, fq = lane >> 4;
    const int nt = g.K / BK, K = g.ld ? g.ld : g.K;
    unsigned voffA[2], voffB[2];
#pragma unroll
    for (int i = 0; i < 2; ++i) { int R, C; stage_rc(tid * 16 + i * 8192, R, C); const int Rb = Epi::PERM ? ((R & ~31) + perm32(R & 31)) : R;
        voffA[i] = (unsigned)(R * K + C) * 2u; voffB[i] = (unsigned)(Rb * K + C) * 2u; }
    const size_t kstep = (size_t)(BK * 2);
    const size_t hstep = (size_t)HALF * K * 2;
    const size_t tstep = 2 * hstep;
    const unsigned ldsw = (unsigned)wid * 1024u;
    const int aoff = lds_byte(wr * 64 + fr, fq * 8), boff = lds_byte(wc * 32 + fr, fq * 8);
#define PG8_SA(b, h) (((b) * 2 + (h)) * HTB)
#define PG8_SB(b, h) ((4 + (b) * 2 + (h)) * HTB)
#define PG8_STAGE(bufoff, gbase, voff) do { _Pragma("unroll") for (int _i = 0; _i < 2; ++_i) \
        __builtin_amdgcn_global_load_lds((const unsigned*)((const char*)(gbase) + (voff)[_i]), (PG8_LAS unsigned*)(lds + (bufoff) + ldsw + _i * 8192), 16, 0, 0); } while (0)
#define PG8_LDA(dst, b, h) do { _Pragma("unroll") for (int m = 0; m < 4; ++m) _Pragma("unroll") for (int k = 0; k < 2; ++k) dst[m][k] = *(const PG8_LAS bf16x8*)(lds + PG8_SA(b, h) + aoff + m * 2048 + k * 1024); } while (0)
#define PG8_LDB(dst, b, h) do { _Pragma("unroll") for (int n = 0; n < 2; ++n) _Pragma("unroll") for (int k = 0; k < 2; ++k) dst[n][k] = *(const PG8_LAS bf16x8*)(lds + PG8_SB(b, h) + boff + n * 2048 + k * 1024); } while (0)
#define PG8_MMA(ai, bj, At, Bt) do { __builtin_amdgcn_s_setprio(1); _Pragma("unroll") for (int m = 0; m < 4; ++m) _Pragma("unroll") for (int n = 0; n < 2; ++n) _Pragma("unroll") for (int k = 0; k < 2; ++k) \
        acc[ai][bj][m][n] = __builtin_amdgcn_mfma_f32_16x16x32_bf16(Bt[n][k], At[m][k], acc[ai][bj][m][n], 0, 0, 0); __builtin_amdgcn_s_setprio(0); } while (0)
#define PG8_WAIT_V(n) asm volatile("s_waitcnt vmcnt(" #n ")" ::: "memory")
#define PG8_WAIT_L(n) asm volatile("s_waitcnt lgkmcnt(" #n ")" ::: "memory")
#define PG8_BAR __builtin_amdgcn_s_barrier()
#define PG8_SCHED __builtin_amdgcn_sched_barrier(0)
    Unit cur, nxt; int ui = 0;
    if (!S.next(0, cur)) return;
    f32x4 acc[2][2][4][2];
#pragma unroll
    for (int a = 0; a < 2; ++a)
#pragma unroll
        for (int b = 0; b < 2; ++b)
#pragma unroll
            for (int m = 0; m < 4; ++m)
#pragma unroll
                for (int n = 0; n < 2; ++n) acc[a][b][m][n] = (f32x4){0.f, 0.f, 0.f, 0.f};
    bf16x8 At[4][2], B0[2][2], B1[2][2];
    const char* cA = (const char*)g.A + (size_t)cur.pm * tstep; const char* cB = (const char*)g.Bt + (size_t)cur.pn * tstep;
    if constexpr (epi_pf<Epi>::v) E.prefetch(cur, 0, wid, lane);
    S.a_ready(cur);
    if constexpr (SP2) {
        PG8_STAGE(PG8_SB(0, 0), cB, voffB); PG8_STAGE(PG8_SB(0, 1), cB + hstep, voffB); PG8_STAGE(PG8_SA(0, 0), cA, voffA); PG8_STAGE(PG8_SA(0, 1), cA + hstep, voffA);
        if (wr == 1) PG8_BAR;
        PG8_WAIT_V(2); PG8_BAR;
        PG8_STAGE(PG8_SB(1, 0), cB + kstep, voffB); PG8_STAGE(PG8_SA(1, 0), cA + kstep, voffA); PG8_STAGE(PG8_SB(1, 1), cB + hstep + kstep, voffB);
        PG8_WAIT_V(6); PG8_BAR;
    } else {
        PG8_STAGE(PG8_SB(0, 0), cB, voffB); PG8_STAGE(PG8_SA(0, 0), cA, voffA); PG8_STAGE(PG8_SB(0, 1), cB + hstep, voffB); PG8_STAGE(PG8_SA(0, 1), cA + hstep, voffA);
        if (wr == 1) PG8_BAR;
        PG8_WAIT_V(4); PG8_BAR;
        PG8_STAGE(PG8_SB(1, 0), cB + kstep, voffB); PG8_STAGE(PG8_SA(1, 0), cA + kstep, voffA); PG8_STAGE(PG8_SB(1, 1), cB + hstep + kstep, voffB);
        PG8_WAIT_V(6); PG8_BAR;
    }
    for (;;) {
        const bool has_next = S.next(ui + 1, nxt);
        const char* nA = has_next ? (const char*)g.A + (size_t)nxt.pm * tstep : cA; const char* nB = has_next ? (const char*)g.Bt + (size_t)nxt.pn * tstep : cB;
        for (int t = 0; t < nt; t += 2) {
            const bool last = (t == nt - 2);
            const char* a1 = cA + (size_t)(t + 1) * kstep;
            const char* a2 = last ? nA : cA + (size_t)(t + 2) * kstep; const char* b2 = last ? nB : cB + (size_t)(t + 2) * kstep;
            const char* a3 = a2 + kstep; const char* b3 = b2 + kstep;
            if (last && has_next) S.a_ready(nxt);
            if constexpr (SP2) {
            PG8_LDB(B0, 0, 0); PG8_LDB(B1, 0, 1); PG8_SCHED; PG8_LDA(At, 0, 0); PG8_STAGE(PG8_SA(1, 1), a1 + hstep, voffA);
            PG8_WAIT_V(8); PG8_WAIT_L(0); PG8_BAR; PG8_MMA(0, 0, At, B0); PG8_MMA(0, 1, At, B1); PG8_BAR; PG8_SCHED;
            PG8_LDA(At, 0, 1); PG8_STAGE(PG8_SB(0, 0), b2, voffB); PG8_STAGE(PG8_SB(0, 1), b2 + hstep, voffB); PG8_STAGE(PG8_SA(0, 0), a2, voffA);
            PG8_WAIT_V(8); PG8_WAIT_L(0); PG8_BAR; PG8_MMA(1, 0, At, B0); PG8_MMA(1, 1, At, B1); PG8_BAR; PG8_SCHED;
            PG8_LDB(B0, 1, 0); PG8_LDB(B1, 1, 1); PG8_SCHED; PG8_LDA(At, 1, 0); PG8_STAGE(PG8_SA(0, 1), a2 + hstep, voffA);
            PG8_WAIT_V(8); PG8_WAIT_L(0); PG8_BAR; PG8_MMA(0, 0, At, B0); PG8_MMA(0, 1, At, B1); PG8_BAR; PG8_SCHED;
            PG8_LDA(At, 1, 1); PG8_STAGE(PG8_SB(1, 0), b3, voffB); PG8_STAGE(PG8_SB(1, 1), b3 + hstep, voffB); PG8_STAGE(PG8_SA(1, 0), a3, voffA);
            PG8_WAIT_V(8); PG8_WAIT_L(0); PG8_BAR; PG8_MMA(1, 0, At, B0); PG8_MMA(1, 1, At, B1); PG8_BAR; PG8_SCHED;
            } else {
            PG8_LDB(B0, 0, 0); PG8_SCHED; PG8_LDA(At, 0, 0); PG8_STAGE(PG8_SA(1, 1), a1 + hstep, voffA);
            PG8_WAIT_L(8); PG8_BAR; PG8_WAIT_L(0); PG8_MMA(0, 0, At, B0); PG8_BAR; PG8_SCHED;
            PG8_LDB(B1, 0, 1); PG8_STAGE(PG8_SB(0, 0), b2, voffB);
            PG8_BAR; PG8_WAIT_L(0); PG8_MMA(0, 1, At, B1); PG8_BAR;
            PG8_LDA(At, 0, 1); PG8_STAGE(PG8_SA(0, 0), a2, voffA);
            PG8_BAR; PG8_WAIT_L(0); PG8_MMA(1, 0, At, B0); PG8_BAR; PG8_SCHED;
            PG8_STAGE(PG8_SB(0, 1), b2 + hstep, voffB);
            PG8_WAIT_V(6); PG8_BAR; PG8_MMA(1, 1, At, B1); PG8_BAR;
            PG8_LDB(B0, 1, 0); PG8_SCHED; PG8_LDA(At, 1, 0); PG8_STAGE(PG8_SA(0, 1), a2 + hstep, voffA);
            PG8_WAIT_L(8); PG8_BAR; PG8_WAIT_L(0); PG8_MMA(0, 0, At, B0); PG8_BAR; PG8_SCHED;
            PG8_LDB(B1, 1, 1); PG8_STAGE(PG8_SB(1, 0), b3, voffB);
            PG8_BAR; PG8_WAIT_L(0); PG8_MMA(0, 1, At, B1); PG8_BAR;
            PG8_LDA(At, 1, 1); PG8_STAGE(PG8_SA(1, 0), a3, voffA);
            PG8_BAR; PG8_WAIT_L(0); PG8_MMA(1, 0, At, B0); PG8_BAR; PG8_SCHED;
            PG8_STAGE(PG8_SB(1, 1), b3 + hstep, voffB);
            PG8_WAIT_V(6); PG8_BAR; PG8_MMA(1, 1, At, B1); PG8_BAR;
            }
        }
        if constexpr (ALIGN_EPI) { if (wr == 0) PG8_BAR; }
        if constexpr (epi_pf<Epi>::v) { if (has_next) E.prefetch(nxt, (ui + 1) & 1, wid, lane); E.run(acc, cur, ui & 1, wr, wc, fr, fq); S.done(cur); } else
        if constexpr (!Epi::AFTER_DRAIN) { E(acc, cur, wr, wc, fr, fq); S.done(cur); }
        if (!has_next) break;
#pragma unroll
        for (int a = 0; a < 2; ++a)
#pragma unroll
            for (int b = 0; b < 2; ++b)
#pragma unroll
                for (int m = 0; m < 4; ++m)
#pragma unroll
                    for (int n = 0; n < 2; ++n) acc[a][b][m][n] = (f32x4){0.f, 0.f, 0.f, 0.f};
        cur = nxt; cA = nA; cB = nB; ++ui;
        if constexpr (ALIGN_EPI) { if (wr == 1) PG8_BAR; }
    }
    PG8_WAIT_V(0);
    if constexpr (!ALIGN_EPI) { if (wr == 0) PG8_BAR; }
    PG8_BAR;
    if constexpr (Epi::AFTER_DRAIN) { E.fused(acc, cur, wr, wc, fr, fq, lds, wid, lane); S.done(cur); }
#undef PG8_SA
#undef PG8_SB
#undef PG8_STAGE
#undef PG8_LDA
#undef PG8_LDB
#undef PG8_MMA
#undef PG8_WAIT_V
#undef PG8_WAIT_L
#undef PG8_BAR
#undef PG8_SCHED
}
}

#ifndef PG8_SP2
#define PG8_SP2 true
#endif
#ifndef PG8_ALIGN
#define PG8_ALIGN true
#endif

namespace att {
constexpr int D = 128;
constexpr float SCALE = 0.08838834764831845f;
constexpr float THR = 8.f;
constexpr bool WSKIP = false;
constexpr int NW = 8, QBLK = 32, KVBLK = 64, QB = NW * QBLK;
constexpr int SHM_V = KVBLK * D * 2, SHM_K = KVBLK * D * 2;
constexpr int LDS_BYTES = 2 * SHM_V + 2 * SHM_K + NW * 64 * 4;
typedef unsigned short bf16;
typedef short bf16x8 __attribute__((ext_vector_type(8)));
typedef short s16x4 __attribute__((ext_vector_type(4)));
typedef float f32x16 __attribute__((ext_vector_type(16)));
typedef float f32x4 __attribute__((ext_vector_type(4)));
typedef unsigned u32x4 __attribute__((ext_vector_type(4)));
template <class A, class Bt> struct same_t { static constexpr bool v = false; };
template <class A> struct same_t<A, A> { static constexpr bool v = true; };

#define KSWZ(row, colB) ((row) * 256 + ((colB) ^ (((row) & 7) << 4)))
#define SBAR() __builtin_amdgcn_sched_barrier(0)
__device__ __forceinline__ int v_st(int k, int c) { const int kk = (k & ~0xC) | ((k & 4) << 1) | ((k & 8) >> 1); return ((kk >> 3) * 4 + (c >> 5)) * 512 + ((kk & 7) * 32 + (c & 31)) * 2; }
__device__ __forceinline__ int v_rd_base(int lane) { return ((lane & 3) << 3) | (((lane >> 2) & 3) << 6) | (((lane >> 4) & 1) << 5) | (((lane >> 5) & 1) << 8); }
constexpr int v_rd_off(int d0, int ks, int half) { return d0 * 512 + ks * 4096 + half * 2048; }
__device__ __forceinline__ int crow(int r, int hi) { return (r & 3) + 8 * (r >> 2) + 4 * hi; }
typedef float f32x2a __attribute__((ext_vector_type(2))); typedef __bf16 bf16x2a __attribute__((ext_vector_type(2)));
__device__ __forceinline__ unsigned cvtpk(float lo, float hi) { const f32x2a v = {lo, hi}; return __builtin_bit_cast(unsigned, __builtin_convertvector(v, bf16x2a)); }
__device__ __forceinline__ bf16x8 pack8(f32x4 a, f32x4 b) {
    u32x4 w = {cvtpk(a[0], a[1]), cvtpk(a[2], a[3]), cvtpk(b[0], b[1]), cvtpk(b[2], b[3])};
    return *reinterpret_cast<bf16x8*>(&w);
}
template <class T> __device__ __forceinline__ bf16x8 load8(const T* p) {
    if constexpr (same_t<T, float>::v) { return pack8(*(const f32x4*)p, *(const f32x4*)(p + 4)); }
    else { return *reinterpret_cast<const bf16x8*>(p); }
}
__device__ __forceinline__ void mask_tile(f32x16& p0, f32x16& p1, int dq, unsigned W) {
    const float NEG = -__builtin_inff();
#pragma unroll
    for (int r = 0; r < 16; ++r) {
        const int c = (r & 3) + 8 * (r >> 2);
        if ((unsigned)(dq - c) >= W) p0[r] = NEG;
        if ((unsigned)(dq - c - 32) >= W) p1[r] = NEG;
    }
}
__device__ __forceinline__ void partialSM(f32x16& p0, f32x16& p1, float& m_reg, float& mn, float& alpha) {
    float pmax = p0[0]; for (int r = 1; r < 16; ++r) pmax = fmaxf(pmax, p0[r]); for (int r = 0; r < 16; ++r) pmax = fmaxf(pmax, p1[r]);
    { auto rr = __builtin_amdgcn_permlane32_swap(__float_as_uint(pmax), __float_as_uint(pmax), false, false);
      pmax = fmaxf(__uint_as_float(rr[0]), __uint_as_float(rr[1])); }
    constexpr float C2 = 1.4426950408889634f * SCALE;
    if (__builtin_expect(__all((pmax - m_reg) * SCALE <= THR), 1)) { mn = m_reg; alpha = 1.f; }
    else { mn = fmaxf(m_reg, pmax); alpha = __builtin_amdgcn_exp2f((m_reg - mn) * C2); m_reg = mn; }
    const float mnL = -mn * C2;
    for (int r = 0; r < 16; ++r) p0[r] = fmaf(p0[r], C2, mnL); for (int r = 0; r < 16; ++r) p1[r] = fmaf(p1[r], C2, mnL);
    for (int r = 0; r < 16; ++r) p0[r] = __builtin_amdgcn_exp2f(p0[r]);
}
__device__ __forceinline__ void finishSM(f32x16& p0, f32x16& p1, float alpha, float& l_reg, bf16x8& pa0, bf16x8& pa1, bf16x8& pa2, bf16x8& pa3) {
    for (int r = 0; r < 16; ++r) p1[r] = __builtin_amdgcn_exp2f(p1[r]);
    float ps = 0; for (int r = 0; r < 16; ++r) ps += p0[r]; for (int r = 0; r < 16; ++r) ps += p1[r];
    { auto rr = __builtin_amdgcn_permlane32_swap(__float_as_uint(ps), __float_as_uint(ps), false, false);
      ps = __uint_as_float(rr[0]) + __uint_as_float(rr[1]); }
    l_reg = l_reg * alpha + ps;
#define PK4(P, B_, OUT) do { unsigned a0 = cvtpk(P[B_+0], P[B_+1]), a1 = cvtpk(P[B_+2], P[B_+3]);                          \
        unsigned b0 = cvtpk(P[B_+4], P[B_+5]), b1 = cvtpk(P[B_+6], P[B_+7]);                                             \
        auto r0 = __builtin_amdgcn_permlane32_swap(a0, b0, false, false); auto r1 = __builtin_amdgcn_permlane32_swap(a1, b1, false, false); \
        u32x4 w = {r0[0], r1[0], r0[1], r1[1]}; OUT = *reinterpret_cast<bf16x8*>(&w); } while (0)
    PK4(p0, 0, pa0); PK4(p0, 8, pa1); PK4(p1, 0, pa2); PK4(p1, 8, pa3);
#undef PK4
}
template <int KB, bool SK>
__device__ __forceinline__ void qkt(f32x16& p0, f32x16& p1, const char* K_lds, int r32, int hi, const bf16x8* qr, bool act) {
    if (SK && !act) { const float NEG = -__builtin_inff();
#pragma unroll
        for (int r = 0; r < 16; ++r) { p0[r] = NEG; p1[r] = NEG; } return; }
    p0 = f32x16{}; p1 = f32x16{};
    const char* kb[4];
#pragma unroll
    for (int dd = 0; dd < 4; ++dd) kb[dd] = K_lds + KB * SHM_K + KSWZ(r32, (dd * 16 + hi * 8) * 2);
#pragma unroll
    for (int d0 = 0; d0 < 8; ++d0) { const char* a = kb[d0 & 3] + (d0 >> 2) * 128;
        bf16x8 b0 = *reinterpret_cast<const bf16x8*>(a);
        bf16x8 b1 = *reinterpret_cast<const bf16x8*>(a + 32 * 256);
        p0 = __builtin_amdgcn_mfma_f32_32x32x16_bf16(b0, qr[d0], p0, 0, 0, 0);
        p1 = __builtin_amdgcn_mfma_f32_32x32x16_bf16(b1, qr[d0], p1, 0, 0, 0); }
}
template <int VB, bool SK>
__device__ __forceinline__ void pv_tile(f32x16* o, int vb0, bf16x8 pa0, bf16x8 pa1, bf16x8 pa2, bf16x8 pa3, bool act) {
    if (SK && !act) return;
#define TRRD(dst, off) asm volatile("ds_read_b64_tr_b16 %0, %1 offset:%2" : "=&v"(dst) : "v"(vb0), "i"(off) : "memory")
#define PV_D0(d0) do { s16x4 l0, l1, l2, l3, h0, h1, h2, h3; constexpr int b_ = VB * SHM_V + v_rd_off(d0, 0, 0);     \
        TRRD(l0, b_); TRRD(h0, b_ + 2048); TRRD(l1, b_ + 4096); TRRD(h1, b_ + 6144); TRRD(l2, b_ + 8192); TRRD(h2, b_ + 10240); TRRD(l3, b_ + 12288); TRRD(h3, b_ + 14336); \
        asm volatile("s_waitcnt lgkmcnt(0)" ::: "memory"); SBAR();                 \
        o[d0] = __builtin_amdgcn_mfma_f32_32x32x16_bf16(pa0, (bf16x8){l0[0], l0[1], l0[2], l0[3], h0[0], h0[1], h0[2], h0[3]}, o[d0], 0, 0, 0);   \
        o[d0] = __builtin_amdgcn_mfma_f32_32x32x16_bf16(pa1, (bf16x8){l1[0], l1[1], l1[2], l1[3], h1[0], h1[1], h1[2], h1[3]}, o[d0], 0, 0, 0);   \
        o[d0] = __builtin_amdgcn_mfma_f32_32x32x16_bf16(pa2, (bf16x8){l2[0], l2[1], l2[2], l2[3], h2[0], h2[1], h2[2], h2[3]}, o[d0], 0, 0, 0);   \
        o[d0] = __builtin_amdgcn_mfma_f32_32x32x16_bf16(pa3, (bf16x8){l3[0], l3[1], l3[2], l3[3], h3[0], h3[1], h3[2], h3[3]}, o[d0], 0, 0, 0); } while (0)
    PV_D0(0); PV_D0(1); PV_D0(2); PV_D0(3);
#undef PV_D0
#undef TRRD
}

template <class TIn, class TOut> struct BlockRef { const TIn* Q; const TIn* K; const TIn* V; TOut* O; int P0; };
template <class TIn> struct Seam {
    bf16x8 qr[8];
    bf16x8 st_v0, st_v1, st_k0, st_k1; f32x4 sf0, sf1, sf2, sf3;
    f32x4 tq[16];
};
__device__ __forceinline__ int swa_jlo(int P0, int W) { const int lowk = P0 - W + 1; return lowk > 0 ? lowk / KVBLK : 0; }
#define ROW(p, k0, rr) ((p) + (size_t)((k0) + (rr)) * D + sc)
#define VMW() asm volatile("s_waitcnt vmcnt(0)" ::: "memory")
#define VMWN(n) asm volatile("s_waitcnt vmcnt(%0)" :: "i"(n) : "memory")
#define SLOAD_H(Kp, Vp, k0) do { S.st_v0 = load8<TIn>(ROW(Vp, k0, sr)); S.st_v1 = load8<TIn>(ROW(Vp, k0, 32 + sr));              \
                         S.st_k0 = load8<TIn>(ROW(Kp, k0, sr)); S.st_k1 = load8<TIn>(ROW(Kp, k0, 32 + sr)); } while (0)
#define SWRITE_HK(bf) do { *(bf16x8*)(K_lds + (bf) * SHM_K + kws) = S.st_k0; *(bf16x8*)(K_lds + (bf) * SHM_K + kws + 32 * 256) = S.st_k1; } while (0)
#define SWRITE_HV(bf) do { *(bf16x8*)(V_lds + (bf) * SHM_V + vst0) = S.st_v0; *(bf16x8*)(V_lds + (bf) * SHM_V + vst1) = S.st_v1; } while (0)
#define SWRITE_H(bf) do { SWRITE_HV(bf); SWRITE_HK(bf); } while (0)
#define SLOAD_F(p, k0) do { S.sf0 = *(const f32x4*)ROW(p, k0, sr); S.sf1 = *(const f32x4*)(ROW(p, k0, sr) + 4);                \
                            S.sf2 = *(const f32x4*)ROW(p, k0, 32 + sr); S.sf3 = *(const f32x4*)(ROW(p, k0, 32 + sr) + 4); } while (0)
#define SWRITE_KF(bf) do { *(bf16x8*)(K_lds + (bf) * SHM_K + kws) = pack8(S.sf0, S.sf1); *(bf16x8*)(K_lds + (bf) * SHM_K + kws + 32 * 256) = pack8(S.sf2, S.sf3); } while (0)
#define SWRITE_VF(bf) do { *(bf16x8*)(V_lds + (bf) * SHM_V + vst0) = pack8(S.sf0, S.sf1); *(bf16x8*)(V_lds + (bf) * SHM_V + vst1) = pack8(S.sf2, S.sf3); } while (0)
template <class TIn, class TOut>
__device__ __forceinline__ void causal_swa_prime(const BlockRef<TIn, TOut>& cur, int W, char* lds, Seam<TIn>& S) {
    constexpr bool F32 = same_t<TIn, float>::v;
    int tid_l_ = threadIdx.x; asm volatile("" : "+v"(tid_l_)); const int tid = tid_l_, wid = __builtin_amdgcn_readfirstlane(tid >> 6), lane = tid & 63, r32 = lane & 31, hi = lane >> 5;
    const int sr = tid >> 4, sc = (tid & 15) * 8, kws = KSWZ(sr, sc * 2); char* K_lds = lds + 2 * SHM_V;
    const int kb0 = swa_jlo(cur.P0, W) * KVBLK;
    for (int d0 = 0; d0 < 8; ++d0) S.qr[d0] = load8<TIn>(cur.Q + (size_t)(wid * QBLK + r32) * D + d0 * 16 + hi * 8);
    if constexpr (F32) { SLOAD_F((const float*)cur.K, kb0); VMW(); SWRITE_KF(0); SBAR(); SLOAD_F((const float*)cur.V, kb0); }
    else { SLOAD_H(cur.K, cur.V, kb0); VMW(); SWRITE_HK(0); }
    __syncthreads();
}
template <class TIn, class TOut>
__device__ __forceinline__ void causal_swa_block(const BlockRef<TIn, TOut>& cur, const BlockRef<TIn, TOut>& nxt, int skv, int W, char* lds, Seam<TIn>& S) {
    constexpr bool F32 = same_t<TIn, float>::v;
    int tid_l_ = threadIdx.x; asm volatile("" : "+v"(tid_l_)); const int tid = tid_l_, wid = __builtin_amdgcn_readfirstlane(tid >> 6), lane = tid & 63, r32 = lane & 31, hi = lane >> 5;
    const int j_lo = swa_jlo(cur.P0, W);
    int j_hi = (cur.P0 + QB - 1) / KVBLK + 1; if (j_hi > skv / KVBLK) j_hi = skv / KVBLK;
    const int NT = j_hi - j_lo;
    const int kbn = swa_jlo(nxt.P0, W) * KVBLK;
    const int qlo = cur.P0 + wid * QBLK, qm = qlo + r32 - 4 * hi;
    char* V_lds = lds; char* K_lds = lds + 2 * SHM_V;
    float* ws = (float*)(lds + 2 * SHM_V + 2 * SHM_K) + wid * 64; float* li_l = ws, * al_l = ws + 32;
    float m_reg = -1e30f, l_reg = 0; f32x16 o[4] = {};
    const int sr = tid >> 4, sc = (tid & 15) * 8, vst0 = v_st(sr, sc), vst1 = v_st(32 + sr, sc), kws = KSWZ(sr, sc * 2);
    const int vb0 = (int)(uintptr_t)V_lds + v_rd_base(lane);
    const TIn* Kh = cur.K; const TIn* Vh = cur.V;
#define RESC(a) do { if (__any((a) < 1.f)) { if (hi == 0) al_l[r32] = (a); asm volatile("s_waitcnt lgkmcnt(0)" ::: "memory");              \
                     for (int d_ = 0; d_ < 4; ++d_) for (int r = 0; r < 16; ++r) o[d_][r] *= al_l[crow(r, hi)]; } } while (0)
#define KBASE(t) ((j_lo + (t)) * KVBLK)
#define ACT(t) (KBASE(t) <= qlo + QBLK - 1 && KBASE(t) + KVBLK - 1 >= qlo - W + 1)
#define MASKT(P0_, P1_, t) do { const int kb_ = KBASE(t); if ((!SK || ACT(t)) && (kb_ + KVBLK - 1 > qlo || kb_ <= qlo + QBLK - 1 - W)) mask_tile(P0_, P1_, qm - kb_, (unsigned)W); } while (0)
    constexpr int NQL = F32 ? 16 : 8;
    constexpr bool SK = WSKIP && !F32;
#define SEAM_K0() do { VMWN(NQL); if constexpr (F32) { SWRITE_KF(0); SBAR(); SLOAD_F((const float*)nxt.V, kbn); } else { SWRITE_HK(0); } SBAR(); } while (0)
    f32x16 pA0, pA1, pB0, pB1; float mnA, mnB, alA, alB; bf16x8 pa0, pa1, pa2, pa3;
    if constexpr (F32) { VMW(); SWRITE_VF(0); SBAR(); } else { SWRITE_HV(0); SBAR(); }
    if (NT > 1) { if constexpr (F32) SLOAD_F((const float*)Kh, KBASE(1)); else SLOAD_H(Kh, Vh, KBASE(1)); }
    SBAR(); qkt<0, SK>(pA0, pA1, K_lds, r32, hi, S.qr, ACT(0));
    if constexpr (F32) { if (NT > 1) { VMW(); SWRITE_KF(1); SBAR(); SLOAD_F((const float*)Vh, KBASE(1)); } }
    MASKT(pA0, pA1, 0); partialSM(pA0, pA1, m_reg, mnA, alA);
    if (NT > 1) { VMW(); if constexpr (F32) { SWRITE_VF(1); SBAR(); if (NT > 2) SLOAD_F((const float*)Kh, KBASE(2)); } else SWRITE_H(1); }
    __syncthreads();
#define HALF_STEP(PX0, PX1, mnX, alX, PY0, PY1, alY, t, KB, VB, SB) do {                                                      \
        SBAR(); qkt<KB, SK>(PX0, PX1, K_lds, r32, hi, S.qr, ACT(t));                                             \
        finishSM(PY0, PY1, alY, l_reg, pa0, pa1, pa2, pa3); SBAR();                                                           \
        if ((t) + 1 < NT) { if constexpr (F32) { VMW(); SWRITE_KF(SB); SBAR(); SLOAD_F((const float*)Vh, KBASE((t) + 1)); }  \
                            else { SLOAD_H(Kh, Vh, KBASE((t) + 1)); } SBAR(); }                                               \
        pv_tile<VB, SK>(o, vb0, pa0, pa1, pa2, pa3, ACT((t) - 1)); MASKT(PX0, PX1, (t)); partialSM(PX0, PX1, m_reg, mnX, alX);                                        \
        __syncthreads();                                                                                                      \
        if ((t) + 1 < NT) { VMW(); if constexpr (F32) { SWRITE_VF(SB); SBAR(); if ((t) + 2 < NT) SLOAD_F((const float*)Kh, KBASE((t) + 2)); } \
                            else { SWRITE_H(SB); } }                                                                          \
        RESC(alX); __syncthreads(); } while (0)
    for (int t = 1; t + 1 < NT; t += 2) {
        HALF_STEP(pB0, pB1, mnB, alB, pA0, pA1, alA, t, 1, 0, 0);
        HALF_STEP(pA0, pA1, mnA, alA, pB0, pB1, alB, t + 1, 0, 1, 1);
    }
    const bool even = (NT & 1) == 0;
    if (even) { SBAR(); qkt<1, SK>(pB0, pB1, K_lds, r32, hi, S.qr, ACT(NT - 1)); SBAR(); }
#define QROW(e) (nxt.Q + (size_t)(wid * QBLK + r32) * D + ((e) >> 1) * 16 + hi * 8 + ((e) & 1) * 4)
    if constexpr (F32) { SLOAD_F((const float*)nxt.K, kbn); SBAR();
#pragma unroll
        for (int e = 0; e < 8; ++e) S.tq[e] = *(const f32x4*)QROW(e); }
    else { SLOAD_H(nxt.K, nxt.V, kbn); SBAR();
#pragma unroll
        for (int d0 = 0; d0 < 8; ++d0) S.qr[d0] = load8<TIn>(nxt.Q + (size_t)(wid * QBLK + r32) * D + d0 * 16 + hi * 8); }
    SBAR();
    finishSM(pA0, pA1, alA, l_reg, pa0, pa1, pa2, pa3); SBAR();
    if constexpr (F32) {
#pragma unroll
        for (int e = 8; e < 16; ++e) S.tq[e] = *(const f32x4*)QROW(e); SBAR(); }
#undef QROW
    pv_tile<0, SK>(o, vb0, pa0, pa1, pa2, pa3, ACT(even ? NT - 2 : NT - 1));
    if (even) { MASKT(pB0, pB1, NT - 1); partialSM(pB0, pB1, m_reg, mnB, alB); __syncthreads(); RESC(alB);
        finishSM(pB0, pB1, alB, l_reg, pa0, pa1, pa2, pa3); SBAR(); pv_tile<1, SK>(o, vb0, pa0, pa1, pa2, pa3, ACT(NT - 1)); }
    SBAR(); SEAM_K0();
    if (hi == 0) li_l[r32] = l_reg; asm volatile("s_waitcnt lgkmcnt(0)" ::: "memory");
    float rli[16];
#pragma unroll
    for (int r = 0; r < 16; ++r) rli[r] = __builtin_amdgcn_rcpf(li_l[crow(r, hi)]);
    TOut* Ow = cur.O + (size_t)(wid * QBLK) * D;
#pragma unroll
    for (int r = 0; r < 16; ++r) { const int orow = crow(r, hi);
#pragma unroll
        for (int d0 = 0; d0 < 4; ++d0) { const float v = o[d0][r] * rli[r];
            if constexpr (same_t<TOut, float>::v) { Ow[(size_t)orow * D + d0 * 32 + r32] = v; }
            else { const float vn = __shfl_xor(v, 1);
                   if ((r32 & 1) == 0) *(unsigned*)(Ow + (size_t)orow * D + d0 * 32 + r32) = cvtpk(v, vn); } } }
    if constexpr (F32) {
#pragma unroll
        for (int d0 = 0; d0 < 8; ++d0) S.qr[d0] = pack8(S.tq[2 * d0], S.tq[2 * d0 + 1]); }
    __syncthreads();
#undef RESC
#undef KBASE
#undef ACT
#undef MASKT
#undef SEAM_K0
#undef HALF_STEP
}
#undef ROW
#undef VMW
#undef VMWN
#undef SLOAD_H
#undef SWRITE_HK
#undef SWRITE_HV
#undef SWRITE_H
#undef SLOAD_F
#undef SWRITE_KF
#undef SWRITE_VF
}

namespace mk {
constexpr int NWAVES = 8, NTHR = 512;
constexpr int BATCH = 2, SEQ = 4096, M = BATCH * SEQ, DM = 4096;
constexpr int DI = 8192, NHEAD = 128, HDIM = 64, NGRP = 8, NST = 128, CONVD = 10240, NCHUNK = 32;
constexpr int NZX = 18560, NZXP = 18688, ZX_XBC = 8192, ZX_DT = 18432, NZXM = 18432;
constexpr int DFF = 11008, NUP = 22016;
constexpr int NQKV = 12288, AH = 16;
constexpr float EPS = 1e-5f;

constexpr size_t MiB = 1u << 20;
constexpr size_t WS_CTL = 0, CTL_ZERO_BYTES = 1 * MiB;
constexpr size_t WS_ROPE = 2 * MiB;
constexpr size_t WS_W = 8 * MiB;
constexpr size_t WL_MAMBA = 468 * MiB, WL_ATTN = 386 * MiB;
constexpr size_t W_IN = 0, W_OUT = 146 * MiB, W_UP_M = 210 * MiB, W_DOWN_M = 382 * MiB;
constexpr size_t W_QKV = 0, W_O = 96 * MiB, W_UP_A = 128 * MiB, W_DOWN_A = 300 * MiB;
constexpr size_t WS_XR = 1716 * MiB;
constexpr size_t WS_U = 1844 * MiB;
constexpr size_t WS_BIG = 1908 * MiB;
constexpr size_t WS_ACT2 = 2252 * MiB;
constexpr size_t WS_XT = 2424 * MiB;
constexpr size_t WS_Y = 2552 * MiB;
constexpr size_t WS_BN = 2680 * MiB, WS_BT = 2696 * MiB, WS_CN = 2712 * MiB, WS_DTF = 2728 * MiB;
constexpr size_t WS_PART = 2732 * MiB;
constexpr size_t WS_END = 2764 * MiB;
constexpr int CW_TMO = 0, CW_CODE = 1, CW_BAR = 4096;
constexpr int CW_SS = 65536;
static_assert((CW_SS + 9 * M * 2) * 4 <= (int)CTL_ZERO_BYTES, "norm statistics inside the memset region");

constexpr int RING_OFF = 0, RING_BYTES = 131072 + 16384;
constexpr int TAB_OFF = 131072, TAB_TILES = 16;
constexpr int LDSCTL_OFF = RING_BYTES, MISC_OFF = LDSCTL_OFF + 320;
constexpr int SIDE_OFF = RING_BYTES + 1024, LDS_BYTES = SIDE_OFF + 12288;
static_assert(MISC_OFF + 128 <= LDS_BYTES, "LDS map");

#define GAS __attribute__((address_space(1)))
#define LAS __attribute__((address_space(3)))
typedef unsigned short bf16;
typedef unsigned v4u __attribute__((ext_vector_type(4)));
typedef unsigned v2u __attribute__((ext_vector_type(2)));
typedef float f32x4 __attribute__((ext_vector_type(4)));
typedef float f32x2 __attribute__((ext_vector_type(2)));
typedef float f32x16 __attribute__((ext_vector_type(16)));
typedef short bf16x8 __attribute__((ext_vector_type(8)));
typedef GAS unsigned gu32;
#define RLX_AGENT __ATOMIC_RELAXED, __HIP_MEMORY_SCOPE_AGENT
#define LDS_WAIT() asm volatile("s_waitcnt lgkmcnt(0)" ::: "memory")
#define VM_WAIT() asm volatile("s_waitcnt vmcnt(0)" ::: "memory")
__device__ __forceinline__ unsigned f2bf(float f) { unsigned u = __builtin_bit_cast(unsigned, f); return (u + 0x7fffu + ((u >> 16) & 1u)) >> 16; }
typedef __bf16 bf16x2_t __attribute__((ext_vector_type(2)));
__device__ __forceinline__ unsigned pk2(float lo, float hi) { const f32x2 v = {lo, hi}; return __builtin_bit_cast(unsigned, __builtin_convertvector(v, bf16x2_t)); }
__device__ __forceinline__ float bf_lo(unsigned w) { return __builtin_bit_cast(float, w << 16); }
__device__ __forceinline__ float bf_hi(unsigned w) { return __builtin_bit_cast(float, w & 0xffff0000u); }
__device__ __forceinline__ float bf1(bf16 h) { return __builtin_bit_cast(float, (unsigned)h << 16); }
__device__ __forceinline__ float silu_f(float a) { return a * __builtin_amdgcn_rcpf(1.f + __expf(-a)); }

#define XB_TMO      128
#define XB_XCNT(j)  (256  + 64 * (j))
#define XB_XSUB(j)  (1280 + 64 * (j))
#define XB_XGEN(j)  (2304 + 64 * (j))
#define XB_TOP      3328
#define XB_TOPGEN   3392
#define XCD_BAR_WORDS 3456
#define XB_SPIN_CAP (1u << 18)
__device__ __forceinline__ unsigned xb_ld(unsigned* p)              { return __hip_atomic_load(p, __ATOMIC_RELAXED, __HIP_MEMORY_SCOPE_AGENT); }
__device__ __forceinline__ unsigned xb_add(unsigned* p, unsigned v) { return __hip_atomic_fetch_add(p, v, __ATOMIC_RELAXED, __HIP_MEMORY_SCOPE_AGENT); }
__device__ __forceinline__ unsigned xb_xcc_id() { return (unsigned)__builtin_amdgcn_s_getreg((3 << 11) | 20) & 0xFu; }
#define XB_SPIN(cond, bar) do { unsigned _sp = 0; while (cond) { __builtin_amdgcn_s_sleep(1); \
    if ((++_sp & 255u) == 0u) { if (xb_ld(&(bar)[XB_TMO])) break; if (_sp > XB_SPIN_CAP) { atomicAdd(&(bar)[XB_TMO], 1u); break; } } } } while (0)
struct XcdBarrier { unsigned* bar; unsigned x; volatile LAS unsigned* st; };
__device__ __forceinline__ XcdBarrier xcd_barrier_post(unsigned* bar, volatile LAS unsigned* st) {
    XcdBarrier b; b.bar = bar; b.x = xb_xcc_id(); b.st = st;
    if (threadIdx.x == 0) (void)xb_add(&bar[XB_XCNT(b.x)], 1u);
    return b;
}
__device__ __forceinline__ void xcd_barrier_complete(unsigned* bar, unsigned x, unsigned& nloc, unsigned& nx) {
    const unsigned G = gridDim.x * gridDim.y * gridDim.z;
    unsigned sum, cnt, mine, sp = 0u;
    for (;;) {
        sum = 0u; cnt = 0u; mine = 0u;
#pragma unroll
        for (unsigned j = 0; j < 16; ++j) { const unsigned c = xb_ld(&bar[XB_XCNT(j)]); sum += c; cnt += (c > 0u) ? 1u : 0u; mine = (j == x) ? c : mine; }
        if (sum == G) break;
        __builtin_amdgcn_s_sleep(1);
        if ((++sp & 255u) == 0u) { if (xb_ld(&bar[XB_TMO])) break; if (sp > XB_SPIN_CAP) { atomicAdd(&bar[XB_TMO], 1u); break; } }
    }
    nloc = mine > 0u ? mine : 1u; nx = cnt > 0u ? cnt : 1u;
}
__device__ __forceinline__ void xcd_barrier(const XcdBarrier& b) {
    asm volatile("s_waitcnt vmcnt(0)" ::: "memory");
    __syncthreads();
    if (threadIdx.x == 0) {
        unsigned long long bar_l_ = (unsigned long long)b.bar; asm volatile("" : "+s"(bar_l_));
        unsigned* bar = (unsigned*)bar_l_;
        __builtin_amdgcn_s_waitcnt(0);
        unsigned bx_l_ = b.x; asm volatile("" : "+s"(bx_l_));
        unsigned nloc = b.st[0], nx = b.st[1];
        if (nloc == 0u) { xcd_barrier_complete(bar, bx_l_, nloc, nx); b.st[0] = nloc; b.st[1] = nx; }
        const unsigned old = xb_add(&bar[XB_XSUB(bx_l_)], 1u);
        const unsigned gen = old / nloc;
        if (old + 1u == (gen + 1u) * nloc) {
            __builtin_amdgcn_fence(__ATOMIC_RELEASE, "agent");
            asm volatile("s_waitcnt vmcnt(0)" ::: "memory");
            const unsigned og = xb_add(&bar[XB_TOP], 1u);
            const unsigned tg = og / nx;
            if (og + 1u == (tg + 1u) * nx) xb_add(&bar[XB_TOPGEN], 1u);
            else XB_SPIN(xb_ld(&bar[XB_TOPGEN]) == tg, bar);
            __builtin_amdgcn_fence(__ATOMIC_ACQUIRE, "agent");
            xb_add(&bar[XB_XGEN(bx_l_)], 1u);
            asm volatile("s_waitcnt vmcnt(0)" ::: "memory");
        } else {
            XB_SPIN(xb_ld(&bar[XB_XGEN(bx_l_)]) == gen, bar);
            __builtin_amdgcn_fence(__ATOMIC_ACQUIRE, "agent");
            asm volatile("s_waitcnt vmcnt(0)" ::: "memory");
        }
    }
    __syncthreads();
}

struct Frame {
    LAS unsigned char* lds;
    unsigned char* ws;
    int tid, lane, wave;
    int vcu, G, bx;
};

__device__ __forceinline__ void relaunder(Frame& F, unsigned char* ws0) { int t = threadIdx.x; asm volatile("" : "+v"(t)); F.tid = t; F.lane = t & 63; F.wave = __builtin_amdgcn_readfirstlane(t >> 6);
    unsigned long long w = (unsigned long long)ws0; asm volatile("" : "+s"(w)); F.ws = (unsigned char*)w;
    int g = gridDim.x; asm volatile("" : "+s"(g)); F.G = g; int bx = blockIdx.x; asm volatile("" : "+s"(bx)); F.bx = bx; F.vcu = (g % 8 == 0) ? (bx % 8) * (g / 8) + bx / 8 : bx; }
__device__ __forceinline__ float wave_sum(float v) {
    int l = threadIdx.x; asm volatile("" : "+v"(l)); l &= 63;
#pragma unroll
    for (int o = 1; o < 64; o <<= 1) v += __builtin_bit_cast(float, __builtin_amdgcn_ds_bpermute((l ^ o) << 2, __builtin_bit_cast(int, v)));
    return v;
}

__device__ __forceinline__ void p0_matrix(Frame& F, const float* W, int K, int N, int NP, bf16* WT, int& prefix, int perm_limit = 0, const float* gain = nullptr, int gv_tiles = 0, int ov_t0 = -1, int ov_stride = 0) {
    const int nnt = NP / 256, nkt = K / 128, ntiles = nkt * nnt, G = F.G, w = F.wave, lane = F.lane;
    const int stride = ov_t0 >= 0 ? ov_stride : G; int t;
    if (ov_t0 >= 0) t = ov_t0; else { t = (F.vcu - prefix) % G; if (t < 0) t += G; prefix = (prefix + ntiles) % G; }
    LAS unsigned char* L = F.lds;
    f32x4 v[16];
#define P0_TILE(tt, kt_, nt_) const int blk_ = (tt) / (16 * nnt), rem_ = (tt) - blk_ * 16 * nnt, bh_ = (nkt - 16 * blk_) < 16 ? (nkt - 16 * blk_) : 16, nt_ = rem_ / bh_, kt_ = 16 * blk_ + (rem_ - nt_ * bh_)
#define P0_LOAD(tt) do { P0_TILE(tt, kt_, nt_); const int n_ = nt_ * 256 + 4 * lane; \
        const GAS float* s_ = (const GAS float*)W + (size_t)(kt_ * 128 + 16 * w) * N + n_; \
        if (n_ < N) { _Pragma("unroll") for (int jj = 0; jj < 16; ++jj) v[jj] = *(const GAS f32x4*)(s_ + (size_t)jj * N); \
            if (gain) { _Pragma("unroll") for (int jj = 0; jj < 16; ++jj) v[jj] = v[jj] * gain[kt_ * 128 + 16 * w + jj]; } } \
        else { _Pragma("unroll") for (int jj = 0; jj < 16; ++jj) v[jj] = (f32x4){0.f, 0.f, 0.f, 0.f}; } } while (0)
    if (t < ntiles) P0_LOAD(t);
    while (t < ntiles) {
#pragma unroll
        for (int i = 0; i < 4; ++i)
#pragma unroll
            for (int h = 0; h < 2; ++h) {
                v4u o; o.x = pk2(v[8 * h + 0][i], v[8 * h + 1][i]); o.y = pk2(v[8 * h + 2][i], v[8 * h + 3][i]); o.z = pk2(v[8 * h + 4][i], v[8 * h + 5][i]); o.w = pk2(v[8 * h + 6][i], v[8 * h + 7][i]);
                *(LAS v4u*)(L + (4 * lane + i) * 256 + (((2 * w + h) ^ (lane & 15)) << 4)) = o;
            }
        P0_TILE(t, kt, nt); const int tn = t + stride;
        if (tn < ntiles) P0_LOAD(tn);
        __syncthreads();
        const int nb = gv_tiles ? ((nt < gv_tiles ? 2 * nt : 2 * (nt - gv_tiles)) * 256 + (nt < gv_tiles ? 0 : 128)) : nt * 256;
        GAS bf16* dst = (GAS bf16*)WT + kt * 128 + 8 * (lane & 15);
        const bool perm = nt * 256 < perm_limit;
#pragma unroll
        for (int jj = 0; jj < 8; ++jj) { const int r = w * 32 + jj * 4 + (lane >> 4);
            const v4u o = *(LAS const v4u*)(L + r * 256 + (((lane & 15) ^ ((r >> 2) & 15)) << 4));
            const int d = r & 127, ro = perm ? ((r & 128) | (d < 64 ? 2 * d : 2 * (d - 64) + 1)) : r;
            const int rr = gv_tiles ? ((ro >> 7) * 256 + (ro & 127)) : ro;
            *(GAS v4u*)(dst + (size_t)(nb + rr) * K) = o; }
        __syncthreads();
        t = tn;
    }
#undef P0_LOAD
#undef P0_TILE
}

__device__ __forceinline__ void rms_row_bf16(const float* xrow, const float* w, bf16* orow, int lane) {
    const GAS f32x4* xr = (const GAS f32x4*)xrow + lane; const GAS f32x4* wr = (const GAS f32x4*)w + lane;
    f32x4 v[16]; float s = 0.f;
#pragma unroll
    for (int j = 0; j < 16; ++j) { v[j] = xr[64 * j]; s += (v[j].x * v[j].x + v[j].y * v[j].y) + (v[j].z * v[j].z + v[j].w * v[j].w); }
    const float rstd = 1.0f / sqrtf(wave_sum(s) * (1.f / DM) + EPS);
    GAS v2u* o8 = (GAS v2u*)orow + lane;
#pragma unroll
    for (int j = 0; j < 16; ++j) { const f32x4 g = wr[64 * j]; v2u o; o.x = pk2(v[j].x * rstd * g.x, v[j].y * rstd * g.y); o.y = pk2(v[j].z * rstd * g.z, v[j].w * rstd * g.w); o8[64 * j] = o; }
}
__device__ __forceinline__ void rms_row_f32(const float* xrow, const float* w, float* orow, int lane) {
    const GAS f32x4* xr = (const GAS f32x4*)xrow + lane; const GAS f32x4* wr = (const GAS f32x4*)w + lane;
    f32x4 v[16]; float s = 0.f;
#pragma unroll
    for (int j = 0; j < 16; ++j) { v[j] = xr[64 * j]; s += (v[j].x * v[j].x + v[j].y * v[j].y) + (v[j].z * v[j].z + v[j].w * v[j].w); }
    const float rstd = 1.0f / sqrtf(wave_sum(s) * (1.f / DM) + EPS);
    GAS f32x4* o = (GAS f32x4*)orow + lane;
#pragma unroll
    for (int j = 0; j < 16; ++j) { const f32x4 g = wr[64 * j]; o[64 * j] = v[j] * rstd * g; }
}
__device__ __forceinline__ void x_row_prep(const float* xrow, bf16* orow, unsigned long long* ssq, int lane) {
    const GAS f32x4* xr = (const GAS f32x4*)xrow + lane;
    f32x4 v[16]; float s = 0.f;
#pragma unroll
    for (int j = 0; j < 16; ++j) { v[j] = xr[64 * j]; s += (v[j].x * v[j].x + v[j].y * v[j].y) + (v[j].z * v[j].z + v[j].w * v[j].w); }
    s = wave_sum(s);
    GAS v2u* o8 = (GAS v2u*)orow + lane;
#pragma unroll
    for (int j = 0; j < 16; ++j) { v2u o; o.x = pk2(v[j].x, v[j].y); o.y = pk2(v[j].z, v[j].w); o8[64 * j] = o; }
    if (lane == 0) *ssq = (unsigned long long)__float2ll_rn(s * 16777216.0f);
}
__device__ __forceinline__ void rmsnorm_phase(Frame& F, const float* x, const float* w, bf16* U) {
    const int gw = F.vcu * NWAVES + F.wave, NGW = F.G * NWAVES;
    for (int m = gw; m < M; m += NGW) rms_row_bf16(x + (size_t)m * DM, w, U + (size_t)m * DM, F.lane);
}

template <class Sched>
__device__ __forceinline__ void rstd_table(Frame& F, const Sched& S, const unsigned long long* ss, int& pm0, int& ntab) {
    int lo = 1 << 30, hi = -1; pg8::Unit u;
    for (int i = 0; S.next(i, u); ++i) { lo = u.pm < lo ? u.pm : lo; hi = u.pm > hi ? u.pm : hi; }
    if (hi < 0) { pm0 = 0; ntab = 0; return; }
    pm0 = lo; ntab = (hi - lo + 1) < TAB_TILES ? (hi - lo + 1) : TAB_TILES;
    LAS float* tab = (LAS float*)(F.lds + TAB_OFF);
    for (int r = F.tid; r < ntab * 256; r += NTHR) tab[r] = 1.0f / sqrtf((float)ss[pm0 * 256 + r] * (1.0f / (4096.0f * 16777216.0f)) + 1e-5f);
    __syncthreads();
}

__device__ __forceinline__ void llc_touch(Frame& F, const void* p, size_t bytes) {
    const GAS v4u* q = (const GAS v4u*)p; const size_t n16 = bytes / 16, st = (size_t)F.G * NTHR; unsigned acc = 0u;
    for (size_t i = (size_t)F.vcu * NTHR + F.tid; i + 3 * st < n16; i += 4 * st) { const v4u a = q[i], b = q[i + st], c = q[i + 2 * st], d = q[i + 3 * st]; acc += (a.x ^ b.y) + (c.z ^ d.w); }
    if (acc == 0x12345677u) ((unsigned*)(F.ws + WS_CTL))[300] = acc;
}
__device__ __forceinline__ void unpack8(const v4u w, float (&o)[8]) { o[0] = bf_lo(w.x); o[1] = bf_hi(w.x); o[2] = bf_lo(w.y); o[3] = bf_hi(w.y); o[4] = bf_lo(w.z); o[5] = bf_hi(w.z); o[6] = bf_lo(w.w); o[7] = bf_hi(w.w); }
__device__ __forceinline__ void ffn_gate_phase(Frame& F, const bf16* H, const float* cw, const float* cb, bf16* GA) {
    constexpr int R = 32, NCHK = DFF / 8, NRB = M / R;
    const int total = NCHK * NRB;
    for (int it = F.vcu * NTHR + F.tid; it < total; it += F.G * NTHR) {
        const int ch = it % NCHK, rb = it / NCHK, c0 = ch * 8, t0 = rb * R;
        float wg[3][8], wv[3][8], bg[8], bv[8];
#pragma unroll
        for (int k = 0; k < 3; ++k) {
            const f32x4 a0 = *(const GAS f32x4*)(cw + (size_t)k * NUP + c0), a1 = *(const GAS f32x4*)(cw + (size_t)k * NUP + c0 + 4);
            const f32x4 b0 = *(const GAS f32x4*)(cw + (size_t)k * NUP + DFF + c0), b1 = *(const GAS f32x4*)(cw + (size_t)k * NUP + DFF + c0 + 4);
#pragma unroll
            for (int j = 0; j < 4; ++j) { wg[k][j] = a0[j]; wg[k][4 + j] = a1[j]; wv[k][j] = b0[j]; wv[k][4 + j] = b1[j]; }
        }
        { const f32x4 a0 = *(const GAS f32x4*)(cb + c0), a1 = *(const GAS f32x4*)(cb + c0 + 4), b0 = *(const GAS f32x4*)(cb + DFF + c0), b1 = *(const GAS f32x4*)(cb + DFF + c0 + 4);
#pragma unroll
          for (int j = 0; j < 4; ++j) { bg[j] = a0[j]; bg[4 + j] = a1[j]; bv[j] = b0[j]; bv[4 + j] = b1[j]; } }
        float g2[8], g1[8], v2[8], v1[8];
        if ((t0 & (SEQ - 1)) == 0) {
#pragma unroll
            for (int j = 0; j < 8; ++j) { g2[j] = 0.f; g1[j] = 0.f; v2[j] = 0.f; v1[j] = 0.f; }
        } else {
            const GAS bf16* r2 = (const GAS bf16*)H + (size_t)(t0 - 2) * NUP + c0; const GAS bf16* r1 = r2 + NUP;
            unpack8(*(const GAS v4u*)r2, g2); unpack8(*(const GAS v4u*)(r2 + DFF), v2); unpack8(*(const GAS v4u*)r1, g1); unpack8(*(const GAS v4u*)(r1 + DFF), v1);
        }
        const GAS bf16* hp = (const GAS bf16*)H + (size_t)t0 * NUP + c0; GAS bf16* op = (GAS bf16*)GA + (size_t)t0 * DFF + c0;
#pragma unroll 8
        for (int r = 0; r < R; ++r) {
            float g0[8], v0[8], o[8];
            unpack8(*(const GAS v4u*)(hp + (size_t)r * NUP), g0); unpack8(*(const GAS v4u*)(hp + (size_t)r * NUP + DFF), v0);
#pragma unroll
            for (int j = 0; j < 8; ++j) {
                const float a = bg[j] + wg[0][j] * g2[j] + wg[1][j] * g1[j] + wg[2][j] * g0[j];
                const float b = bv[j] + wv[0][j] * v2[j] + wv[1][j] * v1[j] + wv[2][j] * v0[j];
                o[j] = silu_f(a) * b; g2[j] = g1[j]; g1[j] = g0[j]; v2[j] = v1[j]; v1[j] = v0[j];
            }
            v4u w; w.x = pk2(o[0], o[1]); w.y = pk2(o[2], o[3]); w.z = pk2(o[4], o[5]); w.w = pk2(o[6], o[7]);
            *(GAS v4u*)(op + (size_t)r * DFF) = w;
        }
    }
}

__device__ __forceinline__ void ffn_fix_phase(Frame& F, const bf16* HB, const float* cw, const float* cb, bf16* GA) {
    constexpr int NCHK = DFF / 8, NSPAN = M / 64;
    for (int it = F.vcu * NTHR + F.tid; it < NCHK * NSPAN; it += F.G * NTHR) {
        const int ch = it % NCHK, s = it / NCHK, c0 = ch * 8, t0 = s * 64;
        float wg[3][8], wv[3][8], bg[8], bv[8];
#pragma unroll
        for (int k = 0; k < 3; ++k) {
            const f32x4 a0 = *(const GAS f32x4*)(cw + (size_t)k * NUP + c0), a1 = *(const GAS f32x4*)(cw + (size_t)k * NUP + c0 + 4);
            const f32x4 b0 = *(const GAS f32x4*)(cw + (size_t)k * NUP + DFF + c0), b1 = *(const GAS f32x4*)(cw + (size_t)k * NUP + DFF + c0 + 4);
#pragma unroll
            for (int j = 0; j < 4; ++j) { wg[k][j] = a0[j]; wg[k][4 + j] = a1[j]; wv[k][j] = b0[j]; wv[k][4 + j] = b1[j]; }
        }
        { const f32x4 a0 = *(const GAS f32x4*)(cb + c0), a1 = *(const GAS f32x4*)(cb + c0 + 4), b0 = *(const GAS f32x4*)(cb + DFF + c0), b1 = *(const GAS f32x4*)(cb + DFF + c0 + 4);
#pragma unroll
          for (int j = 0; j < 4; ++j) { bg[j] = a0[j]; bg[4 + j] = a1[j]; bv[j] = b0[j]; bv[4 + j] = b1[j]; } }
        float g2[8], g1[8], v2[8], v1[8];
        if ((t0 & (SEQ - 1)) == 0) {
#pragma unroll
            for (int j = 0; j < 8; ++j) { g2[j] = 0.f; g1[j] = 0.f; v2[j] = 0.f; v1[j] = 0.f; }
        } else {
            const GAS bf16* pr = (const GAS bf16*)HB + (size_t)(((s - 1) * 4 + 2) * 2) * DFF + c0;
            unpack8(*(const GAS v4u*)pr, g2); unpack8(*(const GAS v4u*)(pr + DFF), v2); unpack8(*(const GAS v4u*)(pr + 2 * DFF), g1); unpack8(*(const GAS v4u*)(pr + 3 * DFF), v1);
        }
        const GAS bf16* cp = (const GAS bf16*)HB + (size_t)((s * 4) * 2) * DFF + c0; GAS bf16* op = (GAS bf16*)GA + (size_t)t0 * DFF + c0;
#pragma unroll
        for (int r = 0; r < 2; ++r) {
            float g0[8], v0[8], o[8];
            unpack8(*(const GAS v4u*)(cp + (size_t)(2 * r) * DFF), g0); unpack8(*(const GAS v4u*)(cp + (size_t)(2 * r + 1) * DFF), v0);
#pragma unroll
            for (int j = 0; j < 8; ++j) {
                const float a = bg[j] + wg[0][j] * g2[j] + wg[1][j] * g1[j] + wg[2][j] * g0[j];
                const float b = bv[j] + wv[0][j] * v2[j] + wv[1][j] * v1[j] + wv[2][j] * v0[j];
                o[j] = silu_f(a) * b; g2[j] = g1[j]; g1[j] = g0[j]; v2[j] = v1[j]; v1[j] = v0[j];
            }
            v4u w; w.x = pk2(o[0], o[1]); w.y = pk2(o[2], o[3]); w.z = pk2(o[4], o[5]); w.w = pk2(o[6], o[7]);
            *(GAS v4u*)(op + (size_t)r * DFF) = w;
        }
    }
}

__device__ __forceinline__ void ssd_prep_phase(Frame& F, const bf16* ZX, const float* cw, const float* cb, const float* dt_bias, bf16* XT, bf16* Bn, bf16* BT, bf16* Cn, float* DTF, const float* part, const unsigned long long* ssq) {
    const int gw = F.vcu * NWAVES + F.wave, NGW = F.G * NWAVES, lane = F.lane, c8 = lane & 7, rg = lane >> 3;
    for (int it = gw; it < 64 * 160; it += NGW) {
        const int cg = it % 160, bc = it / 160;
        const int ch0 = cg * 64 + 8 * c8, m0 = bc * 128;
        const GAS bf16* src = (const GAS bf16*)ZX + (size_t)(m0 + 16 * rg - 3) * NZXP + ZX_XBC + ch0;
        v4u raw[19];
        const bool hist = (rg != 0) || ((bc & 31) != 0);
#pragma unroll
        for (int jj = 0; jj < 19; ++jj) raw[jj] = (jj >= 3 || hist) ? *(const GAS v4u*)(src + (size_t)jj * NZXP) : (v4u){0u, 0u, 0u, 0u};
        float wt[4][8], bb[8];
#pragma unroll
        for (int k = 0; k < 4; ++k) { const f32x4 a = *(const GAS f32x4*)(cw + (size_t)k * CONVD + ch0), b = *(const GAS f32x4*)(cw + (size_t)k * CONVD + ch0 + 4);
#pragma unroll
            for (int e = 0; e < 4; ++e) { wt[k][e] = a[e]; wt[k][4 + e] = b[e]; } }
        { const f32x4 a = *(const GAS f32x4*)(cb + ch0), b = *(const GAS f32x4*)(cb + ch0 + 4);
#pragma unroll
          for (int e = 0; e < 4; ++e) { bb[e] = a[e]; bb[4 + e] = b[e]; } }
        GAS bf16* tdst = nullptr; GAS bf16* ndst = nullptr;
        if (cg < 128) { tdst = (GAS bf16*)XT + ((size_t)(bc * 128 + cg) * 64 + 8 * c8) * 128 + 16 * rg; }
        else if (cg < 144) { const int g = (cg - 128) >> 1, n0 = ((cg - 128) & 1) * 64 + 8 * c8; tdst = (GAS bf16*)BT + ((size_t)(bc * 8 + g) * 128 + n0) * 128 + 16 * rg; ndst = (GAS bf16*)Bn + ((size_t)(bc * 8 + g) * 128 + 16 * rg) * 128 + n0; }
        else { const int g = (cg - 144) >> 1, n0 = ((cg - 144) & 1) * 64 + 8 * c8; ndst = (GAS bf16*)Cn + ((size_t)(bc * 8 + g) * 128 + 16 * rg) * 128 + n0; }
#pragma unroll
        for (int hf = 0; hf < 2; ++hf) {
            unsigned nw[8][4];
#pragma unroll
            for (int ep = 0; ep < 4; ++ep) {
                float oa[8], ob[8];
                float a3 = bf_lo(raw[8 * hf][ep]), a2 = bf_lo(raw[8 * hf + 1][ep]), a1 = bf_lo(raw[8 * hf + 2][ep]), b3 = bf_hi(raw[8 * hf][ep]), b2 = bf_hi(raw[8 * hf + 1][ep]), b1 = bf_hi(raw[8 * hf + 2][ep]);
#pragma unroll
                for (int r = 0; r < 8; ++r) { const float a0 = bf_lo(raw[8 * hf + 3 + r][ep]), b0 = bf_hi(raw[8 * hf + 3 + r][ep]);
                    oa[r] = silu_f(bb[2 * ep] + wt[0][2 * ep] * a3 + wt[1][2 * ep] * a2 + wt[2][2 * ep] * a1 + wt[3][2 * ep] * a0);
                    ob[r] = silu_f(bb[2 * ep + 1] + wt[0][2 * ep + 1] * b3 + wt[1][2 * ep + 1] * b2 + wt[2][2 * ep + 1] * b1 + wt[3][2 * ep + 1] * b0);
                    a3 = a2; a2 = a1; a1 = a0; b3 = b2; b2 = b1; b1 = b0; }
                if (tdst) {
                    v4u t0; t0.x = pk2(oa[0], oa[1]); t0.y = pk2(oa[2], oa[3]); t0.z = pk2(oa[4], oa[5]); t0.w = pk2(oa[6], oa[7]);
                    *(GAS v4u*)(tdst + (size_t)(2 * ep) * 128 + 8 * hf) = t0;
                    t0.x = pk2(ob[0], ob[1]); t0.y = pk2(ob[2], ob[3]); t0.z = pk2(ob[4], ob[5]); t0.w = pk2(ob[6], ob[7]);
                    *(GAS v4u*)(tdst + (size_t)(2 * ep + 1) * 128 + 8 * hf) = t0;
                }
                if (ndst) {
#pragma unroll
                    for (int r = 0; r < 8; ++r) nw[r][ep] = pk2(oa[r], ob[r]);
                }
            }
            if (ndst) {
#pragma unroll
                for (int r = 0; r < 8; ++r) { v4u o; o.x = nw[r][0]; o.y = nw[r][1]; o.z = nw[r][2]; o.w = nw[r][3]; *(GAS v4u*)(ndst + (size_t)(8 * hf + r) * 128) = o; }
            }
        }
    }
    for (int i = F.vcu * NTHR + F.tid; i < M * NHEAD; i += F.G * NTHR) {
        const int h = i & 127, m = i >> 7;
        float raw;
        if (part) { float s = 0.f;
#pragma unroll
            for (int ks = 0; ks < 8; ++ks) s += ((const GAS float*)part)[((size_t)ks * M + m) * 128 + h];
            raw = s * (1.0f / sqrtf((float)ssq[m] * (1.0f / (4096.0f * 16777216.0f)) + 1e-5f)) + dt_bias[h]; }
        else raw = bf1(((const GAS bf16*)ZX)[(size_t)m * NZXP + ZX_DT + h]) + dt_bias[h];
        const float sp = raw > 20.f ? raw : log1pf(__expf(raw));
        ((GAS float*)DTF)[(size_t)((m >> 12) * NHEAD + h) * SEQ + (m & (SEQ - 1))] = sp;
    }
}

#define LDS_BAR() do { asm volatile("s_waitcnt lgkmcnt(0)" ::: "memory"); __builtin_amdgcn_s_barrier(); asm volatile("" ::: "memory"); } while (0)
__device__ __forceinline__ int swz(int r, int q) { return r * 256 + ((q ^ (r & 15)) << 4); }
__device__ __forceinline__ bf16x8 ldfrag(LAS const unsigned char* base, int row, int q) { return *(LAS const bf16x8*)(base + swz(row, q)); }
__device__ __forceinline__ void ssd_phase(Frame& F, const bf16* XT, const bf16* Bn, const bf16* BT, const bf16* Cn, const float* DTF, const float* a_log, const float* d_skip, bf16* Y) {
    constexpr int SC = 0, SB = 32768, SBT = 65536, SXT = 98304, SS = 114688, SM = 131072;
    LAS unsigned char* L = F.lds;
    LAS float* dtv = (LAS float*)(L + SM); LAS float* acs = dtv + 128; LAS float* w2 = dtv + 256;
    const int tid = F.tid, wave = F.wave, lane = F.lane, c = lane & 31, hi = lane >> 5;
    const int lb = wave >> 1, pb = wave & 1, nb = wave >> 1, sb0 = 2 * (wave & 1);
    for (int id = F.vcu; id < BATCH * NHEAD; id += F.G) {
        const int b = id >> 7, h = id & 127, g = h >> 4;
        const float A = -__expf(a_log[h]), Dh = d_skip[h];
        for (int i = tid; i < 1024; i += NTHR) *(LAS v4u*)(L + SS + i * 16) = (v4u){0u, 0u, 0u, 0u};
        f32x16 sacc;
#pragma unroll
        for (int r = 0; r < 16; ++r) sacc[r] = 0.f;
        v4u stC[4], stB[4], stBT[4], stX[2]; f32x2 stdt;
#define SSD_LOAD(cc_) do { const int cidx_ = b * NCHUNK + (cc_); \
            const GAS v4u* pc_ = (const GAS v4u*)(Cn + (size_t)(cidx_ * 8 + g) * 16384); const GAS v4u* pb_ = (const GAS v4u*)(Bn + (size_t)(cidx_ * 8 + g) * 16384); \
            const GAS v4u* pt_ = (const GAS v4u*)(BT + (size_t)(cidx_ * 8 + g) * 16384); const GAS v4u* px_ = (const GAS v4u*)(XT + (size_t)(cidx_ * 128 + h) * 8192); \
            _Pragma("unroll") for (int j_ = 0; j_ < 4; ++j_) { stC[j_] = pc_[tid + 512 * j_]; stB[j_] = pb_[tid + 512 * j_]; stBT[j_] = pt_[tid + 512 * j_]; } \
            _Pragma("unroll") for (int j_ = 0; j_ < 2; ++j_) stX[j_] = px_[tid + 512 * j_]; \
            stdt = *(const GAS f32x2*)(DTF + (size_t)(b * NHEAD + h) * SEQ + (cc_) * 128 + 2 * lane); } while (0)
        SSD_LOAD(0);
        for (int cc = 0; cc < NCHUNK; ++cc) {
#pragma unroll
            for (int j = 0; j < 4; ++j) { const int i = tid + 512 * j, o = swz(i >> 4, i & 15); *(LAS v4u*)(L + SC + o) = stC[j]; *(LAS v4u*)(L + SB + o) = stB[j]; *(LAS v4u*)(L + SBT + o) = stBT[j]; }
#pragma unroll
            for (int j = 0; j < 2; ++j) { const int i = tid + 512 * j; *(LAS v4u*)(L + SXT + swz(i >> 4, i & 15)) = stX[j]; }
            if (wave == 0) {
                const float a0 = stdt.x * A, a1 = stdt.y * A; float p = a0 + a1;
#pragma unroll
                for (int o = 1; o < 64; o <<= 1) { const float t = __shfl_up(p, o); if (lane >= o) p += t; }
                const float tot = __shfl(p, 63);
                acs[2 * lane] = p - a1; acs[2 * lane + 1] = p; dtv[2 * lane] = stdt.x; dtv[2 * lane + 1] = stdt.y;
                w2[2 * lane] = stdt.x * __expf(tot - (p - a1)); w2[2 * lane + 1] = stdt.y * __expf(tot - p);
            }
            LDS_BAR();
            if (cc + 1 < NCHUNK) SSD_LOAD(cc + 1);
            bf16x8 cf[8];
#pragma unroll
            for (int ks = 0; ks < 8; ++ks) cf[ks] = ldfrag(L + SC, 32 * lb + c, 2 * ks + hi);
            f32x16 yacc;
#pragma unroll
            for (int r = 0; r < 16; ++r) yacc[r] = 0.f;
#pragma unroll
            for (int ks = 0; ks < 8; ++ks) yacc = __builtin_amdgcn_mfma_f32_32x32x16_bf16(ldfrag(L + SS, 32 * pb + c, 2 * ks + hi), cf[ks], yacc, 0, 0, 0);
            const float acl = acs[32 * lb + c]; const float el = __expf(acl);
#pragma unroll
            for (int r = 0; r < 16; ++r) yacc[r] *= el;
            f32x16 cb0, cb1;
#pragma unroll
            for (int r = 0; r < 16; ++r) { cb0[r] = 0.f; cb1[r] = 0.f; }
            if (sb0 <= lb) {
#pragma unroll
                for (int ks = 0; ks < 8; ++ks) cb0 = __builtin_amdgcn_mfma_f32_32x32x16_bf16(ldfrag(L + SB, 32 * sb0 + c, 2 * ks + hi), cf[ks], cb0, 0, 0, 0);
            }
            if (sb0 + 1 <= lb) {
#pragma unroll
                for (int ks = 0; ks < 8; ++ks) cb1 = __builtin_amdgcn_mfma_f32_32x32x16_bf16(ldfrag(L + SB, 32 * (sb0 + 1) + c, 2 * ks + hi), cf[ks], cb1, 0, 0, 0);
            }
            const int lrow = 32 * lb + c;
#pragma unroll
            for (int q = 0; q < 4; ++q) {
                const int s0a = 32 * sb0 + 8 * q + 4 * hi, s0b = s0a + 32;
                const f32x4 aa = *(LAS const f32x4*)(acs + s0a), da = *(LAS const f32x4*)(dtv + s0a), ab = *(LAS const f32x4*)(acs + s0b), db = *(LAS const f32x4*)(dtv + s0b);
#pragma unroll
                for (int j = 0; j < 4; ++j) {
                    cb0[4 * q + j] = (s0a + j <= lrow) ? cb0[4 * q + j] * __expf(acl - aa[j]) * da[j] : 0.f;
                    cb1[4 * q + j] = (s0b + j <= lrow) ? cb1[4 * q + j] * __expf(acl - ab[j]) * db[j] : 0.f;
                }
            }
            LDS_BAR();
#pragma unroll
            for (int q = 0; q < 4; ++q) {
                v2u wa, wb; wa.x = pk2(cb0[4 * q], cb0[4 * q + 1]); wa.y = pk2(cb0[4 * q + 2], cb0[4 * q + 3]); wb.x = pk2(cb1[4 * q], cb1[4 * q + 1]); wb.y = pk2(cb1[4 * q + 2], cb1[4 * q + 3]);
                *(LAS v2u*)(L + SB + swz(lrow, 4 * sb0 + q) + 8 * hi) = wa; *(LAS v2u*)(L + SB + swz(lrow, 4 * (sb0 + 1) + q) + 8 * hi) = wb;
            }
            LDS_BAR();
            const int nks = 2 * (lb + 1);
            for (int ks = 0; ks < nks; ++ks) yacc = __builtin_amdgcn_mfma_f32_32x32x16_bf16(ldfrag(L + SXT, 32 * pb + c, 2 * ks + hi), ldfrag(L + SB, lrow, 2 * ks + hi), yacc, 0, 0, 0);
            {
                GAS bf16* yrow = (GAS bf16*)Y + (size_t)(b * SEQ + cc * 128 + lrow) * DI + h * 64 + 32 * pb + 4 * hi;
#pragma unroll
                for (int q = 0; q < 4; ++q) {
                    float yv[4];
#pragma unroll
                    for (int j = 0; j < 4; ++j) { const int p = 32 * pb + 8 * q + 4 * hi + j; const float xv = bf1(*(LAS const bf16*)(L + SXT + swz(p, lrow >> 3) + (lrow & 7) * 2)); yv[j] = yacc[4 * q + j] + Dh * xv; }
                    v2u w; w.x = pk2(yv[0], yv[1]); w.y = pk2(yv[2], yv[3]); *(GAS v2u*)(yrow + 8 * q) = w;
                }
            }
            {
                const float etot = __expf(acs[127]);
#pragma unroll
                for (int r = 0; r < 16; ++r) sacc[r] *= etot;
#pragma unroll
                for (int ks = 0; ks < 8; ++ks) {
                    const bf16x8 xa = ldfrag(L + SXT, 32 * pb + c, 2 * ks + hi);
                    const f32x4 wA = *(LAS const f32x4*)(w2 + 16 * ks + 8 * hi), wB = *(LAS const f32x4*)(w2 + 16 * ks + 8 * hi + 4);
                    const v4u xu = __builtin_bit_cast(v4u, xa);
                    v4u xs; xs.x = pk2(bf_lo(xu.x) * wA[0], bf_hi(xu.x) * wA[1]); xs.y = pk2(bf_lo(xu.y) * wA[2], bf_hi(xu.y) * wA[3]);
                    xs.z = pk2(bf_lo(xu.z) * wB[0], bf_hi(xu.z) * wB[1]); xs.w = pk2(bf_lo(xu.w) * wB[2], bf_hi(xu.w) * wB[3]);
                    sacc = __builtin_amdgcn_mfma_f32_32x32x16_bf16(ldfrag(L + SBT, 32 * nb + c, 2 * ks + hi), __builtin_bit_cast(bf16x8, xs), sacc, 0, 0, 0);
                }
                const int prow = 32 * pb + c;
#pragma unroll
                for (int q = 0; q < 4; ++q) { v2u w; w.x = pk2(sacc[4 * q], sacc[4 * q + 1]); w.y = pk2(sacc[4 * q + 2], sacc[4 * q + 3]); *(LAS v2u*)(L + SS + swz(prow, 4 * nb + q) + 8 * hi) = w; }
            }
            LDS_BAR();
        }
#undef SSD_LOAD
    }
}

__device__ __forceinline__ void gated_norm_phase(Frame& F, const bf16* Y, const bf16* ZX, const float* nw, bf16* G) {
    const int gw = F.vcu * NWAVES + F.wave, NGW = F.G * NWAVES, lane = F.lane;
    constexpr int UN = 8;
    for (int it0 = gw; it0 < M * NGRP; it0 += UN * NGW) {
        v4u yr[UN][2], zr[UN][2];
#pragma unroll
        for (int u = 0; u < UN; ++u) { const int it = it0 + u * NGW, m = it >> 3, g = it & 7;
#pragma unroll
            for (int j = 0; j < 2; ++j) { const int col = g * 1024 + j * 512 + lane * 8;
                if (it < M * NGRP) { yr[u][j] = *(const GAS v4u*)((const GAS bf16*)Y + (size_t)m * DI + col); zr[u][j] = *(const GAS v4u*)((const GAS bf16*)ZX + (size_t)m * NZXP + col); } } }
#pragma unroll
        for (int u = 0; u < UN; ++u) { const int it = it0 + u * NGW, m = it >> 3, g = it & 7;
            if (it >= M * NGRP) break;
            float gv[16]; float ss = 0.f;
#pragma unroll
            for (int j = 0; j < 2; ++j) { float yv[8], zv[8]; unpack8(yr[u][j], yv); unpack8(zr[u][j], zv);
#pragma unroll
                for (int e = 0; e < 8; ++e) { const float t = yv[e] * silu_f(zv[e]); gv[8 * j + e] = t; ss += t * t; } }
            const float rstd = 1.0f / sqrtf(wave_sum(ss) * (1.f / 1024.f) + EPS);
#pragma unroll
            for (int j = 0; j < 2; ++j) {
                const int col = g * 1024 + j * 512 + lane * 8;
                const f32x4 wa = *(const GAS f32x4*)(nw + col), wb = *(const GAS f32x4*)(nw + col + 4);
                v4u o; o.x = pk2(gv[8 * j] * rstd * wa[0], gv[8 * j + 1] * rstd * wa[1]); o.y = pk2(gv[8 * j + 2] * rstd * wa[2], gv[8 * j + 3] * rstd * wa[3]);
                o.z = pk2(gv[8 * j + 4] * rstd * wb[0], gv[8 * j + 5] * rstd * wb[1]); o.w = pk2(gv[8 * j + 6] * rstd * wb[2], gv[8 * j + 7] * rstd * wb[3]);
                *(GAS v4u*)((GAS bf16*)G + (size_t)m * DI + col) = o;
            }
        }
    }
}

__device__ __forceinline__ void rope_table_phase(Frame& F, const int* positions, float* cs, float* sn) {
    for (int i = F.vcu * NTHR + F.tid; i < M * 64; i += F.G * NTHR) {
        const int d = i & 63, m = i >> 6;
        const float inv = 1.0f / powf(10000.0f, (float)(2 * d) * (1.0f / 128.0f));
        const float ang = (float)positions[m] * inv;
        const float k = rintf(ang * 0.15915494309189535f);
        float r = fmaf(-k, 6.28125f, ang); r = fmaf(-k, 1.9353071795864769e-3f, r);
        const float rev = r * 0.15915494309189535f;
        cs[i] = __builtin_amdgcn_cosf(rev); sn[i] = __builtin_amdgcn_sinf(rev);
    }
}
__device__ __forceinline__ void rope_phase(Frame& F, bf16* QKVH, const float* cs, const float* sn) {
    const int total = 64 * M * 8;
    for (int i = F.vcu * NTHR + F.tid; i < total; i += F.G * NTHR) {
        const int d8 = i & 7, m = (i >> 3) & (M - 1), cg = i >> 16;
        GAS bf16* row = (GAS bf16*)QKVH + ((size_t)cg * M + m) * 128 + d8 * 8;
        float a[8], b[8];
        unpack8(*(const GAS v4u*)row, a); unpack8(*(const GAS v4u*)(row + 64), b);
        const f32x4 c0 = *(const GAS f32x4*)(cs + (size_t)m * 64 + d8 * 8), c1 = *(const GAS f32x4*)(cs + (size_t)m * 64 + d8 * 8 + 4);
        const f32x4 s0 = *(const GAS f32x4*)(sn + (size_t)m * 64 + d8 * 8), s1 = *(const GAS f32x4*)(sn + (size_t)m * 64 + d8 * 8 + 4);
        float oa[8], ob[8];
#pragma unroll
        for (int j = 0; j < 8; ++j) { const float cc = j < 4 ? c0[j & 3] : c1[j & 3], ss = j < 4 ? s0[j & 3] : s1[j & 3]; oa[j] = a[j] * cc - b[j] * ss; ob[j] = b[j] * cc + a[j] * ss; }
        v4u wa, wb; wa.x = pk2(oa[0], oa[1]); wa.y = pk2(oa[2], oa[3]); wa.z = pk2(oa[4], oa[5]); wa.w = pk2(oa[6], oa[7]);
        wb.x = pk2(ob[0], ob[1]); wb.y = pk2(ob[2], ob[3]); wb.z = pk2(ob[4], ob[5]); wb.w = pk2(ob[6], ob[7]);
        *(GAS v4u*)row = wa; *(GAS v4u*)(row + 64) = wb;
    }
}
typedef att::BlockRef<att::bf16, float> AttRef;
__device__ __forceinline__ AttRef att_ref(const bf16* QKVH, float* OP, int L, int pass) {
    const int combo = L >> 3, x = L & 7;
    const int vh = combo & 1, c = (combo >> 1) & 1, h = (combo >> 2) & 15, b = combo >> 6;
    const int qb = pass ? 15 - x : x;
    const size_t GS = (size_t)M * 128;
    AttRef r;
    r.Q = QKVH + (size_t)(2 * h + c) * GS + (size_t)(b * SEQ + qb * 256) * 128;
    r.K = QKVH + (size_t)(32 + 2 * h + c) * GS + (size_t)(b * SEQ) * 128;
    r.V = QKVH + (size_t)(64 + 2 * h + vh) * GS + (size_t)(b * SEQ) * 128;
    r.O = OP + (size_t)((2 * h + c) * 2 + vh) * GS + (size_t)(b * SEQ + qb * 256) * 128;
    r.P0 = qb * 256;
    return r;
}
__device__ __forceinline__ void attn_phase(Frame& F, const bf16* QKVH, float* OP, char* lds) {
    constexpr int TOTAL = 1024;
    int L = F.vcu; if (L >= TOTAL) return;
    const int stride = F.G; int pass = 0;
    AttRef cur = att_ref(QKVH, OP, L, 0);
    att::Seam<att::bf16> S;
    att::causal_swa_prime<att::bf16, float>(cur, SEQ, lds, S);
    for (;;) {
        const bool more_pass = pass == 0, more_item = L + stride < TOTAL, last = !more_pass && !more_item;
        int passn = pass + 1, Ln = L;
        if (!more_pass) { passn = 0; Ln = more_item ? L + stride : L; }
        const AttRef nxt = last ? cur : att_ref(QKVH, OP, Ln, passn);
        att::causal_swa_block<att::bf16, float>(cur, nxt, SEQ, SEQ, lds, S);
        if (last) break;
        cur = nxt; pass = passn; L = Ln;
    }
}
namespace att2 {
using att::bf16x8; using att::s16x4; using att::f32x16; using att::f32x4;
constexpr int QROWS = 128, KT = 64, K_BYTES = 16384, V_BYTES = 32768;
constexpr int OFF_K = 0, OFF_V = 2 * K_BYTES, OFF_P = OFF_V + 2 * V_BYTES, OFF_AL = OFF_P + 2 * 4 * 4096, OFF_LL = OFF_AL + 2 * 4 * 32 * 4, LDS_NEED = OFF_LL + 4 * 32 * 4;
__device__ __forceinline__ int v_st2(int k, int c) { const int kk = (k & ~0xC) | ((k & 4) << 1) | ((k & 8) >> 1); return ((kk >> 3) * 8 + (c >> 5)) * 512 + ((kk & 7) * 32 + (c & 31)) * 2; }
struct Blk { const unsigned short* Q; const unsigned short* K; const unsigned short* V0; const unsigned short* V1; float* O; int P0; unsigned short* AO; const float* subln; float lam, post; };
typedef att::u32x4 u4;

template <int PAR>
__device__ __forceinline__ void stageK(const Blk& B, char* lds, int t, int NT, int tid, u4 (&stK)[4]) {
    if (t + 1 < NT) {
#pragma unroll
        for (int j = 0; j < 4; ++j) { const int id = tid + 256 * j, key = id >> 4, col = (id & 15) * 8; *(u4*)(lds + OFF_K + (PAR ^ 1) * K_BYTES + KSWZ(key, col * 2)) = stK[j]; }
    }
    if (t + 2 < NT) {
#pragma unroll
        for (int j = 0; j < 4; ++j) { const int id = tid + 256 * j, key = id >> 4, col = (id & 15) * 8; stK[j] = *(const __attribute__((address_space(1))) u4*)(B.K + (size_t)((t + 2) * KT + key) * 128 + col); }
    }
}
template <int PAR>
__device__ __forceinline__ void stageV(const Blk& B, char* lds, int t, int NT, int tid, u4 (&stV)[8]) {
    if (t < NT) {
#pragma unroll
        for (int j = 0; j < 8; ++j) { const int id = tid + 256 * j, key = id >> 5, col = (id & 31) * 8; *(u4*)(lds + OFF_V + PAR * V_BYTES + v_st2(key, col)) = stV[j]; }
    }
    if (t + 1 < NT) {
#pragma unroll
        for (int j = 0; j < 8; ++j) { const int id = tid + 256 * j, key = id >> 5, col = (id & 31) * 8;
            stV[j] = *(const __attribute__((address_space(1))) u4*)((col < 128 ? B.V0 + col : B.V1 + (col - 128)) + (size_t)((t + 1) * KT + key) * 128); }
    }
}
template <int PAR>
__device__ __forceinline__ void step_prod(const Blk& B, char* lds, int t, int NT, int tid, int wid, int lane, int r32, int hi, const bf16x8 (&qr)[8], float& m_reg, float& l_reg, u4 (&stV)[8]) {
    stageV<PAR>(B, lds, t, NT, tid, stV);
    if (t < NT) {
        f32x16 p0, p1; float mn, al; bf16x8 pa0, pa1, pa2, pa3;
        __builtin_amdgcn_s_setprio(2);
        att::qkt<PAR, false>(p0, p1, lds + OFF_K, r32, hi, qr, true);
        __builtin_amdgcn_s_setprio(0);
        const int kb = t * KT, qlo = B.P0 + wid * 32;
        if (kb + KT - 1 > qlo) att::mask_tile(p0, p1, qlo + r32 - 4 * hi - kb, (unsigned)0x7fffffff);
        att::partialSM(p0, p1, m_reg, mn, al);
        att::finishSM(p0, p1, al, l_reg, pa0, pa1, pa2, pa3);
        char* pb = lds + OFF_P + (PAR * 4 + wid) * 4096 + lane * 16;
        *(bf16x8*)(pb) = pa0; *(bf16x8*)(pb + 1024) = pa1; *(bf16x8*)(pb + 2048) = pa2; *(bf16x8*)(pb + 3072) = pa3;
        if (hi == 0) ((float*)(lds + OFF_AL))[(PAR * 4 + wid) * 32 + r32] = al;
    }
    __syncthreads();
}
template <int PAR>
__device__ __forceinline__ void step_cons(const Blk& B, char* lds, int t, int NT, int tid, int p, int lane, int r32, int hi, f32x16 (&o)[8], u4 (&stK)[4]) {
    stageK<PAR>(B, lds, t, NT, tid - 256, stK);
    if (t >= 1) {
        constexpr int UP = PAR ^ 1;
        const float* alp = (const float*)(lds + OFF_AL) + (UP * 4 + p) * 32;
        const float a = alp[r32];
        if (__any(a < 1.f)) {
#pragma unroll
            for (int r = 0; r < 16; ++r) { const float ar = alp[att::crow(r, hi)];
#pragma unroll
                for (int d = 0; d < 8; ++d) o[d][r] *= ar; }
        }
        const char* pb = lds + OFF_P + (UP * 4 + p) * 4096 + lane * 16;
        const bf16x8 pa0 = *(const bf16x8*)(pb), pa1 = *(const bf16x8*)(pb + 1024), pa2 = *(const bf16x8*)(pb + 2048), pa3 = *(const bf16x8*)(pb + 3072);
        const int vb0 = (int)(uintptr_t)(lds + OFF_V) + att::v_rd_base(lane);
#define A2_TRRD(dst, off) asm volatile("ds_read_b64_tr_b16 %0, %1 offset:%2" : "=&v"(dst) : "v"(vb0), "i"(off) : "memory")
#define A2_LDG(L, H, ks, dh) do { constexpr int b_ = UP * V_BYTES + (ks) * 8192 + (dh) * 2048; \
        A2_TRRD(L[0], b_); A2_TRRD(H[0], b_ + 4096); A2_TRRD(L[1], b_ + 512); A2_TRRD(H[1], b_ + 512 + 4096); A2_TRRD(L[2], b_ + 1024); A2_TRRD(H[2], b_ + 1024 + 4096); A2_TRRD(L[3], b_ + 1536); A2_TRRD(H[3], b_ + 1536 + 4096); } while (0)
#define A2_MMA(L, H, pa, dh) do { _Pragma("unroll") for (int d = 0; d < 4; ++d) \
        o[4 * (dh) + d] = __builtin_amdgcn_mfma_f32_32x32x16_bf16(pa, (bf16x8){L[d][0], L[d][1], L[d][2], L[d][3], H[d][0], H[d][1], H[d][2], H[d][3]}, o[4 * (dh) + d], 0, 0, 0); } while (0)
#define A2_W8() do { asm volatile("s_waitcnt lgkmcnt(8)" ::: "memory"); SBAR(); } while (0)
        {
            s16x4 La[4], Ha[4], Lb[4], Hb[4];
            asm volatile("s_waitcnt lgkmcnt(0)" ::: "memory"); SBAR();
            A2_LDG(La, Ha, 0, 0); A2_LDG(Lb, Hb, 0, 1);
            A2_W8(); A2_MMA(La, Ha, pa0, 0); SBAR(); A2_LDG(La, Ha, 1, 0);
            A2_W8(); A2_MMA(Lb, Hb, pa0, 1); SBAR(); A2_LDG(Lb, Hb, 1, 1);
            A2_W8(); A2_MMA(La, Ha, pa1, 0); SBAR(); A2_LDG(La, Ha, 2, 0);
            A2_W8(); A2_MMA(Lb, Hb, pa1, 1); SBAR(); A2_LDG(Lb, Hb, 2, 1);
            A2_W8(); A2_MMA(La, Ha, pa2, 0); SBAR(); A2_LDG(La, Ha, 3, 0);
            A2_W8(); A2_MMA(Lb, Hb, pa2, 1); SBAR(); A2_LDG(Lb, Hb, 3, 1);
            A2_W8(); A2_MMA(La, Ha, pa3, 0); SBAR();
            asm volatile("s_waitcnt lgkmcnt(0)" ::: "memory"); SBAR(); A2_MMA(Lb, Hb, pa3, 1); SBAR();
        }
#undef A2_W8
#undef A2_MMA
#undef A2_LDG
#undef A2_TRRD
    }
    __syncthreads();
}

template <int MODE>
__device__ __forceinline__ void block(const Blk& B, char* lds) {
    int tl = threadIdx.x; asm volatile("" : "+v"(tl));
    const int tid = tl, wid = __builtin_amdgcn_readfirstlane(tid >> 6), lane = tid & 63, r32 = lane & 31, hi = lane >> 5;
    const int NT = (B.P0 + QROWS - 1) / KT + 1;
    if (wid < 4) {
        bf16x8 qr[8]; float m_reg = -1e30f, l_reg = 0.f; u4 stV[8];
#pragma unroll
        for (int j = 0; j < 8; ++j) { const int id = tid + 256 * j, key = id >> 5, col = (id & 31) * 8; stV[j] = *(const __attribute__((address_space(1))) u4*)((col < 128 ? B.V0 + col : B.V1 + (col - 128)) + (size_t)key * 128); }
#pragma unroll
        for (int d0 = 0; d0 < 8; ++d0) qr[d0] = *(const __attribute__((address_space(1))) bf16x8*)(B.Q + (size_t)(wid * 32 + r32) * 128 + d0 * 16 + hi * 8);
        __syncthreads();
        for (int t = 0; t <= NT; t += 2) {
            step_prod<0>(B, lds, t, NT, tid, wid, lane, r32, hi, qr, m_reg, l_reg, stV);
            if (t + 1 <= NT) step_prod<1>(B, lds, t + 1, NT, tid, wid, lane, r32, hi, qr, m_reg, l_reg, stV);
        }
        if (hi == 0) ((float*)(lds + OFF_LL))[wid * 32 + r32] = l_reg;
        __syncthreads();
    } else {
        f32x16 o[8]; const int p = wid - 4; u4 stK[4];
#pragma unroll
        for (int j = 0; j < 4; ++j) { const int id = (tid - 256) + 256 * j, key = id >> 4, col = (id & 15) * 8; const u4 k0 = *(const __attribute__((address_space(1))) u4*)(B.K + (size_t)key * 128 + col); *(u4*)(lds + OFF_K + KSWZ(key, col * 2)) = k0; }
        if (NT > 1) {
#pragma unroll
            for (int j = 0; j < 4; ++j) { const int id = (tid - 256) + 256 * j, key = id >> 4, col = (id & 15) * 8; stK[j] = *(const __attribute__((address_space(1))) u4*)(B.K + (size_t)(KT + key) * 128 + col); }
        }
#pragma unroll
        for (int d = 0; d < 8; ++d)
#pragma unroll
            for (int r = 0; r < 16; ++r) o[d][r] = 0.f;
        __syncthreads();
        for (int t = 0; t <= NT; t += 2) {
            step_cons<0>(B, lds, t, NT, tid, p, lane, r32, hi, o, stK);
            if (t + 1 <= NT) step_cons<1>(B, lds, t + 1, NT, tid, p, lane, r32, hi, o, stK);
        }
        __syncthreads();
        const float* llp = (const float*)(lds + OFF_LL) + p * 32;
        float* Ow = B.O + (size_t)(p * 32) * 256;
        if constexpr (MODE == 0) {
#pragma unroll
            for (int r = 0; r < 16; ++r) { const int orow = att::crow(r, hi); const float rl = __builtin_amdgcn_rcpf(llp[orow]);
#pragma unroll
                for (int d = 0; d < 8; ++d) ((__attribute__((address_space(1))) float*)Ow)[(size_t)orow * 256 + d * 32 + r32] = o[d][r] * rl; }
        } else {
            asm volatile("s_waitcnt vmcnt(0)" ::: "memory");
            int ll_ = threadIdx.x; asm volatile("" : "+v"(ll_)); ll_ &= 63;
            f32x4 sw0 = {B.subln[r32], B.subln[32 + r32], B.subln[64 + r32], B.subln[96 + r32]}, sw1 = {B.subln[128 + r32], B.subln[160 + r32], B.subln[192 + r32], B.subln[224 + r32]};
#pragma unroll
            for (int r = 0; r < 16; ++r) { const int orow = att::crow(r, hi); const float rl = __builtin_amdgcn_rcpf(llp[orow]) * B.lam; float q = 0.f; float dv[8];
#pragma unroll
                for (int d = 0; d < 8; ++d) { const float o0 = ((const __attribute__((address_space(1))) float*)Ow)[(size_t)orow * 256 + d * 32 + r32]; dv[d] = o0 - o[d][r] * rl; q += dv[d] * dv[d]; }
#pragma unroll
                for (int sft = 1; sft < 32; sft <<= 1) q += __builtin_bit_cast(float, __builtin_amdgcn_ds_bpermute((ll_ ^ sft) << 2, __builtin_bit_cast(int, q)));
                const float rs = B.post / sqrtf(q * (1.f / 256.f) + 1e-5f);
                __attribute__((address_space(1))) unsigned short* arow = (__attribute__((address_space(1))) unsigned short*)B.AO + (size_t)(p * 32 + orow) * 4096 + r32;
#pragma unroll
                for (int d = 0; d < 8; ++d) { const float v = dv[d] * rs * (d < 4 ? sw0[d & 3] : sw1[d & 3]);
                    const float vn = __builtin_bit_cast(float, __builtin_amdgcn_update_dpp(0, __builtin_bit_cast(int, v), 0xB1, 0xf, 0xf, true));
                    if ((r32 & 1) == 0) *(__attribute__((address_space(1))) unsigned*)(arow + d * 32) = att::cvtpk(v, vn); }
            }
        }
    }
    __syncthreads();
}
}

__device__ __forceinline__ att2::Blk att2_ref(const bf16* QKVH, float* OP2, bf16* AO, const float* subln, float lam, float post, int L, int c, int pass) {
    const int bh = L >> 4, y = L & 15; const int h = bh & 15, b = bh >> 4; const int qb = pass ? 31 - y : y;
    const size_t GS = (size_t)M * 128;
    att2::Blk r;
    r.Q = QKVH + (size_t)(2 * h + c) * GS + (size_t)(b * SEQ + qb * 128) * 128;
    r.K = QKVH + (size_t)(32 + 2 * h + c) * GS + (size_t)(b * SEQ) * 128;
    r.V0 = QKVH + (size_t)(64 + 2 * h) * GS + (size_t)(b * SEQ) * 128;
    r.V1 = QKVH + (size_t)(65 + 2 * h) * GS + (size_t)(b * SEQ) * 128;
    r.O = OP2 + (size_t)h * M * 256 + (size_t)(b * SEQ + qb * 128) * 256;
    r.P0 = qb * 128;
    r.AO = AO + (size_t)(b * SEQ + qb * 128) * DM + h * 256; r.subln = subln; r.lam = lam; r.post = post;
    return r;
}
__device__ __forceinline__ void attn2_phase(Frame& F, const bf16* QKVH, float* OP2, char* lds, const float* lq1, const float* lk1, const float* lq2, const float* lk2, const float* subln, float lambda_init, bf16* AO) {
    const int lane = F.lane;
    const float d1 = wave_sum(lq1[lane] * lk1[lane] + lq1[lane + 64] * lk1[lane + 64]), d2 = wave_sum(lq2[lane] * lk2[lane] + lq2[lane + 64] * lk2[lane + 64]);
    const float lam = expf(d1) - expf(d2) + lambda_init, post = 1.0f - lambda_init;
    for (int L = F.vcu; L < 512; L += F.G) {
#pragma unroll 1
        for (int pass = 0; pass < 2; ++pass) {
            { const att2::Blk B = att2_ref(QKVH, OP2, AO, subln, lam, post, L, 0, pass); att2::block<0>(B, lds); }
            { const att2::Blk B = att2_ref(QKVH, OP2, AO, subln, lam, post, L, 1, pass); att2::block<1>(B, lds); }
        }
    }
}
__device__ __forceinline__ void attn_combine_phase(Frame& F, const float* OP, const float* lq1, const float* lk1, const float* lq2, const float* lk2, const float* subln, float lambda_init, bf16* AO) {
    const int gw = F.vcu * NWAVES + F.wave, NGW = F.G * NWAVES, lane = F.lane;
    const float d1 = wave_sum(lq1[lane] * lk1[lane] + lq1[lane + 64] * lk1[lane + 64]), d2 = wave_sum(lq2[lane] * lk2[lane] + lq2[lane + 64] * lk2[lane + 64]);
    const float lam = expf(d1) - expf(d2) + lambda_init, post = 1.0f - lambda_init;
    const int vh = lane >> 5, d = (lane & 31) * 4;
    const f32x4 sw = *(const GAS f32x4*)(subln + vh * 128 + d);
    const size_t GS = (size_t)M * 128;
    constexpr int UN = 8;
    for (int it0 = gw; it0 < M * AH; it0 += UN * NGW) {
        f32x4 o1[UN], o2[UN];
#pragma unroll
        for (int u = 0; u < UN; ++u) { const int it = it0 + u * NGW, m = it >> 4, h = it & 15;
            if (it < M * AH) { o1[u] = *(const GAS f32x4*)(OP + (size_t)(2 * h) * M * 256 + (size_t)m * 256 + vh * 128 + d); o2[u] = *(const GAS f32x4*)(OP + (size_t)(2 * h + 1) * M * 256 + (size_t)m * 256 + vh * 128 + d); } }
#pragma unroll
        for (int u = 0; u < UN; ++u) { const int it = it0 + u * NGW, m = it >> 4, h = it & 15;
            if (it >= M * AH) break;
            const f32x4 o = o1[u] - lam * o2[u];
            const float ss = wave_sum((o.x * o.x + o.y * o.y) + (o.z * o.z + o.w * o.w));
            const float rs = post / sqrtf(ss * (1.f / 256.f) + EPS);
            v2u w; w.x = pk2(o.x * rs * sw.x, o.y * rs * sw.y); w.y = pk2(o.z * rs * sw.z, o.w * rs * sw.w);
            *(GAS v2u*)((GAS bf16*)AO + (size_t)m * DM + h * 256 + vh * 128 + d) = w;
        }
    }
}


struct Args { const float* in[57]; float* out; unsigned char* ws; };
__global__ void __launch_bounds__(NTHR, 2) trunk_fwd(Args args) {
    extern __shared__ __attribute__((aligned(16))) unsigned char lds[];
    Frame F;
    F.lds = (LAS unsigned char*)lds;
    F.tid = threadIdx.x; F.lane = F.tid & 63; F.wave = __builtin_amdgcn_readfirstlane(F.tid >> 6);
    gu32* ctl = (gu32*)(args.ws + WS_CTL);
    for (int u = F.tid; u < (LDS_BYTES - LDSCTL_OFF) / 4; u += NTHR) ((LAS unsigned*)(F.lds + LDSCTL_OFF))[u] = 0u;
    __syncthreads();
    volatile LAS unsigned* MISC = (volatile LAS unsigned*)(F.lds + MISC_OFF);
    XcdBarrier bar = xcd_barrier_post((unsigned*)(ctl + CW_BAR), MISC + 8);
#define GRID_BAR() do { xcd_barrier(bar); relaunder(F, args.ws); } while (0)

#define XR ((float*)(F.ws + WS_XR))
#define U ((bf16*)(F.ws + WS_U))
#define BIG ((bf16*)(F.ws + WS_BIG))
#define ACT2 ((bf16*)(F.ws + WS_ACT2))
#define XT ((bf16*)(F.ws + WS_XT))
#define Yb ((bf16*)(F.ws + WS_Y))
#define Bn ((bf16*)(F.ws + WS_BN))
#define BT ((bf16*)(F.ws + WS_BT))
#define Cn ((bf16*)(F.ws + WS_CN))
#define DTF ((float*)(F.ws + WS_DTF))
#define PART ((float*)(F.ws + WS_PART))
#define OP ((float*)(F.ws + WS_XT))
#define SSQ(k) ((unsigned long long*)((unsigned*)(F.ws + WS_CTL) + CW_SS) + (k) * M)
#define ropec ((float*)(F.ws + WS_ROPE))
#define ropes ((float*)(F.ws + WS_ROPE) + (size_t)M * 64)
    relaunder(F, args.ws);

    {
        int p0_prefix = 0;
#pragma unroll 1
        for (int layer = 0; layer < 4; ++layer) {
            const bool mamba = (layer & 1) == 0;
            const int ib = layer == 0 ? 2 : layer == 1 ? 16 : layer == 2 ? 29 : 43;
            const size_t wlo = WS_W + (layer == 0 ? 0 : layer == 1 ? WL_MAMBA : layer == 2 ? WL_MAMBA + WL_ATTN : 2 * WL_MAMBA + WL_ATTN);
            if (mamba) {
                p0_matrix(F, args.in[ib + 1], DM, NZX, NZXP, (bf16*)(F.ws + wlo + W_IN), p0_prefix, 0, args.in[ib + 0]);
                p0_matrix(F, args.in[ib + 8], DI, DM, DM, (bf16*)(F.ws + wlo + W_OUT), p0_prefix);
                p0_matrix(F, args.in[ib + 10], DM, NUP, NUP, (bf16*)(F.ws + wlo + W_UP_M), p0_prefix, 0, args.in[ib + 9], DFF / 256);
                if (layer == 0 || F.G != 256) p0_matrix(F, args.in[ib + 13], DFF, DM, DM, (bf16*)(F.ws + wlo + W_DOWN_M), p0_prefix);
            } else {
                p0_matrix(F, args.in[ib + 1], DM, NQKV, NQKV, (bf16*)(F.ws + wlo + W_QKV), p0_prefix, 2 * DM, args.in[ib + 0]);
                p0_matrix(F, args.in[ib + 7], DM, DM, DM, (bf16*)(F.ws + wlo + W_O), p0_prefix);
                p0_matrix(F, args.in[ib + 9], DM, NUP, NUP, (bf16*)(F.ws + wlo + W_UP_A), p0_prefix, 0, args.in[ib + 8], DFF / 256);
                if (layer == 0 || F.G != 256) p0_matrix(F, args.in[ib + 12], DFF, DM, DM, (bf16*)(F.ws + wlo + W_DOWN_A), p0_prefix);
            }
        }
        rope_table_phase(F, (const int*)args.in[1], ropec, ropes);
        { const int gw = F.vcu * NWAVES + F.wave, NGW = F.G * NWAVES;
          for (int m = gw; m < M; m += NGW) x_row_prep(args.in[0] + (size_t)m * DM, U + (size_t)m * DM, SSQ(0) + m, F.lane); }
        GRID_BAR();
    }

    {
        constexpr int layer = 0;
        constexpr bool mamba = (layer & 1) == 0;
        constexpr int ib = layer == 0 ? 2 : layer == 1 ? 16 : layer == 2 ? 29 : 43;
        constexpr size_t wlo = WS_W + (layer == 0 ? 0 : layer == 1 ? WL_MAMBA : layer == 2 ? WL_MAMBA + WL_ATTN : 2 * WL_MAMBA + WL_ATTN);
        const float* xin = layer == 0 ? args.in[0] : XR;
        if constexpr (mamba) {
            const bool splitdt = F.G == 256;
            if (splitdt) {
                { pg8::Gemm g{U, (const bf16*)(F.ws + wlo + W_IN), M, NZXM, DM}; pg8::StaticOrder S; S.init(M, NZXM, F.G, F.bx);
                  int pm0, ntab; rstd_table(F, S, SSQ(2 * layer), pm0, ntab);
                  pg8::EpiBf16S E{BIG, NZXP, SSQ(2 * layer), (const LAS float*)(F.lds + TAB_OFF), pm0, ntab};
                  pg8::gemm_phase<pg8::EpiBf16S, pg8::StaticOrder, PG8_ALIGN, PG8_SP2>(F.lds + RING_OFF, g, S, E); }
                { const int ks = F.vcu & 7; pg8::Gemm g{U + ks * 512, (const bf16*)(F.ws + wlo + W_IN) + (size_t)NZXM * DM + ks * 512, M, 256, 512, DM};
                  pg8::OneUnit S{F.vcu >> 3, 1}; pg8::EpiPart E{PART + (size_t)ks * M * 128};
                  pg8::gemm_phase<pg8::EpiPart, pg8::OneUnit, false, PG8_SP2>(F.lds + RING_OFF, g, S, E); }
            } else {
                { pg8::Gemm g{U, (const bf16*)(F.ws + wlo + W_IN), M, NZXP, DM}; pg8::StaticOrder S; S.init(M, NZXP, F.G, F.bx);
                  int pm0, ntab; rstd_table(F, S, SSQ(2 * layer), pm0, ntab);
                  pg8::EpiBf16S E{BIG, NZXP, SSQ(2 * layer), (const LAS float*)(F.lds + TAB_OFF), pm0, ntab};
                  pg8::gemm_phase<pg8::EpiBf16S, pg8::StaticOrder, PG8_ALIGN, PG8_SP2>(F.lds + RING_OFF, g, S, E); }
            }
            GRID_BAR();
            ssd_prep_phase(F, BIG, args.in[ib + 2], args.in[ib + 3], args.in[ib + 4], XT, Bn, BT, Cn, DTF, splitdt ? PART : nullptr, SSQ(2 * layer));
            GRID_BAR();
            ssd_phase(F, XT, Bn, BT, Cn, DTF, args.in[ib + 5], args.in[ib + 6], Yb);
            GRID_BAR();
            gated_norm_phase(F, Yb, BIG, args.in[ib + 7], ACT2);
            GRID_BAR();
            { pg8::Gemm g{ACT2, (const bf16*)(F.ws + wlo + W_OUT), M, DM, DI}; pg8::StaticOrder S; S.init(M, DM, F.G, F.bx);
              pg8::EpiResN E{xin, XR, U, SSQ(2 * layer + 1), DM};
              pg8::gemm_phase<pg8::EpiResN, pg8::StaticOrder, PG8_ALIGN, PG8_SP2>(F.lds + RING_OFF, g, S, E); }
            GRID_BAR();
        } else {
            { pg8::Gemm g{U, (const bf16*)(F.ws + wlo + W_QKV), M, NQKV, DM}; pg8::StaticOrder S; S.init(M, NQKV, F.G, F.bx);
              int pm0, ntab; rstd_table(F, S, SSQ(2 * layer), pm0, ntab);
              pg8::EpiHeadMajor E{BIG, (size_t)M * 128, ropec, ropes, SSQ(2 * layer), (const LAS float*)(F.lds + TAB_OFF), pm0, ntab};
              pg8::gemm_phase<pg8::EpiHeadMajor, pg8::StaticOrder, PG8_ALIGN, PG8_SP2>(F.lds + RING_OFF, g, S, E); }
            GRID_BAR();
            attn2_phase(F, BIG, OP, (char*)lds + RING_OFF, args.in[ib + 2], args.in[ib + 3], args.in[ib + 4], args.in[ib + 5], args.in[ib + 6], 0.8f - 0.6f * expf(-0.3f * (float)layer), ACT2);
            GRID_BAR();
            { pg8::Gemm g{ACT2, (const bf16*)(F.ws + wlo + W_O), M, DM, DM}; pg8::StaticOrder S; S.init(M, DM, F.G, F.bx);
              pg8::EpiResN E{xin, XR, U, SSQ(2 * layer + 1), DM};
              pg8::gemm_phase<pg8::EpiResN, pg8::StaticOrder, PG8_ALIGN, PG8_SP2>(F.lds + RING_OFF, g, S, E); }
            GRID_BAR();
        }
        constexpr int fb = mamba ? ib + 9 : ib + 8;
        { pg8::Gemm g{U, (const bf16*)(F.ws + wlo + (mamba ? W_UP_M : W_UP_A)), M, NUP, DM}; pg8::StaticOrder S; S.init(M, NUP, F.G, F.bx);

          { pg8::EpiGate E{ACT2, BIG, args.in[fb + 2], args.in[fb + 3], NUP, DFF, SSQ(2 * layer + 1), F.lds + SIDE_OFF};
          pg8::gemm_phase<pg8::EpiGate, pg8::StaticOrder, PG8_ALIGN, PG8_SP2>(F.lds + RING_OFF, g, S, E); } }
        if constexpr (layer < 3) { if (F.G == 256 && F.bx >= 192) {
            constexpr bool nm = ((layer + 1) & 1) == 0; constexpr int nib = layer + 1 == 1 ? 16 : layer + 1 == 2 ? 29 : 43;
            constexpr size_t nwlo = WS_W + (layer + 1 == 1 ? WL_MAMBA : layer + 1 == 2 ? WL_MAMBA + WL_ATTN : 2 * WL_MAMBA + WL_ATTN);
            int nopfx = 0; p0_matrix(F, args.in[nib + (nm ? 13 : 12)], DFF, DM, DM, (bf16*)(F.ws + nwlo + (nm ? W_DOWN_M : W_DOWN_A)), nopfx, 0, nullptr, 0, F.bx - 192, 64); } }
        GRID_BAR();
        ffn_fix_phase(F, BIG, args.in[fb + 2], args.in[fb + 3], ACT2);
        GRID_BAR();
        { pg8::Gemm g{ACT2, (const bf16*)(F.ws + wlo + (mamba ? W_DOWN_M : W_DOWN_A)), M, DM, DFF}; pg8::StaticOrder S; S.init(M, DM, F.G, F.bx);
          pg8::EpiResN E{XR, XR, U, SSQ(2 * layer + 2), DM};
          pg8::gemm_phase<pg8::EpiResN, pg8::StaticOrder, PG8_ALIGN, PG8_SP2>(F.lds + RING_OFF, g, S, E); }
        GRID_BAR();
    }
    {
        constexpr int layer = 1;
        constexpr bool mamba = (layer & 1) == 0;
        constexpr int ib = layer == 0 ? 2 : layer == 1 ? 16 : layer == 2 ? 29 : 43;
        constexpr size_t wlo = WS_W + (layer == 0 ? 0 : layer == 1 ? WL_MAMBA : layer == 2 ? WL_MAMBA + WL_ATTN : 2 * WL_MAMBA + WL_ATTN);
        const float* xin = layer == 0 ? args.in[0] : XR;
        if constexpr (mamba) {
            const bool splitdt = F.G == 256;
            if (splitdt) {
                { pg8::Gemm g{U, (const bf16*)(F.ws + wlo + W_IN), M, NZXM, DM}; pg8::StaticOrder S; S.init(M, NZXM, F.G, F.bx);
                  int pm0, ntab; rstd_table(F, S, SSQ(2 * layer), pm0, ntab);
                  pg8::EpiBf16S E{BIG, NZXP, SSQ(2 * layer), (const LAS float*)(F.lds + TAB_OFF), pm0, ntab};
                  pg8::gemm_phase<pg8::EpiBf16S, pg8::StaticOrder, PG8_ALIGN, PG8_SP2>(F.lds + RING_OFF, g, S, E); }
                { const int ks = F.vcu & 7; pg8::Gemm g{U + ks * 512, (const bf16*)(F.ws + wlo + W_IN) + (size_t)NZXM * DM + ks * 512, M, 256, 512, DM};
                  pg8::OneUnit S{F.vcu >> 3, 1}; pg8::EpiPart E{PART + (size_t)ks * M * 128};
                  pg8::gemm_phase<pg8::EpiPart, pg8::OneUnit, false, PG8_SP2>(F.lds + RING_OFF, g, S, E); }
            } else {
                { pg8::Gemm g{U, (const bf16*)(F.ws + wlo + W_IN), M, NZXP, DM}; pg8::StaticOrder S; S.init(M, NZXP, F.G, F.bx);
                  int pm0, ntab; rstd_table(F, S, SSQ(2 * layer), pm0, ntab);
                  pg8::EpiBf16S E{BIG, NZXP, SSQ(2 * layer), (const LAS float*)(F.lds + TAB_OFF), pm0, ntab};
                  pg8::gemm_phase<pg8::EpiBf16S, pg8::StaticOrder, PG8_ALIGN, PG8_SP2>(F.lds + RING_OFF, g, S, E); }
            }
            GRID_BAR();
            ssd_prep_phase(F, BIG, args.in[ib + 2], args.in[ib + 3], args.in[ib + 4], XT, Bn, BT, Cn, DTF, splitdt ? PART : nullptr, SSQ(2 * layer));
            GRID_BAR();
            ssd_phase(F, XT, Bn, BT, Cn, DTF, args.in[ib + 5], args.in[ib + 6], Yb);
            GRID_BAR();
            gated_norm_phase(F, Yb, BIG, args.in[ib + 7], ACT2);
            GRID_BAR();
            { pg8::Gemm g{ACT2, (const bf16*)(F.ws + wlo + W_OUT), M, DM, DI}; pg8::StaticOrder S; S.init(M, DM, F.G, F.bx);
              pg8::EpiResN E{xin, XR, U, SSQ(2 * layer + 1), DM};
              pg8::gemm_phase<pg8::EpiResN, pg8::StaticOrder, PG8_ALIGN, PG8_SP2>(F.lds + RING_OFF, g, S, E); }
            GRID_BAR();
        } else {
            { pg8::Gemm g{U, (const bf16*)(F.ws + wlo + W_QKV), M, NQKV, DM}; pg8::StaticOrder S; S.init(M, NQKV, F.G, F.bx);
              int pm0, ntab; rstd_table(F, S, SSQ(2 * layer), pm0, ntab);
              pg8::EpiHeadMajor E{BIG, (size_t)M * 128, ropec, ropes, SSQ(2 * layer), (const LAS float*)(F.lds + TAB_OFF), pm0, ntab};
              pg8::gemm_phase<pg8::EpiHeadMajor, pg8::StaticOrder, PG8_ALIGN, PG8_SP2>(F.lds + RING_OFF, g, S, E); }
            GRID_BAR();
            attn2_phase(F, BIG, OP, (char*)lds + RING_OFF, args.in[ib + 2], args.in[ib + 3], args.in[ib + 4], args.in[ib + 5], args.in[ib + 6], 0.8f - 0.6f * expf(-0.3f * (float)layer), ACT2);
            GRID_BAR();
            { pg8::Gemm g{ACT2, (const bf16*)(F.ws + wlo + W_O), M, DM, DM}; pg8::StaticOrder S; S.init(M, DM, F.G, F.bx);
              pg8::EpiResN E{xin, XR, U, SSQ(2 * layer + 1), DM};
              pg8::gemm_phase<pg8::EpiResN, pg8::StaticOrder, PG8_ALIGN, PG8_SP2>(F.lds + RING_OFF, g, S, E); }
            GRID_BAR();
        }
        constexpr int fb = mamba ? ib + 9 : ib + 8;
        { pg8::Gemm g{U, (const bf16*)(F.ws + wlo + (mamba ? W_UP_M : W_UP_A)), M, NUP, DM}; pg8::StaticOrder S; S.init(M, NUP, F.G, F.bx);

          { pg8::EpiGate E{ACT2, BIG, args.in[fb + 2], args.in[fb + 3], NUP, DFF, SSQ(2 * layer + 1), F.lds + SIDE_OFF};
          pg8::gemm_phase<pg8::EpiGate, pg8::StaticOrder, PG8_ALIGN, PG8_SP2>(F.lds + RING_OFF, g, S, E); } }
        if constexpr (layer < 3) { if (F.G == 256 && F.bx >= 192) {
            constexpr bool nm = ((layer + 1) & 1) == 0; constexpr int nib = layer + 1 == 1 ? 16 : layer + 1 == 2 ? 29 : 43;
            constexpr size_t nwlo = WS_W + (layer + 1 == 1 ? WL_MAMBA : layer + 1 == 2 ? WL_MAMBA + WL_ATTN : 2 * WL_MAMBA + WL_ATTN);
            int nopfx = 0; p0_matrix(F, args.in[nib + (nm ? 13 : 12)], DFF, DM, DM, (bf16*)(F.ws + nwlo + (nm ? W_DOWN_M : W_DOWN_A)), nopfx, 0, nullptr, 0, F.bx - 192, 64); } }
        GRID_BAR();
        ffn_fix_phase(F, BIG, args.in[fb + 2], args.in[fb + 3], ACT2);
        GRID_BAR();
        { pg8::Gemm g{ACT2, (const bf16*)(F.ws + wlo + (mamba ? W_DOWN_M : W_DOWN_A)), M, DM, DFF}; pg8::StaticOrder S; S.init(M, DM, F.G, F.bx);
          pg8::EpiResN E{XR, XR, U, SSQ(2 * layer + 2), DM};
          pg8::gemm_phase<pg8::EpiResN, pg8::StaticOrder, PG8_ALIGN, PG8_SP2>(F.lds + RING_OFF, g, S, E); }
        GRID_BAR();
    }
    {
        constexpr int layer = 2;
        constexpr bool mamba = (layer & 1) == 0;
        constexpr int ib = layer == 0 ? 2 : layer == 1 ? 16 : layer == 2 ? 29 : 43;
        constexpr size_t wlo = WS_W + (layer == 0 ? 0 : layer == 1 ? WL_MAMBA : layer == 2 ? WL_MAMBA + WL_ATTN : 2 * WL_MAMBA + WL_ATTN);
        const float* xin = layer == 0 ? args.in[0] : XR;
        if constexpr (mamba) {
            const bool splitdt = F.G == 256;
            if (splitdt) {
                { pg8::Gemm g{U, (const bf16*)(F.ws + wlo + W_IN), M, NZXM, DM}; pg8::StaticOrder S; S.init(M, NZXM, F.G, F.bx);
                  int pm0, ntab; rstd_table(F, S, SSQ(2 * layer), pm0, ntab);
                  pg8::EpiBf16S E{BIG, NZXP, SSQ(2 * layer), (const LAS float*)(F.lds + TAB_OFF), pm0, ntab};
                  pg8::gemm_phase<pg8::EpiBf16S, pg8::StaticOrder, PG8_ALIGN, PG8_SP2>(F.lds + RING_OFF, g, S, E); }
                { const int ks = F.vcu & 7; pg8::Gemm g{U + ks * 512, (const bf16*)(F.ws + wlo + W_IN) + (size_t)NZXM * DM + ks * 512, M, 256, 512, DM};
                  pg8::OneUnit S{F.vcu >> 3, 1}; pg8::EpiPart E{PART + (size_t)ks * M * 128};
                  pg8::gemm_phase<pg8::EpiPart, pg8::OneUnit, false, PG8_SP2>(F.lds + RING_OFF, g, S, E); }
            } else {
                { pg8::Gemm g{U, (const bf16*)(F.ws + wlo + W_IN), M, NZXP, DM}; pg8::StaticOrder S; S.init(M, NZXP, F.G, F.bx);
                  int pm0, ntab; rstd_table(F, S, SSQ(2 * layer), pm0, ntab);
                  pg8::EpiBf16S E{BIG, NZXP, SSQ(2 * layer), (const LAS float*)(F.lds + TAB_OFF), pm0, ntab};
                  pg8::gemm_phase<pg8::EpiBf16S, pg8::StaticOrder, PG8_ALIGN, PG8_SP2>(F.lds + RING_OFF, g, S, E); }
            }
            GRID_BAR();
            ssd_prep_phase(F, BIG, args.in[ib + 2], args.in[ib + 3], args.in[ib + 4], XT, Bn, BT, Cn, DTF, splitdt ? PART : nullptr, SSQ(2 * layer));
            GRID_BAR();
            ssd_phase(F, XT, Bn, BT, Cn, DTF, args.in[ib + 5], args.in[ib + 6], Yb);
            GRID_BAR();
            gated_norm_phase(F, Yb, BIG, args.in[ib + 7], ACT2);
            GRID_BAR();
            { pg8::Gemm g{ACT2, (const bf16*)(F.ws + wlo + W_OUT), M, DM, DI}; pg8::StaticOrder S; S.init(M, DM, F.G, F.bx);
              pg8::EpiResN E{xin, XR, U, SSQ(2 * layer + 1), DM};
              pg8::gemm_phase<pg8::EpiResN, pg8::StaticOrder, PG8_ALIGN, PG8_SP2>(F.lds + RING_OFF, g, S, E); }
            GRID_BAR();
        } else {
            { pg8::Gemm g{U, (const bf16*)(F.ws + wlo + W_QKV), M, NQKV, DM}; pg8::StaticOrder S; S.init(M, NQKV, F.G, F.bx);
              int pm0, ntab; rstd_table(F, S, SSQ(2 * layer), pm0, ntab);
              pg8::EpiHeadMajor E{BIG, (size_t)M * 128, ropec, ropes, SSQ(2 * layer), (const LAS float*)(F.lds + TAB_OFF), pm0, ntab};
              pg8::gemm_phase<pg8::EpiHeadMajor, pg8::StaticOrder, PG8_ALIGN, PG8_SP2>(F.lds + RING_OFF, g, S, E); }
            GRID_BAR();
            attn2_phase(F, BIG, OP, (char*)lds + RING_OFF, args.in[ib + 2], args.in[ib + 3], args.in[ib + 4], args.in[ib + 5], args.in[ib + 6], 0.8f - 0.6f * expf(-0.3f * (float)layer), ACT2);
            GRID_BAR();
            { pg8::Gemm g{ACT2, (const bf16*)(F.ws + wlo + W_O), M, DM, DM}; pg8::StaticOrder S; S.init(M, DM, F.G, F.bx);
              pg8::EpiResN E{xin, XR, U, SSQ(2 * layer + 1), DM};
              pg8::gemm_phase<pg8::EpiResN, pg8::StaticOrder, PG8_ALIGN, PG8_SP2>(F.lds + RING_OFF, g, S, E); }
            GRID_BAR();
        }
        constexpr int fb = mamba ? ib + 9 : ib + 8;
        { pg8::Gemm g{U, (const bf16*)(F.ws + wlo + (mamba ? W_UP_M : W_UP_A)), M, NUP, DM}; pg8::StaticOrder S; S.init(M, NUP, F.G, F.bx);

          { pg8::EpiGate E{ACT2, BIG, args.in[fb + 2], args.in[fb + 3], NUP, DFF, SSQ(2 * layer + 1), F.lds + SIDE_OFF};
          pg8::gemm_phase<pg8::EpiGate, pg8::StaticOrder, PG8_ALIGN, PG8_SP2>(F.lds + RING_OFF, g, S, E); } }
        if constexpr (layer < 3) { if (F.G == 256 && F.bx >= 192) {
            constexpr bool nm = ((layer + 1) & 1) == 0; constexpr int nib = layer + 1 == 1 ? 16 : layer + 1 == 2 ? 29 : 43;
            constexpr size_t nwlo = WS_W + (layer + 1 == 1 ? WL_MAMBA : layer + 1 == 2 ? WL_MAMBA + WL_ATTN : 2 * WL_MAMBA + WL_ATTN);
            int nopfx = 0; p0_matrix(F, args.in[nib + (nm ? 13 : 12)], DFF, DM, DM, (bf16*)(F.ws + nwlo + (nm ? W_DOWN_M : W_DOWN_A)), nopfx, 0, nullptr, 0, F.bx - 192, 64); } }
        GRID_BAR();
        ffn_fix_phase(F, BIG, args.in[fb + 2], args.in[fb + 3], ACT2);
        GRID_BAR();
        { pg8::Gemm g{ACT2, (const bf16*)(F.ws + wlo + (mamba ? W_DOWN_M : W_DOWN_A)), M, DM, DFF}; pg8::StaticOrder S; S.init(M, DM, F.G, F.bx);
          pg8::EpiResN E{XR, XR, U, SSQ(2 * layer + 2), DM};
          pg8::gemm_phase<pg8::EpiResN, pg8::StaticOrder, PG8_ALIGN, PG8_SP2>(F.lds + RING_OFF, g, S, E); }
        GRID_BAR();
    }
    {
        constexpr int layer = 3;
        constexpr bool mamba = (layer & 1) == 0;
        constexpr int ib = layer == 0 ? 2 : layer == 1 ? 16 : layer == 2 ? 29 : 43;
        constexpr size_t wlo = WS_W + (layer == 0 ? 0 : layer == 1 ? WL_MAMBA : layer == 2 ? WL_MAMBA + WL_ATTN : 2 * WL_MAMBA + WL_ATTN);
        const float* xin = layer == 0 ? args.in[0] : XR;
        if constexpr (mamba) {
            const bool splitdt = F.G == 256;
            if (splitdt) {
                { pg8::Gemm g{U, (const bf16*)(F.ws + wlo + W_IN), M, NZXM, DM}; pg8::StaticOrder S; S.init(M, NZXM, F.G, F.bx);
                  int pm0, ntab; rstd_table(F, S, SSQ(2 * layer), pm0, ntab);
                  pg8::EpiBf16S E{BIG, NZXP, SSQ(2 * layer), (const LAS float*)(F.lds + TAB_OFF), pm0, ntab};
                  pg8::gemm_phase<pg8::EpiBf16S, pg8::StaticOrder, PG8_ALIGN, PG8_SP2>(F.lds + RING_OFF, g, S, E); }
                { const int ks = F.vcu & 7; pg8::Gemm g{U + ks * 512, (const bf16*)(F.ws + wlo + W_IN) + (size_t)NZXM * DM + ks * 512, M, 256, 512, DM};
                  pg8::OneUnit S{F.vcu >> 3, 1}; pg8::EpiPart E{PART + (size_t)ks * M * 128};
                  pg8::gemm_phase<pg8::EpiPart, pg8::OneUnit, false, PG8_SP2>(F.lds + RING_OFF, g, S, E); }
            } else {
                { pg8::Gemm g{U, (const bf16*)(F.ws + wlo + W_IN), M, NZXP, DM}; pg8::StaticOrder S; S.init(M, NZXP, F.G, F.bx);
                  int pm0, ntab; rstd_table(F, S, SSQ(2 * layer), pm0, ntab);
                  pg8::EpiBf16S E{BIG, NZXP, SSQ(2 * layer), (const LAS float*)(F.lds + TAB_OFF), pm0, ntab};
                  pg8::gemm_phase<pg8::EpiBf16S, pg8::StaticOrder, PG8_ALIGN, PG8_SP2>(F.lds + RING_OFF, g, S, E); }
            }
            GRID_BAR();
            ssd_prep_phase(F, BIG, args.in[ib + 2], args.in[ib + 3], args.in[ib + 4], XT, Bn, BT, Cn, DTF, splitdt ? PART : nullptr, SSQ(2 * layer));
            GRID_BAR();
            ssd_phase(F, XT, Bn, BT, Cn, DTF, args.in[ib + 5], args.in[ib + 6], Yb);
            GRID_BAR();
            gated_norm_phase(F, Yb, BIG, args.in[ib + 7], ACT2);
            GRID_BAR();
            { pg8::Gemm g{ACT2, (const bf16*)(F.ws + wlo + W_OUT), M, DM, DI}; pg8::StaticOrder S; S.init(M, DM, F.G, F.bx);
              pg8::EpiResN E{xin, XR, U, SSQ(2 * layer + 1), DM};
              pg8::gemm_phase<pg8::EpiResN, pg8::StaticOrder, PG8_ALIGN, PG8_SP2>(F.lds + RING_OFF, g, S, E); }
            GRID_BAR();
        } else {
            { pg8::Gemm g{U, (const bf16*)(F.ws + wlo + W_QKV), M, NQKV, DM}; pg8::StaticOrder S; S.init(M, NQKV, F.G, F.bx);
              int pm0, ntab; rstd_table(F, S, SSQ(2 * layer), pm0, ntab);
              pg8::EpiHeadMajor E{BIG, (size_t)M * 128, ropec, ropes, SSQ(2 * layer), (const LAS float*)(F.lds + TAB_OFF), pm0, ntab};
              pg8::gemm_phase<pg8::EpiHeadMajor, pg8::StaticOrder, PG8_ALIGN, PG8_SP2>(F.lds + RING_OFF, g, S, E); }
            GRID_BAR();
            attn2_phase(F, BIG, OP, (char*)lds + RING_OFF, args.in[ib + 2], args.in[ib + 3], args.in[ib + 4], args.in[ib + 5], args.in[ib + 6], 0.8f - 0.6f * expf(-0.3f * (float)layer), ACT2);
            GRID_BAR();
            { pg8::Gemm g{ACT2, (const bf16*)(F.ws + wlo + W_O), M, DM, DM}; pg8::StaticOrder S; S.init(M, DM, F.G, F.bx);
              pg8::EpiResN E{xin, XR, U, SSQ(2 * layer + 1), DM};
              pg8::gemm_phase<pg8::EpiResN, pg8::StaticOrder, PG8_ALIGN, PG8_SP2>(F.lds + RING_OFF, g, S, E); }
            GRID_BAR();
        }
        constexpr int fb = mamba ? ib + 9 : ib + 8;
        { pg8::Gemm g{U, (const bf16*)(F.ws + wlo + (mamba ? W_UP_M : W_UP_A)), M, NUP, DM}; pg8::StaticOrder S; S.init(M, NUP, F.G, F.bx);

          { pg8::EpiGate E{ACT2, BIG, args.in[fb + 2], args.in[fb + 3], NUP, DFF, SSQ(2 * layer + 1), F.lds + SIDE_OFF};
          pg8::gemm_phase<pg8::EpiGate, pg8::StaticOrder, PG8_ALIGN, PG8_SP2>(F.lds + RING_OFF, g, S, E); } }
        if constexpr (layer < 3) { if (F.G == 256 && F.bx >= 192) {
            constexpr bool nm = ((layer + 1) & 1) == 0; constexpr int nib = layer + 1 == 1 ? 16 : layer + 1 == 2 ? 29 : 43;
            constexpr size_t nwlo = WS_W + (layer + 1 == 1 ? WL_MAMBA : layer + 1 == 2 ? WL_MAMBA + WL_ATTN : 2 * WL_MAMBA + WL_ATTN);
            int nopfx = 0; p0_matrix(F, args.in[nib + (nm ? 13 : 12)], DFF, DM, DM, (bf16*)(F.ws + nwlo + (nm ? W_DOWN_M : W_DOWN_A)), nopfx, 0, nullptr, 0, F.bx - 192, 64); } }
        GRID_BAR();
        ffn_fix_phase(F, BIG, args.in[fb + 2], args.in[fb + 3], ACT2);
        GRID_BAR();
        { pg8::Gemm g{ACT2, (const bf16*)(F.ws + wlo + (mamba ? W_DOWN_M : W_DOWN_A)), M, DM, DFF}; pg8::StaticOrder S; S.init(M, DM, F.G, F.bx);
          pg8::EpiResN E{XR, XR, U, SSQ(2 * layer + 2), DM};
          pg8::gemm_phase<pg8::EpiResN, pg8::StaticOrder, PG8_ALIGN, PG8_SP2>(F.lds + RING_OFF, g, S, E); }
        GRID_BAR();
    }
    {
        const int gw = F.vcu * NWAVES + F.wave, NGW = F.G * NWAVES;
        for (int m = gw; m < M; m += NGW) rms_row_f32(XR + (size_t)m * DM, args.in[56], args.out + (size_t)m * DM, F.lane);
    }
#undef GRID_BAR
#undef XR
#undef U
#undef BIG
#undef ACT2
#undef XT
#undef Yb
#undef Bn
#undef BT
#undef Cn
#undef DTF
#undef PART
#undef OP
#undef SSQ
#undef ropec
#undef ropes
}
}

extern "C" void kernel_launch(void* const* d_in, const int* in_sizes, int n_in, void* d_out, int out_size, void* d_ws, size_t ws_size, hipStream_t stream) {
    using namespace mk;
    static int grid = 0;
    if (grid == 0) {
        if (n_in != 57 || out_size != M * DM || ws_size < WS_END) { fprintf(stderr, "kernel_launch: built for 57 inputs, out of %d floats, >= %zu bytes of workspace; got n_in %d, out %d, ws %zu; nothing launched\n", M * DM, (size_t)WS_END, n_in, out_size, ws_size); grid = -1; return; }
        int dev = 0, cus = 0, per_cu = 0;
        if (hipGetDevice(&dev) != hipSuccess || hipDeviceGetAttribute(&cus, hipDeviceAttributeMultiprocessorCount, dev) != hipSuccess) { fprintf(stderr, "kernel_launch: device query failed\n"); grid = -1; return; }
        if (hipFuncSetAttribute((const void*)trunk_fwd, hipFuncAttributeMaxDynamicSharedMemorySize, LDS_BYTES) != hipSuccess) { fprintf(stderr, "kernel_launch: hipFuncSetAttribute failed\n"); grid = -1; return; }
        if (hipOccupancyMaxActiveBlocksPerMultiprocessor(&per_cu, (const void*)trunk_fwd, NTHR, LDS_BYTES) != hipSuccess || per_cu < 1)
            fprintf(stderr, "kernel_launch: note: occupancy query reports %d workgroups per CU\n", per_cu);
        (void)hipGetLastError();
        grid = cus;
    }
    if (grid < 0) return;
    if (hipMemsetAsync((char*)d_ws + WS_CTL, 0, CTL_ZERO_BYTES, stream) != hipSuccess) { fprintf(stderr, "kernel_launch: memset failed\n"); return; }
    Args a{};
    for (int i = 0; i < 57; ++i) a.in[i] = (const float*)d_in[i];
    a.out = (float*)d_out; a.ws = (unsigned char*)d_ws;
    hipLaunchKernelGGL(trunk_fwd, dim3(grid), dim3(NTHR), LDS_BYTES, stream, a);
    const hipError_t le = hipPeekAtLastError();
    if (le != hipSuccess) fprintf(stderr, "kernel_launch: launch failed: %s\n", hipGetErrorName(le));
}
```

```cpp
#include <hip/hip_runtime.h>
#include <cstdio>
#include <cstdint>
namespace pg8 {
#define PG8_LAS __attribute__((address_space(3)))
typedef unsigned short bf16_t;
typedef short bf16x8 __attribute__((ext_vector_type(8)));
typedef float f32x4 __attribute__((ext_vector_type(4)));
typedef unsigned u32x4 __attribute__((ext_vector_type(4)));
constexpr int BM = 256, BK = 64, HALF = 128, HTB = HALF * BK * 2  , STAGE_BYTES = 8 * HTB, NXCD = 8, WGM = 8;

__host__ __device__ __forceinline__ int lds_byte(int r, int c) { const int st = (r >> 4) * 2 + (c >> 5), rr = r & 15, cc = c & 31, ob = rr * 64 + cc * 2; return st * 1024 + (ob ^ (((ob >> 9) & 1) << 5)); }
__host__ __device__ __forceinline__ void stage_rc(int b, int& R, int& C) { const int st = b / 1024, sb = b % 1024, swz = sb ^ (((sb >> 9) & 1) << 5); R = (st >> 1) * 16 + swz / 64; C = (st & 1) * 32 + (swz % 64) / 2; }
__host__ __device__ __forceinline__ int perm32(int rho) { const int n = rho >> 4, i = rho & 15; return 8 * (i >> 2) + 4 * n + (i & 3); }

struct Unit { int pm, pn; };
struct Gemm { const bf16_t* A; const bf16_t* Bt; int M, N, K; int ld = 0; };

struct StaticOrder {
    int nM, nN, nwg, G, c;
    __host__ __device__ void init(int M, int N, int G_, int c_) { nM = M / BM; nN = N / BM; nwg = nM * nN; G = G_; c = c_; }
    __host__ __device__ bool next(int i, Unit& u) const {
        const long L = (long)i * G + c; if (L >= nwg) return false;
        int wgid = (int)L; { const int q = nwg / NXCD, r = nwg % NXCD, xcd = wgid % NXCD, off = wgid / NXCD; wgid = (xcd < r ? xcd * (q + 1) : r * (q + 1) + (xcd - r) * q) + off; }
        const int nig = WGM * nN, gid = wgid / nig, fm = gid * WGM, gsz = (nM - fm) < WGM ? (nM - fm) : WGM;
        u.pm = fm + ((wgid % nig) % gsz); u.pn = (wgid % nig) / gsz; return true;
    }
    __device__ __forceinline__ void a_ready(const Unit&) const {}
    __device__ __forceinline__ void done(const Unit&) const {}
};

typedef float f32x2c __attribute__((ext_vector_type(2))); typedef __bf16 bf16x2c __attribute__((ext_vector_type(2)));
__device__ __forceinline__ unsigned cvt_pk_bf16(float lo, float hi) { const f32x2c v = {lo, hi}; return __builtin_bit_cast(unsigned, __builtin_convertvector(v, bf16x2c)); }
typedef float f32x2 __attribute__((ext_vector_type(2)));
__device__ __forceinline__ f32x2 gelu_pk(f32x2 v) {
    const f32x2 av = __builtin_elementwise_abs(v), d = av * 0.2316418882f + 1.0f;
    f32x2 t; t.x = __builtin_amdgcn_rcpf(d.x); t.y = __builtin_amdgcn_rcpf(d.y);
    f32x2 q = t * 0.5307027145f + (-0.7265760135f); q = q * t + 0.7107068705f; q = q * t + (-0.142248368f); q = q * t + 0.127414796f; q = q * t;
    const f32x2 s = (v * v) * (-0.72134752044f);
    f32x2 e; e.x = __builtin_amdgcn_exp2f(s.x); e.y = __builtin_amdgcn_exp2f(s.y);
    const f32x2 m = v * (q * e), r = v - m;
    f32x2 o; o.x = v.x < 0.f ? m.x : r.x; o.y = v.y < 0.f ? m.y : r.y; return o;
}

template <int ACT  > struct EpiBf16 {
    static constexpr bool PERM = true, AFTER_DRAIN = false; static_assert(ACT == 0 || ACT == 1, "EpiBf16: ACT is 0 (none) or 1 (gelu_pk)");
    bf16_t* O; int ldc; const float* bias; int split_cols; size_t split_stride; float scale0;
    __device__ __forceinline__ void operator()(const f32x4 (&acc)[2][2][4][2], const Unit& u, int wr, int wc, int fr, int fq) const {
        const int row0 = u.pm * BM + wr * 64 + fr; int colt = u.pn * BM; bf16_t* base = O;
        float sc = 1.f; if (split_cols) { const int t = colt / split_cols; base += (size_t)t * split_stride; colt -= t * split_cols; if (t == 0) sc = scale0; }
        const int col0 = colt + wc * 32 + 8 * fq, bcol0 = u.pn * BM + wc * 32 + 8 * fq;
        f32x4 bv[2][2];
#pragma unroll
        for (int bj = 0; bj < 2; ++bj)
#pragma unroll
            for (int n = 0; n < 2; ++n) bv[bj][n] = bias ? *(const f32x4*)(bias + bcol0 + bj * HALF + 4 * n) : (f32x4){0.f, 0.f, 0.f, 0.f};
#pragma unroll
        for (int ai = 0; ai < 2; ++ai)
#pragma unroll
            for (int m = 0; m < 4; ++m) { bf16_t* rowp = base + (size_t)(row0 + ai * HALF + m * 16) * ldc + col0;
#pragma unroll
                for (int bj = 0; bj < 2; ++bj) { f32x4 v0 = acc[ai][bj][m][0] + bv[bj][0], v1 = acc[ai][bj][m][1] + bv[bj][1];
                    if (ACT == 1) { f32x2 a = gelu_pk((f32x2){v0[0], v0[1]}), b = gelu_pk((f32x2){v0[2], v0[3]}), c = gelu_pk((f32x2){v1[0], v1[1]}), d = gelu_pk((f32x2){v1[2], v1[3]});
                        v0 = (f32x4){a.x, a.y, b.x, b.y}; v1 = (f32x4){c.x, c.y, d.x, d.y}; }
                    v0 = v0 * sc; v1 = v1 * sc; u32x4 w; w.x = cvt_pk_bf16(v0[0], v0[1]); w.y = cvt_pk_bf16(v0[2], v0[3]); w.z = cvt_pk_bf16(v1[0], v1[1]); w.w = cvt_pk_bf16(v1[2], v1[3]);
                    *(u32x4*)(rowp + bj * HALF) = w; } }
    }
};


struct EpiRes {
    static constexpr bool PERM = false, AFTER_DRAIN = false;
    const float* base; float* out; int ldc;
    __device__ __forceinline__ void operator()(const f32x4 (&acc)[2][2][4][2], const Unit& u, int wr, int wc, int fr, int fq) const {
        const int col0 = u.pn * BM + wc * 32 + 4 * fq;
#pragma unroll
        for (int ai = 0; ai < 2; ++ai)
#pragma unroll
            for (int m = 0; m < 4; ++m) { const size_t off = (size_t)(u.pm * BM + ai * HALF + wr * 64 + m * 16 + fr) * ldc + col0;
#pragma unroll
                for (int bj = 0; bj < 2; ++bj)
#pragma unroll
                    for (int n = 0; n < 2; ++n) { const f32x4 bs = *(const f32x4*)(base + off + bj * HALF + n * 16); *(f32x4*)(out + off + bj * HALF + n * 16) = bs + acc[ai][bj][m][n]; }
                if (m & 1) asm volatile("" ::: "memory"); }
    }
};
struct EpiHeadMajor {
    static constexpr bool PERM = true, AFTER_DRAIN = false;
    bf16_t* O; size_t gstride; const float* cs; const float* sn; const unsigned long long* ss; const PG8_LAS float* tab; int pm0, ntab;
    __device__ __forceinline__ void operator()(const f32x4 (&acc)[2][2][4][2], const Unit& u, int wr, int wc, int fr, int fq) const {
        const int row0 = u.pm * BM + wr * 64 + fr, col0 = wc * 32 + 8 * fq; const bool rope = u.pn < 32, intab = (unsigned)(u.pm - pm0) < (unsigned)ntab;
#pragma unroll
        for (int ai = 0; ai < 2; ++ai)
#pragma unroll
            for (int m = 0; m < 4; ++m) { const int row = row0 + ai * HALF + m * 16;
                const float rs = intab ? tab[row - pm0 * BM] : 1.0f / sqrtf((float)ss[row] * (1.0f / (4096.0f * 16777216.0f)) + 1e-5f);
                f32x4 c4 = {1.f, 1.f, 1.f, 1.f}, s4 = {0.f, 0.f, 0.f, 0.f};
                if (rope) { c4 = *(const f32x4*)(cs + (size_t)row * 64 + 16 * wc + 4 * fq); s4 = *(const f32x4*)(sn + (size_t)row * 64 + 16 * wc + 4 * fq); }
#pragma unroll
                for (int bj = 0; bj < 2; ++bj) { bf16_t* rowp = O + (size_t)(u.pn * 2 + bj) * gstride + (size_t)row * 128 + col0;
                    const f32x4 v0 = acc[ai][bj][m][0] * rs, v1 = acc[ai][bj][m][1] * rs;
                    const f32x4 r0 = {v0[0] * c4[0] - v0[1] * s4[0], v0[1] * c4[0] + v0[0] * s4[0], v0[2] * c4[1] - v0[3] * s4[1], v0[3] * c4[1] + v0[2] * s4[1]};
                    const f32x4 r1 = {v1[0] * c4[2] - v1[1] * s4[2], v1[1] * c4[2] + v1[0] * s4[2], v1[2] * c4[3] - v1[3] * s4[3], v1[3] * c4[3] + v1[2] * s4[3]};
                    u32x4 w; w.x = cvt_pk_bf16(r0[0], r0[1]); w.y = cvt_pk_bf16(r0[2], r0[3]); w.z = cvt_pk_bf16(r1[0], r1[1]); w.w = cvt_pk_bf16(r1[2], r1[3]);
                    *(u32x4*)rowp = w; } }
    }
};
struct EpiBf16S {
    static constexpr bool PERM = true, AFTER_DRAIN = false;
    bf16_t* O; int ldc; const unsigned long long* ss; const PG8_LAS float* tab; int pm0, ntab;
    __device__ __forceinline__ void operator()(const f32x4 (&acc)[2][2][4][2], const Unit& u, int wr, int wc, int fr, int fq) const {
        const int row0 = u.pm * BM + wr * 64 + fr, col0 = u.pn * BM + wc * 32 + 8 * fq; const bool intab = (unsigned)(u.pm - pm0) < (unsigned)ntab;
#pragma unroll
        for (int ai = 0; ai < 2; ++ai)
#pragma unroll
            for (int m = 0; m < 4; ++m) { const int row = row0 + ai * HALF + m * 16;
                const float rs = intab ? tab[row - pm0 * BM] : 1.0f / sqrtf((float)ss[row] * (1.0f / (4096.0f * 16777216.0f)) + 1e-5f);
                bf16_t* rowp = O + (size_t)row * ldc + col0;
#pragma unroll
                for (int bj = 0; bj < 2; ++bj) { const f32x4 v0 = acc[ai][bj][m][0] * rs, v1 = acc[ai][bj][m][1] * rs;
                    u32x4 w; w.x = cvt_pk_bf16(v0[0], v0[1]); w.y = cvt_pk_bf16(v0[2], v0[3]); w.z = cvt_pk_bf16(v1[0], v1[1]); w.w = cvt_pk_bf16(v1[2], v1[3]);
                    *(u32x4*)(rowp + bj * HALF) = w; } }
    }
};
template <int C, bool BC> __device__ __forceinline__ float eg_dpp(float x) { return __int_as_float(__builtin_amdgcn_update_dpp(0, __float_as_int(x), C, 0xf, 0xf, BC)); }
#define EG_DPP(x, c, bc) eg_dpp<c, bc>(x)
#define EG_SHR1(x) EG_DPP(x, 0x111, true)
#define EG_SHR2(x) EG_DPP(x, 0x112, true)
#define EG_MIR(x) EG_DPP(x, 0x140, false)
#define EG_SWP(x) EG_DPP(x, 0xB1, false)
struct EpiGate {
    static constexpr bool PERM = true, AFTER_DRAIN = false;
    bf16_t* GA; bf16_t* HB; const float* cw; const float* cb; int nup, dff; const unsigned long long* ss; PG8_LAS unsigned char* side;
    __device__ __forceinline__ void prefetch(const Unit& nx, int par, int wid, int lane) const {
        const float* base = (wid < 3 ? cw + (size_t)wid * nup : wid < 6 ? cw + (size_t)(wid - 3) * nup + dff : wid == 6 ? cb : cb + dff) + nx.pn * 128 + lane;
        PG8_LAS unsigned char* d = side + par * 4096 + wid * 512;
        __builtin_amdgcn_global_load_lds((const unsigned*)base, (PG8_LAS unsigned*)d, 4, 0, 0);
        __builtin_amdgcn_global_load_lds((const unsigned*)(base + 64), (PG8_LAS unsigned*)(d + 256), 4, 0, 0);
        __builtin_amdgcn_global_load_lds((const unsigned*)(ss + (size_t)nx.pm * BM) + wid * 64 + lane, (PG8_LAS unsigned*)(side + 8192 + par * 2048 + wid * 256), 4, 0, 0);
    }
    __device__ __forceinline__ void run(const f32x4 (&acc)[2][2][4][2], const Unit& u, int par, int wr, int wc, int fr, int fq) const {
        typedef unsigned u32x2 __attribute__((ext_vector_type(2)));
        const int ch0 = u.pn * 128 + wc * 32 + 8 * fq;
        float rsv[2][4]; { const PG8_LAS unsigned long long* sl = (const PG8_LAS unsigned long long*)(side + 8192 + par * 2048) + wr * 64 + fr;
#pragma unroll
            for (int ai = 0; ai < 2; ++ai)
#pragma unroll
                for (int m = 0; m < 4; ++m) rsv[ai][m] = __builtin_amdgcn_rsqf((float)sl[ai * 128 + m * 16] * (1.0f / (4096.0f * 16777216.0f)) + 1e-5f); }
        const bool f0 = fr == 0, f01 = fr < 2;
#pragma unroll
        for (int n = 0; n < 2; ++n) { const int ch = ch0 + 4 * n;
            const PG8_LAS f32x4* wp = (const PG8_LAS f32x4*)(side + par * 4096) + (wc * 8 + 2 * fq + n);
            const f32x4 wg0 = wp[0], wg1 = wp[32], wg2 = wp[64], wv0 = wp[96], wv1 = wp[128], wv2 = wp[160], bg = wp[192], bv = wp[224];
#pragma unroll
            for (int ai = 0; ai < 2; ++ai) { f32x4 pg1 = {0.f, 0.f, 0.f, 0.f}, pg2 = pg1, pv1 = pg1, pv2 = pg1;
#pragma unroll
                for (int m = 0; m < 4; ++m) { const int row = u.pm * BM + ai * HALF + wr * 64 + m * 16 + fr;
                    const float rs = rsv[ai][m];
                    const f32x4 g = acc[ai][0][m][n] * rs, v = acc[ai][1][m][n] * rs; f32x4 g1, g2, v1, v2, o;
#pragma unroll
                    for (int e = 0; e < 4; ++e) { g1[e] = EG_SHR1(g[e]); g2[e] = EG_SHR2(g[e]); v1[e] = EG_SHR1(v[e]); v2[e] = EG_SHR2(v[e]); }
#pragma unroll
                    for (int e = 0; e < 4; ++e) { const float tg1 = f0 ? pg1[e] : g1[e], tg2 = f01 ? pg2[e] : g2[e], tv1 = f0 ? pv1[e] : v1[e], tv2 = f01 ? pv2[e] : v2[e];
                        const float a = bg[e] + wg0[e] * tg2 + wg1[e] * tg1 + wg2[e] * g[e], b = bv[e] + wv0[e] * tv2 + wv1[e] * tv1 + wv2[e] * v[e];
                        o[e] = a * __builtin_amdgcn_rcpf(1.f + __expf(-a)) * b; }
                    if (m > 0 || !f01) { u32x2 w; w.x = cvt_pk_bf16(o[0], o[1]); w.y = cvt_pk_bf16(o[2], o[3]); *(u32x2*)(GA + (size_t)row * dff + ch) = w; }
                    if ((m == 0 && f01) || (m == 3 && fr >= 14)) { const int j = (m == 0) ? fr : fr - 12;
                        bf16_t* hp = HB + (size_t)(((row >> 6) * 4 + j) * 2) * dff + ch;
                        u32x2 wg_; wg_.x = cvt_pk_bf16(g[0], g[1]); wg_.y = cvt_pk_bf16(g[2], g[3]); *(u32x2*)hp = wg_;
                        u32x2 wv_; wv_.x = cvt_pk_bf16(v[0], v[1]); wv_.y = cvt_pk_bf16(v[2], v[3]); *(u32x2*)(hp + dff) = wv_; }
#pragma unroll
                    for (int e = 0; e < 4; ++e) { pg1[e] = EG_MIR(g[e]); pg2[e] = EG_SWP(pg1[e]); pv1[e] = EG_MIR(v[e]); pv2[e] = EG_SWP(pv1[e]); }
                } } }
    }
};
#undef EG_SHR1
#undef EG_SHR2
#undef EG_MIR
#undef EG_SWP
#undef EG_DPP
template <class T> struct epi_pf { static constexpr bool v = false; };
template <> struct epi_pf<EpiGate> { static constexpr bool v = true; };
struct EpiResN {
    static constexpr bool PERM = false, AFTER_DRAIN = false;
    const float* base; float* out; bf16_t* xb; unsigned long long* ss; int ldc;
    __device__ __forceinline__ void operator()(const f32x4 (&acc)[2][2][4][2], const Unit& u, int wr, int wc, int fr, int fq) const {
        const int col0 = u.pn * BM + wc * 32 + 4 * fq;
        int l = threadIdx.x; asm volatile("" : "+v"(l)); l &= 63;
        typedef unsigned u32x2 __attribute__((ext_vector_type(2)));
        const size_t off0 = (size_t)(u.pm * BM + wr * 64 + fr) * ldc + col0;
        const int ucol = (fq & 1) ? 12 + 4 * fq : 4 * fq;
        f32x4 bsA[2][2][2], bsB[2][2][2];
#define ERN_LOAD(dst, b_) do { _Pragma("unroll") for (int mm = 0; mm < 2; ++mm) _Pragma("unroll") for (int bj = 0; bj < 2; ++bj) _Pragma("unroll") for (int n = 0; n < 2; ++n) \
            dst[mm][bj][n] = *(const f32x4*)(base + off0 + (size_t)(((b_) >> 1) * HALF + (((b_) & 1) * 2 + mm) * 16) * ldc + bj * HALF + n * 16); } while (0)
#define ERN_DO(src, b_) do { _Pragma("unroll") for (int mm = 0; mm < 2; ++mm) { const int ai = (b_) >> 1, m = ((b_) & 1) * 2 + mm; const int row = u.pm * BM + ai * HALF + wr * 64 + m * 16 + fr; \
            const size_t off = off0 + (size_t)(ai * HALF + m * 16) * ldc; float q = 0.f; \
            _Pragma("unroll") for (int bj = 0; bj < 2; ++bj) { const f32x4 o0 = src[mm][bj][0] + acc[ai][bj][m][0], o1 = src[mm][bj][1] + acc[ai][bj][m][1]; \
                *(f32x4*)(out + off + bj * HALF) = o0; *(f32x4*)(out + off + bj * HALF + 16) = o1; \
                q += ((o0[0] * o0[0] + o0[1] * o0[1]) + (o0[2] * o0[2] + o0[3] * o0[3])) + ((o1[0] * o1[0] + o1[1] * o1[1]) + (o1[2] * o1[2] + o1[3] * o1[3])); \
                  \
                const auto r0 = __builtin_amdgcn_permlane16_swap(cvt_pk_bf16(o0[0], o0[1]), cvt_pk_bf16(o1[0], o1[1]), false, false); \
                const auto r1 = __builtin_amdgcn_permlane16_swap(cvt_pk_bf16(o0[2], o0[3]), cvt_pk_bf16(o1[2], o1[3]), false, false); \
                u32x4 w; w.x = r0[0]; w.y = r1[0]; w.z = r0[1]; w.w = r1[1]; \
                *(u32x4*)(xb + off - 4 * fq + ucol + bj * HALF) = w; } \
            q += __builtin_bit_cast(float, __builtin_amdgcn_ds_bpermute((l ^ 16) << 2, __builtin_bit_cast(int, q))); \
            q += __builtin_bit_cast(float, __builtin_amdgcn_ds_bpermute((l ^ 32) << 2, __builtin_bit_cast(int, q))); \
            if (fq == 0) atomicAdd(ss + row, (unsigned long long)__float2ll_rn(q * 16777216.0f)); } } while (0)
        ERN_LOAD(bsA, 0); ERN_LOAD(bsB, 1); asm volatile("" ::: "memory");
        ERN_DO(bsA, 0); asm volatile("" ::: "memory"); ERN_LOAD(bsA, 2); asm volatile("" ::: "memory");
        ERN_DO(bsB, 1); asm volatile("" ::: "memory"); ERN_LOAD(bsB, 3); asm volatile("" ::: "memory");
        ERN_DO(bsA, 2); asm volatile("" ::: "memory");
        ERN_DO(bsB, 3);
#undef ERN_LOAD
#undef ERN_DO
    }
};
struct EpiPart {
    static constexpr bool PERM = false, AFTER_DRAIN = false;
    float* P;
    __device__ __forceinline__ void operator()(const f32x4 (&acc)[2][2][4][2], const Unit& u, int wr, int wc, int fr, int fq) const {
#pragma unroll
        for (int ai = 0; ai < 2; ++ai)
#pragma unroll
            for (int m = 0; m < 4; ++m) { float* rowp = P + (size_t)(u.pm * BM + ai * HALF + wr * 64 + m * 16 + fr) * 128 + wc * 32 + 4 * fq;
#pragma unroll
                for (int n = 0; n < 2; ++n) *(f32x4*)(rowp + n * 16) = acc[ai][0][m][n]; }
    }
};
struct OneUnit {
    int pm, valid;
    __device__ __forceinline__ bool next(int i, Unit& u) const { if (i != 0 || !valid) return false; u.pm = pm; u.pn = 0; return true; }
    __device__ __forceinline__ void a_ready(const Unit&) const {}
    __device__ __forceinline__ void done(const Unit&) const {}
};
struct EpiNull {
    static constexpr bool PERM = true, AFTER_DRAIN = false;
    __device__ __forceinline__ void operator()(const f32x4 (&acc)[2][2][4][2], const Unit& u, int wr, int wc, int fr, int fq) const {
        float s = 0.f;
#pragma unroll
        for (int ai = 0; ai < 2; ++ai)
#pragma unroll
            for (int bj = 0; bj < 2; ++bj)
#pragma unroll
                for (int m = 0; m < 4; ++m)
#pragma unroll
                    for (int n = 0; n < 2; ++n) s += acc[ai][bj][m][n][0] + acc[ai][bj][m][n][1] + acc[ai][bj][m][n][2] + acc[ai][bj][m][n][3];
        if (s == 1.2345e-30f) asm volatile("s_nop 0" ::: "memory");
    }
};
template <class Epi, class Sched, bool ALIGN_EPI = false, bool SP2 = false>
__device__ __forceinline__ void gemm_phase(PG8_LAS unsigned char* lds, const Gemm g, const Sched& S, const Epi& E) {
    int tid_l_ = threadIdx.x; asm volatile("" : "+v"(tid_l_)); const int tid = tid_l_, wid = __builtin_amdgcn_readfirstlane(tid >> 6), lane = tid & 63, wr = wid >> 2, wc = wid & 3, fr = lane & 15, fq = lane >> 4;
    const int nt = g.K / BK, K = g.ld ? g.ld : g.K;
    unsigned voffA[2], voffB[2];
#pragma unroll
    for (int i = 0; i < 2; ++i) { int R, C; stage_rc(tid * 16 + i * 8192, R, C); const int Rb = Epi::PERM ? ((R & ~31) + perm32(R & 31)) : R;
        voffA[i] = (unsigned)(R * K + C) * 2u; voffB[i] = (unsigned)(Rb * K + C) * 2u; }
    const size_t kstep = (size_t)(BK * 2);
    const size_t hstep = (size_t)HALF * K * 2;
    const size_t tstep = 2 * hstep;
    const unsigned ldsw = (unsigned)wid * 1024u;
    const int aoff = lds_byte(wr * 64 + fr, fq * 8), boff = lds_byte(wc * 32 + fr, fq * 8);
#define PG8_SA(b, h) (((b) * 2 + (h)) * HTB)
#define PG8_SB(b, h) ((4 + (b) * 2 + (h)) * HTB)
#define PG8_STAGE(bufoff, gbase, voff) do { _Pragma("unroll") for (int _i = 0; _i < 2; ++_i) \
        __builtin_amdgcn_global_load_lds((const unsigned*)((const char*)(gbase) + (voff)[_i]), (PG8_LAS unsigned*)(lds + (bufoff) + ldsw + _i * 8192), 16, 0, 0); } while (0)
#define PG8_LDA(dst, b, h) do { _Pragma("unroll") for (int m = 0; m < 4; ++m) _Pragma("unroll") for (int k = 0; k < 2; ++k) dst[m][k] = *(const PG8_LAS bf16x8*)(lds + PG8_SA(b, h) + aoff + m * 2048 + k * 1024); } while (0)
#define PG8_LDB(dst, b, h) do { _Pragma("unroll") for (int n = 0; n < 2; ++n) _Pragma("unroll") for (int k = 0; k < 2; ++k) dst[n][k] = *(const PG8_LAS bf16x8*)(lds + PG8_SB(b, h) + boff + n * 2048 + k * 1024); } while (0)
#define PG8_MMA(ai, bj, At, Bt) do { __builtin_amdgcn_s_setprio(1); _Pragma("unroll") for (int m = 0; m < 4; ++m) _Pragma("unroll") for (int n = 0; n < 2; ++n) _Pragma("unroll") for (int k = 0; k < 2; ++k) \
        acc[ai][bj][m][n] = __builtin_amdgcn_mfma_f32_16x16x32_bf16(Bt[n][k], At[m][k], acc[ai][bj][m][n], 0, 0, 0); __builtin_amdgcn_s_setprio(0); } while (0)
#define PG8_WAIT_V(n) asm volatile("s_waitcnt vmcnt(" #n ")" ::: "memory")
#define PG8_WAIT_L(n) asm volatile("s_waitcnt lgkmcnt(" #n ")" ::: "memory")
#define PG8_BAR __builtin_amdgcn_s_barrier()
#define PG8_SCHED __builtin_amdgcn_sched_barrier(0)
    Unit cur, nxt; int ui = 0;
    if (!S.next(0, cur)) return;
    f32x4 acc[2][2][4][2];
#pragma unroll
    for (int a = 0; a < 2; ++a)
#pragma unroll
        for (int b = 0; b < 2; ++b)
#pragma unroll
            for (int m = 0; m < 4; ++m)
#pragma unroll
                for (int n = 0; n < 2; ++n) acc[a][b][m][n] = (f32x4){0.f, 0.f, 0.f, 0.f};
    bf16x8 At[4][2], B0[2][2], B1[2][2];
    const char* cA = (const char*)g.A + (size_t)cur.pm * tstep; const char* cB = (const char*)g.Bt + (size_t)cur.pn * tstep;
    if constexpr (epi_pf<Epi>::v) E.prefetch(cur, 0, wid, lane);
    S.a_ready(cur);
    if constexpr (SP2) {
        PG8_STAGE(PG8_SB(0, 0), cB, voffB); PG8_STAGE(PG8_SB(0, 1), cB + hstep, voffB); PG8_STAGE(PG8_SA(0, 0), cA, voffA); PG8_STAGE(PG8_SA(0, 1), cA + hstep, voffA);
        if (wr == 1) PG8_BAR;
        PG8_WAIT_V(2); PG8_BAR;
        PG8_STAGE(PG8_SB(1, 0), cB + kstep, voffB); PG8_STAGE(PG8_SA(1, 0), cA + kstep, voffA); PG8_STAGE(PG8_SB(1, 1), cB + hstep + kstep, voffB);
        PG8_WAIT_V(6); PG8_BAR;
    } else {
        PG8_STAGE(PG8_SB(0, 0), cB, voffB); PG8_STAGE(PG8_SA(0, 0), cA, voffA); PG8_STAGE(PG8_SB(0, 1), cB + hstep, voffB); PG8_STAGE(PG8_SA(0, 1), cA + hstep, voffA);
        if (wr == 1) PG8_BAR;
        PG8_WAIT_V(4); PG8_BAR;
        PG8_STAGE(PG8_SB(1, 0), cB + kstep, voffB); PG8_STAGE(PG8_SA(1, 0), cA + kstep, voffA); PG8_STAGE(PG8_SB(1, 1), cB + hstep + kstep, voffB);
        PG8_WAIT_V(6); PG8_BAR;
    }
    for (;;) {
        const bool has_next = S.next(ui + 1, nxt);
        const char* nA = has_next ? (const char*)g.A + (size_t)nxt.pm * tstep : cA; const char* nB = has_next ? (const char*)g.Bt + (size_t)nxt.pn * tstep : cB;
        for (int t = 0; t < nt; t += 2) {
            const bool last = (t == nt - 2);
            const char* a1 = cA + (size_t)(t + 1) * kstep;
            const char* a2 = last ? nA : cA + (size_t)(t + 2) * kstep; const char* b2 = last ? nB : cB + (size_t)(t + 2) * kstep;
            const char* a3 = a2 + kstep; const char* b3 = b2 + kstep;
            if (last && has_next) S.a_ready(nxt);
            if constexpr (SP2) {
            PG8_LDB(B0, 0, 0); PG8_LDB(B1, 0, 1); PG8_SCHED; PG8_LDA(At, 0, 0); PG8_STAGE(PG8_SA(1, 1), a1 + hstep, voffA);
            PG8_WAIT_V(8); PG8_WAIT_L(0); PG8_BAR; PG8_MMA(0, 0, At, B0); PG8_MMA(0, 1, At, B1); PG8_BAR; PG8_SCHED;
            PG8_LDA(At, 0, 1); PG8_STAGE(PG8_SB(0, 0), b2, voffB); PG8_STAGE(PG8_SB(0, 1), b2 + hstep, voffB); PG8_STAGE(PG8_SA(0, 0), a2, voffA);
            PG8_WAIT_V(8); PG8_WAIT_L(0); PG8_BAR; PG8_MMA(1, 0, At, B0); PG8_MMA(1, 1, At, B1); PG8_BAR; PG8_SCHED;
            PG8_LDB(B0, 1, 0); PG8_LDB(B1, 1, 1); PG8_SCHED; PG8_LDA(At, 1, 0); PG8_STAGE(PG8_SA(0, 1), a2 + hstep, voffA);
            PG8_WAIT_V(8); PG8_WAIT_L(0); PG8_BAR; PG8_MMA(0, 0, At, B0); PG8_MMA(0, 1, At, B1); PG8_BAR; PG8_SCHED;
            PG8_LDA(At, 1, 1); PG8_STAGE(PG8_SB(1, 0), b3, voffB); PG8_STAGE(PG8_SB(1, 1), b3 + hstep, voffB); PG8_STAGE(PG8_SA(1, 0), a3, voffA);
            PG8_WAIT_V(8); PG8_WAIT_L(0); PG8_BAR; PG8_MMA(1, 0, At, B0); PG8_MMA(1, 1, At, B1); PG8_BAR; PG8_SCHED;
            } else {
            PG8_LDB(B0, 0, 0); PG8_SCHED; PG8_LDA(At, 0, 0); PG8_STAGE(PG8_SA(1, 1), a1 + hstep, voffA);
            PG8_WAIT_L(8); PG8_BAR; PG8_WAIT_L(0); PG8_MMA(0, 0, At, B0); PG8_BAR; PG8_SCHED;
            PG8_LDB(B1, 0, 1); PG8_STAGE(PG8_SB(0, 0), b2, voffB);
            PG8_BAR; PG8_WAIT_L(0); PG8_MMA(0, 1, At, B1); PG8_BAR;
            PG8_LDA(At, 0, 1); PG8_STAGE(PG8_SA(0, 0), a2, voffA);
            PG8_BAR; PG8_WAIT_L(0); PG8_MMA(1, 0, At, B0); PG8_BAR; PG8_SCHED;
            PG8_STAGE(PG8_SB(0, 1), b2 + hstep, voffB);
            PG8_WAIT_V(6); PG8_BAR; PG8_MMA(1, 1, At, B1); PG8_BAR;
            PG8_LDB(B0, 1, 0); PG8_SCHED; PG8_LDA(At, 1, 0); PG8_STAGE(PG8_SA(0, 1), a2 + hstep, voffA);
            PG8_WAIT_L(8); PG8_BAR; PG8_WAIT_L(0); PG8_MMA(0, 0, At, B0); PG8_BAR; PG8_SCHED;
            PG8_LDB(B1, 1, 1); PG8_STAGE(PG8_SB(1, 0), b3, voffB);
            PG8_BAR; PG8_WAIT_L(0); PG8_MMA(0, 1, At, B1); PG8_BAR;
            PG8_LDA(At, 1, 1); PG8_STAGE(PG8_SA(1, 0), a3, voffA);
            PG8_BAR; PG8_WAIT_L(0); PG8_MMA(1, 0, At, B0); PG8_BAR; PG8_SCHED;
            PG8_STAGE(PG8_SB(1, 1), b3 + hstep, voffB);
            PG8_WAIT_V(6); PG8_BAR; PG8_MMA(1, 1, At, B1); PG8_BAR;
            }
        }
        if constexpr (ALIGN_EPI) { if (wr == 0) PG8_BAR; }
        if constexpr (epi_pf<Epi>::v) { if (has_next) E.prefetch(nxt, (ui + 1) & 1, wid, lane); E.run(acc, cur, ui & 1, wr, wc, fr, fq); S.done(cur); } else
        if constexpr (!Epi::AFTER_DRAIN) { E(acc, cur, wr, wc, fr, fq); S.done(cur); }
        if (!has_next) break;
#pragma unroll
        for (int a = 0; a < 2; ++a)
#pragma unroll
            for (int b = 0; b < 2; ++b)
#pragma unroll
                for (int m = 0; m < 4; ++m)
#pragma unroll
                    for (int n = 0; n < 2; ++n) acc[a][b][m][n] = (f32x4){0.f, 0.f, 0.f, 0.f};
        cur = nxt; cA = nA; cB = nB; ++ui;
        if constexpr (ALIGN_EPI) { if (wr == 1) PG8_BAR; }
    }
    PG8_WAIT_V(0);
    if constexpr (!ALIGN_EPI) { if (wr == 0) PG8_BAR; }
    PG8_BAR;
    if constexpr (Epi::AFTER_DRAIN) { E.fused(acc, cur, wr, wc, fr, fq, lds, wid, lane); S.done(cur); }
#undef PG8_SA
#undef PG8_SB
#undef PG8_STAGE
#undef PG8_LDA
#undef PG8_LDB
#undef PG8_MMA
#undef PG8_WAIT_V
#undef PG8_WAIT_L
#undef PG8_BAR
#undef PG8_SCHED
}
}

#ifndef PG8_SP2
#define PG8_SP2 true
#endif
#ifndef PG8_ALIGN
#define PG8_ALIGN true
#endif

namespace att {
constexpr int D = 128;
constexpr float SCALE = 0.08838834764831845f;
constexpr float THR = 8.f;
constexpr bool WSKIP = false;
constexpr int NW = 8, QBLK = 32, KVBLK = 64, QB = NW * QBLK;
constexpr int SHM_V = KVBLK * D * 2, SHM_K = KVBLK * D * 2;
constexpr int LDS_BYTES = 2 * SHM_V + 2 * SHM_K + NW * 64 * 4;
typedef unsigned short bf16;
typedef short bf16x8 __attribute__((ext_vector_type(8)));
typedef short s16x4 __attribute__((ext_vector_type(4)));
typedef float f32x16 __attribute__((ext_vector_type(16)));
typedef float f32x4 __attribute__((ext_vector_type(4)));
typedef unsigned u32x4 __attribute__((ext_vector_type(4)));
template <class A, class Bt> struct same_t { static constexpr bool v = false; };
template <class A> struct same_t<A, A> { static constexpr bool v = true; };

#define KSWZ(row, colB) ((row) * 256 + ((colB) ^ (((row) & 7) << 4)))
#define SBAR() __builtin_amdgcn_sched_barrier(0)
__device__ __forceinline__ int v_st(int k, int c) { const int kk = (k & ~0xC) | ((k & 4) << 1) | ((k & 8) >> 1); return ((kk >> 3) * 4 + (c >> 5)) * 512 + ((kk & 7) * 32 + (c & 31)) * 2; }
__device__ __forceinline__ int v_rd_base(int lane) { return ((lane & 3) << 3) | (((lane >> 2) & 3) << 6) | (((lane >> 4) & 1) << 5) | (((lane >> 5) & 1) << 8); }
constexpr int v_rd_off(int d0, int ks, int half) { return d0 * 512 + ks * 4096 + half * 2048; }
__device__ __forceinline__ int crow(int r, int hi) { return (r & 3) + 8 * (r >> 2) + 4 * hi; }
typedef float f32x2a __attribute__((ext_vector_type(2))); typedef __bf16 bf16x2a __attribute__((ext_vector_type(2)));
__device__ __forceinline__ unsigned cvtpk(float lo, float hi) { const f32x2a v = {lo, hi}; return __builtin_bit_cast(unsigned, __builtin_convertvector(v, bf16x2a)); }
__device__ __forceinline__ bf16x8 pack8(f32x4 a, f32x4 b) {
    u32x4 w = {cvtpk(a[0], a[1]), cvtpk(a[2], a[3]), cvtpk(b[0], b[1]), cvtpk(b[2], b[3])};
    return *reinterpret_cast<bf16x8*>(&w);
}
template <class T> __device__ __forceinline__ bf16x8 load8(const T* p) {
    if constexpr (same_t<T, float>::v) { return pack8(*(const f32x4*)p, *(const f32x4*)(p + 4)); }
    else { return *reinterpret_cast<const bf16x8*>(p); }
}
__device__ __forceinline__ void mask_tile(f32x16& p0, f32x16& p1, int dq, unsigned W) {
    const float NEG = -__builtin_inff();
#pragma unroll
    for (int r = 0; r < 16; ++r) {
        const int c = (r & 3) + 8 * (r >> 2);
        if ((unsigned)(dq - c) >= W) p0[r] = NEG;
        if ((unsigned)(dq - c - 32) >= W) p1[r] = NEG;
    }
}
__device__ __forceinline__ void partialSM(f32x16& p0, f32x16& p1, float& m_reg, float& mn, float& alpha) {
    float pmax = p0[0]; for (int r = 1; r < 16; ++r) pmax = fmaxf(pmax, p0[r]); for (int r = 0; r < 16; ++r) pmax = fmaxf(pmax, p1[r]);
    { auto rr = __builtin_amdgcn_permlane32_swap(__float_as_uint(pmax), __float_as_uint(pmax), false, false);
      pmax = fmaxf(__uint_as_float(rr[0]), __uint_as_float(rr[1])); }
    constexpr float C2 = 1.4426950408889634f * SCALE;
    if (__builtin_expect(__all((pmax - m_reg) * SCALE <= THR), 1)) { mn = m_reg; alpha = 1.f; }
    else { mn = fmaxf(m_reg, pmax); alpha = __builtin_amdgcn_exp2f((m_reg - mn) * C2); m_reg = mn; }
    const float mnL = -mn * C2;
    for (int r = 0; r < 16; ++r) p0[r] = fmaf(p0[r], C2, mnL); for (int r = 0; r < 16; ++r) p1[r] = fmaf(p1[r], C2, mnL);
    for (int r = 0; r < 16; ++r) p0[r] = __builtin_amdgcn_exp2f(p0[r]);
}
__device__ __forceinline__ void finishSM(f32x16& p0, f32x16& p1, float alpha, float& l_reg, bf16x8& pa0, bf16x8& pa1, bf16x8& pa2, bf16x8& pa3) {
    for (int r = 0; r < 16; ++r) p1[r] = __builtin_amdgcn_exp2f(p1[r]);
    float ps = 0; for (int r = 0; r < 16; ++r) ps += p0[r]; for (int r = 0; r < 16; ++r) ps += p1[r];
    { auto rr = __builtin_amdgcn_permlane32_swap(__float_as_uint(ps), __float_as_uint(ps), false, false);
      ps = __uint_as_float(rr[0]) + __uint_as_float(rr[1]); }
    l_reg = l_reg * alpha + ps;
#define PK4(P, B_, OUT) do { unsigned a0 = cvtpk(P[B_+0], P[B_+1]), a1 = cvtpk(P[B_+2], P[B_+3]);                          \
        unsigned b0 = cvtpk(P[B_+4], P[B_+5]), b1 = cvtpk(P[B_+6], P[B_+7]);                                             \
        auto r0 = __builtin_amdgcn_permlane32_swap(a0, b0, false, false); auto r1 = __builtin_amdgcn_permlane32_swap(a1, b1, false, false); \
        u32x4 w = {r0[0], r1[0], r0[1], r1[1]}; OUT = *reinterpret_cast<bf16x8*>(&w); } while (0)
    PK4(p0, 0, pa0); PK4(p0, 8, pa1); PK4(p1, 0, pa2); PK4(p1, 8, pa3);
#undef PK4
}
template <int KB, bool SK>
__device__ __forceinline__ void qkt(f32x16& p0, f32x16& p1, const char* K_lds, int r32, int hi, const bf16x8* qr, bool act) {
    if (SK && !act) { const float NEG = -__builtin_inff();
#pragma unroll
        for (int r = 0; r < 16; ++r) { p0[r] = NEG; p1[r] = NEG; } return; }
    p0 = f32x16{}; p1 = f32x16{};
    const char* kb[4];
#pragma unroll
    for (int dd = 0; dd < 4; ++dd) kb[dd] = K_lds + KB * SHM_K + KSWZ(r32, (dd * 16 + hi * 8) * 2);
#pragma unroll
    for (int d0 = 0; d0 < 8; ++d0) { const char* a = kb[d0 & 3] + (d0 >> 2) * 128;
        bf16x8 b0 = *reinterpret_cast<const bf16x8*>(a);
        bf16x8 b1 = *reinterpret_cast<const bf16x8*>(a + 32 * 256);
        p0 = __builtin_amdgcn_mfma_f32_32x32x16_bf16(b0, qr[d0], p0, 0, 0, 0);
        p1 = __builtin_amdgcn_mfma_f32_32x32x16_bf16(b1, qr[d0], p1, 0, 0, 0); }
}
template <int VB, bool SK>
__device__ __forceinline__ void pv_tile(f32x16* o, int vb0, bf16x8 pa0, bf16x8 pa1, bf16x8 pa2, bf16x8 pa3, bool act) {
    if (SK && !act) return;
#define TRRD(dst, off) asm volatile("ds_read_b64_tr_b16 %0, %1 offset:%2" : "=&v"(dst) : "v"(vb0), "i"(off) : "memory")
#define PV_D0(d0) do { s16x4 l0, l1, l2, l3, h0, h1, h2, h3; constexpr int b_ = VB * SHM_V + v_rd_off(d0, 0, 0);     \
        TRRD(l0, b_); TRRD(h0, b_ + 2048); TRRD(l1, b_ + 4096); TRRD(h1, b_ + 6144); TRRD(l2, b_ + 8192); TRRD(h2, b_ + 10240); TRRD(l3, b_ + 12288); TRRD(h3, b_ + 14336); \
        asm volatile("s_waitcnt lgkmcnt(0)" ::: "memory"); SBAR();                 \
        o[d0] = __builtin_amdgcn_mfma_f32_32x32x16_bf16(pa0, (bf16x8){l0[0], l0[1], l0[2], l0[3], h0[0], h0[1], h0[2], h0[3]}, o[d0], 0, 0, 0);   \
        o[d0] = __builtin_amdgcn_mfma_f32_32x32x16_bf16(pa1, (bf16x8){l1[0], l1[1], l1[2], l1[3], h1[0], h1[1], h1[2], h1[3]}, o[d0], 0, 0, 0);   \
        o[d0] = __builtin_amdgcn_mfma_f32_32x32x16_bf16(pa2, (bf16x8){l2[0], l2[1], l2[2], l2[3], h2[0], h2[1], h2[2], h2[3]}, o[d0], 0, 0, 0);   \
        o[d0] = __builtin_amdgcn_mfma_f32_32x32x16_bf16(pa3, (bf16x8){l3[0], l3[1], l3[2], l3[3], h3[0], h3[1], h3[2], h3[3]}, o[d0], 0, 0, 0); } while (0)
    PV_D0(0); PV_D0(1); PV_D0(2); PV_D0(3);
#undef PV_D0
#undef TRRD
}

template <class TIn, class TOut> struct BlockRef { const TIn* Q; const TIn* K; const TIn* V; TOut* O; int P0; };
template <class TIn> struct Seam {
    bf16x8 qr[8];
    bf16x8 st_v0, st_v1, st_k0, st_k1; f32x4 sf0, sf1, sf2, sf3;
    f32x4 tq[16];
};
__device__ __forceinline__ int swa_jlo(int P0, int W) { const int lowk = P0 - W + 1; return lowk > 0 ? lowk / KVBLK : 0; }
#define ROW(p, k0, rr) ((p) + (size_t)((k0) + (rr)) * D + sc)
#define VMW() asm volatile("s_waitcnt vmcnt(0)" ::: "memory")
#define VMWN(n) asm volatile("s_waitcnt vmcnt(%0)" :: "i"(n) : "memory")
#define SLOAD_H(Kp, Vp, k0) do { S.st_v0 = load8<TIn>(ROW(Vp, k0, sr)); S.st_v1 = load8<TIn>(ROW(Vp, k0, 32 + sr));              \
                         S.st_k0 = load8<TIn>(ROW(Kp, k0, sr)); S.st_k1 = load8<TIn>(ROW(Kp, k0, 32 + sr)); } while (0)
#define SWRITE_HK(bf) do { *(bf16x8*)(K_lds + (bf) * SHM_K + kws) = S.st_k0; *(bf16x8*)(K_lds + (bf) * SHM_K + kws + 32 * 256) = S.st_k1; } while (0)
#define SWRITE_HV(bf) do { *(bf16x8*)(V_lds + (bf) * SHM_V + vst0) = S.st_v0; *(bf16x8*)(V_lds + (bf) * SHM_V + vst1) = S.st_v1; } while (0)
#define SWRITE_H(bf) do { SWRITE_HV(bf); SWRITE_HK(bf); } while (0)
#define SLOAD_F(p, k0) do { S.sf0 = *(const f32x4*)ROW(p, k0, sr); S.sf1 = *(const f32x4*)(ROW(p, k0, sr) + 4);                \
                            S.sf2 = *(const f32x4*)ROW(p, k0, 32 + sr); S.sf3 = *(const f32x4*)(ROW(p, k0, 32 + sr) + 4); } while (0)
#define SWRITE_KF(bf) do { *(bf16x8*)(K_lds + (bf) * SHM_K + kws) = pack8(S.sf0, S.sf1); *(bf16x8*)(K_lds + (bf) * SHM_K + kws + 32 * 256) = pack8(S.sf2, S.sf3); } while (0)
#define SWRITE_VF(bf) do { *(bf16x8*)(V_lds + (bf) * SHM_V + vst0) = pack8(S.sf0, S.sf1); *(bf16x8*)(V_lds + (bf) * SHM_V + vst1) = pack8(S.sf2, S.sf3); } while (0)
template <class TIn, class TOut>
__device__ __forceinline__ void causal_swa_prime(const BlockRef<TIn, TOut>& cur, int W, char* lds, Seam<TIn>& S) {
    constexpr bool F32 = same_t<TIn, float>::v;
    int tid_l_ = threadIdx.x; asm volatile("" : "+v"(tid_l_)); const int tid = tid_l_, wid = __builtin_amdgcn_readfirstlane(tid >> 6), lane = tid & 63, r32 = lane & 31, hi = lane >> 5;
    const int sr = tid >> 4, sc = (tid & 15) * 8, kws = KSWZ(sr, sc * 2); char* K_lds = lds + 2 * SHM_V;
    const int kb0 = swa_jlo(cur.P0, W) * KVBLK;
    for (int d0 = 0; d0 < 8; ++d0) S.qr[d0] = load8<TIn>(cur.Q + (size_t)(wid * QBLK + r32) * D + d0 * 16 + hi * 8);
    if constexpr (F32) { SLOAD_F((const float*)cur.K, kb0); VMW(); SWRITE_KF(0); SBAR(); SLOAD_F((const float*)cur.V, kb0); }
    else { SLOAD_H(cur.K, cur.V, kb0); VMW(); SWRITE_HK(0); }
    __syncthreads();
}
template <class TIn, class TOut>
__device__ __forceinline__ void causal_swa_block(const BlockRef<TIn, TOut>& cur, const BlockRef<TIn, TOut>& nxt, int skv, int W, char* lds, Seam<TIn>& S) {
    constexpr bool F32 = same_t<TIn, float>::v;
    int tid_l_ = threadIdx.x; asm volatile("" : "+v"(tid_l_)); const int tid = tid_l_, wid = __builtin_amdgcn_readfirstlane(tid >> 6), lane = tid & 63, r32 = lane & 31, hi = lane >> 5;
    const int j_lo = swa_jlo(cur.P0, W);
    int j_hi = (cur.P0 + QB - 1) / KVBLK + 1; if (j_hi > skv / KVBLK) j_hi = skv / KVBLK;
    const int NT = j_hi - j_lo;
    const int kbn = swa_jlo(nxt.P0, W) * KVBLK;
    const int qlo = cur.P0 + wid * QBLK, qm = qlo + r32 - 4 * hi;
    char* V_lds = lds; char* K_lds = lds + 2 * SHM_V;
    float* ws = (float*)(lds + 2 * SHM_V + 2 * SHM_K) + wid * 64; float* li_l = ws, * al_l = ws + 32;
    float m_reg = -1e30f, l_reg = 0; f32x16 o[4] = {};
    const int sr = tid >> 4, sc = (tid & 15) * 8, vst0 = v_st(sr, sc), vst1 = v_st(32 + sr, sc), kws = KSWZ(sr, sc * 2);
    const int vb0 = (int)(uintptr_t)V_lds + v_rd_base(lane);
    const TIn* Kh = cur.K; const TIn* Vh = cur.V;
#define RESC(a) do { if (__any((a) < 1.f)) { if (hi == 0) al_l[r32] = (a); asm volatile("s_waitcnt lgkmcnt(0)" ::: "memory");              \
                     for (int d_ = 0; d_ < 4; ++d_) for (int r = 0; r < 16; ++r) o[d_][r] *= al_l[crow(r, hi)]; } } while (0)
#define KBASE(t) ((j_lo + (t)) * KVBLK)
#define ACT(t) (KBASE(t) <= qlo + QBLK - 1 && KBASE(t) + KVBLK - 1 >= qlo - W + 1)
#define MASKT(P0_, P1_, t) do { const int kb_ = KBASE(t); if ((!SK || ACT(t)) && (kb_ + KVBLK - 1 > qlo || kb_ <= qlo + QBLK - 1 - W)) mask_tile(P0_, P1_, qm - kb_, (unsigned)W); } while (0)
    constexpr int NQL = F32 ? 16 : 8;
    constexpr bool SK = WSKIP && !F32;
#define SEAM_K0() do { VMWN(NQL); if constexpr (F32) { SWRITE_KF(0); SBAR(); SLOAD_F((const float*)nxt.V, kbn); } else { SWRITE_HK(0); } SBAR(); } while (0)
    f32x16 pA0, pA1, pB0, pB1; float mnA, mnB, alA, alB; bf16x8 pa0, pa1, pa2, pa3;
    if constexpr (F32) { VMW(); SWRITE_VF(0); SBAR(); } else { SWRITE_HV(0); SBAR(); }
    if (NT > 1) { if constexpr (F32) SLOAD_F((const float*)Kh, KBASE(1)); else SLOAD_H(Kh, Vh, KBASE(1)); }
    SBAR(); qkt<0, SK>(pA0, pA1, K_lds, r32, hi, S.qr, ACT(0));
    if constexpr (F32) { if (NT > 1) { VMW(); SWRITE_KF(1); SBAR(); SLOAD_F((const float*)Vh, KBASE(1)); } }
    MASKT(pA0, pA1, 0); partialSM(pA0, pA1, m_reg, mnA, alA);
    if (NT > 1) { VMW(); if constexpr (F32) { SWRITE_VF(1); SBAR(); if (NT > 2) SLOAD_F((const float*)Kh, KBASE(2)); } else SWRITE_H(1); }
    __syncthreads();
#define HALF_STEP(PX0, PX1, mnX, alX, PY0, PY1, alY, t, KB, VB, SB) do {                                                      \
        SBAR(); qkt<KB, SK>(PX0, PX1, K_lds, r32, hi, S.qr, ACT(t));                                             \
        finishSM(PY0, PY1, alY, l_reg, pa0, pa1, pa2, pa3); SBAR();                                                           \
        if ((t) + 1 < NT) { if constexpr (F32) { VMW(); SWRITE_KF(SB); SBAR(); SLOAD_F((const float*)Vh, KBASE((t) + 1)); }  \
                            else { SLOAD_H(Kh, Vh, KBASE((t) + 1)); } SBAR(); }                                               \
        pv_tile<VB, SK>(o, vb0, pa0, pa1, pa2, pa3, ACT((t) - 1)); MASKT(PX0, PX1, (t)); partialSM(PX0, PX1, m_reg, mnX, alX);                                        \
        __syncthreads();                                                                                                      \
        if ((t) + 1 < NT) { VMW(); if constexpr (F32) { SWRITE_VF(SB); SBAR(); if ((t) + 2 < NT) SLOAD_F((const float*)Kh, KBASE((t) + 2)); } \
                            else { SWRITE_H(SB); } }                                                                          \
        RESC(alX); __syncthreads(); } while (0)
    for (int t = 1; t + 1 < NT; t += 2) {
        HALF_STEP(pB0, pB1, mnB, alB, pA0, pA1, alA, t, 1, 0, 0);
        HALF_STEP(pA0, pA1, mnA, alA, pB0, pB1, alB, t + 1, 0, 1, 1);
    }
    const bool even = (NT & 1) == 0;
    if (even) { SBAR(); qkt<1, SK>(pB0, pB1, K_lds, r32, hi, S.qr, ACT(NT - 1)); SBAR(); }
#define QROW(e) (nxt.Q + (size_t)(wid * QBLK + r32) * D + ((e) >> 1) * 16 + hi * 8 + ((e) & 1) * 4)
    if constexpr (F32) { SLOAD_F((const float*)nxt.K, kbn); SBAR();
#pragma unroll
        for (int e = 0; e < 8; ++e) S.tq[e] = *(const f32x4*)QROW(e); }
    else { SLOAD_H(nxt.K, nxt.V, kbn); SBAR();
#pragma unroll
        for (int d0 = 0; d0 < 8; ++d0) S.qr[d0] = load8<TIn>(nxt.Q + (size_t)(wid * QBLK + r32) * D + d0 * 16 + hi * 8); }
    SBAR();
    finishSM(pA0, pA1, alA, l_reg, pa0, pa1, pa2, pa3); SBAR();
    if constexpr (F32) {
#pragma unroll
        for (int e = 8; e < 16; ++e) S.tq[e] = *(const f32x4*)QROW(e); SBAR(); }
#undef QROW
    pv_tile<0, SK>(o, vb0, pa0, pa1, pa2, pa3, ACT(even ? NT - 2 : NT - 1));
    if (even) { MASKT(pB0, pB1, NT - 1); partialSM(pB0, pB1, m_reg, mnB, alB); __syncthreads(); RESC(alB);
        finishSM(pB0, pB1, alB, l_reg, pa0, pa1, pa2, pa3); SBAR(); pv_tile<1, SK>(o, vb0, pa0, pa1, pa2, pa3, ACT(NT - 1)); }
    SBAR(); SEAM_K0();
    if (hi == 0) li_l[r32] = l_reg; asm volatile("s_waitcnt lgkmcnt(0)" ::: "memory");
    float rli[16];
#pragma unroll
    for (int r = 0; r < 16; ++r) rli[r] = __builtin_amdgcn_rcpf(li_l[crow(r, hi)]);
    TOut* Ow = cur.O + (size_t)(wid * QBLK) * D;
#pragma unroll
    for (int r = 0; r < 16; ++r) { const int orow = crow(r, hi);
#pragma unroll
        for (int d0 = 0; d0 < 4; ++d0) { const float v = o[d0][r] * rli[r];
            if constexpr (same_t<TOut, float>::v) { Ow[(size_t)orow * D + d0 * 32 + r32] = v; }
            else { const float vn = __shfl_xor(v, 1);
                   if ((r32 & 1) == 0) *(unsigned*)(Ow + (size_t)orow * D + d0 * 32 + r32) = cvtpk(v, vn); } } }
    if constexpr (F32) {
#pragma unroll
        for (int d0 = 0; d0 < 8; ++d0) S.qr[d0] = pack8(S.tq[2 * d0], S.tq[2 * d0 + 1]); }
    __syncthreads();
#undef RESC
#undef KBASE
#undef ACT
#undef MASKT
#undef SEAM_K0
#undef HALF_STEP
}
#undef ROW
#undef VMW
#undef VMWN
#undef SLOAD_H
#undef SWRITE_HK
#undef SWRITE_HV
#undef SWRITE_H
#undef SLOAD_F
#undef SWRITE_KF
#undef SWRITE_VF
}

namespace mk {
constexpr int NWAVES = 8, NTHR = 512;
constexpr int BATCH = 2, SEQ = 4096, M = BATCH * SEQ, DM = 4096;
constexpr int DI = 8192, NHEAD = 128, HDIM = 64, NGRP = 8, NST = 128, CONVD = 10240, NCHUNK = 32;
constexpr int NZX = 18560, NZXP = 18688, ZX_XBC = 8192, ZX_DT = 18432, NZXM = 18432;
constexpr int DFF = 11008, NUP = 22016;
constexpr int NQKV = 12288, AH = 16;
constexpr float EPS = 1e-5f;

constexpr size_t MiB = 1u << 20;
constexpr size_t WS_CTL = 0, CTL_ZERO_BYTES = 1 * MiB;
constexpr size_t WS_ROPE = 2 * MiB;
constexpr size_t WS_W = 8 * MiB;
constexpr size_t WL_MAMBA = 468 * MiB, WL_ATTN = 386 * MiB;
constexpr size_t W_IN = 0, W_OUT = 146 * MiB, W_UP_M = 210 * MiB, W_DOWN_M = 382 * MiB;
constexpr size_t W_QKV = 0, W_O = 96 * MiB, W_UP_A = 128 * MiB, W_DOWN_A = 300 * MiB;
constexpr size_t WS_XR = 1716 * MiB;
constexpr size_t WS_U = 1844 * MiB;
constexpr size_t WS_BIG = 1908 * MiB;
constexpr size_t WS_ACT2 = 2252 * MiB;
constexpr size_t WS_XT = 2424 * MiB;
constexpr size_t WS_Y = 2552 * MiB;
constexpr size_t WS_BN = 2680 * MiB, WS_BT = 2696 * MiB, WS_CN = 2712 * MiB, WS_DTF = 2728 * MiB;
constexpr size_t WS_PART = 2732 * MiB;
constexpr size_t WS_END = 2764 * MiB;
constexpr int CW_TMO = 0, CW_CODE = 1, CW_BAR = 4096;
constexpr int CW_SS = 65536;
static_assert((CW_SS + 9 * M * 2) * 4 <= (int)CTL_ZERO_BYTES, "norm statistics inside the memset region");

constexpr int RING_OFF = 0, RING_BYTES = 131072 + 16384;
constexpr int TAB_OFF = 131072, TAB_TILES = 16;
constexpr int LDSCTL_OFF = RING_BYTES, MISC_OFF = LDSCTL_OFF + 320;
constexpr int SIDE_OFF = RING_BYTES + 1024, LDS_BYTES = SIDE_OFF + 12288;
static_assert(MISC_OFF + 128 <= LDS_BYTES, "LDS map");

#define GAS __attribute__((address_space(1)))
#define LAS __attribute__((address_space(3)))
typedef unsigned short bf16;
typedef unsigned v4u __attribute__((ext_vector_type(4)));
typedef unsigned v2u __attribute__((ext_vector_type(2)));
typedef float f32x4 __attribute__((ext_vector_type(4)));
typedef float f32x2 __attribute__((ext_vector_type(2)));
typedef float f32x16 __attribute__((ext_vector_type(16)));
typedef short bf16x8 __attribute__((ext_vector_type(8)));
typedef GAS unsigned gu32;
#define RLX_AGENT __ATOMIC_RELAXED, __HIP_MEMORY_SCOPE_AGENT
#define LDS_WAIT() asm volatile("s_waitcnt lgkmcnt(0)" ::: "memory")
#define VM_WAIT() asm volatile("s_waitcnt vmcnt(0)" ::: "memory")
__device__ __forceinline__ unsigned f2bf(float f) { unsigned u = __builtin_bit_cast(unsigned, f); return (u + 0x7fffu + ((u >> 16) & 1u)) >> 16; }
typedef __bf16 bf16x2_t __attribute__((ext_vector_type(2)));
__device__ __forceinline__ unsigned pk2(float lo, float hi) { const f32x2 v = {lo, hi}; return __builtin_bit_cast(unsigned, __builtin_convertvector(v, bf16x2_t)); }
__device__ __forceinline__ float bf_lo(unsigned w) { return __builtin_bit_cast(float, w << 16); }
__device__ __forceinline__ float bf_hi(unsigned w) { return __builtin_bit_cast(float, w & 0xffff0000u); }
__device__ __forceinline__ float bf1(bf16 h) { return __builtin_bit_cast(float, (unsigned)h << 16); }
__device__ __forceinline__ float silu_f(float a) { return a * __builtin_amdgcn_rcpf(1.f + __expf(-a)); }

#define XB_TMO      128
#define XB_XCNT(j)  (256  + 64 * (j))
#define XB_XSUB(j)  (1280 + 64 * (j))
#define XB_XGEN(j)  (2304 + 64 * (j))
#define XB_TOP      3328
#define XB_TOPGEN   3392
#define XCD_BAR_WORDS 3456
#define XB_SPIN_CAP (1u << 18)
__device__ __forceinline__ unsigned xb_ld(unsigned* p)              { return __hip_atomic_load(p, __ATOMIC_RELAXED, __HIP_MEMORY_SCOPE_AGENT); }
__device__ __forceinline__ unsigned xb_add(unsigned* p, unsigned v) { return __hip_atomic_fetch_add(p, v, __ATOMIC_RELAXED, __HIP_MEMORY_SCOPE_AGENT); }
__device__ __forceinline__ unsigned xb_xcc_id() { return (unsigned)__builtin_amdgcn_s_getreg((3 << 11) | 20) & 0xFu; }
#define XB_SPIN(cond, bar) do { unsigned _sp = 0; while (cond) { __builtin_amdgcn_s_sleep(1); \
    if ((++_sp & 255u) == 0u) { if (xb_ld(&(bar)[XB_TMO])) break; if (_sp > XB_SPIN_CAP) { atomicAdd(&(bar)[XB_TMO], 1u); break; } } } } while (0)
struct XcdBarrier { unsigned* bar; unsigned x; volatile LAS unsigned* st; };
__device__ __forceinline__ XcdBarrier xcd_barrier_post(unsigned* bar, volatile LAS unsigned* st) {
    XcdBarrier b; b.bar = bar; b.x = xb_xcc_id(); b.st = st;
    if (threadIdx.x == 0) (void)xb_add(&bar[XB_XCNT(b.x)], 1u);
    return b;
}
__device__ __forceinline__ void xcd_barrier_complete(unsigned* bar, unsigned x, unsigned& nloc, unsigned& nx) {
    const unsigned G = gridDim.x * gridDim.y * gridDim.z;
    unsigned sum, cnt, mine, sp = 0u;
    for (;;) {
        sum = 0u; cnt = 0u; mine = 0u;
#pragma unroll
        for (unsigned j = 0; j < 16; ++j) { const unsigned c = xb_ld(&bar[XB_XCNT(j)]); sum += c; cnt += (c > 0u) ? 1u : 0u; mine = (j == x) ? c : mine; }
        if (sum == G) break;
        __builtin_amdgcn_s_sleep(1);
        if ((++sp & 255u) == 0u) { if (xb_ld(&bar[XB_TMO])) break; if (sp > XB_SPIN_CAP) { atomicAdd(&bar[XB_TMO], 1u); break; } }
    }
    nloc = mine > 0u ? mine : 1u; nx = cnt > 0u ? cnt : 1u;
}
__device__ __forceinline__ void xcd_barrier(const XcdBarrier& b) {
    asm volatile("s_waitcnt vmcnt(0)" ::: "memory");
    __syncthreads();
    if (threadIdx.x == 0) {
        unsigned long long bar_l_ = (unsigned long long)b.bar; asm volatile("" : "+s"(bar_l_));
        unsigned* bar = (unsigned*)bar_l_;
        __builtin_amdgcn_s_waitcnt(0);
        unsigned bx_l_ = b.x; asm volatile("" : "+s"(bx_l_));
        unsigned nloc = b.st[0], nx = b.st[1];
        if (nloc == 0u) { xcd_barrier_complete(bar, bx_l_, nloc, nx); b.st[0] = nloc; b.st[1] = nx; }
        const unsigned old = xb_add(&bar[XB_XSUB(bx_l_)], 1u);
        const unsigned gen = old / nloc;
        if (old + 1u == (gen + 1u) * nloc) {
            __builtin_amdgcn_fence(__ATOMIC_RELEASE, "agent");
            asm volatile("s_waitcnt vmcnt(0)" ::: "memory");
            const unsigned og = xb_add(&bar[XB_TOP], 1u);
            const unsigned tg = og / nx;
            if (og + 1u == (tg + 1u) * nx) xb_add(&bar[XB_TOPGEN], 1u);
            else XB_SPIN(xb_ld(&bar[XB_TOPGEN]) == tg, bar);
            __builtin_amdgcn_fence(__ATOMIC_ACQUIRE, "agent");
            xb_add(&bar[XB_XGEN(bx_l_)], 1u);
            asm volatile("s_waitcnt vmcnt(0)" ::: "memory");
        } else {
            XB_SPIN(xb_ld(&bar[XB_XGEN(bx_l_)]) == gen, bar);
            __builtin_amdgcn_fence(__ATOMIC_ACQUIRE, "agent");
            asm volatile("s_waitcnt vmcnt(0)" ::: "memory");
        }
    }
    __syncthreads();
}

struct Frame {
    LAS unsigned char* lds;
    unsigned char* ws;
    int tid, lane, wave;
    int vcu, G, bx;
};

__device__ __forceinline__ void relaunder(Frame& F, unsigned char* ws0) { int t = threadIdx.x; asm volatile("" : "+v"(t)); F.tid = t; F.lane = t & 63; F.wave = __builtin_amdgcn_readfirstlane(t >> 6);
    unsigned long long w = (unsigned long long)ws0; asm volatile("" : "+s"(w)); F.ws = (unsigned char*)w;
    int g = gridDim.x; asm volatile("" : "+s"(g)); F.G = g; int bx = blockIdx.x; asm volatile("" : "+s"(bx)); F.bx = bx; F.vcu = (g % 8 == 0) ? (bx % 8) * (g / 8) + bx / 8 : bx; }
__device__ __forceinline__ float wave_sum(float v) {
    int l = threadIdx.x; asm volatile("" : "+v"(l)); l &= 63;
#pragma unroll
    for (int o = 1; o < 64; o <<= 1) v += __builtin_bit_cast(float, __builtin_amdgcn_ds_bpermute((l ^ o) << 2, __builtin_bit_cast(int, v)));
    return v;
}

constexpr int TAIL_TILES = 64 * 12;
__device__ __forceinline__ void p0_matrix(Frame& F, const float* W, int K, int N, int NP, bf16* WT, int& prefix, int perm_limit = 0, const float* gain = nullptr, int gv_tiles = 0, int ov_t0 = -1, int ov_stride = 0, int t_lo = 0, int t_hi = -1) {
    const int nnt = NP / 256, nkt = K / 128, ntiles = nkt * nnt, G = F.G, w = F.wave, lane = F.lane;
    const int stride = ov_t0 >= 0 ? ov_stride : G; int t;
    const int nhi = t_hi >= 0 ? t_hi : ntiles;
    if (ov_t0 >= 0) t = t_lo + ov_t0; else { t = (F.vcu - prefix) % G; if (t < 0) t += G; t += t_lo; prefix = (prefix + (nhi - t_lo)) % G; }
    LAS unsigned char* L = F.lds;
    f32x4 v[16];
#define P0_TILE(tt, kt_, nt_) const int blk_ = (tt) / (16 * nnt), rem_ = (tt) - blk_ * 16 * nnt, bh_ = (nkt - 16 * blk_) < 16 ? (nkt - 16 * blk_) : 16, nt_ = rem_ / bh_, kt_ = 16 * blk_ + (rem_ - nt_ * bh_)
#define P0_LOAD(tt) do { P0_TILE(tt, kt_, nt_); const int n_ = nt_ * 256 + 4 * lane; \
        const GAS float* s_ = (const GAS float*)W + (size_t)(kt_ * 128 + 16 * w) * N + n_; \
        if (n_ < N) { _Pragma("unroll") for (int jj = 0; jj < 16; ++jj) v[jj] = *(const GAS f32x4*)(s_ + (size_t)jj * N); \
            if (gain) { _Pragma("unroll") for (int jj = 0; jj < 16; ++jj) v[jj] = v[jj] * gain[kt_ * 128 + 16 * w + jj]; } } \
        else { _Pragma("unroll") for (int jj = 0; jj < 16; ++jj) v[jj] = (f32x4){0.f, 0.f, 0.f, 0.f}; } } while (0)
    if (t < nhi) P0_LOAD(t);
    while (t < nhi) {
#pragma unroll
        for (int i = 0; i < 4; ++i)
#pragma unroll
            for (int h = 0; h < 2; ++h) {
                v4u o; o.x = pk2(v[8 * h + 0][i], v[8 * h + 1][i]); o.y = pk2(v[8 * h + 2][i], v[8 * h + 3][i]); o.z = pk2(v[8 * h + 4][i], v[8 * h + 5][i]); o.w = pk2(v[8 * h + 6][i], v[8 * h + 7][i]);
                *(LAS v4u*)(L + (4 * lane + i) * 256 + (((2 * w + h) ^ (lane & 15)) << 4)) = o;
            }
        P0_TILE(t, kt, nt); const int tn = t + stride;
        if (tn < nhi) P0_LOAD(tn);
        __syncthreads();
        const int nb = gv_tiles ? ((nt < gv_tiles ? 2 * nt : 2 * (nt - gv_tiles)) * 256 + (nt < gv_tiles ? 0 : 128)) : nt * 256;
        GAS bf16* dst = (GAS bf16*)WT + kt * 128 + 8 * (lane & 15);
        const bool perm = nt * 256 < perm_limit;
#pragma unroll
        for (int jj = 0; jj < 8; ++jj) { const int r = w * 32 + jj * 4 + (lane >> 4);
            const v4u o = *(LAS const v4u*)(L + r * 256 + (((lane & 15) ^ ((r >> 2) & 15)) << 4));
            const int d = r & 127, ro = perm ? ((r & 128) | (d < 64 ? 2 * d : 2 * (d - 64) + 1)) : r;
            const int rr = gv_tiles ? ((ro >> 7) * 256 + (ro & 127)) : ro;
            *(GAS v4u*)(dst + (size_t)(nb + rr) * K) = o; }
        __syncthreads();
        t = tn;
    }
#undef P0_LOAD
#undef P0_TILE
}

__device__ __forceinline__ void rms_row_bf16(const float* xrow, const float* w, bf16* orow, int lane) {
    const GAS f32x4* xr = (const GAS f32x4*)xrow + lane; const GAS f32x4* wr = (const GAS f32x4*)w + lane;
    f32x4 v[16]; float s = 0.f;
#pragma unroll
    for (int j = 0; j < 16; ++j) { v[j] = xr[64 * j]; s += (v[j].x * v[j].x + v[j].y * v[j].y) + (v[j].z * v[j].z + v[j].w * v[j].w); }
    const float rstd = 1.0f / sqrtf(wave_sum(s) * (1.f / DM) + EPS);
    GAS v2u* o8 = (GAS v2u*)orow + lane;
#pragma unroll
    for (int j = 0; j < 16; ++j) { const f32x4 g = wr[64 * j]; v2u o; o.x = pk2(v[j].x * rstd * g.x, v[j].y * rstd * g.y); o.y = pk2(v[j].z * rstd * g.z, v[j].w * rstd * g.w); o8[64 * j] = o; }
}
__device__ __forceinline__ void rms_row_f32(const float* xrow, const float* w, float* orow, int lane) {
    const GAS f32x4* xr = (const GAS f32x4*)xrow + lane; const GAS f32x4* wr = (const GAS f32x4*)w + lane;
    f32x4 v[16]; float s = 0.f;
#pragma unroll
    for (int j = 0; j < 16; ++j) { v[j] = xr[64 * j]; s += (v[j].x * v[j].x + v[j].y * v[j].y) + (v[j].z * v[j].z + v[j].w * v[j].w); }
    const float rstd = 1.0f / sqrtf(wave_sum(s) * (1.f / DM) + EPS);
    GAS f32x4* o = (GAS f32x4*)orow + lane;
#pragma unroll
    for (int j = 0; j < 16; ++j) { const f32x4 g = wr[64 * j]; o[64 * j] = v[j] * rstd * g; }
}
__device__ __forceinline__ void x_row_prep(const float* xrow, bf16* orow, unsigned long long* ssq, int lane) {
    const GAS f32x4* xr = (const GAS f32x4*)xrow + lane;
    f32x4 v[16]; float s = 0.f;
#pragma unroll
    for (int j = 0; j < 16; ++j) { v[j] = xr[64 * j]; s += (v[j].x * v[j].x + v[j].y * v[j].y) + (v[j].z * v[j].z + v[j].w * v[j].w); }
    s = wave_sum(s);
    GAS v2u* o8 = (GAS v2u*)orow + lane;
#pragma unroll
    for (int j = 0; j < 16; ++j) { v2u o; o.x = pk2(v[j].x, v[j].y); o.y = pk2(v[j].z, v[j].w); o8[64 * j] = o; }
    if (lane == 0) *ssq = (unsigned long long)__float2ll_rn(s * 16777216.0f);
}
__device__ __forceinline__ void rmsnorm_phase(Frame& F, const float* x, const float* w, bf16* U) {
    const int gw = F.vcu * NWAVES + F.wave, NGW = F.G * NWAVES;
    for (int m = gw; m < M; m += NGW) rms_row_bf16(x + (size_t)m * DM, w, U + (size_t)m * DM, F.lane);
}

template <class Sched>
__device__ __forceinline__ void rstd_table(Frame& F, const Sched& S, const unsigned long long* ss, int& pm0, int& ntab) {
    int lo = 1 << 30, hi = -1; pg8::Unit u;
    for (int i = 0; S.next(i, u); ++i) { lo = u.pm < lo ? u.pm : lo; hi = u.pm > hi ? u.pm : hi; }
    if (hi < 0) { pm0 = 0; ntab = 0; return; }
    pm0 = lo; ntab = (hi - lo + 1) < TAB_TILES ? (hi - lo + 1) : TAB_TILES;
    LAS float* tab = (LAS float*)(F.lds + TAB_OFF);
    for (int r = F.tid; r < ntab * 256; r += NTHR) tab[r] = 1.0f / sqrtf((float)ss[pm0 * 256 + r] * (1.0f / (4096.0f * 16777216.0f)) + 1e-5f);
    __syncthreads();
}

__device__ __forceinline__ void llc_touch(Frame& F, const void* p, size_t bytes) {
    const GAS v4u* q = (const GAS v4u*)p; const size_t n16 = bytes / 16, st = (size_t)F.G * NTHR; unsigned acc = 0u;
    for (size_t i = (size_t)F.vcu * NTHR + F.tid; i + 3 * st < n16; i += 4 * st) { const v4u a = q[i], b = q[i + st], c = q[i + 2 * st], d = q[i + 3 * st]; acc += (a.x ^ b.y) + (c.z ^ d.w); }
    if (acc == 0x12345677u) ((unsigned*)(F.ws + WS_CTL))[300] = acc;
}
__device__ __forceinline__ void unpack8(const v4u w, float (&o)[8]) { o[0] = bf_lo(w.x); o[1] = bf_hi(w.x); o[2] = bf_lo(w.y); o[3] = bf_hi(w.y); o[4] = bf_lo(w.z); o[5] = bf_hi(w.z); o[6] = bf_lo(w.w); o[7] = bf_hi(w.w); }
__device__ __forceinline__ void ffn_gate_phase(Frame& F, const bf16* H, const float* cw, const float* cb, bf16* GA) {
    constexpr int R = 32, NCHK = DFF / 8, NRB = M / R;
    const int total = NCHK * NRB;
    for (int it = F.vcu * NTHR + F.tid; it < total; it += F.G * NTHR) {
        const int ch = it % NCHK, rb = it / NCHK, c0 = ch * 8, t0 = rb * R;
        float wg[3][8], wv[3][8], bg[8], bv[8];
#pragma unroll
        for (int k = 0; k < 3; ++k) {
            const f32x4 a0 = *(const GAS f32x4*)(cw + (size_t)k * NUP + c0), a1 = *(const GAS f32x4*)(cw + (size_t)k * NUP + c0 + 4);
            const f32x4 b0 = *(const GAS f32x4*)(cw + (size_t)k * NUP + DFF + c0), b1 = *(const GAS f32x4*)(cw + (size_t)k * NUP + DFF + c0 + 4);
#pragma unroll
            for (int j = 0; j < 4; ++j) { wg[k][j] = a0[j]; wg[k][4 + j] = a1[j]; wv[k][j] = b0[j]; wv[k][4 + j] = b1[j]; }
        }
        { const f32x4 a0 = *(const GAS f32x4*)(cb + c0), a1 = *(const GAS f32x4*)(cb + c0 + 4), b0 = *(const GAS f32x4*)(cb + DFF + c0), b1 = *(const GAS f32x4*)(cb + DFF + c0 + 4);
#pragma unroll
          for (int j = 0; j < 4; ++j) { bg[j] = a0[j]; bg[4 + j] = a1[j]; bv[j] = b0[j]; bv[4 + j] = b1[j]; } }
        float g2[8], g1[8], v2[8], v1[8];
        if ((t0 & (SEQ - 1)) == 0) {
#pragma unroll
            for (int j = 0; j < 8; ++j) { g2[j] = 0.f; g1[j] = 0.f; v2[j] = 0.f; v1[j] = 0.f; }
        } else {
            const GAS bf16* r2 = (const GAS bf16*)H + (size_t)(t0 - 2) * NUP + c0; const GAS bf16* r1 = r2 + NUP;
            unpack8(*(const GAS v4u*)r2, g2); unpack8(*(const GAS v4u*)(r2 + DFF), v2); unpack8(*(const GAS v4u*)r1, g1); unpack8(*(const GAS v4u*)(r1 + DFF), v1);
        }
        const GAS bf16* hp = (const GAS bf16*)H + (size_t)t0 * NUP + c0; GAS bf16* op = (GAS bf16*)GA + (size_t)t0 * DFF + c0;
#pragma unroll 8
        for (int r = 0; r < R; ++r) {
            float g0[8], v0[8], o[8];
            unpack8(*(const GAS v4u*)(hp + (size_t)r * NUP), g0); unpack8(*(const GAS v4u*)(hp + (size_t)r * NUP + DFF), v0);
#pragma unroll
            for (int j = 0; j < 8; ++j) {
                const float a = bg[j] + wg[0][j] * g2[j] + wg[1][j] * g1[j] + wg[2][j] * g0[j];
                const float b = bv[j] + wv[0][j] * v2[j] + wv[1][j] * v1[j] + wv[2][j] * v0[j];
                o[j] = silu_f(a) * b; g2[j] = g1[j]; g1[j] = g0[j]; v2[j] = v1[j]; v1[j] = v0[j];
            }
            v4u w; w.x = pk2(o[0], o[1]); w.y = pk2(o[2], o[3]); w.z = pk2(o[4], o[5]); w.w = pk2(o[6], o[7]);
            *(GAS v4u*)(op + (size_t)r * DFF) = w;
        }
    }
}

__device__ __forceinline__ void ffn_fix_phase(Frame& F, const bf16* HB, const float* cw, const float* cb, bf16* GA) {
    constexpr int NCHK = DFF / 8, NSPAN = M / 64;
    for (int it = F.vcu * NTHR + F.tid; it < NCHK * NSPAN; it += F.G * NTHR) {
        const int ch = it % NCHK, s = it / NCHK, c0 = ch * 8, t0 = s * 64;
        float wg[3][8], wv[3][8], bg[8], bv[8];
#pragma unroll
        for (int k = 0; k < 3; ++k) {
            const f32x4 a0 = *(const GAS f32x4*)(cw + (size_t)k * NUP + c0), a1 = *(const GAS f32x4*)(cw + (size_t)k * NUP + c0 + 4);
            const f32x4 b0 = *(const GAS f32x4*)(cw + (size_t)k * NUP + DFF + c0), b1 = *(const GAS f32x4*)(cw + (size_t)k * NUP + DFF + c0 + 4);
#pragma unroll
            for (int j = 0; j < 4; ++j) { wg[k][j] = a0[j]; wg[k][4 + j] = a1[j]; wv[k][j] = b0[j]; wv[k][4 + j] = b1[j]; }
        }
        { const f32x4 a0 = *(const GAS f32x4*)(cb + c0), a1 = *(const GAS f32x4*)(cb + c0 + 4), b0 = *(const GAS f32x4*)(cb + DFF + c0), b1 = *(const GAS f32x4*)(cb + DFF + c0 + 4);
#pragma unroll
          for (int j = 0; j < 4; ++j) { bg[j] = a0[j]; bg[4 + j] = a1[j]; bv[j] = b0[j]; bv[4 + j] = b1[j]; } }
        float g2[8], g1[8], v2[8], v1[8];
        if ((t0 & (SEQ - 1)) == 0) {
#pragma unroll
            for (int j = 0; j < 8; ++j) { g2[j] = 0.f; g1[j] = 0.f; v2[j] = 0.f; v1[j] = 0.f; }
        } else {
            const GAS bf16* pr = (const GAS bf16*)HB + (size_t)(((s - 1) * 4 + 2) * 2) * DFF + c0;
            unpack8(*(const GAS v4u*)pr, g2); unpack8(*(const GAS v4u*)(pr + DFF), v2); unpack8(*(const GAS v4u*)(pr + 2 * DFF), g1); unpack8(*(const GAS v4u*)(pr + 3 * DFF), v1);
        }
        const GAS bf16* cp = (const GAS bf16*)HB + (size_t)((s * 4) * 2) * DFF + c0; GAS bf16* op = (GAS bf16*)GA + (size_t)t0 * DFF + c0;
#pragma unroll
        for (int r = 0; r < 2; ++r) {
            float g0[8], v0[8], o[8];
            unpack8(*(const GAS v4u*)(cp + (size_t)(2 * r) * DFF), g0); unpack8(*(const GAS v4u*)(cp + (size_t)(2 * r + 1) * DFF), v0);
#pragma unroll
            for (int j = 0; j < 8; ++j) {
                const float a = bg[j] + wg[0][j] * g2[j] + wg[1][j] * g1[j] + wg[2][j] * g0[j];
                const float b = bv[j] + wv[0][j] * v2[j] + wv[1][j] * v1[j] + wv[2][j] * v0[j];
                o[j] = silu_f(a) * b; g2[j] = g1[j]; g1[j] = g0[j]; v2[j] = v1[j]; v1[j] = v0[j];
            }
            v4u w; w.x = pk2(o[0], o[1]); w.y = pk2(o[2], o[3]); w.z = pk2(o[4], o[5]); w.w = pk2(o[6], o[7]);
            *(GAS v4u*)(op + (size_t)r * DFF) = w;
        }
    }
}

__device__ __forceinline__ void ssd_prep_phase(Frame& F, const bf16* ZX, const float* cw, const float* cb, const float* dt_bias, bf16* XT, bf16* Bn, bf16* BT, bf16* Cn, float* DTF, const float* part, const unsigned long long* ssq) {
    const int gw = F.vcu * NWAVES + F.wave, NGW = F.G * NWAVES, lane = F.lane, c8 = lane & 7, rg = lane >> 3;
    for (int it = gw; it < 64 * 160; it += NGW) {
        const int cg = it % 160, bc = it / 160;
        const int ch0 = cg * 64 + 8 * c8, m0 = bc * 128;
        const GAS bf16* src = (const GAS bf16*)ZX + (size_t)(m0 + 16 * rg - 3) * NZXP + ZX_XBC + ch0;
        v4u raw[19];
        const bool hist = (rg != 0) || ((bc & 31) != 0);
#pragma unroll
        for (int jj = 0; jj < 19; ++jj) raw[jj] = (jj >= 3 || hist) ? *(const GAS v4u*)(src + (size_t)jj * NZXP) : (v4u){0u, 0u, 0u, 0u};
        float wt[4][8], bb[8];
#pragma unroll
        for (int k = 0; k < 4; ++k) { const f32x4 a = *(const GAS f32x4*)(cw + (size_t)k * CONVD + ch0), b = *(const GAS f32x4*)(cw + (size_t)k * CONVD + ch0 + 4);
#pragma unroll
            for (int e = 0; e < 4; ++e) { wt[k][e] = a[e]; wt[k][4 + e] = b[e]; } }
        { const f32x4 a = *(const GAS f32x4*)(cb + ch0), b = *(const GAS f32x4*)(cb + ch0 + 4);
#pragma unroll
          for (int e = 0; e < 4; ++e) { bb[e] = a[e]; bb[4 + e] = b[e]; } }
        GAS bf16* tdst = nullptr; GAS bf16* ndst = nullptr;
        if (cg < 128) { tdst = (GAS bf16*)XT + ((size_t)(bc * 128 + cg) * 64 + 8 * c8) * 128 + 16 * rg; }
        else if (cg < 144) { const int g = (cg - 128) >> 1, n0 = ((cg - 128) & 1) * 64 + 8 * c8; tdst = (GAS bf16*)BT + ((size_t)(bc * 8 + g) * 128 + n0) * 128 + 16 * rg; ndst = (GAS bf16*)Bn + ((size_t)(bc * 8 + g) * 128 + 16 * rg) * 128 + n0; }
        else { const int g = (cg - 144) >> 1, n0 = ((cg - 144) & 1) * 64 + 8 * c8; ndst = (GAS bf16*)Cn + ((size_t)(bc * 8 + g) * 128 + 16 * rg) * 128 + n0; }
#pragma unroll
        for (int hf = 0; hf < 2; ++hf) {
            unsigned nw[8][4];
#pragma unroll
            for (int ep = 0; ep < 4; ++ep) {
                float oa[8], ob[8];
                float a3 = bf_lo(raw[8 * hf][ep]), a2 = bf_lo(raw[8 * hf + 1][ep]), a1 = bf_lo(raw[8 * hf + 2][ep]), b3 = bf_hi(raw[8 * hf][ep]), b2 = bf_hi(raw[8 * hf + 1][ep]), b1 = bf_hi(raw[8 * hf + 2][ep]);
#pragma unroll
                for (int r = 0; r < 8; ++r) { const float a0 = bf_lo(raw[8 * hf + 3 + r][ep]), b0 = bf_hi(raw[8 * hf + 3 + r][ep]);
                    oa[r] = silu_f(bb[2 * ep] + wt[0][2 * ep] * a3 + wt[1][2 * ep] * a2 + wt[2][2 * ep] * a1 + wt[3][2 * ep] * a0);
                    ob[r] = silu_f(bb[2 * ep + 1] + wt[0][2 * ep + 1] * b3 + wt[1][2 * ep + 1] * b2 + wt[2][2 * ep + 1] * b1 + wt[3][2 * ep + 1] * b0);
                    a3 = a2; a2 = a1; a1 = a0; b3 = b2; b2 = b1; b1 = b0; }
                if (tdst) {
                    v4u t0; t0.x = pk2(oa[0], oa[1]); t0.y = pk2(oa[2], oa[3]); t0.z = pk2(oa[4], oa[5]); t0.w = pk2(oa[6], oa[7]);
                    *(GAS v4u*)(tdst + (size_t)(2 * ep) * 128 + 8 * hf) = t0;
                    t0.x = pk2(ob[0], ob[1]); t0.y = pk2(ob[2], ob[3]); t0.z = pk2(ob[4], ob[5]); t0.w = pk2(ob[6], ob[7]);
                    *(GAS v4u*)(tdst + (size_t)(2 * ep + 1) * 128 + 8 * hf) = t0;
                }
                if (ndst) {
#pragma unroll
                    for (int r = 0; r < 8; ++r) nw[r][ep] = pk2(oa[r], ob[r]);
                }
            }
            if (ndst) {
#pragma unroll
                for (int r = 0; r < 8; ++r) { v4u o; o.x = nw[r][0]; o.y = nw[r][1]; o.z = nw[r][2]; o.w = nw[r][3]; *(GAS v4u*)(ndst + (size_t)(8 * hf + r) * 128) = o; }
            }
        }
    }
    for (int i = F.vcu * NTHR + F.tid; i < M * NHEAD; i += F.G * NTHR) {
        const int h = i & 127, m = i >> 7;
        float raw;
        if (part) { float s = 0.f;
#pragma unroll
            for (int ks = 0; ks < 8; ++ks) s += ((const GAS float*)part)[((size_t)ks * M + m) * 128 + h];
            raw = s * (1.0f / sqrtf((float)ssq[m] * (1.0f / (4096.0f * 16777216.0f)) + 1e-5f)) + dt_bias[h]; }
        else raw = bf1(((const GAS bf16*)ZX)[(size_t)m * NZXP + ZX_DT + h]) + dt_bias[h];
        const float sp = raw > 20.f ? raw : log1pf(__expf(raw));
        ((GAS float*)DTF)[(size_t)((m >> 12) * NHEAD + h) * SEQ + (m & (SEQ - 1))] = sp;
    }
}

#define LDS_BAR() do { asm volatile("s_waitcnt lgkmcnt(0)" ::: "memory"); __builtin_amdgcn_s_barrier(); asm volatile("" ::: "memory"); } while (0)
__device__ __forceinline__ int swz(int r, int q) { return r * 256 + ((q ^ (r & 15)) << 4); }
__device__ __forceinline__ bf16x8 ldfrag(LAS const unsigned char* base, int row, int q) { return *(LAS const bf16x8*)(base + swz(row, q)); }
__device__ __forceinline__ void ssd_phase(Frame& F, const bf16* XT, const bf16* Bn, const bf16* BT, const bf16* Cn, const float* DTF, const float* a_log, const float* d_skip, bf16* Y) {
    constexpr int SC = 0, SB = 32768, SBT = 65536, SXT = 98304, SS = 114688, SM = 131072;
    LAS unsigned char* L = F.lds;
    LAS float* dtv = (LAS float*)(L + SM); LAS float* acs = dtv + 128; LAS float* w2 = dtv + 256;
    const int tid = F.tid, wave = F.wave, lane = F.lane, c = lane & 31, hi = lane >> 5;
    const int lb = wave >> 1, pb = wave & 1, nb = wave >> 1, sb0 = 2 * (wave & 1);
    for (int id = F.vcu; id < BATCH * NHEAD; id += F.G) {
        const int b = id >> 7, h = id & 127, g = h >> 4;
        const float A = -__expf(a_log[h]), Dh = d_skip[h];
        for (int i = tid; i < 1024; i += NTHR) *(LAS v4u*)(L + SS + i * 16) = (v4u){0u, 0u, 0u, 0u};
        f32x16 sacc;
#pragma unroll
        for (int r = 0; r < 16; ++r) sacc[r] = 0.f;
        v4u stC[4], stB[4], stBT[4], stX[2]; f32x2 stdt;
#define SSD_LOAD(cc_) do { const int cidx_ = b * NCHUNK + (cc_); \
            const GAS v4u* pc_ = (const GAS v4u*)(Cn + (size_t)(cidx_ * 8 + g) * 16384); const GAS v4u* pb_ = (const GAS v4u*)(Bn + (size_t)(cidx_ * 8 + g) * 16384); \
            const GAS v4u* pt_ = (const GAS v4u*)(BT + (size_t)(cidx_ * 8 + g) * 16384); const GAS v4u* px_ = (const GAS v4u*)(XT + (size_t)(cidx_ * 128 + h) * 8192); \
            _Pragma("unroll") for (int j_ = 0; j_ < 4; ++j_) { stC[j_] = pc_[tid + 512 * j_]; stB[j_] = pb_[tid + 512 * j_]; stBT[j_] = pt_[tid + 512 * j_]; } \
            _Pragma("unroll") for (int j_ = 0; j_ < 2; ++j_) stX[j_] = px_[tid + 512 * j_]; \
            stdt = *(const GAS f32x2*)(DTF + (size_t)(b * NHEAD + h) * SEQ + (cc_) * 128 + 2 * lane); } while (0)
        SSD_LOAD(0);
        for (int cc = 0; cc < NCHUNK; ++cc) {
#pragma unroll
            for (int j = 0; j < 4; ++j) { const int i = tid + 512 * j, o = swz(i >> 4, i & 15); *(LAS v4u*)(L + SC + o) = stC[j]; *(LAS v4u*)(L + SB + o) = stB[j]; *(LAS v4u*)(L + SBT + o) = stBT[j]; }
#pragma unroll
            for (int j = 0; j < 2; ++j) { const int i = tid + 512 * j; *(LAS v4u*)(L + SXT + swz(i >> 4, i & 15)) = stX[j]; }
            if (wave == 0) {
                const float a0 = stdt.x * A, a1 = stdt.y * A; float p = a0 + a1;
#pragma unroll
                for (int o = 1; o < 64; o <<= 1) { const float t = __shfl_up(p, o); if (lane >= o) p += t; }
                const float tot = __shfl(p, 63);
                acs[2 * lane] = p - a1; acs[2 * lane + 1] = p; dtv[2 * lane] = stdt.x; dtv[2 * lane + 1] = stdt.y;
                w2[2 * lane] = stdt.x * __expf(tot - (p - a1)); w2[2 * lane + 1] = stdt.y * __expf(tot - p);
            }
            LDS_BAR();
            if (cc + 1 < NCHUNK) SSD_LOAD(cc + 1);
            bf16x8 cf[8];
#pragma unroll
            for (int ks = 0; ks < 8; ++ks) cf[ks] = ldfrag(L + SC, 32 * lb + c, 2 * ks + hi);
            f32x16 yacc;
#pragma unroll
            for (int r = 0; r < 16; ++r) yacc[r] = 0.f;
#pragma unroll
            for (int ks = 0; ks < 8; ++ks) yacc = __builtin_amdgcn_mfma_f32_32x32x16_bf16(ldfrag(L + SS, 32 * pb + c, 2 * ks + hi), cf[ks], yacc, 0, 0, 0);
            const float acl = acs[32 * lb + c]; const float el = __expf(acl);
#pragma unroll
            for (int r = 0; r < 16; ++r) yacc[r] *= el;
            f32x16 cb0, cb1;
#pragma unroll
            for (int r = 0; r < 16; ++r) { cb0[r] = 0.f; cb1[r] = 0.f; }
            if (sb0 <= lb) {
#pragma unroll
                for (int ks = 0; ks < 8; ++ks) cb0 = __builtin_amdgcn_mfma_f32_32x32x16_bf16(ldfrag(L + SB, 32 * sb0 + c, 2 * ks + hi), cf[ks], cb0, 0, 0, 0);
            }
            if (sb0 + 1 <= lb) {
#pragma unroll
                for (int ks = 0; ks < 8; ++ks) cb1 = __builtin_amdgcn_mfma_f32_32x32x16_bf16(ldfrag(L + SB, 32 * (sb0 + 1) + c, 2 * ks + hi), cf[ks], cb1, 0, 0, 0);
            }
            const int lrow = 32 * lb + c;
#pragma unroll
            for (int q = 0; q < 4; ++q) {
                const int s0a = 32 * sb0 + 8 * q + 4 * hi, s0b = s0a + 32;
                const f32x4 aa = *(LAS const f32x4*)(acs + s0a), da = *(LAS const f32x4*)(dtv + s0a), ab = *(LAS const f32x4*)(acs + s0b), db = *(LAS const f32x4*)(dtv + s0b);
#pragma unroll
                for (int j = 0; j < 4; ++j) {
                    cb0[4 * q + j] = (s0a + j <= lrow) ? cb0[4 * q + j] * __expf(acl - aa[j]) * da[j] : 0.f;
                    cb1[4 * q + j] = (s0b + j <= lrow) ? cb1[4 * q + j] * __expf(acl - ab[j]) * db[j] : 0.f;
                }
            }
            LDS_BAR();
#pragma unroll
            for (int q = 0; q < 4; ++q) {
                v2u wa, wb; wa.x = pk2(cb0[4 * q], cb0[4 * q + 1]); wa.y = pk2(cb0[4 * q + 2], cb0[4 * q + 3]); wb.x = pk2(cb1[4 * q], cb1[4 * q + 1]); wb.y = pk2(cb1[4 * q + 2], cb1[4 * q + 3]);
                *(LAS v2u*)(L + SB + swz(lrow, 4 * sb0 + q) + 8 * hi) = wa; *(LAS v2u*)(L + SB + swz(lrow, 4 * (sb0 + 1) + q) + 8 * hi) = wb;
            }
            LDS_BAR();
            const int nks = 2 * (lb + 1);
            for (int ks = 0; ks < nks; ++ks) yacc = __builtin_amdgcn_mfma_f32_32x32x16_bf16(ldfrag(L + SXT, 32 * pb + c, 2 * ks + hi), ldfrag(L + SB, lrow, 2 * ks + hi), yacc, 0, 0, 0);
            {
                GAS bf16* yrow = (GAS bf16*)Y + (size_t)(b * SEQ + cc * 128 + lrow) * DI + h * 64 + 32 * pb + 4 * hi;
#pragma unroll
                for (int q = 0; q < 4; ++q) {
                    float yv[4];
#pragma unroll
                    for (int j = 0; j < 4; ++j) { const int p = 32 * pb + 8 * q + 4 * hi + j; const float xv = bf1(*(LAS const bf16*)(L + SXT + swz(p, lrow >> 3) + (lrow & 7) * 2)); yv[j] = yacc[4 * q + j] + Dh * xv; }
                    v2u w; w.x = pk2(yv[0], yv[1]); w.y = pk2(yv[2], yv[3]); *(GAS v2u*)(yrow + 8 * q) = w;
                }
            }
            {
                const float etot = __expf(acs[127]);
#pragma unroll
                for (int r = 0; r < 16; ++r) sacc[r] *= etot;
#pragma unroll
                for (int ks = 0; ks < 8; ++ks) {
                    const bf16x8 xa = ldfrag(L + SXT, 32 * pb + c, 2 * ks + hi);
                    const f32x4 wA = *(LAS const f32x4*)(w2 + 16 * ks + 8 * hi), wB = *(LAS const f32x4*)(w2 + 16 * ks + 8 * hi + 4);
                    const v4u xu = __builtin_bit_cast(v4u, xa);
                    v4u xs; xs.x = pk2(bf_lo(xu.x) * wA[0], bf_hi(xu.x) * wA[1]); xs.y = pk2(bf_lo(xu.y) * wA[2], bf_hi(xu.y) * wA[3]);
                    xs.z = pk2(bf_lo(xu.z) * wB[0], bf_hi(xu.z) * wB[1]); xs.w = pk2(bf_lo(xu.w) * wB[2], bf_hi(xu.w) * wB[3]);
                    sacc = __builtin_amdgcn_mfma_f32_32x32x16_bf16(ldfrag(L + SBT, 32 * nb + c, 2 * ks + hi), __builtin_bit_cast(bf16x8, xs), sacc, 0, 0, 0);
                }
                const int prow = 32 * pb + c;
#pragma unroll
                for (int q = 0; q < 4; ++q) { v2u w; w.x = pk2(sacc[4 * q], sacc[4 * q + 1]); w.y = pk2(sacc[4 * q + 2], sacc[4 * q + 3]); *(LAS v2u*)(L + SS + swz(prow, 4 * nb + q) + 8 * hi) = w; }
            }
            LDS_BAR();
        }
#undef SSD_LOAD
    }
}

__device__ __forceinline__ void gated_norm_phase(Frame& F, const bf16* Y, const bf16* ZX, const float* nw, bf16* G) {
    const int gw = F.vcu * NWAVES + F.wave, NGW = F.G * NWAVES, lane = F.lane;
    constexpr int UN = 8;
    for (int it0 = gw; it0 < M * NGRP; it0 += UN * NGW) {
        v4u yr[UN][2], zr[UN][2];
#pragma unroll
        for (int u = 0; u < UN; ++u) { const int it = it0 + u * NGW, m = it >> 3, g = it & 7;
#pragma unroll
            for (int j = 0; j < 2; ++j) { const int col = g * 1024 + j * 512 + lane * 8;
                if (it < M * NGRP) { yr[u][j] = *(const GAS v4u*)((const GAS bf16*)Y + (size_t)m * DI + col); zr[u][j] = *(const GAS v4u*)((const GAS bf16*)ZX + (size_t)m * NZXP + col); } } }
#pragma unroll
        for (int u = 0; u < UN; ++u) { const int it = it0 + u * NGW, m = it >> 3, g = it & 7;
            if (it >= M * NGRP) break;
            float gv[16]; float ss = 0.f;
#pragma unroll
            for (int j = 0; j < 2; ++j) { float yv[8], zv[8]; unpack8(yr[u][j], yv); unpack8(zr[u][j], zv);
#pragma unroll
                for (int e = 0; e < 8; ++e) { const float t = yv[e] * silu_f(zv[e]); gv[8 * j + e] = t; ss += t * t; } }
            const float rstd = 1.0f / sqrtf(wave_sum(ss) * (1.f / 1024.f) + EPS);
#pragma unroll
            for (int j = 0; j < 2; ++j) {
                const int col = g * 1024 + j * 512 + lane * 8;
                const f32x4 wa = *(const GAS f32x4*)(nw + col), wb = *(const GAS f32x4*)(nw + col + 4);
                v4u o; o.x = pk2(gv[8 * j] * rstd * wa[0], gv[8 * j + 1] * rstd * wa[1]); o.y = pk2(gv[8 * j + 2] * rstd * wa[2], gv[8 * j + 3] * rstd * wa[3]);
                o.z = pk2(gv[8 * j + 4] * rstd * wb[0], gv[8 * j + 5] * rstd * wb[1]); o.w = pk2(gv[8 * j + 6] * rstd * wb[2], gv[8 * j + 7] * rstd * wb[3]);
                *(GAS v4u*)((GAS bf16*)G + (size_t)m * DI + col) = o;
            }
        }
    }
}

__device__ __forceinline__ void rope_table_phase(Frame& F, const int* positions, float* cs, float* sn) {
    for (int i = F.vcu * NTHR + F.tid; i < M * 64; i += F.G * NTHR) {
        const int d = i & 63, m = i >> 6;
        const float inv = 1.0f / powf(10000.0f, (float)(2 * d) * (1.0f / 128.0f));
        const float ang = (float)positions[m] * inv;
        const float k = rintf(ang * 0.15915494309189535f);
        float r = fmaf(-k, 6.28125f, ang); r = fmaf(-k, 1.9353071795864769e-3f, r);
        const float rev = r * 0.15915494309189535f;
        cs[i] = __builtin_amdgcn_cosf(rev); sn[i] = __builtin_amdgcn_sinf(rev);
    }
}
__device__ __forceinline__ void rope_phase(Frame& F, bf16* QKVH, const float* cs, const float* sn) {
    const int total = 64 * M * 8;
    for (int i = F.vcu * NTHR + F.tid; i < total; i += F.G * NTHR) {
        const int d8 = i & 7, m = (i >> 3) & (M - 1), cg = i >> 16;
        GAS bf16* row = (GAS bf16*)QKVH + ((size_t)cg * M + m) * 128 + d8 * 8;
        float a[8], b[8];
        unpack8(*(const GAS v4u*)row, a); unpack8(*(const GAS v4u*)(row + 64), b);
        const f32x4 c0 = *(const GAS f32x4*)(cs + (size_t)m * 64 + d8 * 8), c1 = *(const GAS f32x4*)(cs + (size_t)m * 64 + d8 * 8 + 4);
        const f32x4 s0 = *(const GAS f32x4*)(sn + (size_t)m * 64 + d8 * 8), s1 = *(const GAS f32x4*)(sn + (size_t)m * 64 + d8 * 8 + 4);
        float oa[8], ob[8];
#pragma unroll
        for (int j = 0; j < 8; ++j) { const float cc = j < 4 ? c0[j & 3] : c1[j & 3], ss = j < 4 ? s0[j & 3] : s1[j & 3]; oa[j] = a[j] * cc - b[j] * ss; ob[j] = b[j] * cc + a[j] * ss; }
        v4u wa, wb; wa.x = pk2(oa[0], oa[1]); wa.y = pk2(oa[2], oa[3]); wa.z = pk2(oa[4], oa[5]); wa.w = pk2(oa[6], oa[7]);
        wb.x = pk2(ob[0], ob[1]); wb.y = pk2(ob[2], ob[3]); wb.z = pk2(ob[4], ob[5]); wb.w = pk2(ob[6], ob[7]);
        *(GAS v4u*)row = wa; *(GAS v4u*)(row + 64) = wb;
    }
}
typedef att::BlockRef<att::bf16, float> AttRef;
__device__ __forceinline__ AttRef att_ref(const bf16* QKVH, float* OP, int L, int pass) {
    const int combo = L >> 3, x = L & 7;
    const int vh = combo & 1, c = (combo >> 1) & 1, h = (combo >> 2) & 15, b = combo >> 6;
    const int qb = pass ? 15 - x : x;
    const size_t GS = (size_t)M * 128;
    AttRef r;
    r.Q = QKVH + (size_t)(2 * h + c) * GS + (size_t)(b * SEQ + qb * 256) * 128;
    r.K = QKVH + (size_t)(32 + 2 * h + c) * GS + (size_t)(b * SEQ) * 128;
    r.V = QKVH + (size_t)(64 + 2 * h + vh) * GS + (size_t)(b * SEQ) * 128;
    r.O = OP + (size_t)((2 * h + c) * 2 + vh) * GS + (size_t)(b * SEQ + qb * 256) * 128;
    r.P0 = qb * 256;
    return r;
}
__device__ __forceinline__ void attn_phase(Frame& F, const bf16* QKVH, float* OP, char* lds) {
    constexpr int TOTAL = 1024;
    int L = F.vcu; if (L >= TOTAL) return;
    const int stride = F.G; int pass = 0;
    AttRef cur = att_ref(QKVH, OP, L, 0);
    att::Seam<att::bf16> S;
    att::causal_swa_prime<att::bf16, float>(cur, SEQ, lds, S);
    for (;;) {
        const bool more_pass = pass == 0, more_item = L + stride < TOTAL, last = !more_pass && !more_item;
        int passn = pass + 1, Ln = L;
        if (!more_pass) { passn = 0; Ln = more_item ? L + stride : L; }
        const AttRef nxt = last ? cur : att_ref(QKVH, OP, Ln, passn);
        att::causal_swa_block<att::bf16, float>(cur, nxt, SEQ, SEQ, lds, S);
        if (last) break;
        cur = nxt; pass = passn; L = Ln;
    }
}
namespace att2 {
using att::bf16x8; using att::s16x4; using att::f32x16; using att::f32x4;
constexpr int QROWS = 128, KT = 64, K_BYTES = 16384, V_BYTES = 32768;
constexpr int OFF_K = 0, OFF_V = 2 * K_BYTES, OFF_P = OFF_V + 2 * V_BYTES, OFF_AL = OFF_P + 2 * 4 * 4096, OFF_LL = OFF_AL + 2 * 4 * 32 * 4, LDS_NEED = OFF_LL + 4 * 32 * 4;
__device__ __forceinline__ int v_st2(int k, int c) { const int kk = (k & ~0xC) | ((k & 4) << 1) | ((k & 8) >> 1); return ((kk >> 3) * 8 + (c >> 5)) * 512 + ((kk & 7) * 32 + (c & 31)) * 2; }
struct Blk { const unsigned short* Q; const unsigned short* K; const unsigned short* V0; const unsigned short* V1; float* O; int P0; unsigned short* AO; const float* subln; float lam, post; };
typedef att::u32x4 u4;

template <int PAR>
__device__ __forceinline__ void stageK(const Blk& B, char* lds, int t, int NT, int tid, u4 (&stK)[4]) {
    if (t + 1 < NT) {
#pragma unroll
        for (int j = 0; j < 4; ++j) { const int id = tid + 256 * j, key = id >> 4, col = (id & 15) * 8; *(u4*)(lds + OFF_K + (PAR ^ 1) * K_BYTES + KSWZ(key, col * 2)) = stK[j]; }
    }
    if (t + 2 < NT) {
#pragma unroll
        for (int j = 0; j < 4; ++j) { const int id = tid + 256 * j, key = id >> 4, col = (id & 15) * 8; stK[j] = *(const __attribute__((address_space(1))) u4*)(B.K + (size_t)((t + 2) * KT + key) * 128 + col); }
    }
}
template <int PAR>
__device__ __forceinline__ void stageV(const Blk& B, char* lds, int t, int NT, int tid, u4 (&stV)[8]) {
    if (t < NT) {
#pragma unroll
        for (int j = 0; j < 8; ++j) { const int id = tid + 256 * j, key = id >> 5, col = (id & 31) * 8; *(u4*)(lds + OFF_V + PAR * V_BYTES + v_st2(key, col)) = stV[j]; }
    }
    if (t + 1 < NT) {
#pragma unroll
        for (int j = 0; j < 8; ++j) { const int id = tid + 256 * j, key = id >> 5, col = (id & 31) * 8;
            stV[j] = *(const __attribute__((address_space(1))) u4*)((col < 128 ? B.V0 + col : B.V1 + (col - 128)) + (size_t)((t + 1) * KT + key) * 128); }
    }
}
template <int PAR>
__device__ __forceinline__ void step_prod(const Blk& B, char* lds, int t, int NT, int tid, int wid, int lane, int r32, int hi, const bf16x8 (&qr)[8], float& m_reg, float& l_reg, u4 (&stV)[8]) {
    stageV<PAR>(B, lds, t, NT, tid, stV);
    if (t < NT) {
        f32x16 p0, p1; float mn, al; bf16x8 pa0, pa1, pa2, pa3;
        __builtin_amdgcn_s_setprio(2);
        att::qkt<PAR, false>(p0, p1, lds + OFF_K, r32, hi, qr, true);
        __builtin_amdgcn_s_setprio(0);
        const int kb = t * KT, qlo = B.P0 + wid * 32;
        if (kb + KT - 1 > qlo) att::mask_tile(p0, p1, qlo + r32 - 4 * hi - kb, (unsigned)0x7fffffff);
        att::partialSM(p0, p1, m_reg, mn, al);
        att::finishSM(p0, p1, al, l_reg, pa0, pa1, pa2, pa3);
        char* pb = lds + OFF_P + (PAR * 4 + wid) * 4096 + lane * 16;
        *(bf16x8*)(pb) = pa0; *(bf16x8*)(pb + 1024) = pa1; *(bf16x8*)(pb + 2048) = pa2; *(bf16x8*)(pb + 3072) = pa3;
        if (hi == 0) ((float*)(lds + OFF_AL))[(PAR * 4 + wid) * 32 + r32] = al;
    }
    __syncthreads();
}
template <int PAR>
__device__ __forceinline__ void step_cons(const Blk& B, char* lds, int t, int NT, int tid, int p, int lane, int r32, int hi, f32x16 (&o)[8], u4 (&stK)[4]) {
    stageK<PAR>(B, lds, t, NT, tid - 256, stK);
    if (t >= 1) {
        constexpr int UP = PAR ^ 1;
        const float* alp = (const float*)(lds + OFF_AL) + (UP * 4 + p) * 32;
        const float a = alp[r32];
        if (__any(a < 1.f)) {
#pragma unroll
            for (int r = 0; r < 16; ++r) { const float ar = alp[att::crow(r, hi)];
#pragma unroll
                for (int d = 0; d < 8; ++d) o[d][r] *= ar; }
        }
        const char* pb = lds + OFF_P + (UP * 4 + p) * 4096 + lane * 16;
        const bf16x8 pa0 = *(const bf16x8*)(pb), pa1 = *(const bf16x8*)(pb + 1024), pa2 = *(const bf16x8*)(pb + 2048), pa3 = *(const bf16x8*)(pb + 3072);
        const int vb0 = (int)(uintptr_t)(lds + OFF_V) + att::v_rd_base(lane);
#define A2_TRRD(dst, off) asm volatile("ds_read_b64_tr_b16 %0, %1 offset:%2" : "=&v"(dst) : "v"(vb0), "i"(off) : "memory")
#define A2_LDG(L, H, ks, dh) do { constexpr int b_ = UP * V_BYTES + (ks) * 8192 + (dh) * 2048; \
        A2_TRRD(L[0], b_); A2_TRRD(H[0], b_ + 4096); A2_TRRD(L[1], b_ + 512); A2_TRRD(H[1], b_ + 512 + 4096); A2_TRRD(L[2], b_ + 1024); A2_TRRD(H[2], b_ + 1024 + 4096); A2_TRRD(L[3], b_ + 1536); A2_TRRD(H[3], b_ + 1536 + 4096); } while (0)
#define A2_MMA(L, H, pa, dh) do { _Pragma("unroll") for (int d = 0; d < 4; ++d) \
        o[4 * (dh) + d] = __builtin_amdgcn_mfma_f32_32x32x16_bf16(pa, (bf16x8){L[d][0], L[d][1], L[d][2], L[d][3], H[d][0], H[d][1], H[d][2], H[d][3]}, o[4 * (dh) + d], 0, 0, 0); } while (0)
#define A2_W8() do { asm volatile("s_waitcnt lgkmcnt(8)" ::: "memory"); SBAR(); } while (0)
        {
            s16x4 La[4], Ha[4], Lb[4], Hb[4];
            asm volatile("s_waitcnt lgkmcnt(0)" ::: "memory"); SBAR();
            A2_LDG(La, Ha, 0, 0); A2_LDG(Lb, Hb, 0, 1);
            A2_W8(); A2_MMA(La, Ha, pa0, 0); SBAR(); A2_LDG(La, Ha, 1, 0);
            A2_W8(); A2_MMA(Lb, Hb, pa0, 1); SBAR(); A2_LDG(Lb, Hb, 1, 1);
            A2_W8(); A2_MMA(La, Ha, pa1, 0); SBAR(); A2_LDG(La, Ha, 2, 0);
            A2_W8(); A2_MMA(Lb, Hb, pa1, 1); SBAR(); A2_LDG(Lb, Hb, 2, 1);
            A2_W8(); A2_MMA(La, Ha, pa2, 0); SBAR(); A2_LDG(La, Ha, 3, 0);
            A2_W8(); A2_MMA(Lb, Hb, pa2, 1); SBAR(); A2_LDG(Lb, Hb, 3, 1);
            A2_W8(); A2_MMA(La, Ha, pa3, 0); SBAR();
            asm volatile("s_waitcnt lgkmcnt(0)" ::: "memory"); SBAR(); A2_MMA(Lb, Hb, pa3, 1); SBAR();
        }
#undef A2_W8
#undef A2_MMA
#undef A2_LDG
#undef A2_TRRD
    }
    __syncthreads();
}

template <int MODE>
__device__ __forceinline__ void block(const Blk& B, char* lds) {
    int tl = threadIdx.x; asm volatile("" : "+v"(tl));
    const int tid = tl, wid = __builtin_amdgcn_readfirstlane(tid >> 6), lane = tid & 63, r32 = lane & 31, hi = lane >> 5;
    const int NT = (B.P0 + QROWS - 1) / KT + 1;
    if (wid < 4) {
        bf16x8 qr[8]; float m_reg = -1e30f, l_reg = 0.f; u4 stV[8];
#pragma unroll
        for (int j = 0; j < 8; ++j) { const int id = tid + 256 * j, key = id >> 5, col = (id & 31) * 8; stV[j] = *(const __attribute__((address_space(1))) u4*)((col < 128 ? B.V0 + col : B.V1 + (col - 128)) + (size_t)key * 128); }
#pragma unroll
        for (int d0 = 0; d0 < 8; ++d0) qr[d0] = *(const __attribute__((address_space(1))) bf16x8*)(B.Q + (size_t)(wid * 32 + r32) * 128 + d0 * 16 + hi * 8);
        __syncthreads();
        for (int t = 0; t <= NT; t += 2) {
            step_prod<0>(B, lds, t, NT, tid, wid, lane, r32, hi, qr, m_reg, l_reg, stV);
            if (t + 1 <= NT) step_prod<1>(B, lds, t + 1, NT, tid, wid, lane, r32, hi, qr, m_reg, l_reg, stV);
        }
        if (hi == 0) ((float*)(lds + OFF_LL))[wid * 32 + r32] = l_reg;
        __syncthreads();
    } else {
        f32x16 o[8]; const int p = wid - 4; u4 stK[4];
#pragma unroll
        for (int j = 0; j < 4; ++j) { const int id = (tid - 256) + 256 * j, key = id >> 4, col = (id & 15) * 8; const u4 k0 = *(const __attribute__((address_space(1))) u4*)(B.K + (size_t)key * 128 + col); *(u4*)(lds + OFF_K + KSWZ(key, col * 2)) = k0; }
        if (NT > 1) {
#pragma unroll
            for (int j = 0; j < 4; ++j) { const int id = (tid - 256) + 256 * j, key = id >> 4, col = (id & 15) * 8; stK[j] = *(const __attribute__((address_space(1))) u4*)(B.K + (size_t)(KT + key) * 128 + col); }
        }
#pragma unroll
        for (int d = 0; d < 8; ++d)
#pragma unroll
            for (int r = 0; r < 16; ++r) o[d][r] = 0.f;
        __syncthreads();
        for (int t = 0; t <= NT; t += 2) {
            step_cons<0>(B, lds, t, NT, tid, p, lane, r32, hi, o, stK);
            if (t + 1 <= NT) step_cons<1>(B, lds, t + 1, NT, tid, p, lane, r32, hi, o, stK);
        }
        __syncthreads();
        const float* llp = (const float*)(lds + OFF_LL) + p * 32;
        float* Ow = B.O + (size_t)(p * 32) * 256;
        if constexpr (MODE == 0) {
#pragma unroll
            for (int r = 0; r < 16; ++r) { const int orow = att::crow(r, hi); const float rl = __builtin_amdgcn_rcpf(llp[orow]);
#pragma unroll
                for (int d = 0; d < 8; ++d) ((__attribute__((address_space(1))) float*)Ow)[(size_t)orow * 256 + d * 32 + r32] = o[d][r] * rl; }
        } else {
            asm volatile("s_waitcnt vmcnt(0)" ::: "memory");
            int ll_ = threadIdx.x; asm volatile("" : "+v"(ll_)); ll_ &= 63;
            f32x4 sw0 = {B.subln[r32], B.subln[32 + r32], B.subln[64 + r32], B.subln[96 + r32]}, sw1 = {B.subln[128 + r32], B.subln[160 + r32], B.subln[192 + r32], B.subln[224 + r32]};
#pragma unroll
            for (int r = 0; r < 16; ++r) { const int orow = att::crow(r, hi); const float rl = __builtin_amdgcn_rcpf(llp[orow]) * B.lam; float q = 0.f; float dv[8];
#pragma unroll
                for (int d = 0; d < 8; ++d) { const float o0 = ((const __attribute__((address_space(1))) float*)Ow)[(size_t)orow * 256 + d * 32 + r32]; dv[d] = o0 - o[d][r] * rl; q += dv[d] * dv[d]; }
#pragma unroll
                for (int sft = 1; sft < 32; sft <<= 1) q += __builtin_bit_cast(float, __builtin_amdgcn_ds_bpermute((ll_ ^ sft) << 2, __builtin_bit_cast(int, q)));
                const float rs = B.post / sqrtf(q * (1.f / 256.f) + 1e-5f);
                __attribute__((address_space(1))) unsigned short* arow = (__attribute__((address_space(1))) unsigned short*)B.AO + (size_t)(p * 32 + orow) * 4096 + r32;
#pragma unroll
                for (int d = 0; d < 8; ++d) { const float v = dv[d] * rs * (d < 4 ? sw0[d & 3] : sw1[d & 3]);
                    const float vn = __builtin_bit_cast(float, __builtin_amdgcn_update_dpp(0, __builtin_bit_cast(int, v), 0xB1, 0xf, 0xf, true));
                    if ((r32 & 1) == 0) *(__attribute__((address_space(1))) unsigned*)(arow + d * 32) = att::cvtpk(v, vn); }
            }
        }
    }
    __syncthreads();
}
}

__device__ __forceinline__ att2::Blk att2_ref(const bf16* QKVH, float* OP2, bf16* AO, const float* subln, float lam, float post, int L, int c, int pass) {
    const int bh = L >> 4, y = L & 15; const int h = bh & 15, b = bh >> 4; const int qb = pass ? 31 - y : y;
    const size_t GS = (size_t)M * 128;
    att2::Blk r;
    r.Q = QKVH + (size_t)(2 * h + c) * GS + (size_t)(b * SEQ + qb * 128) * 128;
    r.K = QKVH + (size_t)(32 + 2 * h + c) * GS + (size_t)(b * SEQ) * 128;
    r.V0 = QKVH + (size_t)(64 + 2 * h) * GS + (size_t)(b * SEQ) * 128;
    r.V1 = QKVH + (size_t)(65 + 2 * h) * GS + (size_t)(b * SEQ) * 128;
    r.O = OP2 + (size_t)h * M * 256 + (size_t)(b * SEQ + qb * 128) * 256;
    r.P0 = qb * 128;
    r.AO = AO + (size_t)(b * SEQ + qb * 128) * DM + h * 256; r.subln = subln; r.lam = lam; r.post = post;
    return r;
}
__device__ __forceinline__ void attn2_phase(Frame& F, const bf16* QKVH, float* OP2, char* lds, const float* lq1, const float* lk1, const float* lq2, const float* lk2, const float* subln, float lambda_init, bf16* AO) {
    const int lane = F.lane;
    const float d1 = wave_sum(lq1[lane] * lk1[lane] + lq1[lane + 64] * lk1[lane + 64]), d2 = wave_sum(lq2[lane] * lk2[lane] + lq2[lane + 64] * lk2[lane + 64]);
    const float lam = expf(d1) - expf(d2) + lambda_init, post = 1.0f - lambda_init;
    for (int L = F.vcu; L < 512; L += F.G) {
#pragma unroll 1
        for (int pass = 0; pass < 2; ++pass) {
            { const att2::Blk B = att2_ref(QKVH, OP2, AO, subln, lam, post, L, 0, pass); att2::block<0>(B, lds); }
            { const att2::Blk B = att2_ref(QKVH, OP2, AO, subln, lam, post, L, 1, pass); att2::block<1>(B, lds); }
        }
    }
}
__device__ __forceinline__ void attn_combine_phase(Frame& F, const float* OP, const float* lq1, const float* lk1, const float* lq2, const float* lk2, const float* subln, float lambda_init, bf16* AO) {
    const int gw = F.vcu * NWAVES + F.wave, NGW = F.G * NWAVES, lane = F.lane;
    const float d1 = wave_sum(lq1[lane] * lk1[lane] + lq1[lane + 64] * lk1[lane + 64]), d2 = wave_sum(lq2[lane] * lk2[lane] + lq2[lane + 64] * lk2[lane + 64]);
    const float lam = expf(d1) - expf(d2) + lambda_init, post = 1.0f - lambda_init;
    const int vh = lane >> 5, d = (lane & 31) * 4;
    const f32x4 sw = *(const GAS f32x4*)(subln + vh * 128 + d);
    const size_t GS = (size_t)M * 128;
    constexpr int UN = 8;
    for (int it0 = gw; it0 < M * AH; it0 += UN * NGW) {
        f32x4 o1[UN], o2[UN];
#pragma unroll
        for (int u = 0; u < UN; ++u) { const int it = it0 + u * NGW, m = it >> 4, h = it & 15;
            if (it < M * AH) { o1[u] = *(const GAS f32x4*)(OP + (size_t)(2 * h) * M * 256 + (size_t)m * 256 + vh * 128 + d); o2[u] = *(const GAS f32x4*)(OP + (size_t)(2 * h + 1) * M * 256 + (size_t)m * 256 + vh * 128 + d); } }
#pragma unroll
        for (int u = 0; u < UN; ++u) { const int it = it0 + u * NGW, m = it >> 4, h = it & 15;
            if (it >= M * AH) break;
            const f32x4 o = o1[u] - lam * o2[u];
            const float ss = wave_sum((o.x * o.x + o.y * o.y) + (o.z * o.z + o.w * o.w));
            const float rs = post / sqrtf(ss * (1.f / 256.f) + EPS);
            v2u w; w.x = pk2(o.x * rs * sw.x, o.y * rs * sw.y); w.y = pk2(o.z * rs * sw.z, o.w * rs * sw.w);
            *(GAS v2u*)((GAS bf16*)AO + (size_t)m * DM + h * 256 + vh * 128 + d) = w;
        }
    }
}


struct Args { const float* in[57]; float* out; unsigned char* ws; };
__global__ void __launch_bounds__(NTHR, 2) trunk_fwd(Args args) {
    extern __shared__ __attribute__((aligned(16))) unsigned char lds[];
    Frame F;
    F.lds = (LAS unsigned char*)lds;
    F.tid = threadIdx.x; F.lane = F.tid & 63; F.wave = __builtin_amdgcn_readfirstlane(F.tid >> 6);
    gu32* ctl = (gu32*)(args.ws + WS_CTL);
    for (int u = F.tid; u < (LDS_BYTES - LDSCTL_OFF) / 4; u += NTHR) ((LAS unsigned*)(F.lds + LDSCTL_OFF))[u] = 0u;
    __syncthreads();
    volatile LAS unsigned* MISC = (volatile LAS unsigned*)(F.lds + MISC_OFF);
    XcdBarrier bar = xcd_barrier_post((unsigned*)(ctl + CW_BAR), MISC + 8);
#define GRID_BAR() do { xcd_barrier(bar); relaunder(F, args.ws); } while (0)

#define XR ((float*)(F.ws + WS_XR))
#define U ((bf16*)(F.ws + WS_U))
#define BIG ((bf16*)(F.ws + WS_BIG))
#define ACT2 ((bf16*)(F.ws + WS_ACT2))
#define XT ((bf16*)(F.ws + WS_XT))
#define Yb ((bf16*)(F.ws + WS_Y))
#define Bn ((bf16*)(F.ws + WS_BN))
#define BT ((bf16*)(F.ws + WS_BT))
#define Cn ((bf16*)(F.ws + WS_CN))
#define DTF ((float*)(F.ws + WS_DTF))
#define PART ((float*)(F.ws + WS_PART))
#define OP ((float*)(F.ws + WS_XT))
#define SSQ(k) ((unsigned long long*)((unsigned*)(F.ws + WS_CTL) + CW_SS) + (k) * M)
#define ropec ((float*)(F.ws + WS_ROPE))
#define ropes ((float*)(F.ws + WS_ROPE) + (size_t)M * 64)
    relaunder(F, args.ws);

    {
        int p0_prefix = 0;
#pragma unroll 1
        for (int layer = 0; layer < 4; ++layer) {
            const bool mamba = (layer & 1) == 0;
            const int ib = layer == 0 ? 2 : layer == 1 ? 16 : layer == 2 ? 29 : 43;
            const size_t wlo = WS_W + (layer == 0 ? 0 : layer == 1 ? WL_MAMBA : layer == 2 ? WL_MAMBA + WL_ATTN : 2 * WL_MAMBA + WL_ATTN);
            if (mamba) {
                p0_matrix(F, args.in[ib + 1], DM, NZX, NZXP, (bf16*)(F.ws + wlo + W_IN), p0_prefix, 0, args.in[ib + 0]);
                p0_matrix(F, args.in[ib + 8], DI, DM, DM, (bf16*)(F.ws + wlo + W_OUT), p0_prefix);
                p0_matrix(F, args.in[ib + 10], DM, NUP, NUP, (bf16*)(F.ws + wlo + W_UP_M), p0_prefix, 0, args.in[ib + 9], DFF / 256);
                p0_matrix(F, args.in[ib + 13], DFF, DM, DM, (bf16*)(F.ws + wlo + W_DOWN_M), p0_prefix, 0, nullptr, 0, -1, 0, (layer == 0 || F.G != 256) ? 0 : TAIL_TILES);
            } else {
                p0_matrix(F, args.in[ib + 1], DM, NQKV, NQKV, (bf16*)(F.ws + wlo + W_QKV), p0_prefix, 2 * DM, args.in[ib + 0]);
                p0_matrix(F, args.in[ib + 7], DM, DM, DM, (bf16*)(F.ws + wlo + W_O), p0_prefix);
                p0_matrix(F, args.in[ib + 9], DM, NUP, NUP, (bf16*)(F.ws + wlo + W_UP_A), p0_prefix, 0, args.in[ib + 8], DFF / 256);
                p0_matrix(F, args.in[ib + 12], DFF, DM, DM, (bf16*)(F.ws + wlo + W_DOWN_A), p0_prefix, 0, nullptr, 0, -1, 0, (layer == 0 || F.G != 256) ? 0 : TAIL_TILES);
            }
        }
        rope_table_phase(F, (const int*)args.in[1], ropec, ropes);
        { const int gw = F.vcu * NWAVES + F.wave, NGW = F.G * NWAVES;
          for (int m = gw; m < M; m += NGW) x_row_prep(args.in[0] + (size_t)m * DM, U + (size_t)m * DM, SSQ(0) + m, F.lane); }
        GRID_BAR();
    }

    {
        constexpr int layer = 0;
        constexpr bool mamba = (layer & 1) == 0;
        constexpr int ib = layer == 0 ? 2 : layer == 1 ? 16 : layer == 2 ? 29 : 43;
        constexpr size_t wlo = WS_W + (layer == 0 ? 0 : layer == 1 ? WL_MAMBA : layer == 2 ? WL_MAMBA + WL_ATTN : 2 * WL_MAMBA + WL_ATTN);
        const float* xin = layer == 0 ? args.in[0] : XR;
        if constexpr (mamba) {
            const bool splitdt = F.G == 256;
            if (splitdt) {
                { pg8::Gemm g{U, (const bf16*)(F.ws + wlo + W_IN), M, NZXM, DM}; pg8::StaticOrder S; S.init(M, NZXM, F.G, F.bx);
                  int pm0, ntab; rstd_table(F, S, SSQ(2 * layer), pm0, ntab);
                  pg8::EpiBf16S E{BIG, NZXP, SSQ(2 * layer), (const LAS float*)(F.lds + TAB_OFF), pm0, ntab};
                  pg8::gemm_phase<pg8::EpiBf16S, pg8::StaticOrder, PG8_ALIGN, PG8_SP2>(F.lds + RING_OFF, g, S, E); }
                { const int ks = F.vcu & 7; pg8::Gemm g{U + ks * 512, (const bf16*)(F.ws + wlo + W_IN) + (size_t)NZXM * DM + ks * 512, M, 256, 512, DM};
                  pg8::OneUnit S{F.vcu >> 3, 1}; pg8::EpiPart E{PART + (size_t)ks * M * 128};
                  pg8::gemm_phase<pg8::EpiPart, pg8::OneUnit, false, PG8_SP2>(F.lds + RING_OFF, g, S, E); }
            } else {
                { pg8::Gemm g{U, (const bf16*)(F.ws + wlo + W_IN), M, NZXP, DM}; pg8::StaticOrder S; S.init(M, NZXP, F.G, F.bx);
                  int pm0, ntab; rstd_table(F, S, SSQ(2 * layer), pm0, ntab);
                  pg8::EpiBf16S E{BIG, NZXP, SSQ(2 * layer), (const LAS float*)(F.lds + TAB_OFF), pm0, ntab};
                  pg8::gemm_phase<pg8::EpiBf16S, pg8::StaticOrder, PG8_ALIGN, PG8_SP2>(F.lds + RING_OFF, g, S, E); }
            }
            GRID_BAR();
            ssd_prep_phase(F, BIG, args.in[ib + 2], args.in[ib + 3], args.in[ib + 4], XT, Bn, BT, Cn, DTF, splitdt ? PART : nullptr, SSQ(2 * layer));
            GRID_BAR();
            ssd_phase(F, XT, Bn, BT, Cn, DTF, args.in[ib + 5], args.in[ib + 6], Yb);
            GRID_BAR();
            gated_norm_phase(F, Yb, BIG, args.in[ib + 7], ACT2);
            GRID_BAR();
            { pg8::Gemm g{ACT2, (const bf16*)(F.ws + wlo + W_OUT), M, DM, DI}; pg8::StaticOrder S; S.init(M, DM, F.G, F.bx);
              pg8::EpiResN E{xin, XR, U, SSQ(2 * layer + 1), DM};
              pg8::gemm_phase<pg8::EpiResN, pg8::StaticOrder, PG8_ALIGN, PG8_SP2>(F.lds + RING_OFF, g, S, E); }
            GRID_BAR();
        } else {
            { pg8::Gemm g{U, (const bf16*)(F.ws + wlo + W_QKV), M, NQKV, DM}; pg8::StaticOrder S; S.init(M, NQKV, F.G, F.bx);
              int pm0, ntab; rstd_table(F, S, SSQ(2 * layer), pm0, ntab);
              pg8::EpiHeadMajor E{BIG, (size_t)M * 128, ropec, ropes, SSQ(2 * layer), (const LAS float*)(F.lds + TAB_OFF), pm0, ntab};
              pg8::gemm_phase<pg8::EpiHeadMajor, pg8::StaticOrder, PG8_ALIGN, PG8_SP2>(F.lds + RING_OFF, g, S, E); }
            GRID_BAR();
            attn2_phase(F, BIG, OP, (char*)lds + RING_OFF, args.in[ib + 2], args.in[ib + 3], args.in[ib + 4], args.in[ib + 5], args.in[ib + 6], 0.8f - 0.6f * expf(-0.3f * (float)layer), ACT2);
            GRID_BAR();
            { pg8::Gemm g{ACT2, (const bf16*)(F.ws + wlo + W_O), M, DM, DM}; pg8::StaticOrder S; S.init(M, DM, F.G, F.bx);
              pg8::EpiResN E{xin, XR, U, SSQ(2 * layer + 1), DM};
              pg8::gemm_phase<pg8::EpiResN, pg8::StaticOrder, PG8_ALIGN, PG8_SP2>(F.lds + RING_OFF, g, S, E); }
            GRID_BAR();
        }
        constexpr int fb = mamba ? ib + 9 : ib + 8;
        { pg8::Gemm g{U, (const bf16*)(F.ws + wlo + (mamba ? W_UP_M : W_UP_A)), M, NUP, DM}; pg8::StaticOrder S; S.init(M, NUP, F.G, F.bx);

          { pg8::EpiGate E{ACT2, BIG, args.in[fb + 2], args.in[fb + 3], NUP, DFF, SSQ(2 * layer + 1), F.lds + SIDE_OFF};
          pg8::gemm_phase<pg8::EpiGate, pg8::StaticOrder, PG8_ALIGN, PG8_SP2>(F.lds + RING_OFF, g, S, E); } }
        if constexpr (layer < 3) { if (F.G == 256 && F.bx >= 192) {
            constexpr bool nm = ((layer + 1) & 1) == 0; constexpr int nib = layer + 1 == 1 ? 16 : layer + 1 == 2 ? 29 : 43;
            constexpr size_t nwlo = WS_W + (layer + 1 == 1 ? WL_MAMBA : layer + 1 == 2 ? WL_MAMBA + WL_ATTN : 2 * WL_MAMBA + WL_ATTN);
            int nopfx = 0; p0_matrix(F, args.in[nib + (nm ? 13 : 12)], DFF, DM, DM, (bf16*)(F.ws + nwlo + (nm ? W_DOWN_M : W_DOWN_A)), nopfx, 0, nullptr, 0, F.bx - 192, 64, 0, TAIL_TILES); } }
        GRID_BAR();
        ffn_fix_phase(F, BIG, args.in[fb + 2], args.in[fb + 3], ACT2);
        GRID_BAR();
        { pg8::Gemm g{ACT2, (const bf16*)(F.ws + wlo + (mamba ? W_DOWN_M : W_DOWN_A)), M, DM, DFF}; pg8::StaticOrder S; S.init(M, DM, F.G, F.bx);
          pg8::EpiResN E{XR, XR, U, SSQ(2 * layer + 2), DM};
          pg8::gemm_phase<pg8::EpiResN, pg8::StaticOrder, PG8_ALIGN, PG8_SP2>(F.lds + RING_OFF, g, S, E); }
        GRID_BAR();
    }
    {
        constexpr int layer = 1;
        constexpr bool mamba = (layer & 1) == 0;
        constexpr int ib = layer == 0 ? 2 : layer == 1 ? 16 : layer == 2 ? 29 : 43;
        constexpr size_t wlo = WS_W + (layer == 0 ? 0 : layer == 1 ? WL_MAMBA : layer == 2 ? WL_MAMBA + WL_ATTN : 2 * WL_MAMBA + WL_ATTN);
        const float* xin = layer == 0 ? args.in[0] : XR;
        if constexpr (mamba) {
            const bool splitdt = F.G == 256;
            if (splitdt) {
                { pg8::Gemm g{U, (const bf16*)(F.ws + wlo + W_IN), M, NZXM, DM}; pg8::StaticOrder S; S.init(M, NZXM, F.G, F.bx);
                  int pm0, ntab; rstd_table(F, S, SSQ(2 * layer), pm0, ntab);
                  pg8::EpiBf16S E{BIG, NZXP, SSQ(2 * layer), (const LAS float*)(F.lds + TAB_OFF), pm0, ntab};
                  pg8::gemm_phase<pg8::EpiBf16S, pg8::StaticOrder, PG8_ALIGN, PG8_SP2>(F.lds + RING_OFF, g, S, E); }
                { const int ks = F.vcu & 7; pg8::Gemm g{U + ks * 512, (const bf16*)(F.ws + wlo + W_IN) + (size_t)NZXM * DM + ks * 512, M, 256, 512, DM};
                  pg8::OneUnit S{F.vcu >> 3, 1}; pg8::EpiPart E{PART + (size_t)ks * M * 128};
                  pg8::gemm_phase<pg8::EpiPart, pg8::OneUnit, false, PG8_SP2>(F.lds + RING_OFF, g, S, E); }
            } else {
                { pg8::Gemm g{U, (const bf16*)(F.ws + wlo + W_IN), M, NZXP, DM}; pg8::StaticOrder S; S.init(M, NZXP, F.G, F.bx);
                  int pm0, ntab; rstd_table(F, S, SSQ(2 * layer), pm0, ntab);
                  pg8::EpiBf16S E{BIG, NZXP, SSQ(2 * layer), (const LAS float*)(F.lds + TAB_OFF), pm0, ntab};
                  pg8::gemm_phase<pg8::EpiBf16S, pg8::StaticOrder, PG8_ALIGN, PG8_SP2>(F.lds + RING_OFF, g, S, E); }
            }
            GRID_BAR();
            ssd_prep_phase(F, BIG, args.in[ib + 2], args.in[ib + 3], args.in[ib + 4], XT, Bn, BT, Cn, DTF, splitdt ? PART : nullptr, SSQ(2 * layer));
            GRID_BAR();
            ssd_phase(F, XT, Bn, BT, Cn, DTF, args.in[ib + 5], args.in[ib + 6], Yb);
            GRID_BAR();
            gated_norm_phase(F, Yb, BIG, args.in[ib + 7], ACT2);
            GRID_BAR();
            { pg8::Gemm g{ACT2, (const bf16*)(F.ws + wlo + W_OUT), M, DM, DI}; pg8::StaticOrder S; S.init(M, DM, F.G, F.bx);
              pg8::EpiResN E{xin, XR, U, SSQ(2 * layer + 1), DM};
              pg8::gemm_phase<pg8::EpiResN, pg8::StaticOrder, PG8_ALIGN, PG8_SP2>(F.lds + RING_OFF, g, S, E); }
            GRID_BAR();
        } else {
            { pg8::Gemm g{U, (const bf16*)(F.ws + wlo + W_QKV), M, NQKV, DM}; pg8::StaticOrder S; S.init(M, NQKV, F.G, F.bx);
              int pm0, ntab; rstd_table(F, S, SSQ(2 * layer), pm0, ntab);
              pg8::EpiHeadMajor E{BIG, (size_t)M * 128, ropec, ropes, SSQ(2 * layer), (const LAS float*)(F.lds + TAB_OFF), pm0, ntab};
              pg8::gemm_phase<pg8::EpiHeadMajor, pg8::StaticOrder, PG8_ALIGN, PG8_SP2>(F.lds + RING_OFF, g, S, E); }
            GRID_BAR();
            attn2_phase(F, BIG, OP, (char*)lds + RING_OFF, args.in[ib + 2], args.in[ib + 3], args.in[ib + 4], args.in[ib + 5], args.in[ib + 6], 0.8f - 0.6f * expf(-0.3f * (float)layer), ACT2);
            GRID_BAR();
            { pg8::Gemm g{ACT2, (const bf16*)(F.ws + wlo + W_O), M, DM, DM}; pg8::StaticOrder S; S.init(M, DM, F.G, F.bx);
              pg8::EpiResN E{xin, XR, U, SSQ(2 * layer + 1), DM};
              pg8::gemm_phase<pg8::EpiResN, pg8::StaticOrder, PG8_ALIGN, PG8_SP2>(F.lds + RING_OFF, g, S, E); }
            GRID_BAR();
        }
        constexpr int fb = mamba ? ib + 9 : ib + 8;
        { pg8::Gemm g{U, (const bf16*)(F.ws + wlo + (mamba ? W_UP_M : W_UP_A)), M, NUP, DM}; pg8::StaticOrder S; S.init(M, NUP, F.G, F.bx);

          { pg8::EpiGate E{ACT2, BIG, args.in[fb + 2], args.in[fb + 3], NUP, DFF, SSQ(2 * layer + 1), F.lds + SIDE_OFF};
          pg8::gemm_phase<pg8::EpiGate, pg8::StaticOrder, PG8_ALIGN, PG8_SP2>(F.lds + RING_OFF, g, S, E); } }
        if constexpr (layer < 3) { if (F.G == 256 && F.bx >= 192) {
            constexpr bool nm = ((layer + 1) & 1) == 0; constexpr int nib = layer + 1 == 1 ? 16 : layer + 1 == 2 ? 29 : 43;
            constexpr size_t nwlo = WS_W + (layer + 1 == 1 ? WL_MAMBA : layer + 1 == 2 ? WL_MAMBA + WL_ATTN : 2 * WL_MAMBA + WL_ATTN);
            int nopfx = 0; p0_matrix(F, args.in[nib + (nm ? 13 : 12)], DFF, DM, DM, (bf16*)(F.ws + nwlo + (nm ? W_DOWN_M : W_DOWN_A)), nopfx, 0, nullptr, 0, F.bx - 192, 64, 0, TAIL_TILES); } }
        GRID_BAR();
        ffn_fix_phase(F, BIG, args.in[fb + 2], args.in[fb + 3], ACT2);
        GRID_BAR();
        { pg8::Gemm g{ACT2, (const bf16*)(F.ws + wlo + (mamba ? W_DOWN_M : W_DOWN_A)), M, DM, DFF}; pg8::StaticOrder S; S.init(M, DM, F.G, F.bx);
          pg8::EpiResN E{XR, XR, U, SSQ(2 * layer + 2), DM};
          pg8::gemm_phase<pg8::EpiResN, pg8::StaticOrder, PG8_ALIGN, PG8_SP2>(F.lds + RING_OFF, g, S, E); }
        GRID_BAR();
    }
    {
        constexpr int layer = 2;
        constexpr bool mamba = (layer & 1) == 0;
        constexpr int ib = layer == 0 ? 2 : layer == 1 ? 16 : layer == 2 ? 29 : 43;
        constexpr size_t wlo = WS_W + (layer == 0 ? 0 : layer == 1 ? WL_MAMBA : layer == 2 ? WL_MAMBA + WL_ATTN : 2 * WL_MAMBA + WL_ATTN);
        const float* xin = layer == 0 ? args.in[0] : XR;
        if constexpr (mamba) {
            const bool splitdt = F.G == 256;
            if (splitdt) {
                { pg8::Gemm g{U, (const bf16*)(F.ws + wlo + W_IN), M, NZXM, DM}; pg8::StaticOrder S; S.init(M, NZXM, F.G, F.bx);
                  int pm0, ntab; rstd_table(F, S, SSQ(2 * layer), pm0, ntab);
                  pg8::EpiBf16S E{BIG, NZXP, SSQ(2 * layer), (const LAS float*)(F.lds + TAB_OFF), pm0, ntab};
                  pg8::gemm_phase<pg8::EpiBf16S, pg8::StaticOrder, PG8_ALIGN, PG8_SP2>(F.lds + RING_OFF, g, S, E); }
                { const int ks = F.vcu & 7; pg8::Gemm g{U + ks * 512, (const bf16*)(F.ws + wlo + W_IN) + (size_t)NZXM * DM + ks * 512, M, 256, 512, DM};
                  pg8::OneUnit S{F.vcu >> 3, 1}; pg8::EpiPart E{PART + (size_t)ks * M * 128};
                  pg8::gemm_phase<pg8::EpiPart, pg8::OneUnit, false, PG8_SP2>(F.lds + RING_OFF, g, S, E); }
            } else {
                { pg8::Gemm g{U, (const bf16*)(F.ws + wlo + W_IN), M, NZXP, DM}; pg8::StaticOrder S; S.init(M, NZXP, F.G, F.bx);
                  int pm0, ntab; rstd_table(F, S, SSQ(2 * layer), pm0, ntab);
                  pg8::EpiBf16S E{BIG, NZXP, SSQ(2 * layer), (const LAS float*)(F.lds + TAB_OFF), pm0, ntab};
                  pg8::gemm_phase<pg8::EpiBf16S, pg8::StaticOrder, PG8_ALIGN, PG8_SP2>(F.lds + RING_OFF, g, S, E); }
            }
            GRID_BAR();
            ssd_prep_phase(F, BIG, args.in[ib + 2], args.in[ib + 3], args.in[ib + 4], XT, Bn, BT, Cn, DTF, splitdt ? PART : nullptr, SSQ(2 * layer));
            GRID_BAR();
            ssd_phase(F, XT, Bn, BT, Cn, DTF, args.in[ib + 5], args.in[ib + 6], Yb);
            GRID_BAR();
            gated_norm_phase(F, Yb, BIG, args.in[ib + 7], ACT2);
            GRID_BAR();
            { pg8::Gemm g{ACT2, (const bf16*)(F.ws + wlo + W_OUT), M, DM, DI}; pg8::StaticOrder S; S.init(M, DM, F.G, F.bx);
              pg8::EpiResN E{xin, XR, U, SSQ(2 * layer + 1), DM};
              pg8::gemm_phase<pg8::EpiResN, pg8::StaticOrder, PG8_ALIGN, PG8_SP2>(F.lds + RING_OFF, g, S, E); }
            GRID_BAR();
        } else {
            { pg8::Gemm g{U, (const bf16*)(F.ws + wlo + W_QKV), M, NQKV, DM}; pg8::StaticOrder S; S.init(M, NQKV, F.G, F.bx);
              int pm0, ntab; rstd_table(F, S, SSQ(2 * layer), pm0, ntab);
              pg8::EpiHeadMajor E{BIG, (size_t)M * 128, ropec, ropes, SSQ(2 * layer), (const LAS float*)(F.lds + TAB_OFF), pm0, ntab};
              pg8::gemm_phase<pg8::EpiHeadMajor, pg8::StaticOrder, PG8_ALIGN, PG8_SP2>(F.lds + RING_OFF, g, S, E); }
            GRID_BAR();
            attn2_phase(F, BIG, OP, (char*)lds + RING_OFF, args.in[ib + 2], args.in[ib + 3], args.in[ib + 4], args.in[ib + 5], args.in[ib + 6], 0.8f - 0.6f * expf(-0.3f * (float)layer), ACT2);
            GRID_BAR();
            { pg8::Gemm g{ACT2, (const bf16*)(F.ws + wlo + W_O), M, DM, DM}; pg8::StaticOrder S; S.init(M, DM, F.G, F.bx);
              pg8::EpiResN E{xin, XR, U, SSQ(2 * layer + 1), DM};
              pg8::gemm_phase<pg8::EpiResN, pg8::StaticOrder, PG8_ALIGN, PG8_SP2>(F.lds + RING_OFF, g, S, E); }
            GRID_BAR();
        }
        constexpr int fb = mamba ? ib + 9 : ib + 8;
        { pg8::Gemm g{U, (const bf16*)(F.ws + wlo + (mamba ? W_UP_M : W_UP_A)), M, NUP, DM}; pg8::StaticOrder S; S.init(M, NUP, F.G, F.bx);

          { pg8::EpiGate E{ACT2, BIG, args.in[fb + 2], args.in[fb + 3], NUP, DFF, SSQ(2 * layer + 1), F.lds + SIDE_OFF};
          pg8::gemm_phase<pg8::EpiGate, pg8::StaticOrder, PG8_ALIGN, PG8_SP2>(F.lds + RING_OFF, g, S, E); } }
        if constexpr (layer < 3) { if (F.G == 256 && F.bx >= 192) {
            constexpr bool nm = ((layer + 1) & 1) == 0; constexpr int nib = layer + 1 == 1 ? 16 : layer + 1 == 2 ? 29 : 43;
            constexpr size_t nwlo = WS_W + (layer + 1 == 1 ? WL_MAMBA : layer + 1 == 2 ? WL_MAMBA + WL_ATTN : 2 * WL_MAMBA + WL_ATTN);
            int nopfx = 0; p0_matrix(F, args.in[nib + (nm ? 13 : 12)], DFF, DM, DM, (bf16*)(F.ws + nwlo + (nm ? W_DOWN_M : W_DOWN_A)), nopfx, 0, nullptr, 0, F.bx - 192, 64, 0, TAIL_TILES); } }
        GRID_BAR();
        ffn_fix_phase(F, BIG, args.in[fb + 2], args.in[fb + 3], ACT2);
        GRID_BAR();
        { pg8::Gemm g{ACT2, (const bf16*)(F.ws + wlo + (mamba ? W_DOWN_M : W_DOWN_A)), M, DM, DFF}; pg8::StaticOrder S; S.init(M, DM, F.G, F.bx);
          pg8::EpiResN E{XR, XR, U, SSQ(2 * layer + 2), DM};
          pg8::gemm_phase<pg8::EpiResN, pg8::StaticOrder, PG8_ALIGN, PG8_SP2>(F.lds + RING_OFF, g, S, E); }
        GRID_BAR();
    }
    {
        constexpr int layer = 3;
        constexpr bool mamba = (layer & 1) == 0;
        constexpr int ib = layer == 0 ? 2 : layer == 1 ? 16 : layer == 2 ? 29 : 43;
        constexpr size_t wlo = WS_W + (layer == 0 ? 0 : layer == 1 ? WL_MAMBA : layer == 2 ? WL_MAMBA + WL_ATTN : 2 * WL_MAMBA + WL_ATTN);
        const float* xin = layer == 0 ? args.in[0] : XR;
        if constexpr (mamba) {
            const bool splitdt = F.G == 256;
            if (splitdt) {
                { pg8::Gemm g{U, (const bf16*)(F.ws + wlo + W_IN), M, NZXM, DM}; pg8::StaticOrder S; S.init(M, NZXM, F.G, F.bx);
                  int pm0, ntab; rstd_table(F, S, SSQ(2 * layer), pm0, ntab);
                  pg8::EpiBf16S E{BIG, NZXP, SSQ(2 * layer), (const LAS float*)(F.lds + TAB_OFF), pm0, ntab};
                  pg8::gemm_phase<pg8::EpiBf16S, pg8::StaticOrder, PG8_ALIGN, PG8_SP2>(F.lds + RING_OFF, g, S, E); }
                { const int ks = F.vcu & 7; pg8::Gemm g{U + ks * 512, (const bf16*)(F.ws + wlo + W_IN) + (size_t)NZXM * DM + ks * 512, M, 256, 512, DM};
                  pg8::OneUnit S{F.vcu >> 3, 1}; pg8::EpiPart E{PART + (size_t)ks * M * 128};
                  pg8::gemm_phase<pg8::EpiPart, pg8::OneUnit, false, PG8_SP2>(F.lds + RING_OFF, g, S, E); }
            } else {
                { pg8::Gemm g{U, (const bf16*)(F.ws + wlo + W_IN), M, NZXP, DM}; pg8::StaticOrder S; S.init(M, NZXP, F.G, F.bx);
                  int pm0, ntab; rstd_table(F, S, SSQ(2 * layer), pm0, ntab);
                  pg8::EpiBf16S E{BIG, NZXP, SSQ(2 * layer), (const LAS float*)(F.lds + TAB_OFF), pm0, ntab};
                  pg8::gemm_phase<pg8::EpiBf16S, pg8::StaticOrder, PG8_ALIGN, PG8_SP2>(F.lds + RING_OFF, g, S, E); }
            }
            GRID_BAR();
            ssd_prep_phase(F, BIG, args.in[ib + 2], args.in[ib + 3], args.in[ib + 4], XT, Bn, BT, Cn, DTF, splitdt ? PART : nullptr, SSQ(2 * layer));
            GRID_BAR();
            ssd_phase(F, XT, Bn, BT, Cn, DTF, args.in[ib + 5], args.in[ib + 6], Yb);
            GRID_BAR();
            gated_norm_phase(F, Yb, BIG, args.in[ib + 7], ACT2);
            GRID_BAR();
            { pg8::Gemm g{ACT2, (const bf16*)(F.ws + wlo + W_OUT), M, DM, DI}; pg8::StaticOrder S; S.init(M, DM, F.G, F.bx);
              pg8::EpiResN E{xin, XR, U, SSQ(2 * layer + 1), DM};
              pg8::gemm_phase<pg8::EpiResN, pg8::StaticOrder, PG8_ALIGN, PG8_SP2>(F.lds + RING_OFF, g, S, E); }
            GRID_BAR();
        } else {
            { pg8::Gemm g{U, (const bf16*)(F.ws + wlo + W_QKV), M, NQKV, DM}; pg8::StaticOrder S; S.init(M, NQKV, F.G, F.bx);
              int pm0, ntab; rstd_table(F, S, SSQ(2 * layer), pm0, ntab);
              pg8::EpiHeadMajor E{BIG, (size_t)M * 128, ropec, ropes, SSQ(2 * layer), (const LAS float*)(F.lds + TAB_OFF), pm0, ntab};
              pg8::gemm_phase<pg8::EpiHeadMajor, pg8::StaticOrder, PG8_ALIGN, PG8_SP2>(F.lds + RING_OFF, g, S, E); }
            GRID_BAR();
            attn2_phase(F, BIG, OP, (char*)lds + RING_OFF, args.in[ib + 2], args.in[ib + 3], args.in[ib + 4], args.in[ib + 5], args.in[ib + 6], 0.8f - 0.6f * expf(-0.3f * (float)layer), ACT2);
            GRID_BAR();
            { pg8::Gemm g{ACT2, (const bf16*)(F.ws + wlo + W_O), M, DM, DM}; pg8::StaticOrder S; S.init(M, DM, F.G, F.bx);
              pg8::EpiResN E{xin, XR, U, SSQ(2 * layer + 1), DM};
              pg8::gemm_phase<pg8::EpiResN, pg8::StaticOrder, PG8_ALIGN, PG8_SP2>(F.lds + RING_OFF, g, S, E); }
            GRID_BAR();
        }
        constexpr int fb = mamba ? ib + 9 : ib + 8;
        { pg8::Gemm g{U, (const bf16*)(F.ws + wlo + (mamba ? W_UP_M : W_UP_A)), M, NUP, DM}; pg8::StaticOrder S; S.init(M, NUP, F.G, F.bx);

          { pg8::EpiGate E{ACT2, BIG, args.in[fb + 2], args.in[fb + 3], NUP, DFF, SSQ(2 * layer + 1), F.lds + SIDE_OFF};
          pg8::gemm_phase<pg8::EpiGate, pg8::StaticOrder, PG8_ALIGN, PG8_SP2>(F.lds + RING_OFF, g, S, E); } }
        if constexpr (layer < 3) { if (F.G == 256 && F.bx >= 192) {
            constexpr bool nm = ((layer + 1) & 1) == 0; constexpr int nib = layer + 1 == 1 ? 16 : layer + 1 == 2 ? 29 : 43;
            constexpr size_t nwlo = WS_W + (layer + 1 == 1 ? WL_MAMBA : layer + 1 == 2 ? WL_MAMBA + WL_ATTN : 2 * WL_MAMBA + WL_ATTN);
            int nopfx = 0; p0_matrix(F, args.in[nib + (nm ? 13 : 12)], DFF, DM, DM, (bf16*)(F.ws + nwlo + (nm ? W_DOWN_M : W_DOWN_A)), nopfx, 0, nullptr, 0, F.bx - 192, 64, 0, TAIL_TILES); } }
        GRID_BAR();
        ffn_fix_phase(F, BIG, args.in[fb + 2], args.in[fb + 3], ACT2);
        GRID_BAR();
        { pg8::Gemm g{ACT2, (const bf16*)(F.ws + wlo + (mamba ? W_DOWN_M : W_DOWN_A)), M, DM, DFF}; pg8::StaticOrder S; S.init(M, DM, F.G, F.bx);
          pg8::EpiResN E{XR, XR, U, SSQ(2 * layer + 2), DM};
          pg8::gemm_phase<pg8::EpiResN, pg8::StaticOrder, PG8_ALIGN, PG8_SP2>(F.lds + RING_OFF, g, S, E); }
        GRID_BAR();
    }
    {
        const int gw = F.vcu * NWAVES + F.wave, NGW = F.G * NWAVES;
        for (int m = gw; m < M; m += NGW) rms_row_f32(XR + (size_t)m * DM, args.in[56], args.out + (size_t)m * DM, F.lane);
    }
#undef GRID_BAR
#undef XR
#undef U
#undef BIG
#undef ACT2
#undef XT
#undef Yb
#undef Bn
#undef BT
#undef Cn
#undef DTF
#undef PART
#undef OP
#undef SSQ
#undef ropec
#undef ropes
}
}

extern "C" void kernel_launch(void* const* d_in, const int* in_sizes, int n_in, void* d_out, int out_size, void* d_ws, size_t ws_size, hipStream_t stream) {
    using namespace mk;
    static int grid = 0;
    if (grid == 0) {
        if (n_in != 57 || out_size != M * DM || ws_size < WS_END) { fprintf(stderr, "kernel_launch: built for 57 inputs, out of %d floats, >= %zu bytes of workspace; got n_in %d, out %d, ws %zu; nothing launched\n", M * DM, (size_t)WS_END, n_in, out_size, ws_size); grid = -1; return; }
        int dev = 0, cus = 0, per_cu = 0;
        if (hipGetDevice(&dev) != hipSuccess || hipDeviceGetAttribute(&cus, hipDeviceAttributeMultiprocessorCount, dev) != hipSuccess) { fprintf(stderr, "kernel_launch: device query failed\n"); grid = -1; return; }
        if (hipFuncSetAttribute((const void*)trunk_fwd, hipFuncAttributeMaxDynamicSharedMemorySize, LDS_BYTES) != hipSuccess) { fprintf(stderr, "kernel_launch: hipFuncSetAttribute failed\n"); grid = -1; return; }
        if (hipOccupancyMaxActiveBlocksPerMultiprocessor(&per_cu, (const void*)trunk_fwd, NTHR, LDS_BYTES) != hipSuccess || per_cu < 1)
            fprintf(stderr, "kernel_launch: note: occupancy query reports %d workgroups per CU\n", per_cu);
        (void)hipGetLastError();
        grid = cus;
    }
    if (grid < 0) return;
    if (hipMemsetAsync((char*)d_ws + WS_CTL, 0, CTL_ZERO_BYTES, stream) != hipSuccess) { fprintf(stderr, "kernel_launch: memset failed\n"); return; }
    Args a{};
    for (int i = 0; i < 57; ++i) a.in[i] = (const float*)d_in[i];
    a.out = (float*)d_out; a.ws = (unsigned char*)d_ws;
    hipLaunchKernelGGL(trunk_fwd, dim3(grid), dim3(NTHR), LDS_BYTES, stream, a);
    const hipError_t le = hipPeekAtLastError();
    if (le != hipSuccess) fprintf(stderr, "kernel_launch: launch failed: %s\n", hipGetErrorName(le));
}
```

```cpp
#include <hip/hip_runtime.h>
#include <cstdio>
#include <cstdint>
namespace pg8 {
#define PG8_LAS __attribute__((address_space(3)))
typedef unsigned short bf16_t;
typedef short bf16x8 __attribute__((ext_vector_type(8)));
typedef float f32x4 __attribute__((ext_vector_type(4)));
typedef unsigned u32x4 __attribute__((ext_vector_type(4)));
constexpr int BM = 256, BK = 64, HALF = 128, HTB = HALF * BK * 2  , STAGE_BYTES = 8 * HTB, NXCD = 8, WGM = 8;

__host__ __device__ __forceinline__ int lds_byte(int r, int c) { const int st = (r >> 4) * 2 + (c >> 5), rr = r & 15, cc = c & 31, ob = rr * 64 + cc * 2; return st * 1024 + (ob ^ (((ob >> 9) & 1) << 5)); }
__host__ __device__ __forceinline__ void stage_rc(int b, int& R, int& C) { const int st = b / 1024, sb = b % 1024, swz = sb ^ (((sb >> 9) & 1) << 5); R = (st >> 1) * 16 + swz / 64; C = (st & 1) * 32 + (swz % 64) / 2; }
__host__ __device__ __forceinline__ int perm32(int rho) { const int n = rho >> 4, i = rho & 15; return 8 * (i >> 2) + 4 * n + (i & 3); }

struct Unit { int pm, pn; };
struct Gemm { const bf16_t* A; const bf16_t* Bt; int M, N, K; int ld = 0; };

struct StaticOrder {
    int nM, nN, nwg, G, c;
    __host__ __device__ void init(int M, int N, int G_, int c_) { nM = M / BM; nN = N / BM; nwg = nM * nN; G = G_; c = c_; }
    __host__ __device__ bool next(int i, Unit& u) const {
        const long L = (long)i * G + c; if (L >= nwg) return false;
        int wgid = (int)L; { const int q = nwg / NXCD, r = nwg % NXCD, xcd = wgid % NXCD, off = wgid / NXCD; wgid = (xcd < r ? xcd * (q + 1) : r * (q + 1) + (xcd - r) * q) + off; }
        const int nig = WGM * nN, gid = wgid / nig, fm = gid * WGM, gsz = (nM - fm) < WGM ? (nM - fm) : WGM;
        u.pm = fm + ((wgid % nig) % gsz); u.pn = (wgid % nig) / gsz; return true;
    }
    __device__ __forceinline__ void a_ready(const Unit&) const {}
    __device__ __forceinline__ void done(const Unit&) const {}
};

typedef float f32x2c __attribute__((ext_vector_type(2))); typedef __bf16 bf16x2c __attribute__((ext_vector_type(2)));
__device__ __forceinline__ unsigned cvt_pk_bf16(float lo, float hi) { const f32x2c v = {lo, hi}; return __builtin_bit_cast(unsigned, __builtin_convertvector(v, bf16x2c)); }
typedef float f32x2 __attribute__((ext_vector_type(2)));
__device__ __forceinline__ f32x2 gelu_pk(f32x2 v) {
    const f32x2 av = __builtin_elementwise_abs(v), d = av * 0.2316418882f + 1.0f;
    f32x2 t; t.x = __builtin_amdgcn_rcpf(d.x); t.y = __builtin_amdgcn_rcpf(d.y);
    f32x2 q = t * 0.5307027145f + (-0.7265760135f); q = q * t + 0.7107068705f; q = q * t + (-0.142248368f); q = q * t + 0.127414796f; q = q * t;
    const f32x2 s = (v * v) * (-0.72134752044f);
    f32x2 e; e.x = __builtin_amdgcn_exp2f(s.x); e.y = __builtin_amdgcn_exp2f(s.y);
    const f32x2 m = v * (q * e), r = v - m;
    f32x2 o; o.x = v.x < 0.f ? m.x : r.x; o.y = v.y < 0.f ? m.y : r.y; return o;
}

template <int ACT  > struct EpiBf16 {
    static constexpr bool PERM = true, AFTER_DRAIN = false; static_assert(ACT == 0 || ACT == 1, "EpiBf16: ACT is 0 (none) or 1 (gelu_pk)");
    bf16_t* O; int ldc; const float* bias; int split_cols; size_t split_stride; float scale0;
    __device__ __forceinline__ void operator()(const f32x4 (&acc)[2][2][4][2], const Unit& u, int wr, int wc, int fr, int fq) const {
        const int row0 = u.pm * BM + wr * 64 + fr; int colt = u.pn * BM; bf16_t* base = O;
        float sc = 1.f; if (split_cols) { const int t = colt / split_cols; base += (size_t)t * split_stride; colt -= t * split_cols; if (t == 0) sc = scale0; }
        const int col0 = colt + wc * 32 + 8 * fq, bcol0 = u.pn * BM + wc * 32 + 8 * fq;
        f32x4 bv[2][2];
#pragma unroll
        for (int bj = 0; bj < 2; ++bj)
#pragma unroll
            for (int n = 0; n < 2; ++n) bv[bj][n] = bias ? *(const f32x4*)(bias + bcol0 + bj * HALF + 4 * n) : (f32x4){0.f, 0.f, 0.f, 0.f};
#pragma unroll
        for (int ai = 0; ai < 2; ++ai)
#pragma unroll
            for (int m = 0; m < 4; ++m) { bf16_t* rowp = base + (size_t)(row0 + ai * HALF + m * 16) * ldc + col0;
#pragma unroll
                for (int bj = 0; bj < 2; ++bj) { f32x4 v0 = acc[ai][bj][m][0] + bv[bj][0], v1 = acc[ai][bj][m][1] + bv[bj][1];
                    if (ACT == 1) { f32x2 a = gelu_pk((f32x2){v0[0], v0[1]}), b = gelu_pk((f32x2){v0[2], v0[3]}), c = gelu_pk((f32x2){v1[0], v1[1]}), d = gelu_pk((f32x2){v1[2], v1[3]});
                        v0 = (f32x4){a.x, a.y, b.x, b.y}; v1 = (f32x4){c.x, c.y, d.x, d.y}; }
                    v0 = v0 * sc; v1 = v1 * sc; u32x4 w; w.x = cvt_pk_bf16(v0[0], v0[1]); w.y = cvt_pk_bf16(v0[2], v0[3]); w.z = cvt_pk_bf16(v1[0], v1[1]); w.w = cvt_pk_bf16(v1[2], v1[3]);
                    *(u32x4*)(rowp + bj * HALF) = w; } }
    }
};


struct EpiRes {
    static constexpr bool PERM = false, AFTER_DRAIN = false;
    const float* base; float* out; int ldc;
    __device__ __forceinline__ void operator()(const f32x4 (&acc)[2][2][4][2], const Unit& u, int wr, int wc, int fr, int fq) const {
        const int col0 = u.pn * BM + wc * 32 + 4 * fq;
#pragma unroll
        for (int ai = 0; ai < 2; ++ai)
#pragma unroll
            for (int m = 0; m < 4; ++m) { const size_t off = (size_t)(u.pm * BM + ai * HALF + wr * 64 + m * 16 + fr) * ldc + col0;
#pragma unroll
                for (int bj = 0; bj < 2; ++bj)
#pragma unroll
                    for (int n = 0; n < 2; ++n) { const f32x4 bs = *(const f32x4*)(base + off + bj * HALF + n * 16); *(f32x4*)(out + off + bj * HALF + n * 16) = bs + acc[ai][bj][m][n]; }
                if (m & 1) asm volatile("" ::: "memory"); }
    }
};
struct EpiHeadMajor {
    static constexpr bool PERM = true, AFTER_DRAIN = false;
    bf16_t* O; size_t gstride; const float* cs; const float* sn; const unsigned long long* ss; const PG8_LAS float* tab; int pm0, ntab;
    __device__ __forceinline__ void operator()(const f32x4 (&acc)[2][2][4][2], const Unit& u, int wr, int wc, int fr, int fq) const {
        const int row0 = u.pm * BM + wr * 64 + fr, col0 = wc * 32 + 8 * fq; const bool rope = u.pn < 32, intab = (unsigned)(u.pm - pm0) < (unsigned)ntab;
#pragma unroll
        for (int ai = 0; ai < 2; ++ai)
#pragma unroll
            for (int m = 0; m < 4; ++m) { const int row = row0 + ai * HALF + m * 16;
                const float rs = intab ? tab[row - pm0 * BM] : 1.0f / sqrtf((float)ss[row] * (1.0f / (4096.0f * 16777216.0f)) + 1e-5f);
                f32x4 c4 = {1.f, 1.f, 1.f, 1.f}, s4 = {0.f, 0.f, 0.f, 0.f};
                if (rope) { c4 = *(const f32x4*)(cs + (size_t)row * 64 + 16 * wc + 4 * fq); s4 = *(const f32x4*)(sn + (size_t)row * 64 + 16 * wc + 4 * fq); }
#pragma unroll
                for (int bj = 0; bj < 2; ++bj) { bf16_t* rowp = O + (size_t)(u.pn * 2 + bj) * gstride + (size_t)row * 128 + col0;
                    const f32x4 v0 = acc[ai][bj][m][0] * rs, v1 = acc[ai][bj][m][1] * rs;
                    const f32x4 r0 = {v0[0] * c4[0] - v0[1] * s4[0], v0[1] * c4[0] + v0[0] * s4[0], v0[2] * c4[1] - v0[3] * s4[1], v0[3] * c4[1] + v0[2] * s4[1]};
                    const f32x4 r1 = {v1[0] * c4[2] - v1[1] * s4[2], v1[1] * c4[2] + v1[0] * s4[2], v1[2] * c4[3] - v1[3] * s4[3], v1[3] * c4[3] + v1[2] * s4[3]};
                    u32x4 w; w.x = cvt_pk_bf16(r0[0], r0[1]); w.y = cvt_pk_bf16(r0[2], r0[3]); w.z = cvt_pk_bf16(r1[0], r1[1]); w.w = cvt_pk_bf16(r1[2], r1[3]);
                    *(u32x4*)rowp = w; } }
    }
};
struct EpiBf16S {
    static constexpr bool PERM = true, AFTER_DRAIN = false;
    bf16_t* O; int ldc; const unsigned long long* ss; const PG8_LAS float* tab; int pm0, ntab;
    __device__ __forceinline__ void operator()(const f32x4 (&acc)[2][2][4][2], const Unit& u, int wr, int wc, int fr, int fq) const {
        const int row0 = u.pm * BM + wr * 64 + fr, col0 = u.pn * BM + wc * 32 + 8 * fq; const bool intab = (unsigned)(u.pm - pm0) < (unsigned)ntab;
#pragma unroll
        for (int ai = 0; ai < 2; ++ai)
#pragma unroll
            for (int m = 0; m < 4; ++m) { const int row = row0 + ai * HALF + m * 16;
                const float rs = intab ? tab[row - pm0 * BM] : 1.0f / sqrtf((float)ss[row] * (1.0f / (4096.0f * 16777216.0f)) + 1e-5f);
                bf16_t* rowp = O + (size_t)row * ldc + col0;
#pragma unroll
                for (int bj = 0; bj < 2; ++bj) { const f32x4 v0 = acc[ai][bj][m][0] * rs, v1 = acc[ai][bj][m][1] * rs;
                    u32x4 w; w.x = cvt_pk_bf16(v0[0], v0[1]); w.y = cvt_pk_bf16(v0[2], v0[3]); w.z = cvt_pk_bf16(v1[0], v1[1]); w.w = cvt_pk_bf16(v1[2], v1[3]);
                    *(u32x4*)(rowp + bj * HALF) = w; } }
    }
};
template <int C, bool BC> __device__ __forceinline__ float eg_dpp(float x) { return __int_as_float(__builtin_amdgcn_update_dpp(0, __float_as_int(x), C, 0xf, 0xf, BC)); }
#define EG_DPP(x, c, bc) eg_dpp<c, bc>(x)
#define EG_SHR1(x) EG_DPP(x, 0x111, true)
#define EG_SHR2(x) EG_DPP(x, 0x112, true)
#define EG_MIR(x) EG_DPP(x, 0x140, false)
#define EG_SWP(x) EG_DPP(x, 0xB1, false)
struct EpiGate {
    static constexpr bool PERM = true, AFTER_DRAIN = false;
    bf16_t* GA; bf16_t* HB; const float* cw; const float* cb; int nup, dff; const unsigned long long* ss; PG8_LAS unsigned char* side;
    __device__ __forceinline__ void prefetch(const Unit& nx, int par, int wid, int lane) const {
        const float* base = (wid < 3 ? cw + (size_t)wid * nup : wid < 6 ? cw + (size_t)(wid - 3) * nup + dff : wid == 6 ? cb : cb + dff) + nx.pn * 128 + lane;
        PG8_LAS unsigned char* d = side + par * 4096 + wid * 512;
        __builtin_amdgcn_global_load_lds((const unsigned*)base, (PG8_LAS unsigned*)d, 4, 0, 0);
        __builtin_amdgcn_global_load_lds((const unsigned*)(base + 64), (PG8_LAS unsigned*)(d + 256), 4, 0, 0);
        __builtin_amdgcn_global_load_lds((const unsigned*)(ss + (size_t)nx.pm * BM) + wid * 64 + lane, (PG8_LAS unsigned*)(side + 8192 + par * 2048 + wid * 256), 4, 0, 0);
    }
    __device__ __forceinline__ void run(const f32x4 (&acc)[2][2][4][2], const Unit& u, int par, int wr, int wc, int fr, int fq) const {
        typedef unsigned u32x2 __attribute__((ext_vector_type(2)));
        const int ch0 = u.pn * 128 + wc * 32 + 8 * fq;
        float rsv[2][4]; { const PG8_LAS unsigned long long* sl = (const PG8_LAS unsigned long long*)(side + 8192 + par * 2048) + wr * 64 + fr;
#pragma unroll
            for (int ai = 0; ai < 2; ++ai)
#pragma unroll
                for (int m = 0; m < 4; ++m) rsv[ai][m] = __builtin_amdgcn_rsqf((float)sl[ai * 128 + m * 16] * (1.0f / (4096.0f * 16777216.0f)) + 1e-5f); }
        const bool f0 = fr == 0, f01 = fr < 2;
#pragma unroll
        for (int n = 0; n < 2; ++n) { const int ch = ch0 + 4 * n;
            const PG8_LAS f32x4* wp = (const PG8_LAS f32x4*)(side + par * 4096) + (wc * 8 + 2 * fq + n);
            const f32x4 wg0 = wp[0], wg1 = wp[32], wg2 = wp[64], wv0 = wp[96], wv1 = wp[128], wv2 = wp[160], bg = wp[192], bv = wp[224];
#pragma unroll
            for (int ai = 0; ai < 2; ++ai) { f32x4 pg1 = {0.f, 0.f, 0.f, 0.f}, pg2 = pg1, pv1 = pg1, pv2 = pg1;
#pragma unroll
                for (int m = 0; m < 4; ++m) { const int row = u.pm * BM + ai * HALF + wr * 64 + m * 16 + fr;
                    const float rs = rsv[ai][m];
                    const f32x4 g = acc[ai][0][m][n] * rs, v = acc[ai][1][m][n] * rs; f32x4 g1, g2, v1, v2, o;
#pragma unroll
                    for (int e = 0; e < 4; ++e) { g1[e] = EG_SHR1(g[e]); g2[e] = EG_SHR2(g[e]); v1[e] = EG_SHR1(v[e]); v2[e] = EG_SHR2(v[e]); }
#pragma unroll
                    for (int e = 0; e < 4; ++e) { const float tg1 = f0 ? pg1[e] : g1[e], tg2 = f01 ? pg2[e] : g2[e], tv1 = f0 ? pv1[e] : v1[e], tv2 = f01 ? pv2[e] : v2[e];
                        const float a = bg[e] + wg0[e] * tg2 + wg1[e] * tg1 + wg2[e] * g[e], b = bv[e] + wv0[e] * tv2 + wv1[e] * tv1 + wv2[e] * v[e];
                        o[e] = a * __builtin_amdgcn_rcpf(1.f + __expf(-a)) * b; }
                    if (m > 0 || !f01) { u32x2 w; w.x = cvt_pk_bf16(o[0], o[1]); w.y = cvt_pk_bf16(o[2], o[3]); *(u32x2*)(GA + (size_t)row * dff + ch) = w; }
                    if ((m == 0 && f01) || (m == 3 && fr >= 14)) { const int j = (m == 0) ? fr : fr - 12;
                        bf16_t* hp = HB + (size_t)(((row >> 6) * 4 + j) * 2) * dff + ch;
                        u32x2 wg_; wg_.x = cvt_pk_bf16(g[0], g[1]); wg_.y = cvt_pk_bf16(g[2], g[3]); *(u32x2*)hp = wg_;
                        u32x2 wv_; wv_.x = cvt_pk_bf16(v[0], v[1]); wv_.y = cvt_pk_bf16(v[2], v[3]); *(u32x2*)(hp + dff) = wv_; }
#pragma unroll
                    for (int e = 0; e < 4; ++e) { pg1[e] = EG_MIR(g[e]); pg2[e] = EG_SWP(pg1[e]); pv1[e] = EG_MIR(v[e]); pv2[e] = EG_SWP(pv1[e]); }
                } } }
    }
};
#undef EG_SHR1
#undef EG_SHR2
#undef EG_MIR
#undef EG_SWP
#undef EG_DPP
template <class T> struct epi_pf { static constexpr bool v = false; };
template <> struct epi_pf<EpiGate> { static constexpr bool v = true; };
struct EpiResN {
    static constexpr bool PERM = false, AFTER_DRAIN = false;
    const float* base; float* out; bf16_t* xb; unsigned long long* ss; int ldc;
    __device__ __forceinline__ void operator()(const f32x4 (&acc)[2][2][4][2], const Unit& u, int wr, int wc, int fr, int fq) const {
        const int col0 = u.pn * BM + wc * 32 + 4 * fq;
        int l = threadIdx.x; asm volatile("" : "+v"(l)); l &= 63;
        typedef unsigned u32x2 __attribute__((ext_vector_type(2)));
        const size_t off0 = (size_t)(u.pm * BM + wr * 64 + fr) * ldc + col0;
        const int ucol = (fq & 1) ? 12 + 4 * fq : 4 * fq;
        f32x4 bsA[2][2][2], bsB[2][2][2];
#define ERN_LOAD(dst, b_) do { _Pragma("unroll") for (int mm = 0; mm < 2; ++mm) _Pragma("unroll") for (int bj = 0; bj < 2; ++bj) _Pragma("unroll") for (int n = 0; n < 2; ++n) \
            dst[mm][bj][n] = *(const f32x4*)(base + off0 + (size_t)(((b_) >> 1) * HALF + (((b_) & 1) * 2 + mm) * 16) * ldc + bj * HALF + n * 16); } while (0)
#define ERN_DO(src, b_) do { _Pragma("unroll") for (int mm = 0; mm < 2; ++mm) { const int ai = (b_) >> 1, m = ((b_) & 1) * 2 + mm; const int row = u.pm * BM + ai * HALF + wr * 64 + m * 16 + fr; \
            const size_t off = off0 + (size_t)(ai * HALF + m * 16) * ldc; float q = 0.f; \
            _Pragma("unroll") for (int bj = 0; bj < 2; ++bj) { const f32x4 o0 = src[mm][bj][0] + acc[ai][bj][m][0], o1 = src[mm][bj][1] + acc[ai][bj][m][1]; \
                *(f32x4*)(out + off + bj * HALF) = o0; *(f32x4*)(out + off + bj * HALF + 16) = o1; \
                q += ((o0[0] * o0[0] + o0[1] * o0[1]) + (o0[2] * o0[2] + o0[3] * o0[3])) + ((o1[0] * o1[0] + o1[1] * o1[1]) + (o1[2] * o1[2] + o1[3] * o1[3])); \
                  \
                if (xb) { const auto r0 = __builtin_amdgcn_permlane16_swap(cvt_pk_bf16(o0[0], o0[1]), cvt_pk_bf16(o1[0], o1[1]), false, false);     \
                const auto r1 = __builtin_amdgcn_permlane16_swap(cvt_pk_bf16(o0[2], o0[3]), cvt_pk_bf16(o1[2], o1[3]), false, false); \
                u32x4 w; w.x = r0[0]; w.y = r1[0]; w.z = r0[1]; w.w = r1[1]; \
                *(u32x4*)(xb + off - 4 * fq + ucol + bj * HALF) = w; } } \
            q += __builtin_bit_cast(float, __builtin_amdgcn_ds_bpermute((l ^ 16) << 2, __builtin_bit_cast(int, q))); \
            q += __builtin_bit_cast(float, __builtin_amdgcn_ds_bpermute((l ^ 32) << 2, __builtin_bit_cast(int, q))); \
            if (fq == 0) atomicAdd(ss + row, (unsigned long long)__float2ll_rn(q * 16777216.0f)); } } while (0)
        ERN_LOAD(bsA, 0); ERN_LOAD(bsB, 1); asm volatile("" ::: "memory");
        ERN_DO(bsA, 0); asm volatile("" ::: "memory"); ERN_LOAD(bsA, 2); asm volatile("" ::: "memory");
        ERN_DO(bsB, 1); asm volatile("" ::: "memory"); ERN_LOAD(bsB, 3); asm volatile("" ::: "memory");
        ERN_DO(bsA, 2); asm volatile("" ::: "memory");
        ERN_DO(bsB, 3);
#undef ERN_LOAD
#undef ERN_DO
    }
};
struct EpiPart {
    static constexpr bool PERM = false, AFTER_DRAIN = false;
    float* P;
    __device__ __forceinline__ void operator()(const f32x4 (&acc)[2][2][4][2], const Unit& u, int wr, int wc, int fr, int fq) const {
#pragma unroll
        for (int ai = 0; ai < 2; ++ai)
#pragma unroll
            for (int m = 0; m < 4; ++m) { float* rowp = P + (size_t)(u.pm * BM + ai * HALF + wr * 64 + m * 16 + fr) * 128 + wc * 32 + 4 * fq;
#pragma unroll
                for (int n = 0; n < 2; ++n) *(f32x4*)(rowp + n * 16) = acc[ai][0][m][n]; }
    }
};
struct OneUnit {
    int pm, valid;
    __device__ __forceinline__ bool next(int i, Unit& u) const { if (i != 0 || !valid) return false; u.pm = pm; u.pn = 0; return true; }
    __device__ __forceinline__ void a_ready(const Unit&) const {}
    __device__ __forceinline__ void done(const Unit&) const {}
};
struct EpiNull {
    static constexpr bool PERM = true, AFTER_DRAIN = false;
    __device__ __forceinline__ void operator()(const f32x4 (&acc)[2][2][4][2], const Unit& u, int wr, int wc, int fr, int fq) const {
        float s = 0.f;
#pragma unroll
        for (int ai = 0; ai < 2; ++ai)
#pragma unroll
            for (int bj = 0; bj < 2; ++bj)
#pragma unroll
                for (int m = 0; m < 4; ++m)
#pragma unroll
                    for (int n = 0; n < 2; ++n) s += acc[ai][bj][m][n][0] + acc[ai][bj][m][n][1] + acc[ai][bj][m][n][2] + acc[ai][bj][m][n][3];
        if (s == 1.2345e-30f) asm volatile("s_nop 0" ::: "memory");
    }
};
template <class Epi, class Sched, bool ALIGN_EPI = false, bool SP2 = false>
__device__ __forceinline__ void gemm_phase(PG8_LAS unsigned char* lds, const Gemm g, const Sched& S, const Epi& E) {
    int tid_l_ = threadIdx.x; asm volatile("" : "+v"(tid_l_)); const int tid = tid_l_, wid = __builtin_amdgcn_readfirstlane(tid >> 6), lane = tid & 63, wr = wid >> 2, wc = wid & 3, fr = lane & 15, fq = lane >> 4;
    const int nt = g.K / BK, K = g.ld ? g.ld : g.K;
    unsigned voffA[2], voffB[2];
#pragma unroll
    for (int i = 0; i < 2; ++i) { int R, C; stage_rc(tid * 16 + i * 8192, R, C); const int Rb = Epi::PERM ? ((R & ~31) + perm32(R & 31)) : R;
        voffA[i] = (unsigned)(R * K + C) * 2u; voffB[i] = (unsigned)(Rb * K + C) * 2u; }
    const size_t kstep = (size_t)(BK * 2);
    const size_t hstep = (size_t)HALF * K * 2;
    const size_t tstep = 2 * hstep;
    const unsigned ldsw = (unsigned)wid * 1024u;
    const int aoff = lds_byte(wr * 64 + fr, fq * 8), boff = lds_byte(wc * 32 + fr, fq * 8);
#define PG8_SA(b, h) (((b) * 2 + (h)) * HTB)
#define PG8_SB(b, h) ((4 + (b) * 2 + (h)) * HTB)
#define PG8_STAGE(bufoff, gbase, voff) do { _Pragma("unroll") for (int _i = 0; _i < 2; ++_i) \
        __builtin_amdgcn_global_load_lds((const unsigned*)((const char*)(gbase) + (voff)[_i]), (PG8_LAS unsigned*)(lds + (bufoff) + ldsw + _i * 8192), 16, 0, 0); } while (0)
#define PG8_LDA(dst, b, h) do { _Pragma("unroll") for (int m = 0; m < 4; ++m) _Pragma("unroll") for (int k = 0; k < 2; ++k) dst[m][k] = *(const PG8_LAS bf16x8*)(lds + PG8_SA(b, h) + aoff + m * 2048 + k * 1024); } while (0)
#define PG8_LDB(dst, b, h) do { _Pragma("unroll") for (int n = 0; n < 2; ++n) _Pragma("unroll") for (int k = 0; k < 2; ++k) dst[n][k] = *(const PG8_LAS bf16x8*)(lds + PG8_SB(b, h) + boff + n * 2048 + k * 1024); } while (0)
#define PG8_MMA(ai, bj, At, Bt) do { __builtin_amdgcn_s_setprio(1); _Pragma("unroll") for (int m = 0; m < 4; ++m) _Pragma("unroll") for (int n = 0; n < 2; ++n) _Pragma("unroll") for (int k = 0; k < 2; ++k) \
        acc[ai][bj][m][n] = __builtin_amdgcn_mfma_f32_16x16x32_bf16(Bt[n][k], At[m][k], acc[ai][bj][m][n], 0, 0, 0); __builtin_amdgcn_s_setprio(0); } while (0)
#define PG8_WAIT_V(n) asm volatile("s_waitcnt vmcnt(" #n ")" ::: "memory")
#define PG8_WAIT_L(n) asm volatile("s_waitcnt lgkmcnt(" #n ")" ::: "memory")
#define PG8_BAR __builtin_amdgcn_s_barrier()
#define PG8_SCHED __builtin_amdgcn_sched_barrier(0)
    Unit cur, nxt; int ui = 0;
    if (!S.next(0, cur)) return;
    f32x4 acc[2][2][4][2];
#pragma unroll
    for (int a = 0; a < 2; ++a)
#pragma unroll
        for (int b = 0; b < 2; ++b)
#pragma unroll
            for (int m = 0; m < 4; ++m)
#pragma unroll
                for (int n = 0; n < 2; ++n) acc[a][b][m][n] = (f32x4){0.f, 0.f, 0.f, 0.f};
    bf16x8 At[4][2], B0[2][2], B1[2][2];
    const char* cA = (const char*)g.A + (size_t)cur.pm * tstep; const char* cB = (const char*)g.Bt + (size_t)cur.pn * tstep;
    if constexpr (epi_pf<Epi>::v) E.prefetch(cur, 0, wid, lane);
    S.a_ready(cur);
    if constexpr (SP2) {
        PG8_STAGE(PG8_SB(0, 0), cB, voffB); PG8_STAGE(PG8_SB(0, 1), cB + hstep, voffB); PG8_STAGE(PG8_SA(0, 0), cA, voffA); PG8_STAGE(PG8_SA(0, 1), cA + hstep, voffA);
        if (wr == 1) PG8_BAR;
        PG8_WAIT_V(2); PG8_BAR;
        PG8_STAGE(PG8_SB(1, 0), cB + kstep, voffB); PG8_STAGE(PG8_SA(1, 0), cA + kstep, voffA); PG8_STAGE(PG8_SB(1, 1), cB + hstep + kstep, voffB);
        PG8_WAIT_V(6); PG8_BAR;
    } else {
        PG8_STAGE(PG8_SB(0, 0), cB, voffB); PG8_STAGE(PG8_SA(0, 0), cA, voffA); PG8_STAGE(PG8_SB(0, 1), cB + hstep, voffB); PG8_STAGE(PG8_SA(0, 1), cA + hstep, voffA);
        if (wr == 1) PG8_BAR;
        PG8_WAIT_V(4); PG8_BAR;
        PG8_STAGE(PG8_SB(1, 0), cB + kstep, voffB); PG8_STAGE(PG8_SA(1, 0), cA + kstep, voffA); PG8_STAGE(PG8_SB(1, 1), cB + hstep + kstep, voffB);
        PG8_WAIT_V(6); PG8_BAR;
    }
    for (;;) {
        const bool has_next = S.next(ui + 1, nxt);
        const char* nA = has_next ? (const char*)g.A + (size_t)nxt.pm * tstep : cA; const char* nB = has_next ? (const char*)g.Bt + (size_t)nxt.pn * tstep : cB;
        for (int t = 0; t < nt; t += 2) {
            const bool last = (t == nt - 2);
            const char* a1 = cA + (size_t)(t + 1) * kstep;
            const char* a2 = last ? nA : cA + (size_t)(t + 2) * kstep; const char* b2 = last ? nB : cB + (size_t)(t + 2) * kstep;
            const char* a3 = a2 + kstep; const char* b3 = b2 + kstep;
            if (last && has_next) S.a_ready(nxt);
            if constexpr (SP2) {
            PG8_LDB(B0, 0, 0); PG8_LDB(B1, 0, 1); PG8_SCHED; PG8_LDA(At, 0, 0); PG8_STAGE(PG8_SA(1, 1), a1 + hstep, voffA);
            PG8_WAIT_V(8); PG8_WAIT_L(0); PG8_BAR; PG8_MMA(0, 0, At, B0); PG8_MMA(0, 1, At, B1); PG8_BAR; PG8_SCHED;
            PG8_LDA(At, 0, 1); PG8_STAGE(PG8_SB(0, 0), b2, voffB); PG8_STAGE(PG8_SB(0, 1), b2 + hstep, voffB); PG8_STAGE(PG8_SA(0, 0), a2, voffA);
            PG8_WAIT_V(8); PG8_WAIT_L(0); PG8_BAR; PG8_MMA(1, 0, At, B0); PG8_MMA(1, 1, At, B1); PG8_BAR; PG8_SCHED;
            PG8_LDB(B0, 1, 0); PG8_LDB(B1, 1, 1); PG8_SCHED; PG8_LDA(At, 1, 0); PG8_STAGE(PG8_SA(0, 1), a2 + hstep, voffA);
            PG8_WAIT_V(8); PG8_WAIT_L(0); PG8_BAR; PG8_MMA(0, 0, At, B0); PG8_MMA(0, 1, At, B1); PG8_BAR; PG8_SCHED;
            PG8_LDA(At, 1, 1); PG8_STAGE(PG8_SB(1, 0), b3, voffB); PG8_STAGE(PG8_SB(1, 1), b3 + hstep, voffB); PG8_STAGE(PG8_SA(1, 0), a3, voffA);
            PG8_WAIT_V(8); PG8_WAIT_L(0); PG8_BAR; PG8_MMA(1, 0, At, B0); PG8_MMA(1, 1, At, B1); PG8_BAR; PG8_SCHED;
            } else {
            PG8_LDB(B0, 0, 0); PG8_SCHED; PG8_LDA(At, 0, 0); PG8_STAGE(PG8_SA(1, 1), a1 + hstep, voffA);
            PG8_WAIT_L(8); PG8_BAR; PG8_WAIT_L(0); PG8_MMA(0, 0, At, B0); PG8_BAR; PG8_SCHED;
            PG8_LDB(B1, 0, 1); PG8_STAGE(PG8_SB(0, 0), b2, voffB);
            PG8_BAR; PG8_WAIT_L(0); PG8_MMA(0, 1, At, B1); PG8_BAR;
            PG8_LDA(At, 0, 1); PG8_STAGE(PG8_SA(0, 0), a2, voffA);
            PG8_BAR; PG8_WAIT_L(0); PG8_MMA(1, 0, At, B0); PG8_BAR; PG8_SCHED;
            PG8_STAGE(PG8_SB(0, 1), b2 + hstep, voffB);
            PG8_WAIT_V(6); PG8_BAR; PG8_MMA(1, 1, At, B1); PG8_BAR;
            PG8_LDB(B0, 1, 0); PG8_SCHED; PG8_LDA(At, 1, 0); PG8_STAGE(PG8_SA(0, 1), a2 + hstep, voffA);
            PG8_WAIT_L(8); PG8_BAR; PG8_WAIT_L(0); PG8_MMA(0, 0, At, B0); PG8_BAR; PG8_SCHED;
            PG8_LDB(B1, 1, 1); PG8_STAGE(PG8_SB(1, 0), b3, voffB);
            PG8_BAR; PG8_WAIT_L(0); PG8_MMA(0, 1, At, B1); PG8_BAR;
            PG8_LDA(At, 1, 1); PG8_STAGE(PG8_SA(1, 0), a3, voffA);
            PG8_BAR; PG8_WAIT_L(0); PG8_MMA(1, 0, At, B0); PG8_BAR; PG8_SCHED;
            PG8_STAGE(PG8_SB(1, 1), b3 + hstep, voffB);
            PG8_WAIT_V(6); PG8_BAR; PG8_MMA(1, 1, At, B1); PG8_BAR;
            }
        }
        if constexpr (ALIGN_EPI) { if (wr == 0) PG8_BAR; }
        if constexpr (epi_pf<Epi>::v) { if (has_next) E.prefetch(nxt, (ui + 1) & 1, wid, lane); E.run(acc, cur, ui & 1, wr, wc, fr, fq); S.done(cur); } else
        if constexpr (!Epi::AFTER_DRAIN) { E(acc, cur, wr, wc, fr, fq); S.done(cur); }
        if (!has_next) break;
#pragma unroll
        for (int a = 0; a < 2; ++a)
#pragma unroll
            for (int b = 0; b < 2; ++b)
#pragma unroll
                for (int m = 0; m < 4; ++m)
#pragma unroll
                    for (int n = 0; n < 2; ++n) acc[a][b][m][n] = (f32x4){0.f, 0.f, 0.f, 0.f};
        cur = nxt; cA = nA; cB = nB; ++ui;
        if constexpr (ALIGN_EPI) { if (wr == 1) PG8_BAR; }
    }
    PG8_WAIT_V(0);
    if constexpr (!ALIGN_EPI) { if (wr == 0) PG8_BAR; }
    PG8_BAR;
    if constexpr (Epi::AFTER_DRAIN) { E.fused(acc, cur, wr, wc, fr, fq, lds, wid, lane); S.done(cur); }
#undef PG8_SA
#undef PG8_SB
#undef PG8_STAGE
#undef PG8_LDA
#undef PG8_LDB
#undef PG8_MMA
#undef PG8_WAIT_V
#undef PG8_WAIT_L
#undef PG8_BAR
#undef PG8_SCHED
}
}

#ifndef PG8_SP2
#define PG8_SP2 true
#endif
#ifndef PG8_ALIGN
#define PG8_ALIGN true
#endif

namespace att {
constexpr int D = 128;
constexpr float SCALE = 0.08838834764831845f;
constexpr float THR = 8.f;
constexpr bool WSKIP = false;
constexpr int NW = 8, QBLK = 32, KVBLK = 64, QB = NW * QBLK;
constexpr int SHM_V = KVBLK * D * 2, SHM_K = KVBLK * D * 2;
constexpr int LDS_BYTES = 2 * SHM_V + 2 * SHM_K + NW * 64 * 4;
typedef unsigned short bf16;
typedef short bf16x8 __attribute__((ext_vector_type(8)));
typedef short s16x4 __attribute__((ext_vector_type(4)));
typedef float f32x16 __attribute__((ext_vector_type(16)));
typedef float f32x4 __attribute__((ext_vector_type(4)));
typedef unsigned u32x4 __attribute__((ext_vector_type(4)));
template <class A, class Bt> struct same_t { static constexpr bool v = false; };
template <class A> struct same_t<A, A> { static constexpr bool v = true; };

#define KSWZ(row, colB) ((row) * 256 + ((colB) ^ (((row) & 7) << 4)))
#define SBAR() __builtin_amdgcn_sched_barrier(0)
__device__ __forceinline__ int v_st(int k, int c) { const int kk = (k & ~0xC) | ((k & 4) << 1) | ((k & 8) >> 1); return ((kk >> 3) * 4 + (c >> 5)) * 512 + ((kk & 7) * 32 + (c & 31)) * 2; }
__device__ __forceinline__ int v_rd_base(int lane) { return ((lane & 3) << 3) | (((lane >> 2) & 3) << 6) | (((lane >> 4) & 1) << 5) | (((lane >> 5) & 1) << 8); }
constexpr int v_rd_off(int d0, int ks, int half) { return d0 * 512 + ks * 4096 + half * 2048; }
__device__ __forceinline__ int crow(int r, int hi) { return (r & 3) + 8 * (r >> 2) + 4 * hi; }
typedef float f32x2a __attribute__((ext_vector_type(2))); typedef __bf16 bf16x2a __attribute__((ext_vector_type(2)));
__device__ __forceinline__ unsigned cvtpk(float lo, float hi) { const f32x2a v = {lo, hi}; return __builtin_bit_cast(unsigned, __builtin_convertvector(v, bf16x2a)); }
__device__ __forceinline__ bf16x8 pack8(f32x4 a, f32x4 b) {
    u32x4 w = {cvtpk(a[0], a[1]), cvtpk(a[2], a[3]), cvtpk(b[0], b[1]), cvtpk(b[2], b[3])};
    return *reinterpret_cast<bf16x8*>(&w);
}
template <class T> __device__ __forceinline__ bf16x8 load8(const T* p) {
    if constexpr (same_t<T, float>::v) { return pack8(*(const f32x4*)p, *(const f32x4*)(p + 4)); }
    else { return *reinterpret_cast<const bf16x8*>(p); }
}
__device__ __forceinline__ void mask_tile(f32x16& p0, f32x16& p1, int dq, unsigned W) {
    const float NEG = -__builtin_inff();
#pragma unroll
    for (int r = 0; r < 16; ++r) {
        const int c = (r & 3) + 8 * (r >> 2);
        if ((unsigned)(dq - c) >= W) p0[r] = NEG;
        if ((unsigned)(dq - c - 32) >= W) p1[r] = NEG;
    }
}
__device__ __forceinline__ void partialSM(f32x16& p0, f32x16& p1, float& m_reg, float& mn, float& alpha) {
    float pmax = p0[0]; for (int r = 1; r < 16; ++r) pmax = fmaxf(pmax, p0[r]); for (int r = 0; r < 16; ++r) pmax = fmaxf(pmax, p1[r]);
    { auto rr = __builtin_amdgcn_permlane32_swap(__float_as_uint(pmax), __float_as_uint(pmax), false, false);
      pmax = fmaxf(__uint_as_float(rr[0]), __uint_as_float(rr[1])); }
    constexpr float C2 = 1.4426950408889634f * SCALE;
    if (__builtin_expect(__all((pmax - m_reg) * SCALE <= THR), 1)) { mn = m_reg; alpha = 1.f; }
    else { mn = fmaxf(m_reg, pmax); alpha = __builtin_amdgcn_exp2f((m_reg - mn) * C2); m_reg = mn; }
    const float mnL = -mn * C2;
    for (int r = 0; r < 16; ++r) p0[r] = fmaf(p0[r], C2, mnL); for (int r = 0; r < 16; ++r) p1[r] = fmaf(p1[r], C2, mnL);
    for (int r = 0; r < 16; ++r) p0[r] = __builtin_amdgcn_exp2f(p0[r]);
}
__device__ __forceinline__ void finishSM(f32x16& p0, f32x16& p1, float alpha, float& l_reg, bf16x8& pa0, bf16x8& pa1, bf16x8& pa2, bf16x8& pa3) {
    for (int r = 0; r < 16; ++r) p1[r] = __builtin_amdgcn_exp2f(p1[r]);
    float ps = 0; for (int r = 0; r < 16; ++r) ps += p0[r]; for (int r = 0; r < 16; ++r) ps += p1[r];
    { auto rr = __builtin_amdgcn_permlane32_swap(__float_as_uint(ps), __float_as_uint(ps), false, false);
      ps = __uint_as_float(rr[0]) + __uint_as_float(rr[1]); }
    l_reg = l_reg * alpha + ps;
#define PK4(P, B_, OUT) do { unsigned a0 = cvtpk(P[B_+0], P[B_+1]), a1 = cvtpk(P[B_+2], P[B_+3]);                          \
        unsigned b0 = cvtpk(P[B_+4], P[B_+5]), b1 = cvtpk(P[B_+6], P[B_+7]);                                             \
        auto r0 = __builtin_amdgcn_permlane32_swap(a0, b0, false, false); auto r1 = __builtin_amdgcn_permlane32_swap(a1, b1, false, false); \
        u32x4 w = {r0[0], r1[0], r0[1], r1[1]}; OUT = *reinterpret_cast<bf16x8*>(&w); } while (0)
    PK4(p0, 0, pa0); PK4(p0, 8, pa1); PK4(p1, 0, pa2); PK4(p1, 8, pa3);
#undef PK4
}
template <int KB, bool SK>
__device__ __forceinline__ void qkt(f32x16& p0, f32x16& p1, const char* K_lds, int r32, int hi, const bf16x8* qr, bool act) {
    if (SK && !act) { const float NEG = -__builtin_inff();
#pragma unroll
        for (int r = 0; r < 16; ++r) { p0[r] = NEG; p1[r] = NEG; } return; }
    p0 = f32x16{}; p1 = f32x16{};
    const char* kb[4];
#pragma unroll
    for (int dd = 0; dd < 4; ++dd) kb[dd] = K_lds + KB * SHM_K + KSWZ(r32, (dd * 16 + hi * 8) * 2);
#pragma unroll
    for (int d0 = 0; d0 < 8; ++d0) { const char* a = kb[d0 & 3] + (d0 >> 2) * 128;
        bf16x8 b0 = *reinterpret_cast<const bf16x8*>(a);
        bf16x8 b1 = *reinterpret_cast<const bf16x8*>(a + 32 * 256);
        p0 = __builtin_amdgcn_mfma_f32_32x32x16_bf16(b0, qr[d0], p0, 0, 0, 0);
        p1 = __builtin_amdgcn_mfma_f32_32x32x16_bf16(b1, qr[d0], p1, 0, 0, 0); }
}
template <int VB, bool SK>
__device__ __forceinline__ void pv_tile(f32x16* o, int vb0, bf16x8 pa0, bf16x8 pa1, bf16x8 pa2, bf16x8 pa3, bool act) {
    if (SK && !act) return;
#define TRRD(dst, off) asm volatile("ds_read_b64_tr_b16 %0, %1 offset:%2" : "=&v"(dst) : "v"(vb0), "i"(off) : "memory")
#define PV_D0(d0) do { s16x4 l0, l1, l2, l3, h0, h1, h2, h3; constexpr int b_ = VB * SHM_V + v_rd_off(d0, 0, 0);     \
        TRRD(l0, b_); TRRD(h0, b_ + 2048); TRRD(l1, b_ + 4096); TRRD(h1, b_ + 6144); TRRD(l2, b_ + 8192); TRRD(h2, b_ + 10240); TRRD(l3, b_ + 12288); TRRD(h3, b_ + 14336); \
        asm volatile("s_waitcnt lgkmcnt(0)" ::: "memory"); SBAR();                 \
        o[d0] = __builtin_amdgcn_mfma_f32_32x32x16_bf16(pa0, (bf16x8){l0[0], l0[1], l0[2], l0[3], h0[0], h0[1], h0[2], h0[3]}, o[d0], 0, 0, 0);   \
        o[d0] = __builtin_amdgcn_mfma_f32_32x32x16_bf16(pa1, (bf16x8){l1[0], l1[1], l1[2], l1[3], h1[0], h1[1], h1[2], h1[3]}, o[d0], 0, 0, 0);   \
        o[d0] = __builtin_amdgcn_mfma_f32_32x32x16_bf16(pa2, (bf16x8){l2[0], l2[1], l2[2], l2[3], h2[0], h2[1], h2[2], h2[3]}, o[d0], 0, 0, 0);   \
        o[d0] = __builtin_amdgcn_mfma_f32_32x32x16_bf16(pa3, (bf16x8){l3[0], l3[1], l3[2], l3[3], h3[0], h3[1], h3[2], h3[3]}, o[d0], 0, 0, 0); } while (0)
    PV_D0(0); PV_D0(1); PV_D0(2); PV_D0(3);
#undef PV_D0
#undef TRRD
}

template <class TIn, class TOut> struct BlockRef { const TIn* Q; const TIn* K; const TIn* V; TOut* O; int P0; };
template <class TIn> struct Seam {
    bf16x8 qr[8];
    bf16x8 st_v0, st_v1, st_k0, st_k1; f32x4 sf0, sf1, sf2, sf3;
    f32x4 tq[16];
};
__device__ __forceinline__ int swa_jlo(int P0, int W) { const int lowk = P0 - W + 1; return lowk > 0 ? lowk / KVBLK : 0; }
#define ROW(p, k0, rr) ((p) + (size_t)((k0) + (rr)) * D + sc)
#define VMW() asm volatile("s_waitcnt vmcnt(0)" ::: "memory")
#define VMWN(n) asm volatile("s_waitcnt vmcnt(%0)" :: "i"(n) : "memory")
#define SLOAD_H(Kp, Vp, k0) do { S.st_v0 = load8<TIn>(ROW(Vp, k0, sr)); S.st_v1 = load8<TIn>(ROW(Vp, k0, 32 + sr));              \
                         S.st_k0 = load8<TIn>(ROW(Kp, k0, sr)); S.st_k1 = load8<TIn>(ROW(Kp, k0, 32 + sr)); } while (0)
#define SWRITE_HK(bf) do { *(bf16x8*)(K_lds + (bf) * SHM_K + kws) = S.st_k0; *(bf16x8*)(K_lds + (bf) * SHM_K + kws + 32 * 256) = S.st_k1; } while (0)
#define SWRITE_HV(bf) do { *(bf16x8*)(V_lds + (bf) * SHM_V + vst0) = S.st_v0; *(bf16x8*)(V_lds + (bf) * SHM_V + vst1) = S.st_v1; } while (0)
#define SWRITE_H(bf) do { SWRITE_HV(bf); SWRITE_HK(bf); } while (0)
#define SLOAD_F(p, k0) do { S.sf0 = *(const f32x4*)ROW(p, k0, sr); S.sf1 = *(const f32x4*)(ROW(p, k0, sr) + 4);                \
                            S.sf2 = *(const f32x4*)ROW(p, k0, 32 + sr); S.sf3 = *(const f32x4*)(ROW(p, k0, 32 + sr) + 4); } while (0)
#define SWRITE_KF(bf) do { *(bf16x8*)(K_lds + (bf) * SHM_K + kws) = pack8(S.sf0, S.sf1); *(bf16x8*)(K_lds + (bf) * SHM_K + kws + 32 * 256) = pack8(S.sf2, S.sf3); } while (0)
#define SWRITE_VF(bf) do { *(bf16x8*)(V_lds + (bf) * SHM_V + vst0) = pack8(S.sf0, S.sf1); *(bf16x8*)(V_lds + (bf) * SHM_V + vst1) = pack8(S.sf2, S.sf3); } while (0)
template <class TIn, class TOut>
__device__ __forceinline__ void causal_swa_prime(const BlockRef<TIn, TOut>& cur, int W, char* lds, Seam<TIn>& S) {
    constexpr bool F32 = same_t<TIn, float>::v;
    int tid_l_ = threadIdx.x; asm volatile("" : "+v"(tid_l_)); const int tid = tid_l_, wid = __builtin_amdgcn_readfirstlane(tid >> 6), lane = tid & 63, r32 = lane & 31, hi = lane >> 5;
    const int sr = tid >> 4, sc = (tid & 15) * 8, kws = KSWZ(sr, sc * 2); char* K_lds = lds + 2 * SHM_V;
    const int kb0 = swa_jlo(cur.P0, W) * KVBLK;
    for (int d0 = 0; d0 < 8; ++d0) S.qr[d0] = load8<TIn>(cur.Q + (size_t)(wid * QBLK + r32) * D + d0 * 16 + hi * 8);
    if constexpr (F32) { SLOAD_F((const float*)cur.K, kb0); VMW(); SWRITE_KF(0); SBAR(); SLOAD_F((const float*)cur.V, kb0); }
    else { SLOAD_H(cur.K, cur.V, kb0); VMW(); SWRITE_HK(0); }
    __syncthreads();
}
template <class TIn, class TOut>
__device__ __forceinline__ void causal_swa_block(const BlockRef<TIn, TOut>& cur, const BlockRef<TIn, TOut>& nxt, int skv, int W, char* lds, Seam<TIn>& S) {
    constexpr bool F32 = same_t<TIn, float>::v;
    int tid_l_ = threadIdx.x; asm volatile("" : "+v"(tid_l_)); const int tid = tid_l_, wid = __builtin_amdgcn_readfirstlane(tid >> 6), lane = tid & 63, r32 = lane & 31, hi = lane >> 5;
    const int j_lo = swa_jlo(cur.P0, W);
    int j_hi = (cur.P0 + QB - 1) / KVBLK + 1; if (j_hi > skv / KVBLK) j_hi = skv / KVBLK;
    const int NT = j_hi - j_lo;
    const int kbn = swa_jlo(nxt.P0, W) * KVBLK;
    const int qlo = cur.P0 + wid * QBLK, qm = qlo + r32 - 4 * hi;
    char* V_lds = lds; char* K_lds = lds + 2 * SHM_V;
    float* ws = (float*)(lds + 2 * SHM_V + 2 * SHM_K) + wid * 64; float* li_l = ws, * al_l = ws + 32;
    float m_reg = -1e30f, l_reg = 0; f32x16 o[4] = {};
    const int sr = tid >> 4, sc = (tid & 15) * 8, vst0 = v_st(sr, sc), vst1 = v_st(32 + sr, sc), kws = KSWZ(sr, sc * 2);
    const int vb0 = (int)(uintptr_t)V_lds + v_rd_base(lane);
    const TIn* Kh = cur.K; const TIn* Vh = cur.V;
#define RESC(a) do { if (__any((a) < 1.f)) { if (hi == 0) al_l[r32] = (a); asm volatile("s_waitcnt lgkmcnt(0)" ::: "memory");              \
                     for (int d_ = 0; d_ < 4; ++d_) for (int r = 0; r < 16; ++r) o[d_][r] *= al_l[crow(r, hi)]; } } while (0)
#define KBASE(t) ((j_lo + (t)) * KVBLK)
#define ACT(t) (KBASE(t) <= qlo + QBLK - 1 && KBASE(t) + KVBLK - 1 >= qlo - W + 1)
#define MASKT(P0_, P1_, t) do { const int kb_ = KBASE(t); if ((!SK || ACT(t)) && (kb_ + KVBLK - 1 > qlo || kb_ <= qlo + QBLK - 1 - W)) mask_tile(P0_, P1_, qm - kb_, (unsigned)W); } while (0)
    constexpr int NQL = F32 ? 16 : 8;
    constexpr bool SK = WSKIP && !F32;
#define SEAM_K0() do { VMWN(NQL); if constexpr (F32) { SWRITE_KF(0); SBAR(); SLOAD_F((const float*)nxt.V, kbn); } else { SWRITE_HK(0); } SBAR(); } while (0)
    f32x16 pA0, pA1, pB0, pB1; float mnA, mnB, alA, alB; bf16x8 pa0, pa1, pa2, pa3;
    if constexpr (F32) { VMW(); SWRITE_VF(0); SBAR(); } else { SWRITE_HV(0); SBAR(); }
    if (NT > 1) { if constexpr (F32) SLOAD_F((const float*)Kh, KBASE(1)); else SLOAD_H(Kh, Vh, KBASE(1)); }
    SBAR(); qkt<0, SK>(pA0, pA1, K_lds, r32, hi, S.qr, ACT(0));
    if constexpr (F32) { if (NT > 1) { VMW(); SWRITE_KF(1); SBAR(); SLOAD_F((const float*)Vh, KBASE(1)); } }
    MASKT(pA0, pA1, 0); partialSM(pA0, pA1, m_reg, mnA, alA);
    if (NT > 1) { VMW(); if constexpr (F32) { SWRITE_VF(1); SBAR(); if (NT > 2) SLOAD_F((const float*)Kh, KBASE(2)); } else SWRITE_H(1); }
    __syncthreads();
#define HALF_STEP(PX0, PX1, mnX, alX, PY0, PY1, alY, t, KB, VB, SB) do {                                                      \
        SBAR(); qkt<KB, SK>(PX0, PX1, K_lds, r32, hi, S.qr, ACT(t));                                             \
        finishSM(PY0, PY1, alY, l_reg, pa0, pa1, pa2, pa3); SBAR();                                                           \
        if ((t) + 1 < NT) { if constexpr (F32) { VMW(); SWRITE_KF(SB); SBAR(); SLOAD_F((const float*)Vh, KBASE((t) + 1)); }  \
                            else { SLOAD_H(Kh, Vh, KBASE((t) + 1)); } SBAR(); }                                               \
        pv_tile<VB, SK>(o, vb0, pa0, pa1, pa2, pa3, ACT((t) - 1)); MASKT(PX0, PX1, (t)); partialSM(PX0, PX1, m_reg, mnX, alX);                                        \
        __syncthreads();                                                                                                      \
        if ((t) + 1 < NT) { VMW(); if constexpr (F32) { SWRITE_VF(SB); SBAR(); if ((t) + 2 < NT) SLOAD_F((const float*)Kh, KBASE((t) + 2)); } \
                            else { SWRITE_H(SB); } }                                                                          \
        RESC(alX); __syncthreads(); } while (0)
    for (int t = 1; t + 1 < NT; t += 2) {
        HALF_STEP(pB0, pB1, mnB, alB, pA0, pA1, alA, t, 1, 0, 0);
        HALF_STEP(pA0, pA1, mnA, alA, pB0, pB1, alB, t + 1, 0, 1, 1);
    }
    const bool even = (NT & 1) == 0;
    if (even) { SBAR(); qkt<1, SK>(pB0, pB1, K_lds, r32, hi, S.qr, ACT(NT - 1)); SBAR(); }
#define QROW(e) (nxt.Q + (size_t)(wid * QBLK + r32) * D + ((e) >> 1) * 16 + hi * 8 + ((e) & 1) * 4)
    if constexpr (F32) { SLOAD_F((const float*)nxt.K, kbn); SBAR();
#pragma unroll
        for (int e = 0; e < 8; ++e) S.tq[e] = *(const f32x4*)QROW(e); }
    else { SLOAD_H(nxt.K, nxt.V, kbn); SBAR();
#pragma unroll
        for (int d0 = 0; d0 < 8; ++d0) S.qr[d0] = load8<TIn>(nxt.Q + (size_t)(wid * QBLK + r32) * D + d0 * 16 + hi * 8); }
    SBAR();
    finishSM(pA0, pA1, alA, l_reg, pa0, pa1, pa2, pa3); SBAR();
    if constexpr (F32) {
#pragma unroll
        for (int e = 8; e < 16; ++e) S.tq[e] = *(const f32x4*)QROW(e); SBAR(); }
#undef QROW
    pv_tile<0, SK>(o, vb0, pa0, pa1, pa2, pa3, ACT(even ? NT - 2 : NT - 1));
    if (even) { MASKT(pB0, pB1, NT - 1); partialSM(pB0, pB1, m_reg, mnB, alB); __syncthreads(); RESC(alB);
        finishSM(pB0, pB1, alB, l_reg, pa0, pa1, pa2, pa3); SBAR(); pv_tile<1, SK>(o, vb0, pa0, pa1, pa2, pa3, ACT(NT - 1)); }
    SBAR(); SEAM_K0();
    if (hi == 0) li_l[r32] = l_reg; asm volatile("s_waitcnt lgkmcnt(0)" ::: "memory");
    float rli[16];
#pragma unroll
    for (int r = 0; r < 16; ++r) rli[r] = __builtin_amdgcn_rcpf(li_l[crow(r, hi)]);
    TOut* Ow = cur.O + (size_t)(wid * QBLK) * D;
#pragma unroll
    for (int r = 0; r < 16; ++r) { const int orow = crow(r, hi);
#pragma unroll
        for (int d0 = 0; d0 < 4; ++d0) { const float v = o[d0][r] * rli[r];
            if constexpr (same_t<TOut, float>::v) { Ow[(size_t)orow * D + d0 * 32 + r32] = v; }
            else { const float vn = __shfl_xor(v, 1);
                   if ((r32 & 1) == 0) *(unsigned*)(Ow + (size_t)orow * D + d0 * 32 + r32) = cvtpk(v, vn); } } }
    if constexpr (F32) {
#pragma unroll
        for (int d0 = 0; d0 < 8; ++d0) S.qr[d0] = pack8(S.tq[2 * d0], S.tq[2 * d0 + 1]); }
    __syncthreads();
#undef RESC
#undef KBASE
#undef ACT
#undef MASKT
#undef SEAM_K0
#undef HALF_STEP
}
#undef ROW
#undef VMW
#undef VMWN
#undef SLOAD_H
#undef SWRITE_HK
#undef SWRITE_HV
#undef SWRITE_H
#undef SLOAD_F
#undef SWRITE_KF
#undef SWRITE_VF
}

namespace mk {
constexpr int NWAVES = 8, NTHR = 512;
constexpr int BATCH = 2, SEQ = 4096, M = BATCH * SEQ, DM = 4096;
constexpr int DI = 8192, NHEAD = 128, HDIM = 64, NGRP = 8, NST = 128, CONVD = 10240, NCHUNK = 32;
constexpr int NZX = 18560, NZXP = 18688, ZX_XBC = 8192, ZX_DT = 18432, NZXM = 18432;
constexpr int DFF = 11008, NUP = 22016;
constexpr int NQKV = 12288, AH = 16;
constexpr float EPS = 1e-5f;

constexpr size_t MiB = 1u << 20;
constexpr size_t WS_CTL = 0, CTL_ZERO_BYTES = 1 * MiB;
constexpr size_t WS_ROPE = 2 * MiB;
constexpr size_t WS_W = 8 * MiB;
constexpr size_t WL_MAMBA = 468 * MiB, WL_ATTN = 386 * MiB;
constexpr size_t W_IN = 0, W_OUT = 146 * MiB, W_UP_M = 210 * MiB, W_DOWN_M = 382 * MiB;
constexpr size_t W_QKV = 0, W_O = 96 * MiB, W_UP_A = 128 * MiB, W_DOWN_A = 300 * MiB;
constexpr size_t WS_XR = 1716 * MiB;
constexpr size_t WS_U = 1844 * MiB;
constexpr size_t WS_BIG = 1908 * MiB;
constexpr size_t WS_ACT2 = 2252 * MiB;
constexpr size_t WS_XT = 2424 * MiB;
constexpr size_t WS_Y = 2552 * MiB;
constexpr size_t WS_BN = 2680 * MiB, WS_BT = 2696 * MiB, WS_CN = 2712 * MiB, WS_DTF = 2728 * MiB;
constexpr size_t WS_PART = 2732 * MiB;
constexpr size_t WS_END = 2764 * MiB;
constexpr int CW_TMO = 0, CW_CODE = 1, CW_BAR = 4096;
constexpr int CW_SS = 65536;
static_assert((CW_SS + 9 * M * 2) * 4 <= (int)CTL_ZERO_BYTES, "norm statistics inside the memset region");

constexpr int RING_OFF = 0, RING_BYTES = 131072 + 16384;
constexpr int TAB_OFF = 131072, TAB_TILES = 16;
constexpr int LDSCTL_OFF = RING_BYTES, MISC_OFF = LDSCTL_OFF + 320;
constexpr int SIDE_OFF = RING_BYTES + 1024, LDS_BYTES = SIDE_OFF + 12288;
static_assert(MISC_OFF + 128 <= LDS_BYTES, "LDS map");

#define GAS __attribute__((address_space(1)))
#define LAS __attribute__((address_space(3)))
typedef unsigned short bf16;
typedef unsigned v4u __attribute__((ext_vector_type(4)));
typedef unsigned v2u __attribute__((ext_vector_type(2)));
typedef float f32x4 __attribute__((ext_vector_type(4)));
typedef float f32x2 __attribute__((ext_vector_type(2)));
typedef float f32x16 __attribute__((ext_vector_type(16)));
typedef short bf16x8 __attribute__((ext_vector_type(8)));
typedef GAS unsigned gu32;
#define RLX_AGENT __ATOMIC_RELAXED, __HIP_MEMORY_SCOPE_AGENT
#define LDS_WAIT() asm volatile("s_waitcnt lgkmcnt(0)" ::: "memory")
#define VM_WAIT() asm volatile("s_waitcnt vmcnt(0)" ::: "memory")
__device__ __forceinline__ unsigned f2bf(float f) { unsigned u = __builtin_bit_cast(unsigned, f); return (u + 0x7fffu + ((u >> 16) & 1u)) >> 16; }
typedef __bf16 bf16x2_t __attribute__((ext_vector_type(2)));
__device__ __forceinline__ unsigned pk2(float lo, float hi) { const f32x2 v = {lo, hi}; return __builtin_bit_cast(unsigned, __builtin_convertvector(v, bf16x2_t)); }
__device__ __forceinline__ float bf_lo(unsigned w) { return __builtin_bit_cast(float, w << 16); }
__device__ __forceinline__ float bf_hi(unsigned w) { return __builtin_bit_cast(float, w & 0xffff0000u); }
__device__ __forceinline__ float bf1(bf16 h) { return __builtin_bit_cast(float, (unsigned)h << 16); }
__device__ __forceinline__ float silu_f(float a) { return a * __builtin_amdgcn_rcpf(1.f + __expf(-a)); }

#define XB_TMO      128
#define XB_XCNT(j)  (256  + 64 * (j))
#define XB_XSUB(j)  (1280 + 64 * (j))
#define XB_XGEN(j)  (2304 + 64 * (j))
#define XB_TOP      3328
#define XB_TOPGEN   3392
#define XCD_BAR_WORDS 3456
#define XB_SPIN_CAP (1u << 18)
__device__ __forceinline__ unsigned xb_ld(unsigned* p)              { return __hip_atomic_load(p, __ATOMIC_RELAXED, __HIP_MEMORY_SCOPE_AGENT); }
__device__ __forceinline__ unsigned xb_add(unsigned* p, unsigned v) { return __hip_atomic_fetch_add(p, v, __ATOMIC_RELAXED, __HIP_MEMORY_SCOPE_AGENT); }
__device__ __forceinline__ unsigned xb_xcc_id() { return (unsigned)__builtin_amdgcn_s_getreg((3 << 11) | 20) & 0xFu; }
#define XB_SPIN(cond, bar) do { unsigned _sp = 0; while (cond) { __builtin_amdgcn_s_sleep(1); \
    if ((++_sp & 255u) == 0u) { if (xb_ld(&(bar)[XB_TMO])) break; if (_sp > XB_SPIN_CAP) { atomicAdd(&(bar)[XB_TMO], 1u); break; } } } } while (0)
struct XcdBarrier { unsigned* bar; unsigned x; volatile LAS unsigned* st; };
__device__ __forceinline__ XcdBarrier xcd_barrier_post(unsigned* bar, volatile LAS unsigned* st) {
    XcdBarrier b; b.bar = bar; b.x = xb_xcc_id(); b.st = st;
    if (threadIdx.x == 0) (void)xb_add(&bar[XB_XCNT(b.x)], 1u);
    return b;
}
__device__ __forceinline__ void xcd_barrier_complete(unsigned* bar, unsigned x, unsigned& nloc, unsigned& nx) {
    const unsigned G = gridDim.x * gridDim.y * gridDim.z;
    unsigned sum, cnt, mine, sp = 0u;
    for (;;) {
        sum = 0u; cnt = 0u; mine = 0u;
#pragma unroll
        for (unsigned j = 0; j < 16; ++j) { const unsigned c = xb_ld(&bar[XB_XCNT(j)]); sum += c; cnt += (c > 0u) ? 1u : 0u; mine = (j == x) ? c : mine; }
        if (sum == G) break;
        __builtin_amdgcn_s_sleep(1);
        if ((++sp & 255u) == 0u) { if (xb_ld(&bar[XB_TMO])) break; if (sp > XB_SPIN_CAP) { atomicAdd(&bar[XB_TMO], 1u); break; } }
    }
    nloc = mine > 0u ? mine : 1u; nx = cnt > 0u ? cnt : 1u;
}
__device__ __forceinline__ void xcd_barrier(const XcdBarrier& b) {
    asm volatile("s_waitcnt vmcnt(0)" ::: "memory");
    __syncthreads();
    if (threadIdx.x == 0) {
        unsigned long long bar_l_ = (unsigned long long)b.bar; asm volatile("" : "+s"(bar_l_));
        unsigned* bar = (unsigned*)bar_l_;
        __builtin_amdgcn_s_waitcnt(0);
        unsigned bx_l_ = b.x; asm volatile("" : "+s"(bx_l_));
        unsigned nloc = b.st[0], nx = b.st[1];
        if (nloc == 0u) { xcd_barrier_complete(bar, bx_l_, nloc, nx); b.st[0] = nloc; b.st[1] = nx; }
        const unsigned old = xb_add(&bar[XB_XSUB(bx_l_)], 1u);
        const unsigned gen = old / nloc;
        if (old + 1u == (gen + 1u) * nloc) {
            __builtin_amdgcn_fence(__ATOMIC_RELEASE, "agent");
            asm volatile("s_waitcnt vmcnt(0)" ::: "memory");
            const unsigned og = xb_add(&bar[XB_TOP], 1u);
            const unsigned tg = og / nx;
            if (og + 1u == (tg + 1u) * nx) xb_add(&bar[XB_TOPGEN], 1u);
            else XB_SPIN(xb_ld(&bar[XB_TOPGEN]) == tg, bar);
            __builtin_amdgcn_fence(__ATOMIC_ACQUIRE, "agent");
            xb_add(&bar[XB_XGEN(bx_l_)], 1u);
            asm volatile("s_waitcnt vmcnt(0)" ::: "memory");
        } else {
            XB_SPIN(xb_ld(&bar[XB_XGEN(bx_l_)]) == gen, bar);
            __builtin_amdgcn_fence(__ATOMIC_ACQUIRE, "agent");
            asm volatile("s_waitcnt vmcnt(0)" ::: "memory");
        }
    }
    __syncthreads();
}

struct Frame {
    LAS unsigned char* lds;
    unsigned char* ws;
    int tid, lane, wave;
    int vcu, G, bx;
};

__device__ __forceinline__ void relaunder(Frame& F, unsigned char* ws0) { int t = threadIdx.x; asm volatile("" : "+v"(t)); F.tid = t; F.lane = t & 63; F.wave = __builtin_amdgcn_readfirstlane(t >> 6);
    unsigned long long w = (unsigned long long)ws0; asm volatile("" : "+s"(w)); F.ws = (unsigned char*)w;
    int g = gridDim.x; asm volatile("" : "+s"(g)); F.G = g; int bx = blockIdx.x; asm volatile("" : "+s"(bx)); F.bx = bx; F.vcu = (g % 8 == 0) ? (bx % 8) * (g / 8) + bx / 8 : bx; }
__device__ __forceinline__ float wave_sum(float v) {
    int l = threadIdx.x; asm volatile("" : "+v"(l)); l &= 63;
#pragma unroll
    for (int o = 1; o < 64; o <<= 1) v += __builtin_bit_cast(float, __builtin_amdgcn_ds_bpermute((l ^ o) << 2, __builtin_bit_cast(int, v)));
    return v;
}

constexpr int TAIL_TILES = 64 * 12;
__device__ __forceinline__ void p0_matrix(Frame& F, const float* W, int K, int N, int NP, bf16* WT, int& prefix, int perm_limit = 0, const float* gain = nullptr, int gv_tiles = 0, int ov_t0 = -1, int ov_stride = 0, int t_lo = 0, int t_hi = -1) {
    const int nnt = NP / 256, nkt = K / 128, ntiles = nkt * nnt, G = F.G, w = F.wave, lane = F.lane;
    const int stride = ov_t0 >= 0 ? ov_stride : G; int t;
    const int nhi = t_hi >= 0 ? t_hi : ntiles;
    if (ov_t0 >= 0) t = t_lo + ov_t0; else { t = (F.vcu - prefix) % G; if (t < 0) t += G; t += t_lo; prefix = (prefix + (nhi - t_lo)) % G; }
    LAS unsigned char* L = F.lds;
    f32x4 v[16];
#define P0_TILE(tt, kt_, nt_) const int blk_ = (tt) / (16 * nnt), rem_ = (tt) - blk_ * 16 * nnt, bh_ = (nkt - 16 * blk_) < 16 ? (nkt - 16 * blk_) : 16, nt_ = rem_ / bh_, kt_ = 16 * blk_ + (rem_ - nt_ * bh_)
#define P0_LOAD(tt) do { P0_TILE(tt, kt_, nt_); const int n_ = nt_ * 256 + 4 * lane; \
        const GAS float* s_ = (const GAS float*)W + (size_t)(kt_ * 128 + 16 * w) * N + n_; \
        if (n_ < N) { _Pragma("unroll") for (int jj = 0; jj < 16; ++jj) v[jj] = *(const GAS f32x4*)(s_ + (size_t)jj * N); \
            if (gain) { _Pragma("unroll") for (int jj = 0; jj < 16; ++jj) v[jj] = v[jj] * gain[kt_ * 128 + 16 * w + jj]; } } \
        else { _Pragma("unroll") for (int jj = 0; jj < 16; ++jj) v[jj] = (f32x4){0.f, 0.f, 0.f, 0.f}; } } while (0)
    if (t < nhi) P0_LOAD(t);
    while (t < nhi) {
#pragma unroll
        for (int i = 0; i < 4; ++i)
#pragma unroll
            for (int h = 0; h < 2; ++h) {
                v4u o; o.x = pk2(v[8 * h + 0][i], v[8 * h + 1][i]); o.y = pk2(v[8 * h + 2][i], v[8 * h + 3][i]); o.z = pk2(v[8 * h + 4][i], v[8 * h + 5][i]); o.w = pk2(v[8 * h + 6][i], v[8 * h + 7][i]);
                *(LAS v4u*)(L + (4 * lane + i) * 256 + (((2 * w + h) ^ (lane & 15)) << 4)) = o;
            }
        P0_TILE(t, kt, nt); const int tn = t + stride;
        if (tn < nhi) P0_LOAD(tn);
        __syncthreads();
        const int nb = gv_tiles ? ((nt < gv_tiles ? 2 * nt : 2 * (nt - gv_tiles)) * 256 + (nt < gv_tiles ? 0 : 128)) : nt * 256;
        GAS bf16* dst = (GAS bf16*)WT + kt * 128 + 8 * (lane & 15);
        const bool perm = nt * 256 < perm_limit;
#pragma unroll
        for (int jj = 0; jj < 8; ++jj) { const int r = w * 32 + jj * 4 + (lane >> 4);
            const v4u o = *(LAS const v4u*)(L + r * 256 + (((lane & 15) ^ ((r >> 2) & 15)) << 4));
            const int d = r & 127, ro = perm ? ((r & 128) | (d < 64 ? 2 * d : 2 * (d - 64) + 1)) : r;
            const int rr = gv_tiles ? ((ro >> 7) * 256 + (ro & 127)) : ro;
            *(GAS v4u*)(dst + (size_t)(nb + rr) * K) = o; }
        __syncthreads();
        t = tn;
    }
#undef P0_LOAD
#undef P0_TILE
}

__device__ __forceinline__ void rms_row_bf16(const float* xrow, const float* w, bf16* orow, int lane) {
    const GAS f32x4* xr = (const GAS f32x4*)xrow + lane; const GAS f32x4* wr = (const GAS f32x4*)w + lane;
    f32x4 v[16]; float s = 0.f;
#pragma unroll
    for (int j = 0; j < 16; ++j) { v[j] = xr[64 * j]; s += (v[j].x * v[j].x + v[j].y * v[j].y) + (v[j].z * v[j].z + v[j].w * v[j].w); }
    const float rstd = 1.0f / sqrtf(wave_sum(s) * (1.f / DM) + EPS);
    GAS v2u* o8 = (GAS v2u*)orow + lane;
#pragma unroll
    for (int j = 0; j < 16; ++j) { const f32x4 g = wr[64 * j]; v2u o; o.x = pk2(v[j].x * rstd * g.x, v[j].y * rstd * g.y); o.y = pk2(v[j].z * rstd * g.z, v[j].w * rstd * g.w); o8[64 * j] = o; }
}
__device__ __forceinline__ void rms_row_f32(const float* xrow, const float* w, float* orow, int lane) {
    const GAS f32x4* xr = (const GAS f32x4*)xrow + lane; const GAS f32x4* wr = (const GAS f32x4*)w + lane;
    f32x4 v[16]; float s = 0.f;
#pragma unroll
    for (int j = 0; j < 16; ++j) { v[j] = xr[64 * j]; s += (v[j].x * v[j].x + v[j].y * v[j].y) + (v[j].z * v[j].z + v[j].w * v[j].w); }
    const float rstd = 1.0f / sqrtf(wave_sum(s) * (1.f / DM) + EPS);
    GAS f32x4* o = (GAS f32x4*)orow + lane;
#pragma unroll
    for (int j = 0; j < 16; ++j) { const f32x4 g = wr[64 * j]; o[64 * j] = v[j] * rstd * g; }
}
__device__ __forceinline__ void x_row_prep(const float* xrow, bf16* orow, unsigned long long* ssq, int lane) {
    const GAS f32x4* xr = (const GAS f32x4*)xrow + lane;
    f32x4 v[16]; float s = 0.f;
#pragma unroll
    for (int j = 0; j < 16; ++j) { v[j] = xr[64 * j]; s += (v[j].x * v[j].x + v[j].y * v[j].y) + (v[j].z * v[j].z + v[j].w * v[j].w); }
    s = wave_sum(s);
    GAS v2u* o8 = (GAS v2u*)orow + lane;
#pragma unroll
    for (int j = 0; j < 16; ++j) { v2u o; o.x = pk2(v[j].x, v[j].y); o.y = pk2(v[j].z, v[j].w); o8[64 * j] = o; }
    if (lane == 0) *ssq = (unsigned long long)__float2ll_rn(s * 16777216.0f);
}
__device__ __forceinline__ void rmsnorm_phase(Frame& F, const float* x, const float* w, bf16* U) {
    const int gw = F.vcu * NWAVES + F.wave, NGW = F.G * NWAVES;
    for (int m = gw; m < M; m += NGW) rms_row_bf16(x + (size_t)m * DM, w, U + (size_t)m * DM, F.lane);
}

template <class Sched>
__device__ __forceinline__ void rstd_table(Frame& F, const Sched& S, const unsigned long long* ss, int& pm0, int& ntab) {
    int lo = 1 << 30, hi = -1; pg8::Unit u;
    for (int i = 0; S.next(i, u); ++i) { lo = u.pm < lo ? u.pm : lo; hi = u.pm > hi ? u.pm : hi; }
    if (hi < 0) { pm0 = 0; ntab = 0; return; }
    pm0 = lo; ntab = (hi - lo + 1) < TAB_TILES ? (hi - lo + 1) : TAB_TILES;
    LAS float* tab = (LAS float*)(F.lds + TAB_OFF);
    for (int r = F.tid; r < ntab * 256; r += NTHR) tab[r] = 1.0f / sqrtf((float)ss[pm0 * 256 + r] * (1.0f / (4096.0f * 16777216.0f)) + 1e-5f);
    __syncthreads();
}

__device__ __forceinline__ void llc_touch(Frame& F, const void* p, size_t bytes) {
    const GAS v4u* q = (const GAS v4u*)p; const size_t n16 = bytes / 16, st = (size_t)F.G * NTHR; unsigned acc = 0u;
    for (size_t i = (size_t)F.vcu * NTHR + F.tid; i + 3 * st < n16; i += 4 * st) { const v4u a = q[i], b = q[i + st], c = q[i + 2 * st], d = q[i + 3 * st]; acc += (a.x ^ b.y) + (c.z ^ d.w); }
    if (acc == 0x12345677u) ((unsigned*)(F.ws + WS_CTL))[300] = acc;
}
__device__ __forceinline__ void unpack8(const v4u w, float (&o)[8]) { o[0] = bf_lo(w.x); o[1] = bf_hi(w.x); o[2] = bf_lo(w.y); o[3] = bf_hi(w.y); o[4] = bf_lo(w.z); o[5] = bf_hi(w.z); o[6] = bf_lo(w.w); o[7] = bf_hi(w.w); }
__device__ __forceinline__ void ffn_gate_phase(Frame& F, const bf16* H, const float* cw, const float* cb, bf16* GA) {
    constexpr int R = 32, NCHK = DFF / 8, NRB = M / R;
    const int total = NCHK * NRB;
    for (int it = F.vcu * NTHR + F.tid; it < total; it += F.G * NTHR) {
        const int ch = it % NCHK, rb = it / NCHK, c0 = ch * 8, t0 = rb * R;
        float wg[3][8], wv[3][8], bg[8], bv[8];
#pragma unroll
        for (int k = 0; k < 3; ++k) {
            const f32x4 a0 = *(const GAS f32x4*)(cw + (size_t)k * NUP + c0), a1 = *(const GAS f32x4*)(cw + (size_t)k * NUP + c0 + 4);
            const f32x4 b0 = *(const GAS f32x4*)(cw + (size_t)k * NUP + DFF + c0), b1 = *(const GAS f32x4*)(cw + (size_t)k * NUP + DFF + c0 + 4);
#pragma unroll
            for (int j = 0; j < 4; ++j) { wg[k][j] = a0[j]; wg[k][4 + j] = a1[j]; wv[k][j] = b0[j]; wv[k][4 + j] = b1[j]; }
        }
        { const f32x4 a0 = *(const GAS f32x4*)(cb + c0), a1 = *(const GAS f32x4*)(cb + c0 + 4), b0 = *(const GAS f32x4*)(cb + DFF + c0), b1 = *(const GAS f32x4*)(cb + DFF + c0 + 4);
#pragma unroll
          for (int j = 0; j < 4; ++j) { bg[j] = a0[j]; bg[4 + j] = a1[j]; bv[j] = b0[j]; bv[4 + j] = b1[j]; } }
        float g2[8], g1[8], v2[8], v1[8];
        if ((t0 & (SEQ - 1)) == 0) {
#pragma unroll
            for (int j = 0; j < 8; ++j) { g2[j] = 0.f; g1[j] = 0.f; v2[j] = 0.f; v1[j] = 0.f; }
        } else {
            const GAS bf16* r2 = (const GAS bf16*)H + (size_t)(t0 - 2) * NUP + c0; const GAS bf16* r1 = r2 + NUP;
            unpack8(*(const GAS v4u*)r2, g2); unpack8(*(const GAS v4u*)(r2 + DFF), v2); unpack8(*(const GAS v4u*)r1, g1); unpack8(*(const GAS v4u*)(r1 + DFF), v1);
        }
        const GAS bf16* hp = (const GAS bf16*)H + (size_t)t0 * NUP + c0; GAS bf16* op = (GAS bf16*)GA + (size_t)t0 * DFF + c0;
#pragma unroll 8
        for (int r = 0; r < R; ++r) {
            float g0[8], v0[8], o[8];
            unpack8(*(const GAS v4u*)(hp + (size_t)r * NUP), g0); unpack8(*(const GAS v4u*)(hp + (size_t)r * NUP + DFF), v0);
#pragma unroll
            for (int j = 0; j < 8; ++j) {
                const float a = bg[j] + wg[0][j] * g2[j] + wg[1][j] * g1[j] + wg[2][j] * g0[j];
                const float b = bv[j] + wv[0][j] * v2[j] + wv[1][j] * v1[j] + wv[2][j] * v0[j];
                o[j] = silu_f(a) * b; g2[j] = g1[j]; g1[j] = g0[j]; v2[j] = v1[j]; v1[j] = v0[j];
            }
            v4u w; w.x = pk2(o[0], o[1]); w.y = pk2(o[2], o[3]); w.z = pk2(o[4], o[5]); w.w = pk2(o[6], o[7]);
            *(GAS v4u*)(op + (size_t)r * DFF) = w;
        }
    }
}

__device__ __forceinline__ void ffn_fix_phase(Frame& F, const bf16* HB, const float* cw, const float* cb, bf16* GA) {
    constexpr int NCHK = DFF / 8, NSPAN = M / 64;
    for (int it = F.vcu * NTHR + F.tid; it < NCHK * NSPAN; it += F.G * NTHR) {
        const int ch = it % NCHK, s = it / NCHK, c0 = ch * 8, t0 = s * 64;
        float wg[3][8], wv[3][8], bg[8], bv[8];
#pragma unroll
        for (int k = 0; k < 3; ++k) {
            const f32x4 a0 = *(const GAS f32x4*)(cw + (size_t)k * NUP + c0), a1 = *(const GAS f32x4*)(cw + (size_t)k * NUP + c0 + 4);
            const f32x4 b0 = *(const GAS f32x4*)(cw + (size_t)k * NUP + DFF + c0), b1 = *(const GAS f32x4*)(cw + (size_t)k * NUP + DFF + c0 + 4);
#pragma unroll
            for (int j = 0; j < 4; ++j) { wg[k][j] = a0[j]; wg[k][4 + j] = a1[j]; wv[k][j] = b0[j]; wv[k][4 + j] = b1[j]; }
        }
        { const f32x4 a0 = *(const GAS f32x4*)(cb + c0), a1 = *(const GAS f32x4*)(cb + c0 + 4), b0 = *(const GAS f32x4*)(cb + DFF + c0), b1 = *(const GAS f32x4*)(cb + DFF + c0 + 4);
#pragma unroll
          for (int j = 0; j < 4; ++j) { bg[j] = a0[j]; bg[4 + j] = a1[j]; bv[j] = b0[j]; bv[4 + j] = b1[j]; } }
        float g2[8], g1[8], v2[8], v1[8];
        if ((t0 & (SEQ - 1)) == 0) {
#pragma unroll
            for (int j = 0; j < 8; ++j) { g2[j] = 0.f; g1[j] = 0.f; v2[j] = 0.f; v1[j] = 0.f; }
        } else {
            const GAS bf16* pr = (const GAS bf16*)HB + (size_t)(((s - 1) * 4 + 2) * 2) * DFF + c0;
            unpack8(*(const GAS v4u*)pr, g2); unpack8(*(const GAS v4u*)(pr + DFF), v2); unpack8(*(const GAS v4u*)(pr + 2 * DFF), g1); unpack8(*(const GAS v4u*)(pr + 3 * DFF), v1);
        }
        const GAS bf16* cp = (const GAS bf16*)HB + (size_t)((s * 4) * 2) * DFF + c0; GAS bf16* op = (GAS bf16*)GA + (size_t)t0 * DFF + c0;
#pragma unroll
        for (int r = 0; r < 2; ++r) {
            float g0[8], v0[8], o[8];
            unpack8(*(const GAS v4u*)(cp + (size_t)(2 * r) * DFF), g0); unpack8(*(const GAS v4u*)(cp + (size_t)(2 * r + 1) * DFF), v0);
#pragma unroll
            for (int j = 0; j < 8; ++j) {
                const float a = bg[j] + wg[0][j] * g2[j] + wg[1][j] * g1[j] + wg[2][j] * g0[j];
                const float b = bv[j] + wv[0][j] * v2[j] + wv[1][j] * v1[j] + wv[2][j] * v0[j];
                o[j] = silu_f(a) * b; g2[j] = g1[j]; g1[j] = g0[j]; v2[j] = v1[j]; v1[j] = v0[j];
            }
            v4u w; w.x = pk2(o[0], o[1]); w.y = pk2(o[2], o[3]); w.z = pk2(o[4], o[5]); w.w = pk2(o[6], o[7]);
            *(GAS v4u*)(op + (size_t)r * DFF) = w;
        }
    }
}

__device__ __forceinline__ void ssd_prep_phase(Frame& F, const bf16* ZX, const float* cw, const float* cb, const float* dt_bias, bf16* XT, bf16* Bn, bf16* BT, bf16* Cn, float* DTF, const float* part, const unsigned long long* ssq) {
    const int gw = F.vcu * NWAVES + F.wave, NGW = F.G * NWAVES, lane = F.lane, c8 = lane & 7, rg = lane >> 3;
    for (int it = gw; it < 64 * 160; it += NGW) {
        const int cg = it % 160, bc = it / 160;
        const int ch0 = cg * 64 + 8 * c8, m0 = bc * 128;
        const GAS bf16* src = (const GAS bf16*)ZX + (size_t)(m0 + 16 * rg - 3) * NZXP + ZX_XBC + ch0;
        v4u raw[19];
        const bool hist = (rg != 0) || ((bc & 31) != 0);
#pragma unroll
        for (int jj = 0; jj < 19; ++jj) raw[jj] = (jj >= 3 || hist) ? *(const GAS v4u*)(src + (size_t)jj * NZXP) : (v4u){0u, 0u, 0u, 0u};
        float wt[4][8], bb[8];
#pragma unroll
        for (int k = 0; k < 4; ++k) { const f32x4 a = *(const GAS f32x4*)(cw + (size_t)k * CONVD + ch0), b = *(const GAS f32x4*)(cw + (size_t)k * CONVD + ch0 + 4);
#pragma unroll
            for (int e = 0; e < 4; ++e) { wt[k][e] = a[e]; wt[k][4 + e] = b[e]; } }
        { const f32x4 a = *(const GAS f32x4*)(cb + ch0), b = *(const GAS f32x4*)(cb + ch0 + 4);
#pragma unroll
          for (int e = 0; e < 4; ++e) { bb[e] = a[e]; bb[4 + e] = b[e]; } }
        GAS bf16* tdst = nullptr; GAS bf16* ndst = nullptr;
        if (cg < 128) { tdst = (GAS bf16*)XT + ((size_t)(bc * 128 + cg) * 64 + 8 * c8) * 128 + 16 * rg; }
        else if (cg < 144) { const int g = (cg - 128) >> 1, n0 = ((cg - 128) & 1) * 64 + 8 * c8; tdst = (GAS bf16*)BT + ((size_t)(bc * 8 + g) * 128 + n0) * 128 + 16 * rg; ndst = (GAS bf16*)Bn + ((size_t)(bc * 8 + g) * 128 + 16 * rg) * 128 + n0; }
        else { const int g = (cg - 144) >> 1, n0 = ((cg - 144) & 1) * 64 + 8 * c8; ndst = (GAS bf16*)Cn + ((size_t)(bc * 8 + g) * 128 + 16 * rg) * 128 + n0; }
#pragma unroll
        for (int hf = 0; hf < 2; ++hf) {
            unsigned nw[8][4];
#pragma unroll
            for (int ep = 0; ep < 4; ++ep) {
                float oa[8], ob[8];
                float a3 = bf_lo(raw[8 * hf][ep]), a2 = bf_lo(raw[8 * hf + 1][ep]), a1 = bf_lo(raw[8 * hf + 2][ep]), b3 = bf_hi(raw[8 * hf][ep]), b2 = bf_hi(raw[8 * hf + 1][ep]), b1 = bf_hi(raw[8 * hf + 2][ep]);
#pragma unroll
                for (int r = 0; r < 8; ++r) { const float a0 = bf_lo(raw[8 * hf + 3 + r][ep]), b0 = bf_hi(raw[8 * hf + 3 + r][ep]);
                    oa[r] = silu_f(bb[2 * ep] + wt[0][2 * ep] * a3 + wt[1][2 * ep] * a2 + wt[2][2 * ep] * a1 + wt[3][2 * ep] * a0);
                    ob[r] = silu_f(bb[2 * ep + 1] + wt[0][2 * ep + 1] * b3 + wt[1][2 * ep + 1] * b2 + wt[2][2 * ep + 1] * b1 + wt[3][2 * ep + 1] * b0);
                    a3 = a2; a2 = a1; a1 = a0; b3 = b2; b2 = b1; b1 = b0; }
                if (tdst) {
                    v4u t0; t0.x = pk2(oa[0], oa[1]); t0.y = pk2(oa[2], oa[3]); t0.z = pk2(oa[4], oa[5]); t0.w = pk2(oa[6], oa[7]);
                    *(GAS v4u*)(tdst + (size_t)(2 * ep) * 128 + 8 * hf) = t0;
                    t0.x = pk2(ob[0], ob[1]); t0.y = pk2(ob[2], ob[3]); t0.z = pk2(ob[4], ob[5]); t0.w = pk2(ob[6], ob[7]);
                    *(GAS v4u*)(tdst + (size_t)(2 * ep + 1) * 128 + 8 * hf) = t0;
                }
                if (ndst) {
#pragma unroll
                    for (int r = 0; r < 8; ++r) nw[r][ep] = pk2(oa[r], ob[r]);
                }
            }
            if (ndst) {
#pragma unroll
                for (int r = 0; r < 8; ++r) { v4u o; o.x = nw[r][0]; o.y = nw[r][1]; o.z = nw[r][2]; o.w = nw[r][3]; *(GAS v4u*)(ndst + (size_t)(8 * hf + r) * 128) = o; }
            }
        }
    }
    for (int i = F.vcu * NTHR + F.tid; i < M * NHEAD; i += F.G * NTHR) {
        const int h = i & 127, m = i >> 7;
        float raw;
        if (part) { float s = 0.f;
#pragma unroll
            for (int ks = 0; ks < 8; ++ks) s += ((const GAS float*)part)[((size_t)ks * M + m) * 128 + h];
            raw = s * (1.0f / sqrtf((float)ssq[m] * (1.0f / (4096.0f * 16777216.0f)) + 1e-5f)) + dt_bias[h]; }
        else raw = bf1(((const GAS bf16*)ZX)[(size_t)m * NZXP + ZX_DT + h]) + dt_bias[h];
        const float sp = raw > 20.f ? raw : log1pf(__expf(raw));
        ((GAS float*)DTF)[(size_t)((m >> 12) * NHEAD + h) * SEQ + (m & (SEQ - 1))] = sp;
    }
}

#define LDS_BAR() do { asm volatile("s_waitcnt lgkmcnt(0)" ::: "memory"); __builtin_amdgcn_s_barrier(); asm volatile("" ::: "memory"); } while (0)
__device__ __forceinline__ int swz(int r, int q) { return r * 256 + ((q ^ (r & 15)) << 4); }
__device__ __forceinline__ bf16x8 ldfrag(LAS const unsigned char* base, int row, int q) { return *(LAS const bf16x8*)(base + swz(row, q)); }
__device__ __forceinline__ void ssd_phase(Frame& F, const bf16* XT, const bf16* Bn, const bf16* BT, const bf16* Cn, const float* DTF, const float* a_log, const float* d_skip, bf16* Y) {
    constexpr int SC = 0, SB = 32768, SBT = 65536, SXT = 98304, SS = 114688, SM = 131072;
    LAS unsigned char* L = F.lds;
    LAS float* dtv = (LAS float*)(L + SM); LAS float* acs = dtv + 128; LAS float* w2 = dtv + 256;
    const int tid = F.tid, wave = F.wave, lane = F.lane, c = lane & 31, hi = lane >> 5;
    const int lb = wave >> 1, pb = wave & 1, nb = wave >> 1, sb0 = 2 * (wave & 1);
    for (int id = F.vcu; id < BATCH * NHEAD; id += F.G) {
        const int b = id >> 7, h = id & 127, g = h >> 4;
        const float A = -__expf(a_log[h]), Dh = d_skip[h];
        for (int i = tid; i < 1024; i += NTHR) *(LAS v4u*)(L + SS + i * 16) = (v4u){0u, 0u, 0u, 0u};
        f32x16 sacc;
#pragma unroll
        for (int r = 0; r < 16; ++r) sacc[r] = 0.f;
        v4u stC[4], stB[4], stBT[4], stX[2]; f32x2 stdt;
#define SSD_LOAD(cc_) do { const int cidx_ = b * NCHUNK + (cc_); \
            const GAS v4u* pc_ = (const GAS v4u*)(Cn + (size_t)(cidx_ * 8 + g) * 16384); const GAS v4u* pb_ = (const GAS v4u*)(Bn + (size_t)(cidx_ * 8 + g) * 16384); \
            const GAS v4u* pt_ = (const GAS v4u*)(BT + (size_t)(cidx_ * 8 + g) * 16384); const GAS v4u* px_ = (const GAS v4u*)(XT + (size_t)(cidx_ * 128 + h) * 8192); \
            _Pragma("unroll") for (int j_ = 0; j_ < 4; ++j_) { stC[j_] = pc_[tid + 512 * j_]; stB[j_] = pb_[tid + 512 * j_]; stBT[j_] = pt_[tid + 512 * j_]; } \
            _Pragma("unroll") for (int j_ = 0; j_ < 2; ++j_) stX[j_] = px_[tid + 512 * j_]; \
            stdt = *(const GAS f32x2*)(DTF + (size_t)(b * NHEAD + h) * SEQ + (cc_) * 128 + 2 * lane); } while (0)
        SSD_LOAD(0);
        for (int cc = 0; cc < NCHUNK; ++cc) {
#pragma unroll
            for (int j = 0; j < 4; ++j) { const int i = tid + 512 * j, o = swz(i >> 4, i & 15); *(LAS v4u*)(L + SC + o) = stC[j]; *(LAS v4u*)(L + SB + o) = stB[j]; *(LAS v4u*)(L + SBT + o) = stBT[j]; }
#pragma unroll
            for (int j = 0; j < 2; ++j) { const int i = tid + 512 * j; *(LAS v4u*)(L + SXT + swz(i >> 4, i & 15)) = stX[j]; }
            if (wave == 0) {
                const float a0 = stdt.x * A, a1 = stdt.y * A; float p = a0 + a1;
#pragma unroll
                for (int o = 1; o < 64; o <<= 1) { const float t = __shfl_up(p, o); if (lane >= o) p += t; }
                const float tot = __shfl(p, 63);
                acs[2 * lane] = p - a1; acs[2 * lane + 1] = p; dtv[2 * lane] = stdt.x; dtv[2 * lane + 1] = stdt.y;
                w2[2 * lane] = stdt.x * __expf(tot - (p - a1)); w2[2 * lane + 1] = stdt.y * __expf(tot - p);
            }
            LDS_BAR();
            if (cc + 1 < NCHUNK) SSD_LOAD(cc + 1);
            bf16x8 cf[8];
#pragma unroll
            for (int ks = 0; ks < 8; ++ks) cf[ks] = ldfrag(L + SC, 32 * lb + c, 2 * ks + hi);
            f32x16 yacc;
#pragma unroll
            for (int r = 0; r < 16; ++r) yacc[r] = 0.f;
#pragma unroll
            for (int ks = 0; ks < 8; ++ks) yacc = __builtin_amdgcn_mfma_f32_32x32x16_bf16(ldfrag(L + SS, 32 * pb + c, 2 * ks + hi), cf[ks], yacc, 0, 0, 0);
            const float acl = acs[32 * lb + c]; const float el = __expf(acl);
#pragma unroll
            for (int r = 0; r < 16; ++r) yacc[r] *= el;
            f32x16 cb0, cb1;
#pragma unroll
            for (int r = 0; r < 16; ++r) { cb0[r] = 0.f; cb1[r] = 0.f; }
            if (sb0 <= lb) {
#pragma unroll
                for (int ks = 0; ks < 8; ++ks) cb0 = __builtin_amdgcn_mfma_f32_32x32x16_bf16(ldfrag(L + SB, 32 * sb0 + c, 2 * ks + hi), cf[ks], cb0, 0, 0, 0);
            }
            if (sb0 + 1 <= lb) {
#pragma unroll
                for (int ks = 0; ks < 8; ++ks) cb1 = __builtin_amdgcn_mfma_f32_32x32x16_bf16(ldfrag(L + SB, 32 * (sb0 + 1) + c, 2 * ks + hi), cf[ks], cb1, 0, 0, 0);
            }
            const int lrow = 32 * lb + c;
#pragma unroll
            for (int q = 0; q < 4; ++q) {
                const int s0a = 32 * sb0 + 8 * q + 4 * hi, s0b = s0a + 32;
                const f32x4 aa = *(LAS const f32x4*)(acs + s0a), da = *(LAS const f32x4*)(dtv + s0a), ab = *(LAS const f32x4*)(acs + s0b), db = *(LAS const f32x4*)(dtv + s0b);
#pragma unroll
                for (int j = 0; j < 4; ++j) {
                    cb0[4 * q + j] = (s0a + j <= lrow) ? cb0[4 * q + j] * __expf(acl - aa[j]) * da[j] : 0.f;
                    cb1[4 * q + j] = (s0b + j <= lrow) ? cb1[4 * q + j] * __expf(acl - ab[j]) * db[j] : 0.f;
                }
            }
            LDS_BAR();
#pragma unroll
            for (int q = 0; q < 4; ++q) {
                v2u wa, wb; wa.x = pk2(cb0[4 * q], cb0[4 * q + 1]); wa.y = pk2(cb0[4 * q + 2], cb0[4 * q + 3]); wb.x = pk2(cb1[4 * q], cb1[4 * q + 1]); wb.y = pk2(cb1[4 * q + 2], cb1[4 * q + 3]);
                *(LAS v2u*)(L + SB + swz(lrow, 4 * sb0 + q) + 8 * hi) = wa; *(LAS v2u*)(L + SB + swz(lrow, 4 * (sb0 + 1) + q) + 8 * hi) = wb;
            }
            LDS_BAR();
            const int nks = 2 * (lb + 1);
            for (int ks = 0; ks < nks; ++ks) yacc = __builtin_amdgcn_mfma_f32_32x32x16_bf16(ldfrag(L + SXT, 32 * pb + c, 2 * ks + hi), ldfrag(L + SB, lrow, 2 * ks + hi), yacc, 0, 0, 0);
            {
                GAS bf16* yrow = (GAS bf16*)Y + (size_t)(b * SEQ + cc * 128 + lrow) * DI + h * 64 + 32 * pb + 4 * hi;
#pragma unroll
                for (int q = 0; q < 4; ++q) {
                    float yv[4];
#pragma unroll
                    for (int j = 0; j < 4; ++j) { const int p = 32 * pb + 8 * q + 4 * hi + j; const float xv = bf1(*(LAS const bf16*)(L + SXT + swz(p, lrow >> 3) + (lrow & 7) * 2)); yv[j] = yacc[4 * q + j] + Dh * xv; }
                    v2u w; w.x = pk2(yv[0], yv[1]); w.y = pk2(yv[2], yv[3]); *(GAS v2u*)(yrow + 8 * q) = w;
                }
            }
            {
                const float etot = __expf(acs[127]);
#pragma unroll
                for (int r = 0; r < 16; ++r) sacc[r] *= etot;
#pragma unroll
                for (int ks = 0; ks < 8; ++ks) {
                    const bf16x8 xa = ldfrag(L + SXT, 32 * pb + c, 2 * ks + hi);
                    const f32x4 wA = *(LAS const f32x4*)(w2 + 16 * ks + 8 * hi), wB = *(LAS const f32x4*)(w2 + 16 * ks + 8 * hi + 4);
                    const v4u xu = __builtin_bit_cast(v4u, xa);
                    v4u xs; xs.x = pk2(bf_lo(xu.x) * wA[0], bf_hi(xu.x) * wA[1]); xs.y = pk2(bf_lo(xu.y) * wA[2], bf_hi(xu.y) * wA[3]);
                    xs.z = pk2(bf_lo(xu.z) * wB[0], bf_hi(xu.z) * wB[1]); xs.w = pk2(bf_lo(xu.w) * wB[2], bf_hi(xu.w) * wB[3]);
                    sacc = __builtin_amdgcn_mfma_f32_32x32x16_bf16(ldfrag(L + SBT, 32 * nb + c, 2 * ks + hi), __builtin_bit_cast(bf16x8, xs), sacc, 0, 0, 0);
                }
                const int prow = 32 * pb + c;
#pragma unroll
                for (int q = 0; q < 4; ++q) { v2u w; w.x = pk2(sacc[4 * q], sacc[4 * q + 1]); w.y = pk2(sacc[4 * q + 2], sacc[4 * q + 3]); *(LAS v2u*)(L + SS + swz(prow, 4 * nb + q) + 8 * hi) = w; }
            }
            LDS_BAR();
        }
#undef SSD_LOAD
    }
}

__device__ __forceinline__ void gated_norm_phase(Frame& F, const bf16* Y, const bf16* ZX, const float* nw, bf16* G) {
    const int gw = F.vcu * NWAVES + F.wave, NGW = F.G * NWAVES, lane = F.lane;
    constexpr int UN = 8;
    for (int it0 = gw; it0 < M * NGRP; it0 += UN * NGW) {
        v4u yr[UN][2], zr[UN][2];
#pragma unroll
        for (int u = 0; u < UN; ++u) { const int it = it0 + u * NGW, m = it >> 3, g = it & 7;
#pragma unroll
            for (int j = 0; j < 2; ++j) { const int col = g * 1024 + j * 512 + lane * 8;
                if (it < M * NGRP) { yr[u][j] = *(const GAS v4u*)((const GAS bf16*)Y + (size_t)m * DI + col); zr[u][j] = *(const GAS v4u*)((const GAS bf16*)ZX + (size_t)m * NZXP + col); } } }
#pragma unroll
        for (int u = 0; u < UN; ++u) { const int it = it0 + u * NGW, m = it >> 3, g = it & 7;
            if (it >= M * NGRP) break;
            float gv[16]; float ss = 0.f;
#pragma unroll
            for (int j = 0; j < 2; ++j) { float yv[8], zv[8]; unpack8(yr[u][j], yv); unpack8(zr[u][j], zv);
#pragma unroll
                for (int e = 0; e < 8; ++e) { const float t = yv[e] * silu_f(zv[e]); gv[8 * j + e] = t; ss += t * t; } }
            const float rstd = 1.0f / sqrtf(wave_sum(ss) * (1.f / 1024.f) + EPS);
#pragma unroll
            for (int j = 0; j < 2; ++j) {
                const int col = g * 1024 + j * 512 + lane * 8;
                const f32x4 wa = *(const GAS f32x4*)(nw + col), wb = *(const GAS f32x4*)(nw + col + 4);
                v4u o; o.x = pk2(gv[8 * j] * rstd * wa[0], gv[8 * j + 1] * rstd * wa[1]); o.y = pk2(gv[8 * j + 2] * rstd * wa[2], gv[8 * j + 3] * rstd * wa[3]);
                o.z = pk2(gv[8 * j + 4] * rstd * wb[0], gv[8 * j + 5] * rstd * wb[1]); o.w = pk2(gv[8 * j + 6] * rstd * wb[2], gv[8 * j + 7] * rstd * wb[3]);
                *(GAS v4u*)((GAS bf16*)G + (size_t)m * DI + col) = o;
            }
        }
    }
}

__device__ __forceinline__ void rope_table_phase(Frame& F, const int* positions, float* cs, float* sn) {
    for (int i = F.vcu * NTHR + F.tid; i < M * 64; i += F.G * NTHR) {
        const int d = i & 63, m = i >> 6;
        const float inv = 1.0f / powf(10000.0f, (float)(2 * d) * (1.0f / 128.0f));
        const float ang = (float)positions[m] * inv;
        const float k = rintf(ang * 0.15915494309189535f);
        float r = fmaf(-k, 6.28125f, ang); r = fmaf(-k, 1.9353071795864769e-3f, r);
        const float rev = r * 0.15915494309189535f;
        cs[i] = __builtin_amdgcn_cosf(rev); sn[i] = __builtin_amdgcn_sinf(rev);
    }
}
__device__ __forceinline__ void rope_phase(Frame& F, bf16* QKVH, const float* cs, const float* sn) {
    const int total = 64 * M * 8;
    for (int i = F.vcu * NTHR + F.tid; i < total; i += F.G * NTHR) {
        const int d8 = i & 7, m = (i >> 3) & (M - 1), cg = i >> 16;
        GAS bf16* row = (GAS bf16*)QKVH + ((size_t)cg * M + m) * 128 + d8 * 8;
        float a[8], b[8];
        unpack8(*(const GAS v4u*)row, a); unpack8(*(const GAS v4u*)(row + 64), b);
        const f32x4 c0 = *(const GAS f32x4*)(cs + (size_t)m * 64 + d8 * 8), c1 = *(const GAS f32x4*)(cs + (size_t)m * 64 + d8 * 8 + 4);
        const f32x4 s0 = *(const GAS f32x4*)(sn + (size_t)m * 64 + d8 * 8), s1 = *(const GAS f32x4*)(sn + (size_t)m * 64 + d8 * 8 + 4);
        float oa[8], ob[8];
#pragma unroll
        for (int j = 0; j < 8; ++j) { const float cc = j < 4 ? c0[j & 3] : c1[j & 3], ss = j < 4 ? s0[j & 3] : s1[j & 3]; oa[j] = a[j] * cc - b[j] * ss; ob[j] = b[j] * cc + a[j] * ss; }
        v4u wa, wb; wa.x = pk2(oa[0], oa[1]); wa.y = pk2(oa[2], oa[3]); wa.z = pk2(oa[4], oa[5]); wa.w = pk2(oa[6], oa[7]);
        wb.x = pk2(ob[0], ob[1]); wb.y = pk2(ob[2], ob[3]); wb.z = pk2(ob[4], ob[5]); wb.w = pk2(ob[6], ob[7]);
        *(GAS v4u*)row = wa; *(GAS v4u*)(row + 64) = wb;
    }
}
typedef att::BlockRef<att::bf16, float> AttRef;
__device__ __forceinline__ AttRef att_ref(const bf16* QKVH, float* OP, int L, int pass) {
    const int combo = L >> 3, x = L & 7;
    const int vh = combo & 1, c = (combo >> 1) & 1, h = (combo >> 2) & 15, b = combo >> 6;
    const int qb = pass ? 15 - x : x;
    const size_t GS = (size_t)M * 128;
    AttRef r;
    r.Q = QKVH + (size_t)(2 * h + c) * GS + (size_t)(b * SEQ + qb * 256) * 128;
    r.K = QKVH + (size_t)(32 + 2 * h + c) * GS + (size_t)(b * SEQ) * 128;
    r.V = QKVH + (size_t)(64 + 2 * h + vh) * GS + (size_t)(b * SEQ) * 128;
    r.O = OP + (size_t)((2 * h + c) * 2 + vh) * GS + (size_t)(b * SEQ + qb * 256) * 128;
    r.P0 = qb * 256;
    return r;
}
__device__ __forceinline__ void attn_phase(Frame& F, const bf16* QKVH, float* OP, char* lds) {
    constexpr int TOTAL = 1024;
    int L = F.vcu; if (L >= TOTAL) return;
    const int stride = F.G; int pass = 0;
    AttRef cur = att_ref(QKVH, OP, L, 0);
    att::Seam<att::bf16> S;
    att::causal_swa_prime<att::bf16, float>(cur, SEQ, lds, S);
    for (;;) {
        const bool more_pass = pass == 0, more_item = L + stride < TOTAL, last = !more_pass && !more_item;
        int passn = pass + 1, Ln = L;
        if (!more_pass) { passn = 0; Ln = more_item ? L + stride : L; }
        const AttRef nxt = last ? cur : att_ref(QKVH, OP, Ln, passn);
        att::causal_swa_block<att::bf16, float>(cur, nxt, SEQ, SEQ, lds, S);
        if (last) break;
        cur = nxt; pass = passn; L = Ln;
    }
}
namespace att2 {
using att::bf16x8; using att::s16x4; using att::f32x16; using att::f32x4;
constexpr int QROWS = 128, KT = 64, K_BYTES = 16384, V_BYTES = 32768;
constexpr int OFF_K = 0, OFF_V = 2 * K_BYTES, OFF_P = OFF_V + 2 * V_BYTES, OFF_AL = OFF_P + 2 * 4 * 4096, OFF_LL = OFF_AL + 2 * 4 * 32 * 4, LDS_NEED = OFF_LL + 4 * 32 * 4;
__device__ __forceinline__ int v_st2(int k, int c) { const int kk = (k & ~0xC) | ((k & 4) << 1) | ((k & 8) >> 1); return ((kk >> 3) * 8 + (c >> 5)) * 512 + ((kk & 7) * 32 + (c & 31)) * 2; }
struct Blk { const unsigned short* Q; const unsigned short* K; const unsigned short* V0; const unsigned short* V1; float* O; int P0; unsigned short* AO; const float* subln; float lam, post; };
typedef att::u32x4 u4;

template <int PAR>
__device__ __forceinline__ void stageK(const Blk& B, char* lds, int t, int NT, int tid, u4 (&stK)[4]) {
    if (t + 1 < NT) {
#pragma unroll
        for (int j = 0; j < 4; ++j) { const int id = tid + 256 * j, key = id >> 4, col = (id & 15) * 8; *(u4*)(lds + OFF_K + (PAR ^ 1) * K_BYTES + KSWZ(key, col * 2)) = stK[j]; }
    }
    if (t + 2 < NT) {
#pragma unroll
        for (int j = 0; j < 4; ++j) { const int id = tid + 256 * j, key = id >> 4, col = (id & 15) * 8; stK[j] = *(const __attribute__((address_space(1))) u4*)(B.K + (size_t)((t + 2) * KT + key) * 128 + col); }
    }
}
template <int PAR>
__device__ __forceinline__ void stageV(const Blk& B, char* lds, int t, int NT, int tid, u4 (&stV)[8]) {
    if (t < NT) {
#pragma unroll
        for (int j = 0; j < 8; ++j) { const int id = tid + 256 * j, key = id >> 5, col = (id & 31) * 8; *(u4*)(lds + OFF_V + PAR * V_BYTES + v_st2(key, col)) = stV[j]; }
    }
    if (t + 1 < NT) {
#pragma unroll
        for (int j = 0; j < 8; ++j) { const int id = tid + 256 * j, key = id >> 5, col = (id & 31) * 8;
            stV[j] = *(const __attribute__((address_space(1))) u4*)((col < 128 ? B.V0 + col : B.V1 + (col - 128)) + (size_t)((t + 1) * KT + key) * 128); }
    }
}
template <int PAR>
__device__ __forceinline__ void step_prod(const Blk& B, char* lds, int t, int NT, int tid, int wid, int lane, int r32, int hi, const bf16x8 (&qr)[8], float& m_reg, float& l_reg, u4 (&stV)[8]) {
    stageV<PAR>(B, lds, t, NT, tid, stV);
    if (t < NT) {
        f32x16 p0, p1; float mn, al; bf16x8 pa0, pa1, pa2, pa3;
        __builtin_amdgcn_s_setprio(2);
        att::qkt<PAR, false>(p0, p1, lds + OFF_K, r32, hi, qr, true);
        __builtin_amdgcn_s_setprio(0);
        const int kb = t * KT, qlo = B.P0 + wid * 32;
        if (kb + KT - 1 > qlo) att::mask_tile(p0, p1, qlo + r32 - 4 * hi - kb, (unsigned)0x7fffffff);
        att::partialSM(p0, p1, m_reg, mn, al);
        att::finishSM(p0, p1, al, l_reg, pa0, pa1, pa2, pa3);
        char* pb = lds + OFF_P + (PAR * 4 + wid) * 4096 + lane * 16;
        *(bf16x8*)(pb) = pa0; *(bf16x8*)(pb + 1024) = pa1; *(bf16x8*)(pb + 2048) = pa2; *(bf16x8*)(pb + 3072) = pa3;
        if (hi == 0) ((float*)(lds + OFF_AL))[(PAR * 4 + wid) * 32 + r32] = al;
    }
    __syncthreads();
}
template <int PAR>
__device__ __forceinline__ void step_cons(const Blk& B, char* lds, int t, int NT, int tid, int p, int lane, int r32, int hi, f32x16 (&o)[8], u4 (&stK)[4]) {
    stageK<PAR>(B, lds, t, NT, tid - 256, stK);
    if (t >= 1) {
        constexpr int UP = PAR ^ 1;
        const float* alp = (const float*)(lds + OFF_AL) + (UP * 4 + p) * 32;
        const float a = alp[r32];
        if (__any(a < 1.f)) {
#pragma unroll
            for (int r = 0; r < 16; ++r) { const float ar = alp[att::crow(r, hi)];
#pragma unroll
                for (int d = 0; d < 8; ++d) o[d][r] *= ar; }
        }
        const char* pb = lds + OFF_P + (UP * 4 + p) * 4096 + lane * 16;
        const bf16x8 pa0 = *(const bf16x8*)(pb), pa1 = *(const bf16x8*)(pb + 1024), pa2 = *(const bf16x8*)(pb + 2048), pa3 = *(const bf16x8*)(pb + 3072);
        const int vb0 = (int)(uintptr_t)(lds + OFF_V) + att::v_rd_base(lane);
#define A2_TRRD(dst, off) asm volatile("ds_read_b64_tr_b16 %0, %1 offset:%2" : "=&v"(dst) : "v"(vb0), "i"(off) : "memory")
#define A2_LDG(L, H, ks, dh) do { constexpr int b_ = UP * V_BYTES + (ks) * 8192 + (dh) * 2048; \
        A2_TRRD(L[0], b_); A2_TRRD(H[0], b_ + 4096); A2_TRRD(L[1], b_ + 512); A2_TRRD(H[1], b_ + 512 + 4096); A2_TRRD(L[2], b_ + 1024); A2_TRRD(H[2], b_ + 1024 + 4096); A2_TRRD(L[3], b_ + 1536); A2_TRRD(H[3], b_ + 1536 + 4096); } while (0)
#define A2_MMA(L, H, pa, dh) do { _Pragma("unroll") for (int d = 0; d < 4; ++d) \
        o[4 * (dh) + d] = __builtin_amdgcn_mfma_f32_32x32x16_bf16(pa, (bf16x8){L[d][0], L[d][1], L[d][2], L[d][3], H[d][0], H[d][1], H[d][2], H[d][3]}, o[4 * (dh) + d], 0, 0, 0); } while (0)
#define A2_W8() do { asm volatile("s_waitcnt lgkmcnt(8)" ::: "memory"); SBAR(); } while (0)
        {
            s16x4 La[4], Ha[4], Lb[4], Hb[4];
            asm volatile("s_waitcnt lgkmcnt(0)" ::: "memory"); SBAR();
            A2_LDG(La, Ha, 0, 0); A2_LDG(Lb, Hb, 0, 1);
            A2_W8(); A2_MMA(La, Ha, pa0, 0); SBAR(); A2_LDG(La, Ha, 1, 0);
            A2_W8(); A2_MMA(Lb, Hb, pa0, 1); SBAR(); A2_LDG(Lb, Hb, 1, 1);
            A2_W8(); A2_MMA(La, Ha, pa1, 0); SBAR(); A2_LDG(La, Ha, 2, 0);
            A2_W8(); A2_MMA(Lb, Hb, pa1, 1); SBAR(); A2_LDG(Lb, Hb, 2, 1);
            A2_W8(); A2_MMA(La, Ha, pa2, 0); SBAR(); A2_LDG(La, Ha, 3, 0);
            A2_W8(); A2_MMA(Lb, Hb, pa2, 1); SBAR(); A2_LDG(Lb, Hb, 3, 1);
            A2_W8(); A2_MMA(La, Ha, pa3, 0); SBAR();
            asm volatile("s_waitcnt lgkmcnt(0)" ::: "memory"); SBAR(); A2_MMA(Lb, Hb, pa3, 1); SBAR();
        }
#undef A2_W8
#undef A2_MMA
#undef A2_LDG
#undef A2_TRRD
    }
    __syncthreads();
}

template <int MODE>
__device__ __forceinline__ void block(const Blk& B, char* lds) {
    int tl = threadIdx.x; asm volatile("" : "+v"(tl));
    const int tid = tl, wid = __builtin_amdgcn_readfirstlane(tid >> 6), lane = tid & 63, r32 = lane & 31, hi = lane >> 5;
    const int NT = (B.P0 + QROWS - 1) / KT + 1;
    if (wid < 4) {
        bf16x8 qr[8]; float m_reg = -1e30f, l_reg = 0.f; u4 stV[8];
#pragma unroll
        for (int j = 0; j < 8; ++j) { const int id = tid + 256 * j, key = id >> 5, col = (id & 31) * 8; stV[j] = *(const __attribute__((address_space(1))) u4*)((col < 128 ? B.V0 + col : B.V1 + (col - 128)) + (size_t)key * 128); }
#pragma unroll
        for (int d0 = 0; d0 < 8; ++d0) qr[d0] = *(const __attribute__((address_space(1))) bf16x8*)(B.Q + (size_t)(wid * 32 + r32) * 128 + d0 * 16 + hi * 8);
        __syncthreads();
        for (int t = 0; t <= NT; t += 2) {
            step_prod<0>(B, lds, t, NT, tid, wid, lane, r32, hi, qr, m_reg, l_reg, stV);
            if (t + 1 <= NT) step_prod<1>(B, lds, t + 1, NT, tid, wid, lane, r32, hi, qr, m_reg, l_reg, stV);
        }
        if (hi == 0) ((float*)(lds + OFF_LL))[wid * 32 + r32] = l_reg;
        __syncthreads();
    } else {
        f32x16 o[8]; const int p = wid - 4; u4 stK[4];
#pragma unroll
        for (int j = 0; j < 4; ++j) { const int id = (tid - 256) + 256 * j, key = id >> 4, col = (id & 15) * 8; const u4 k0 = *(const __attribute__((address_space(1))) u4*)(B.K + (size_t)key * 128 + col); *(u4*)(lds + OFF_K + KSWZ(key, col * 2)) = k0; }
        if (NT > 1) {
#pragma unroll
            for (int j = 0; j < 4; ++j) { const int id = (tid - 256) + 256 * j, key = id >> 4, col = (id & 15) * 8; stK[j] = *(const __attribute__((address_space(1))) u4*)(B.K + (size_t)(KT + key) * 128 + col); }
        }
#pragma unroll
        for (int d = 0; d < 8; ++d)
#pragma unroll
            for (int r = 0; r < 16; ++r) o[d][r] = 0.f;
        __syncthreads();
        for (int t = 0; t <= NT; t += 2) {
            step_cons<0>(B, lds, t, NT, tid, p, lane, r32, hi, o, stK);
            if (t + 1 <= NT) step_cons<1>(B, lds, t + 1, NT, tid, p, lane, r32, hi, o, stK);
        }
        __syncthreads();
        const float* llp = (const float*)(lds + OFF_LL) + p * 32;
        float* Ow = B.O + (size_t)(p * 32) * 256;
        if constexpr (MODE == 0) {
#pragma unroll
            for (int r = 0; r < 16; ++r) { const int orow = att::crow(r, hi); const float rl = __builtin_amdgcn_rcpf(llp[orow]);
#pragma unroll
                for (int d = 0; d < 8; ++d) ((__attribute__((address_space(1))) float*)Ow)[(size_t)orow * 256 + d * 32 + r32] = o[d][r] * rl; }
        } else {
            asm volatile("s_waitcnt vmcnt(0)" ::: "memory");
            int ll_ = threadIdx.x; asm volatile("" : "+v"(ll_)); ll_ &= 63;
            f32x4 sw0 = {B.subln[r32], B.subln[32 + r32], B.subln[64 + r32], B.subln[96 + r32]}, sw1 = {B.subln[128 + r32], B.subln[160 + r32], B.subln[192 + r32], B.subln[224 + r32]};
#pragma unroll
            for (int r = 0; r < 16; ++r) { const int orow = att::crow(r, hi); const float rl = __builtin_amdgcn_rcpf(llp[orow]) * B.lam; float q = 0.f; float dv[8];
#pragma unroll
                for (int d = 0; d < 8; ++d) { const float o0 = ((const __attribute__((address_space(1))) float*)Ow)[(size_t)orow * 256 + d * 32 + r32]; dv[d] = o0 - o[d][r] * rl; q += dv[d] * dv[d]; }
#pragma unroll
                for (int sft = 1; sft < 32; sft <<= 1) q += __builtin_bit_cast(float, __builtin_amdgcn_ds_bpermute((ll_ ^ sft) << 2, __builtin_bit_cast(int, q)));
                const float rs = B.post / sqrtf(q * (1.f / 256.f) + 1e-5f);
                __attribute__((address_space(1))) unsigned short* arow = (__attribute__((address_space(1))) unsigned short*)B.AO + (size_t)(p * 32 + orow) * 4096 + r32;
#pragma unroll
                for (int d = 0; d < 8; ++d) { const float v = dv[d] * rs * (d < 4 ? sw0[d & 3] : sw1[d & 3]);
                    const float vn = __builtin_bit_cast(float, __builtin_amdgcn_update_dpp(0, __builtin_bit_cast(int, v), 0xB1, 0xf, 0xf, true));
                    if ((r32 & 1) == 0) *(__attribute__((address_space(1))) unsigned*)(arow + d * 32) = att::cvtpk(v, vn); }
            }
        }
    }
    __syncthreads();
}
}

__device__ __forceinline__ att2::Blk att2_ref(const bf16* QKVH, float* OP2, bf16* AO, const float* subln, float lam, float post, int L, int c, int pass) {
    const int bh = L >> 4, y = L & 15; const int h = bh & 15, b = bh >> 4; const int qb = pass ? 31 - y : y;
    const size_t GS = (size_t)M * 128;
    att2::Blk r;
    r.Q = QKVH + (size_t)(2 * h + c) * GS + (size_t)(b * SEQ + qb * 128) * 128;
    r.K = QKVH + (size_t)(32 + 2 * h + c) * GS + (size_t)(b * SEQ) * 128;
    r.V0 = QKVH + (size_t)(64 + 2 * h) * GS + (size_t)(b * SEQ) * 128;
    r.V1 = QKVH + (size_t)(65 + 2 * h) * GS + (size_t)(b * SEQ) * 128;
    r.O = OP2 + (size_t)h * M * 256 + (size_t)(b * SEQ + qb * 128) * 256;
    r.P0 = qb * 128;
    r.AO = AO + (size_t)(b * SEQ + qb * 128) * DM + h * 256; r.subln = subln; r.lam = lam; r.post = post;
    return r;
}
__device__ __forceinline__ void attn2_phase(Frame& F, const bf16* QKVH, float* OP2, char* lds, const float* lq1, const float* lk1, const float* lq2, const float* lk2, const float* subln, float lambda_init, bf16* AO) {
    const int lane = F.lane;
    const float d1 = wave_sum(lq1[lane] * lk1[lane] + lq1[lane + 64] * lk1[lane + 64]), d2 = wave_sum(lq2[lane] * lk2[lane] + lq2[lane + 64] * lk2[lane + 64]);
    const float lam = expf(d1) - expf(d2) + lambda_init, post = 1.0f - lambda_init;
    for (int L = F.vcu; L < 512; L += F.G) {
#pragma unroll 1
        for (int pass = 0; pass < 2; ++pass) {
            { const att2::Blk B = att2_ref(QKVH, OP2, AO, subln, lam, post, L, 0, pass); att2::block<0>(B, lds); }
            { const att2::Blk B = att2_ref(QKVH, OP2, AO, subln, lam, post, L, 1, pass); att2::block<1>(B, lds); }
        }
    }
}
__device__ __forceinline__ void attn_combine_phase(Frame& F, const float* OP, const float* lq1, const float* lk1, const float* lq2, const float* lk2, const float* subln, float lambda_init, bf16* AO) {
    const int gw = F.vcu * NWAVES + F.wave, NGW = F.G * NWAVES, lane = F.lane;
    const float d1 = wave_sum(lq1[lane] * lk1[lane] + lq1[lane + 64] * lk1[lane + 64]), d2 = wave_sum(lq2[lane] * lk2[lane] + lq2[lane + 64] * lk2[lane + 64]);
    const float lam = expf(d1) - expf(d2) + lambda_init, post = 1.0f - lambda_init;
    const int vh = lane >> 5, d = (lane & 31) * 4;
    const f32x4 sw = *(const GAS f32x4*)(subln + vh * 128 + d);
    const size_t GS = (size_t)M * 128;
    constexpr int UN = 8;
    for (int it0 = gw; it0 < M * AH; it0 += UN * NGW) {
        f32x4 o1[UN], o2[UN];
#pragma unroll
        for (int u = 0; u < UN; ++u) { const int it = it0 + u * NGW, m = it >> 4, h = it & 15;
            if (it < M * AH) { o1[u] = *(const GAS f32x4*)(OP + (size_t)(2 * h) * M * 256 + (size_t)m * 256 + vh * 128 + d); o2[u] = *(const GAS f32x4*)(OP + (size_t)(2 * h + 1) * M * 256 + (size_t)m * 256 + vh * 128 + d); } }
#pragma unroll
        for (int u = 0; u < UN; ++u) { const int it = it0 + u * NGW, m = it >> 4, h = it & 15;
            if (it >= M * AH) break;
            const f32x4 o = o1[u] - lam * o2[u];
            const float ss = wave_sum((o.x * o.x + o.y * o.y) + (o.z * o.z + o.w * o.w));
            const float rs = post / sqrtf(ss * (1.f / 256.f) + EPS);
            v2u w; w.x = pk2(o.x * rs * sw.x, o.y * rs * sw.y); w.y = pk2(o.z * rs * sw.z, o.w * rs * sw.w);
            *(GAS v2u*)((GAS bf16*)AO + (size_t)m * DM + h * 256 + vh * 128 + d) = w;
        }
    }
}


struct Args { const float* in[57]; float* out; unsigned char* ws; };
__global__ void __launch_bounds__(NTHR, 2) trunk_fwd(Args args) {
    extern __shared__ __attribute__((aligned(16))) unsigned char lds[];
    Frame F;
    F.lds = (LAS unsigned char*)lds;
    F.tid = threadIdx.x; F.lane = F.tid & 63; F.wave = __builtin_amdgcn_readfirstlane(F.tid >> 6);
    gu32* ctl = (gu32*)(args.ws + WS_CTL);
    for (int u = F.tid; u < (LDS_BYTES - LDSCTL_OFF) / 4; u += NTHR) ((LAS unsigned*)(F.lds + LDSCTL_OFF))[u] = 0u;
    __syncthreads();
    volatile LAS unsigned* MISC = (volatile LAS unsigned*)(F.lds + MISC_OFF);
    XcdBarrier bar = xcd_barrier_post((unsigned*)(ctl + CW_BAR), MISC + 8);
#define GRID_BAR() do { xcd_barrier(bar); relaunder(F, args.ws); } while (0)

#define XR ((float*)(F.ws + WS_XR))
#define U ((bf16*)(F.ws + WS_U))
#define BIG ((bf16*)(F.ws + WS_BIG))
#define ACT2 ((bf16*)(F.ws + WS_ACT2))
#define XT ((bf16*)(F.ws + WS_XT))
#define Yb ((bf16*)(F.ws + WS_Y))
#define Bn ((bf16*)(F.ws + WS_BN))
#define BT ((bf16*)(F.ws + WS_BT))
#define Cn ((bf16*)(F.ws + WS_CN))
#define DTF ((float*)(F.ws + WS_DTF))
#define PART ((float*)(F.ws + WS_PART))
#define OP ((float*)(F.ws + WS_XT))
#define SSQ(k) ((unsigned long long*)((unsigned*)(F.ws + WS_CTL) + CW_SS) + (k) * M)
#define ropec ((float*)(F.ws + WS_ROPE))
#define ropes ((float*)(F.ws + WS_ROPE) + (size_t)M * 64)
    relaunder(F, args.ws);

    {
        int p0_prefix = 0;
#pragma unroll 1
        for (int layer = 0; layer < 4; ++layer) {
            const bool mamba = (layer & 1) == 0;
            const int ib = layer == 0 ? 2 : layer == 1 ? 16 : layer == 2 ? 29 : 43;
            const size_t wlo = WS_W + (layer == 0 ? 0 : layer == 1 ? WL_MAMBA : layer == 2 ? WL_MAMBA + WL_ATTN : 2 * WL_MAMBA + WL_ATTN);
            if (mamba) {
                p0_matrix(F, args.in[ib + 1], DM, NZX, NZXP, (bf16*)(F.ws + wlo + W_IN), p0_prefix, 0, args.in[ib + 0]);
                p0_matrix(F, args.in[ib + 8], DI, DM, DM, (bf16*)(F.ws + wlo + W_OUT), p0_prefix);
                p0_matrix(F, args.in[ib + 10], DM, NUP, NUP, (bf16*)(F.ws + wlo + W_UP_M), p0_prefix, 0, args.in[ib + 9], DFF / 256);
                p0_matrix(F, args.in[ib + 13], DFF, DM, DM, (bf16*)(F.ws + wlo + W_DOWN_M), p0_prefix, 0, nullptr, 0, -1, 0, (layer == 0 || F.G != 256) ? 0 : TAIL_TILES);
            } else {
                p0_matrix(F, args.in[ib + 1], DM, NQKV, NQKV, (bf16*)(F.ws + wlo + W_QKV), p0_prefix, 2 * DM, args.in[ib + 0]);
                p0_matrix(F, args.in[ib + 7], DM, DM, DM, (bf16*)(F.ws + wlo + W_O), p0_prefix);
                p0_matrix(F, args.in[ib + 9], DM, NUP, NUP, (bf16*)(F.ws + wlo + W_UP_A), p0_prefix, 0, args.in[ib + 8], DFF / 256);
                p0_matrix(F, args.in[ib + 12], DFF, DM, DM, (bf16*)(F.ws + wlo + W_DOWN_A), p0_prefix, 0, nullptr, 0, -1, 0, (layer == 0 || F.G != 256) ? 0 : TAIL_TILES);
            }
        }
        rope_table_phase(F, (const int*)args.in[1], ropec, ropes);
        { const int gw = F.vcu * NWAVES + F.wave, NGW = F.G * NWAVES;
          for (int m = gw; m < M; m += NGW) x_row_prep(args.in[0] + (size_t)m * DM, U + (size_t)m * DM, SSQ(0) + m, F.lane); }
        GRID_BAR();
    }

    {
        constexpr int layer = 0;
        constexpr bool mamba = (layer & 1) == 0;
        constexpr int ib = layer == 0 ? 2 : layer == 1 ? 16 : layer == 2 ? 29 : 43;
        constexpr size_t wlo = WS_W + (layer == 0 ? 0 : layer == 1 ? WL_MAMBA : layer == 2 ? WL_MAMBA + WL_ATTN : 2 * WL_MAMBA + WL_ATTN);
        const float* xin = layer == 0 ? args.in[0] : XR;
        if constexpr (mamba) {
            const bool splitdt = F.G == 256;
            if (splitdt) {
                { pg8::Gemm g{U, (const bf16*)(F.ws + wlo + W_IN), M, NZXM, DM}; pg8::StaticOrder S; S.init(M, NZXM, F.G, F.bx);
                  int pm0, ntab; rstd_table(F, S, SSQ(2 * layer), pm0, ntab);
                  pg8::EpiBf16S E{BIG, NZXP, SSQ(2 * layer), (const LAS float*)(F.lds + TAB_OFF), pm0, ntab};
                  pg8::gemm_phase<pg8::EpiBf16S, pg8::StaticOrder, PG8_ALIGN, PG8_SP2>(F.lds + RING_OFF, g, S, E); }
                { const int ks = F.vcu & 7; pg8::Gemm g{U + ks * 512, (const bf16*)(F.ws + wlo + W_IN) + (size_t)NZXM * DM + ks * 512, M, 256, 512, DM};
                  pg8::OneUnit S{F.vcu >> 3, 1}; pg8::EpiPart E{PART + (size_t)ks * M * 128};
                  pg8::gemm_phase<pg8::EpiPart, pg8::OneUnit, false, PG8_SP2>(F.lds + RING_OFF, g, S, E); }
            } else {
                { pg8::Gemm g{U, (const bf16*)(F.ws + wlo + W_IN), M, NZXP, DM}; pg8::StaticOrder S; S.init(M, NZXP, F.G, F.bx);
                  int pm0, ntab; rstd_table(F, S, SSQ(2 * layer), pm0, ntab);
                  pg8::EpiBf16S E{BIG, NZXP, SSQ(2 * layer), (const LAS float*)(F.lds + TAB_OFF), pm0, ntab};
                  pg8::gemm_phase<pg8::EpiBf16S, pg8::StaticOrder, PG8_ALIGN, PG8_SP2>(F.lds + RING_OFF, g, S, E); }
            }
            GRID_BAR();
            ssd_prep_phase(F, BIG, args.in[ib + 2], args.in[ib + 3], args.in[ib + 4], XT, Bn, BT, Cn, DTF, splitdt ? PART : nullptr, SSQ(2 * layer));
            GRID_BAR();
            ssd_phase(F, XT, Bn, BT, Cn, DTF, args.in[ib + 5], args.in[ib + 6], Yb);
            GRID_BAR();
            gated_norm_phase(F, Yb, BIG, args.in[ib + 7], ACT2);
            GRID_BAR();
            { pg8::Gemm g{ACT2, (const bf16*)(F.ws + wlo + W_OUT), M, DM, DI}; pg8::StaticOrder S; S.init(M, DM, F.G, F.bx);
              pg8::EpiResN E{xin, XR, U, SSQ(2 * layer + 1), DM};
              pg8::gemm_phase<pg8::EpiResN, pg8::StaticOrder, PG8_ALIGN, PG8_SP2>(F.lds + RING_OFF, g, S, E); }
            GRID_BAR();
        } else {
            { pg8::Gemm g{U, (const bf16*)(F.ws + wlo + W_QKV), M, NQKV, DM}; pg8::StaticOrder S; S.init(M, NQKV, F.G, F.bx);
              int pm0, ntab; rstd_table(F, S, SSQ(2 * layer), pm0, ntab);
              pg8::EpiHeadMajor E{BIG, (size_t)M * 128, ropec, ropes, SSQ(2 * layer), (const LAS float*)(F.lds + TAB_OFF), pm0, ntab};
              pg8::gemm_phase<pg8::EpiHeadMajor, pg8::StaticOrder, PG8_ALIGN, PG8_SP2>(F.lds + RING_OFF, g, S, E); }
            GRID_BAR();
            attn2_phase(F, BIG, OP, (char*)lds + RING_OFF, args.in[ib + 2], args.in[ib + 3], args.in[ib + 4], args.in[ib + 5], args.in[ib + 6], 0.8f - 0.6f * expf(-0.3f * (float)layer), ACT2);
            GRID_BAR();
            { pg8::Gemm g{ACT2, (const bf16*)(F.ws + wlo + W_O), M, DM, DM}; pg8::StaticOrder S; S.init(M, DM, F.G, F.bx);
              pg8::EpiResN E{xin, XR, U, SSQ(2 * layer + 1), DM};
              pg8::gemm_phase<pg8::EpiResN, pg8::StaticOrder, PG8_ALIGN, PG8_SP2>(F.lds + RING_OFF, g, S, E); }
            GRID_BAR();
        }
        constexpr int fb = mamba ? ib + 9 : ib + 8;
        { pg8::Gemm g{U, (const bf16*)(F.ws + wlo + (mamba ? W_UP_M : W_UP_A)), M, NUP, DM}; pg8::StaticOrder S; S.init(M, NUP, F.G, F.bx);

          { pg8::EpiGate E{ACT2, BIG, args.in[fb + 2], args.in[fb + 3], NUP, DFF, SSQ(2 * layer + 1), F.lds + SIDE_OFF};
          pg8::gemm_phase<pg8::EpiGate, pg8::StaticOrder, PG8_ALIGN, PG8_SP2>(F.lds + RING_OFF, g, S, E); } }
        if constexpr (layer < 3) { if (F.G == 256 && F.bx >= 192) {
            constexpr bool nm = ((layer + 1) & 1) == 0; constexpr int nib = layer + 1 == 1 ? 16 : layer + 1 == 2 ? 29 : 43;
            constexpr size_t nwlo = WS_W + (layer + 1 == 1 ? WL_MAMBA : layer + 1 == 2 ? WL_MAMBA + WL_ATTN : 2 * WL_MAMBA + WL_ATTN);
            int nopfx = 0; p0_matrix(F, args.in[nib + (nm ? 13 : 12)], DFF, DM, DM, (bf16*)(F.ws + nwlo + (nm ? W_DOWN_M : W_DOWN_A)), nopfx, 0, nullptr, 0, F.bx - 192, 64, 0, TAIL_TILES); } }
        GRID_BAR();
        ffn_fix_phase(F, BIG, args.in[fb + 2], args.in[fb + 3], ACT2);
        GRID_BAR();
        { pg8::Gemm g{ACT2, (const bf16*)(F.ws + wlo + (mamba ? W_DOWN_M : W_DOWN_A)), M, DM, DFF}; pg8::StaticOrder S; S.init(M, DM, F.G, F.bx);
          pg8::EpiResN E{XR, XR, layer == 3 ? (bf16*)nullptr : U, SSQ(2 * layer + 2), DM};
          pg8::gemm_phase<pg8::EpiResN, pg8::StaticOrder, PG8_ALIGN, PG8_SP2>(F.lds + RING_OFF, g, S, E); }
        GRID_BAR();
    }
    {
        constexpr int layer = 1;
        constexpr bool mamba = (layer & 1) == 0;
        constexpr int ib = layer == 0 ? 2 : layer == 1 ? 16 : layer == 2 ? 29 : 43;
        constexpr size_t wlo = WS_W + (layer == 0 ? 0 : layer == 1 ? WL_MAMBA : layer == 2 ? WL_MAMBA + WL_ATTN : 2 * WL_MAMBA + WL_ATTN);
        const float* xin = layer == 0 ? args.in[0] : XR;
        if constexpr (mamba) {
            const bool splitdt = F.G == 256;
            if (splitdt) {
                { pg8::Gemm g{U, (const bf16*)(F.ws + wlo + W_IN), M, NZXM, DM}; pg8::StaticOrder S; S.init(M, NZXM, F.G, F.bx);
                  int pm0, ntab; rstd_table(F, S, SSQ(2 * layer), pm0, ntab);
                  pg8::EpiBf16S E{BIG, NZXP, SSQ(2 * layer), (const LAS float*)(F.lds + TAB_OFF), pm0, ntab};
                  pg8::gemm_phase<pg8::EpiBf16S, pg8::StaticOrder, PG8_ALIGN, PG8_SP2>(F.lds + RING_OFF, g, S, E); }
                { const int ks = F.vcu & 7; pg8::Gemm g{U + ks * 512, (const bf16*)(F.ws + wlo + W_IN) + (size_t)NZXM * DM + ks * 512, M, 256, 512, DM};
                  pg8::OneUnit S{F.vcu >> 3, 1}; pg8::EpiPart E{PART + (size_t)ks * M * 128};
                  pg8::gemm_phase<pg8::EpiPart, pg8::OneUnit, false, PG8_SP2>(F.lds + RING_OFF, g, S, E); }
            } else {
                { pg8::Gemm g{U, (const bf16*)(F.ws + wlo + W_IN), M, NZXP, DM}; pg8::StaticOrder S; S.init(M, NZXP, F.G, F.bx);
                  int pm0, ntab; rstd_table(F, S, SSQ(2 * layer), pm0, ntab);
                  pg8::EpiBf16S E{BIG, NZXP, SSQ(2 * layer), (const LAS float*)(F.lds + TAB_OFF), pm0, ntab};
                  pg8::gemm_phase<pg8::EpiBf16S, pg8::StaticOrder, PG8_ALIGN, PG8_SP2>(F.lds + RING_OFF, g, S, E); }
            }
            GRID_BAR();
            ssd_prep_phase(F, BIG, args.in[ib + 2], args.in[ib + 3], args.in[ib + 4], XT, Bn, BT, Cn, DTF, splitdt ? PART : nullptr, SSQ(2 * layer));
            GRID_BAR();
            ssd_phase(F, XT, Bn, BT, Cn, DTF, args.in[ib + 5], args.in[ib + 6], Yb);
            GRID_BAR();
            gated_norm_phase(F, Yb, BIG, args.in[ib + 7], ACT2);
            GRID_BAR();
            { pg8::Gemm g{ACT2, (const bf16*)(F.ws + wlo + W_OUT), M, DM, DI}; pg8::StaticOrder S; S.init(M, DM, F.G, F.bx);
              pg8::EpiResN E{xin, XR, U, SSQ(2 * layer + 1), DM};
              pg8::gemm_phase<pg8::EpiResN, pg8::StaticOrder, PG8_ALIGN, PG8_SP2>(F.lds + RING_OFF, g, S, E); }
            GRID_BAR();
        } else {
            { pg8::Gemm g{U, (const bf16*)(F.ws + wlo + W_QKV), M, NQKV, DM}; pg8::StaticOrder S; S.init(M, NQKV, F.G, F.bx);
              int pm0, ntab; rstd_table(F, S, SSQ(2 * layer), pm0, ntab);
              pg8::EpiHeadMajor E{BIG, (size_t)M * 128, ropec, ropes, SSQ(2 * layer), (const LAS float*)(F.lds + TAB_OFF), pm0, ntab};
              pg8::gemm_phase<pg8::EpiHeadMajor, pg8::StaticOrder, PG8_ALIGN, PG8_SP2>(F.lds + RING_OFF, g, S, E); }
            GRID_BAR();
            attn2_phase(F, BIG, OP, (char*)lds + RING_OFF, args.in[ib + 2], args.in[ib + 3], args.in[ib + 4], args.in[ib + 5], args.in[ib + 6], 0.8f - 0.6f * expf(-0.3f * (float)layer), ACT2);
            GRID_BAR();
            { pg8::Gemm g{ACT2, (const bf16*)(F.ws + wlo + W_O), M, DM, DM}; pg8::StaticOrder S; S.init(M, DM, F.G, F.bx);
              pg8::EpiResN E{xin, XR, U, SSQ(2 * layer + 1), DM};
              pg8::gemm_phase<pg8::EpiResN, pg8::StaticOrder, PG8_ALIGN, PG8_SP2>(F.lds + RING_OFF, g, S, E); }
            GRID_BAR();
        }
        constexpr int fb = mamba ? ib + 9 : ib + 8;
        { pg8::Gemm g{U, (const bf16*)(F.ws + wlo + (mamba ? W_UP_M : W_UP_A)), M, NUP, DM}; pg8::StaticOrder S; S.init(M, NUP, F.G, F.bx);

          { pg8::EpiGate E{ACT2, BIG, args.in[fb + 2], args.in[fb + 3], NUP, DFF, SSQ(2 * layer + 1), F.lds + SIDE_OFF};
          pg8::gemm_phase<pg8::EpiGate, pg8::StaticOrder, PG8_ALIGN, PG8_SP2>(F.lds + RING_OFF, g, S, E); } }
        if constexpr (layer < 3) { if (F.G == 256 && F.bx >= 192) {
            constexpr bool nm = ((layer + 1) & 1) == 0; constexpr int nib = layer + 1 == 1 ? 16 : layer + 1 == 2 ? 29 : 43;
            constexpr size_t nwlo = WS_W + (layer + 1 == 1 ? WL_MAMBA : layer + 1 == 2 ? WL_MAMBA + WL_ATTN : 2 * WL_MAMBA + WL_ATTN);
            int nopfx = 0; p0_matrix(F, args.in[nib + (nm ? 13 : 12)], DFF, DM, DM, (bf16*)(F.ws + nwlo + (nm ? W_DOWN_M : W_DOWN_A)), nopfx, 0, nullptr, 0, F.bx - 192, 64, 0, TAIL_TILES); } }
        GRID_BAR();
        ffn_fix_phase(F, BIG, args.in[fb + 2], args.in[fb + 3], ACT2);
        GRID_BAR();
        { pg8::Gemm g{ACT2, (const bf16*)(F.ws + wlo + (mamba ? W_DOWN_M : W_DOWN_A)), M, DM, DFF}; pg8::StaticOrder S; S.init(M, DM, F.G, F.bx);
          pg8::EpiResN E{XR, XR, layer == 3 ? (bf16*)nullptr : U, SSQ(2 * layer + 2), DM};
          pg8::gemm_phase<pg8::EpiResN, pg8::StaticOrder, PG8_ALIGN, PG8_SP2>(F.lds + RING_OFF, g, S, E); }
        GRID_BAR();
    }
    {
        constexpr int layer = 2;
        constexpr bool mamba = (layer & 1) == 0;
        constexpr int ib = layer == 0 ? 2 : layer == 1 ? 16 : layer == 2 ? 29 : 43;
        constexpr size_t wlo = WS_W + (layer == 0 ? 0 : layer == 1 ? WL_MAMBA : layer == 2 ? WL_MAMBA + WL_ATTN : 2 * WL_MAMBA + WL_ATTN);
        const float* xin = layer == 0 ? args.in[0] : XR;
        if constexpr (mamba) {
            const bool splitdt = F.G == 256;
            if (splitdt) {
                { pg8::Gemm g{U, (const bf16*)(F.ws + wlo + W_IN), M, NZXM, DM}; pg8::StaticOrder S; S.init(M, NZXM, F.G, F.bx);
                  int pm0, ntab; rstd_table(F, S, SSQ(2 * layer), pm0, ntab);
                  pg8::EpiBf16S E{BIG, NZXP, SSQ(2 * layer), (const LAS float*)(F.lds + TAB_OFF), pm0, ntab};
                  pg8::gemm_phase<pg8::EpiBf16S, pg8::StaticOrder, PG8_ALIGN, PG8_SP2>(F.lds + RING_OFF, g, S, E); }
                { const int ks = F.vcu & 7; pg8::Gemm g{U + ks * 512, (const bf16*)(F.ws + wlo + W_IN) + (size_t)NZXM * DM + ks * 512, M, 256, 512, DM};
                  pg8::OneUnit S{F.vcu >> 3, 1}; pg8::EpiPart E{PART + (size_t)ks * M * 128};
                  pg8::gemm_phase<pg8::EpiPart, pg8::OneUnit, false, PG8_SP2>(F.lds + RING_OFF, g, S, E); }
            } else {
                { pg8::Gemm g{U, (const bf16*)(F.ws + wlo + W_IN), M, NZXP, DM}; pg8::StaticOrder S; S.init(M, NZXP, F.G, F.bx);
                  int pm0, ntab; rstd_table(F, S, SSQ(2 * layer), pm0, ntab);
                  pg8::EpiBf16S E{BIG, NZXP, SSQ(2 * layer), (const LAS float*)(F.lds + TAB_OFF), pm0, ntab};
                  pg8::gemm_phase<pg8::EpiBf16S, pg8::StaticOrder, PG8_ALIGN, PG8_SP2>(F.lds + RING_OFF, g, S, E); }
            }
            GRID_BAR();
            ssd_prep_phase(F, BIG, args.in[ib + 2], args.in[ib + 3], args.in[ib + 4], XT, Bn, BT, Cn, DTF, splitdt ? PART : nullptr, SSQ(2 * layer));
            GRID_BAR();
            ssd_phase(F, XT, Bn, BT, Cn, DTF, args.in[ib + 5], args.in[ib + 6], Yb);
            GRID_BAR();
            gated_norm_phase(F, Yb, BIG, args.in[ib + 7], ACT2);
            GRID_BAR();
            { pg8::Gemm g{ACT2, (const bf16*)(F.ws + wlo + W_OUT), M, DM, DI}; pg8::StaticOrder S; S.init(M, DM, F.G, F.bx);
              pg8::EpiResN E{xin, XR, U, SSQ(2 * layer + 1), DM};
              pg8::gemm_phase<pg8::EpiResN, pg8::StaticOrder, PG8_ALIGN, PG8_SP2>(F.lds + RING_OFF, g, S, E); }
            GRID_BAR();
        } else {
            { pg8::Gemm g{U, (const bf16*)(F.ws + wlo + W_QKV), M, NQKV, DM}; pg8::StaticOrder S; S.init(M, NQKV, F.G, F.bx);
              int pm0, ntab; rstd_table(F, S, SSQ(2 * layer), pm0, ntab);
              pg8::EpiHeadMajor E{BIG, (size_t)M * 128, ropec, ropes, SSQ(2 * layer), (const LAS float*)(F.lds + TAB_OFF), pm0, ntab};
              pg8::gemm_phase<pg8::EpiHeadMajor, pg8::StaticOrder, PG8_ALIGN, PG8_SP2>(F.lds + RING_OFF, g, S, E); }
            GRID_BAR();
            attn2_phase(F, BIG, OP, (char*)lds + RING_OFF, args.in[ib + 2], args.in[ib + 3], args.in[ib + 4], args.in[ib + 5], args.in[ib + 6], 0.8f - 0.6f * expf(-0.3f * (float)layer), ACT2);
            GRID_BAR();
            { pg8::Gemm g{ACT2, (const bf16*)(F.ws + wlo + W_O), M, DM, DM}; pg8::StaticOrder S; S.init(M, DM, F.G, F.bx);
              pg8::EpiResN E{xin, XR, U, SSQ(2 * layer + 1), DM};
              pg8::gemm_phase<pg8::EpiResN, pg8::StaticOrder, PG8_ALIGN, PG8_SP2>(F.lds + RING_OFF, g, S, E); }
            GRID_BAR();
        }
        constexpr int fb = mamba ? ib + 9 : ib + 8;
        { pg8::Gemm g{U, (const bf16*)(F.ws + wlo + (mamba ? W_UP_M : W_UP_A)), M, NUP, DM}; pg8::StaticOrder S; S.init(M, NUP, F.G, F.bx);

          { pg8::EpiGate E{ACT2, BIG, args.in[fb + 2], args.in[fb + 3], NUP, DFF, SSQ(2 * layer + 1), F.lds + SIDE_OFF};
          pg8::gemm_phase<pg8::EpiGate, pg8::StaticOrder, PG8_ALIGN, PG8_SP2>(F.lds + RING_OFF, g, S, E); } }
        if constexpr (layer < 3) { if (F.G == 256 && F.bx >= 192) {
            constexpr bool nm = ((layer + 1) & 1) == 0; constexpr int nib = layer + 1 == 1 ? 16 : layer + 1 == 2 ? 29 : 43;
            constexpr size_t nwlo = WS_W + (layer + 1 == 1 ? WL_MAMBA : layer + 1 == 2 ? WL_MAMBA + WL_ATTN : 2 * WL_MAMBA + WL_ATTN);
            int nopfx = 0; p0_matrix(F, args.in[nib + (nm ? 13 : 12)], DFF, DM, DM, (bf16*)(F.ws + nwlo + (nm ? W_DOWN_M : W_DOWN_A)), nopfx, 0, nullptr, 0, F.bx - 192, 64, 0, TAIL_TILES); } }
        GRID_BAR();
        ffn_fix_phase(F, BIG, args.in[fb + 2], args.in[fb + 3], ACT2);
        GRID_BAR();
        { pg8::Gemm g{ACT2, (const bf16*)(F.ws + wlo + (mamba ? W_DOWN_M : W_DOWN_A)), M, DM, DFF}; pg8::StaticOrder S; S.init(M, DM, F.G, F.bx);
          pg8::EpiResN E{XR, XR, layer == 3 ? (bf16*)nullptr : U, SSQ(2 * layer + 2), DM};
          pg8::gemm_phase<pg8::EpiResN, pg8::StaticOrder, PG8_ALIGN, PG8_SP2>(F.lds + RING_OFF, g, S, E); }
        GRID_BAR();
    }
    {
        constexpr int layer = 3;
        constexpr bool mamba = (layer & 1) == 0;
        constexpr int ib = layer == 0 ? 2 : layer == 1 ? 16 : layer == 2 ? 29 : 43;
        constexpr size_t wlo = WS_W + (layer == 0 ? 0 : layer == 1 ? WL_MAMBA : layer == 2 ? WL_MAMBA + WL_ATTN : 2 * WL_MAMBA + WL_ATTN);
        const float* xin = layer == 0 ? args.in[0] : XR;
        if constexpr (mamba) {
            const bool splitdt = F.G == 256;
            if (splitdt) {
                { pg8::Gemm g{U, (const bf16*)(F.ws + wlo + W_IN), M, NZXM, DM}; pg8::StaticOrder S; S.init(M, NZXM, F.G, F.bx);
                  int pm0, ntab; rstd_table(F, S, SSQ(2 * layer), pm0, ntab);
                  pg8::EpiBf16S E{BIG, NZXP, SSQ(2 * layer), (const LAS float*)(F.lds + TAB_OFF), pm0, ntab};
                  pg8::gemm_phase<pg8::EpiBf16S, pg8::StaticOrder, PG8_ALIGN, PG8_SP2>(F.lds + RING_OFF, g, S, E); }
                { const int ks = F.vcu & 7; pg8::Gemm g{U + ks * 512, (const bf16*)(F.ws + wlo + W_IN) + (size_t)NZXM * DM + ks * 512, M, 256, 512, DM};
                  pg8::OneUnit S{F.vcu >> 3, 1}; pg8::EpiPart E{PART + (size_t)ks * M * 128};
                  pg8::gemm_phase<pg8::EpiPart, pg8::OneUnit, false, PG8_SP2>(F.lds + RING_OFF, g, S, E); }
            } else {
                { pg8::Gemm g{U, (const bf16*)(F.ws + wlo + W_IN), M, NZXP, DM}; pg8::StaticOrder S; S.init(M, NZXP, F.G, F.bx);
                  int pm0, ntab; rstd_table(F, S, SSQ(2 * layer), pm0, ntab);
                  pg8::EpiBf16S E{BIG, NZXP, SSQ(2 * layer), (const LAS float*)(F.lds + TAB_OFF), pm0, ntab};
                  pg8::gemm_phase<pg8::EpiBf16S, pg8::StaticOrder, PG8_ALIGN, PG8_SP2>(F.lds + RING_OFF, g, S, E); }
            }
            GRID_BAR();
            ssd_prep_phase(F, BIG, args.in[ib + 2], args.in[ib + 3], args.in[ib + 4], XT, Bn, BT, Cn, DTF, splitdt ? PART : nullptr, SSQ(2 * layer));
            GRID_BAR();
            ssd_phase(F, XT, Bn, BT, Cn, DTF, args.in[ib + 5], args.in[ib + 6], Yb);
            GRID_BAR();
            gated_norm_phase(F, Yb, BIG, args.in[ib + 7], ACT2);
            GRID_BAR();
            { pg8::Gemm g{ACT2, (const bf16*)(F.ws + wlo + W_OUT), M, DM, DI}; pg8::StaticOrder S; S.init(M, DM, F.G, F.bx);
              pg8::EpiResN E{xin, XR, U, SSQ(2 * layer + 1), DM};
              pg8::gemm_phase<pg8::EpiResN, pg8::StaticOrder, PG8_ALIGN, PG8_SP2>(F.lds + RING_OFF, g, S, E); }
            GRID_BAR();
        } else {
            { pg8::Gemm g{U, (const bf16*)(F.ws + wlo + W_QKV), M, NQKV, DM}; pg8::StaticOrder S; S.init(M, NQKV, F.G, F.bx);
              int pm0, ntab; rstd_table(F, S, SSQ(2 * layer), pm0, ntab);
              pg8::EpiHeadMajor E{BIG, (size_t)M * 128, ropec, ropes, SSQ(2 * layer), (const LAS float*)(F.lds + TAB_OFF), pm0, ntab};
              pg8::gemm_phase<pg8::EpiHeadMajor, pg8::StaticOrder, PG8_ALIGN, PG8_SP2>(F.lds + RING_OFF, g, S, E); }
            GRID_BAR();
            attn2_phase(F, BIG, OP, (char*)lds + RING_OFF, args.in[ib + 2], args.in[ib + 3], args.in[ib + 4], args.in[ib + 5], args.in[ib + 6], 0.8f - 0.6f * expf(-0.3f * (float)layer), ACT2);
            GRID_BAR();
            { pg8::Gemm g{ACT2, (const bf16*)(F.ws + wlo + W_O), M, DM, DM}; pg8::StaticOrder S; S.init(M, DM, F.G, F.bx);
              pg8::EpiResN E{xin, XR, U, SSQ(2 * layer + 1), DM};
              pg8::gemm_phase<pg8::EpiResN, pg8::StaticOrder, PG8_ALIGN, PG8_SP2>(F.lds + RING_OFF, g, S, E); }
            GRID_BAR();
        }
        constexpr int fb = mamba ? ib + 9 : ib + 8;
        { pg8::Gemm g{U, (const bf16*)(F.ws + wlo + (mamba ? W_UP_M : W_UP_A)), M, NUP, DM}; pg8::StaticOrder S; S.init(M, NUP, F.G, F.bx);

          { pg8::EpiGate E{ACT2, BIG, args.in[fb + 2], args.in[fb + 3], NUP, DFF, SSQ(2 * layer + 1), F.lds + SIDE_OFF};
          pg8::gemm_phase<pg8::EpiGate, pg8::StaticOrder, PG8_ALIGN, PG8_SP2>(F.lds + RING_OFF, g, S, E); } }
        if constexpr (layer < 3) { if (F.G == 256 && F.bx >= 192) {
            constexpr bool nm = ((layer + 1) & 1) == 0; constexpr int nib = layer + 1 == 1 ? 16 : layer + 1 == 2 ? 29 : 43;
            constexpr size_t nwlo = WS_W + (layer + 1 == 1 ? WL_MAMBA : layer + 1 == 2 ? WL_MAMBA + WL_ATTN : 2 * WL_MAMBA + WL_ATTN);
            int nopfx = 0; p0_matrix(F, args.in[nib + (nm ? 13 : 12)], DFF, DM, DM, (bf16*)(F.ws + nwlo + (nm ? W_DOWN_M : W_DOWN_A)), nopfx, 0, nullptr, 0, F.bx - 192, 64, 0, TAIL_TILES); } }
        GRID_BAR();
        ffn_fix_phase(F, BIG, args.in[fb + 2], args.in[fb + 3], ACT2);
        GRID_BAR();
        { pg8::Gemm g{ACT2, (const bf16*)(F.ws + wlo + (mamba ? W_DOWN_M : W_DOWN_A)), M, DM, DFF}; pg8::StaticOrder S; S.init(M, DM, F.G, F.bx);
          pg8::EpiResN E{XR, XR, layer == 3 ? (bf16*)nullptr : U, SSQ(2 * layer + 2), DM};
          pg8::gemm_phase<pg8::EpiResN, pg8::StaticOrder, PG8_ALIGN, PG8_SP2>(F.lds + RING_OFF, g, S, E); }
        GRID_BAR();
    }
    {
        const int gw = F.vcu * NWAVES + F.wave, NGW = F.G * NWAVES;
        for (int m = gw; m < M; m += NGW) rms_row_f32(XR + (size_t)m * DM, args.in[56], args.out + (size_t)m * DM, F.lane);
    }
#undef GRID_BAR
#undef XR
#undef U
#undef BIG
#undef ACT2
#undef XT
#undef Yb
#undef Bn
#undef BT
#undef Cn
#undef DTF
#undef PART
#undef OP
#undef SSQ
#undef ropec
#undef ropes
}
}

extern "C" void kernel_launch(void* const* d_in, const int* in_sizes, int n_in, void* d_out, int out_size, void* d_ws, size_t ws_size, hipStream_t stream) {
    using namespace mk;
    static int grid = 0;
    if (grid == 0) {
        if (n_in != 57 || out_size != M * DM || ws_size < WS_END) { fprintf(stderr, "kernel_launch: built for 57 inputs, out of %d floats, >= %zu bytes of workspace; got n_in %d, out %d, ws %zu; nothing launched\n", M * DM, (size_t)WS_END, n_in, out_size, ws_size); grid = -1; return; }
        int dev = 0, cus = 0, per_cu = 0;
        if (hipGetDevice(&dev) != hipSuccess || hipDeviceGetAttribute(&cus, hipDeviceAttributeMultiprocessorCount, dev) != hipSuccess) { fprintf(stderr, "kernel_launch: device query failed\n"); grid = -1; return; }
        if (hipFuncSetAttribute((const void*)trunk_fwd, hipFuncAttributeMaxDynamicSharedMemorySize, LDS_BYTES) != hipSuccess) { fprintf(stderr, "kernel_launch: hipFuncSetAttribute failed\n"); grid = -1; return; }
        if (hipOccupancyMaxActiveBlocksPerMultiprocessor(&per_cu, (const void*)trunk_fwd, NTHR, LDS_BYTES) != hipSuccess || per_cu < 1)
            fprintf(stderr, "kernel_launch: note: occupancy query reports %d workgroups per CU\n", per_cu);
        (void)hipGetLastError();
        grid = cus;
    }
    if (grid < 0) return;
    if (hipMemsetAsync((char*)d_ws + WS_CTL, 0, CTL_ZERO_BYTES, stream) != hipSuccess) { fprintf(stderr, "kernel_launch: memset failed\n"); return; }
    Args a{};
    for (int i = 0; i < 57; ++i) a.in[i] = (const float*)d_in[i];
    a.out = (float*)d_out; a.ws = (unsigned char*)d_ws;
    hipLaunchKernelGGL(trunk_fwd, dim3(grid), dim3(NTHR), LDS_BYTES, stream, a);
    const hipError_t le = hipPeekAtLastError();
    if (le != hipSuccess) fprintf(stderr, "kernel_launch: launch failed: %s\n", hipGetErrorName(le));
}
```

```cpp
#include <hip/hip_runtime.h>
#include <cstdio>
#include <cstdint>
namespace pg8 {
#define PG8_LAS __attribute__((address_space(3)))
typedef unsigned short bf16_t;
typedef short bf16x8 __attribute__((ext_vector_type(8)));
typedef float f32x4 __attribute__((ext_vector_type(4)));
typedef unsigned u32x4 __attribute__((ext_vector_type(4)));
constexpr int BM = 256, BK = 64, HALF = 128, HTB = HALF * BK * 2  , STAGE_BYTES = 8 * HTB, NXCD = 8, WGM = 8;

__host__ __device__ __forceinline__ int lds_byte(int r, int c) { const int st = (r >> 4) * 2 + (c >> 5), rr = r & 15, cc = c & 31, ob = rr * 64 + cc * 2; return st * 1024 + (ob ^ (((ob >> 9) & 1) << 5)); }
__host__ __device__ __forceinline__ void stage_rc(int b, int& R, int& C) { const int st = b / 1024, sb = b % 1024, swz = sb ^ (((sb >> 9) & 1) << 5); R = (st >> 1) * 16 + swz / 64; C = (st & 1) * 32 + (swz % 64) / 2; }
__host__ __device__ __forceinline__ int perm32(int rho) { const int n = rho >> 4, i = rho & 15; return 8 * (i >> 2) + 4 * n + (i & 3); }

struct Unit { int pm, pn; };
struct Gemm { const bf16_t* A; const bf16_t* Bt; int M, N, K; int ld = 0; };

struct StaticOrder {
    int nM, nN, nwg, G, c;
    __host__ __device__ void init(int M, int N, int G_, int c_) { nM = M / BM; nN = N / BM; nwg = nM * nN; G = G_; c = c_; }
    __host__ __device__ bool next(int i, Unit& u) const {
        const long L = (long)i * G + c; if (L >= nwg) return false;
        int wgid = (int)L; { const int q = nwg / NXCD, r = nwg % NXCD, xcd = wgid % NXCD, off = wgid / NXCD; wgid = (xcd < r ? xcd * (q + 1) : r * (q + 1) + (xcd - r) * q) + off; }
        const int nig = WGM * nN, gid = wgid / nig, fm = gid * WGM, gsz = (nM - fm) < WGM ? (nM - fm) : WGM;
        u.pm = fm + ((wgid % nig) % gsz); u.pn = (wgid % nig) / gsz; return true;
    }
    __device__ __forceinline__ void a_ready(const Unit&) const {}
    __device__ __forceinline__ void done(const Unit&) const {}
};

typedef float f32x2c __attribute__((ext_vector_type(2))); typedef __bf16 bf16x2c __attribute__((ext_vector_type(2)));
__device__ __forceinline__ unsigned cvt_pk_bf16(float lo, float hi) { const f32x2c v = {lo, hi}; return __builtin_bit_cast(unsigned, __builtin_convertvector(v, bf16x2c)); }
typedef float f32x2 __attribute__((ext_vector_type(2)));
__device__ __forceinline__ f32x2 gelu_pk(f32x2 v) {
    const f32x2 av = __builtin_elementwise_abs(v), d = av * 0.2316418882f + 1.0f;
    f32x2 t; t.x = __builtin_amdgcn_rcpf(d.x); t.y = __builtin_amdgcn_rcpf(d.y);
    f32x2 q = t * 0.5307027145f + (-0.7265760135f); q = q * t + 0.7107068705f; q = q * t + (-0.142248368f); q = q * t + 0.127414796f; q = q * t;
    const f32x2 s = (v * v) * (-0.72134752044f);
    f32x2 e; e.x = __builtin_amdgcn_exp2f(s.x); e.y = __builtin_amdgcn_exp2f(s.y);
    const f32x2 m = v * (q * e), r = v - m;
    f32x2 o; o.x = v.x < 0.f ? m.x : r.x; o.y = v.y < 0.f ? m.y : r.y; return o;
}

template <int ACT  > struct EpiBf16 {
    static constexpr bool PERM = true, AFTER_DRAIN = false; static_assert(ACT == 0 || ACT == 1, "EpiBf16: ACT is 0 (none) or 1 (gelu_pk)");
    bf16_t* O; int ldc; const float* bias; int split_cols; size_t split_stride; float scale0;
    __device__ __forceinline__ void operator()(const f32x4 (&acc)[2][2][4][2], const Unit& u, int wr, int wc, int fr, int fq) const {
        const int row0 = u.pm * BM + wr * 64 + fr; int colt = u.pn * BM; bf16_t* base = O;
        float sc = 1.f; if (split_cols) { const int t = colt / split_cols; base += (size_t)t * split_stride; colt -= t * split_cols; if (t == 0) sc = scale0; }
        const int col0 = colt + wc * 32 + 8 * fq, bcol0 = u.pn * BM + wc * 32 + 8 * fq;
        f32x4 bv[2][2];
#pragma unroll
        for (int bj = 0; bj < 2; ++bj)
#pragma unroll
            for (int n = 0; n < 2; ++n) bv[bj][n] = bias ? *(const f32x4*)(bias + bcol0 + bj * HALF + 4 * n) : (f32x4){0.f, 0.f, 0.f, 0.f};
#pragma unroll
        for (int ai = 0; ai < 2; ++ai)
#pragma unroll
            for (int m = 0; m < 4; ++m) { bf16_t* rowp = base + (size_t)(row0 + ai * HALF + m * 16) * ldc + col0;
#pragma unroll
                for (int bj = 0; bj < 2; ++bj) { f32x4 v0 = acc[ai][bj][m][0] + bv[bj][0], v1 = acc[ai][bj][m][1] + bv[bj][1];
                    if (ACT == 1) { f32x2 a = gelu_pk((f32x2){v0[0], v0[1]}), b = gelu_pk((f32x2){v0[2], v0[3]}), c = gelu_pk((f32x2){v1[0], v1[1]}), d = gelu_pk((f32x2){v1[2], v1[3]});
                        v0 = (f32x4){a.x, a.y, b.x, b.y}; v1 = (f32x4){c.x, c.y, d.x, d.y}; }
                    v0 = v0 * sc; v1 = v1 * sc; u32x4 w; w.x = cvt_pk_bf16(v0[0], v0[1]); w.y = cvt_pk_bf16(v0[2], v0[3]); w.z = cvt_pk_bf16(v1[0], v1[1]); w.w = cvt_pk_bf16(v1[2], v1[3]);
                    *(u32x4*)(rowp + bj * HALF) = w; } }
    }
};


struct EpiRes {
    static constexpr bool PERM = false, AFTER_DRAIN = false;
    const float* base; float* out; int ldc;
    __device__ __forceinline__ void operator()(const f32x4 (&acc)[2][2][4][2], const Unit& u, int wr, int wc, int fr, int fq) const {
        const int col0 = u.pn * BM + wc * 32 + 4 * fq;
#pragma unroll
        for (int ai = 0; ai < 2; ++ai)
#pragma unroll
            for (int m = 0; m < 4; ++m) { const size_t off = (size_t)(u.pm * BM + ai * HALF + wr * 64 + m * 16 + fr) * ldc + col0;
#pragma unroll
                for (int bj = 0; bj < 2; ++bj)
#pragma unroll
                    for (int n = 0; n < 2; ++n) { const f32x4 bs = *(const f32x4*)(base + off + bj * HALF + n * 16); *(f32x4*)(out + off + bj * HALF + n * 16) = bs + acc[ai][bj][m][n]; }
                if (m & 1) asm volatile("" ::: "memory"); }
    }
};
struct EpiHeadMajor {
    static constexpr bool PERM = true, AFTER_DRAIN = false;
    bf16_t* O; size_t gstride; const float* cs; const float* sn; const unsigned long long* ss; const PG8_LAS float* tab; int pm0, ntab;
    __device__ __forceinline__ void operator()(const f32x4 (&acc)[2][2][4][2], const Unit& u, int wr, int wc, int fr, int fq) const {
        const int row0 = u.pm * BM + wr * 64 + fr, col0 = wc * 32 + 8 * fq; const bool rope = u.pn < 32, intab = (unsigned)(u.pm - pm0) < (unsigned)ntab;
#pragma unroll
        for (int ai = 0; ai < 2; ++ai)
#pragma unroll
            for (int m = 0; m < 4; ++m) { const int row = row0 + ai * HALF + m * 16;
                const float rs = intab ? tab[row - pm0 * BM] : 1.0f / sqrtf((float)ss[row] * (1.0f / (4096.0f * 16777216.0f)) + 1e-5f);
                f32x4 c4 = {1.f, 1.f, 1.f, 1.f}, s4 = {0.f, 0.f, 0.f, 0.f};
                if (rope) { c4 = *(const f32x4*)(cs + (size_t)row * 64 + 16 * wc + 4 * fq); s4 = *(const f32x4*)(sn + (size_t)row * 64 + 16 * wc + 4 * fq); }
#pragma unroll
                for (int bj = 0; bj < 2; ++bj) { bf16_t* rowp = O + (size_t)(u.pn * 2 + bj) * gstride + (size_t)row * 128 + col0;
                    const f32x4 v0 = acc[ai][bj][m][0] * rs, v1 = acc[ai][bj][m][1] * rs;
                    const f32x4 r0 = {v0[0] * c4[0] - v0[1] * s4[0], v0[1] * c4[0] + v0[0] * s4[0], v0[2] * c4[1] - v0[3] * s4[1], v0[3] * c4[1] + v0[2] * s4[1]};
                    const f32x4 r1 = {v1[0] * c4[2] - v1[1] * s4[2], v1[1] * c4[2] + v1[0] * s4[2], v1[2] * c4[3] - v1[3] * s4[3], v1[3] * c4[3] + v1[2] * s4[3]};
                    u32x4 w; w.x = cvt_pk_bf16(r0[0], r0[1]); w.y = cvt_pk_bf16(r0[2], r0[3]); w.z = cvt_pk_bf16(r1[0], r1[1]); w.w = cvt_pk_bf16(r1[2], r1[3]);
                    *(u32x4*)rowp = w; } }
    }
};
struct EpiBf16S {
    static constexpr bool PERM = true, AFTER_DRAIN = false;
    bf16_t* O; int ldc; const unsigned long long* ss; const PG8_LAS float* tab; int pm0, ntab;
    __device__ __forceinline__ void operator()(const f32x4 (&acc)[2][2][4][2], const Unit& u, int wr, int wc, int fr, int fq) const {
        const int row0 = u.pm * BM + wr * 64 + fr, col0 = u.pn * BM + wc * 32 + 8 * fq; const bool intab = (unsigned)(u.pm - pm0) < (unsigned)ntab;
#pragma unroll
        for (int ai = 0; ai < 2; ++ai)
#pragma unroll
            for (int m = 0; m < 4; ++m) { const int row = row0 + ai * HALF + m * 16;
                const float rs = intab ? tab[row - pm0 * BM] : 1.0f / sqrtf((float)ss[row] * (1.0f / (4096.0f * 16777216.0f)) + 1e-5f);
                bf16_t* rowp = O + (size_t)row * ldc + col0;
#pragma unroll
                for (int bj = 0; bj < 2; ++bj) { const f32x4 v0 = acc[ai][bj][m][0] * rs, v1 = acc[ai][bj][m][1] * rs;
                    u32x4 w; w.x = cvt_pk_bf16(v0[0], v0[1]); w.y = cvt_pk_bf16(v0[2], v0[3]); w.z = cvt_pk_bf16(v1[0], v1[1]); w.w = cvt_pk_bf16(v1[2], v1[3]);
                    *(u32x4*)(rowp + bj * HALF) = w; } }
    }
};
template <int C, bool BC> __device__ __forceinline__ float eg_dpp(float x) { return __int_as_float(__builtin_amdgcn_update_dpp(0, __float_as_int(x), C, 0xf, 0xf, BC)); }
#define EG_DPP(x, c, bc) eg_dpp<c, bc>(x)
template <int C> __device__ __forceinline__ float eg_dpp_old(float keep, float x) { return __int_as_float(__builtin_amdgcn_update_dpp(__float_as_int(keep), __float_as_int(x), C, 0xf, 0xf, false)); }
#define EG_SHR1(x) EG_DPP(x, 0x111, true)
#define EG_SHR2(x) EG_DPP(x, 0x112, true)
#define EG_MIR(x) EG_DPP(x, 0x140, false)
#define EG_SWP(x) EG_DPP(x, 0xB1, false)
struct EpiGate {
    static constexpr bool PERM = true, AFTER_DRAIN = false;
    bf16_t* GA; bf16_t* HB; const float* cw; const float* cb; int nup, dff; const unsigned long long* ss; PG8_LAS unsigned char* side;
    __device__ __forceinline__ void prefetch(const Unit& nx, int par, int wid, int lane) const {
        const float* base = (wid < 3 ? cw + (size_t)wid * nup : wid < 6 ? cw + (size_t)(wid - 3) * nup + dff : wid == 6 ? cb : cb + dff) + nx.pn * 128 + lane;
        PG8_LAS unsigned char* d = side + par * 4096 + wid * 512;
        __builtin_amdgcn_global_load_lds((const unsigned*)base, (PG8_LAS unsigned*)d, 4, 0, 0);
        __builtin_amdgcn_global_load_lds((const unsigned*)(base + 64), (PG8_LAS unsigned*)(d + 256), 4, 0, 0);
        __builtin_amdgcn_global_load_lds((const unsigned*)(ss + (size_t)nx.pm * BM) + wid * 64 + lane, (PG8_LAS unsigned*)(side + 8192 + par * 2048 + wid * 256), 4, 0, 0);
    }
    __device__ __forceinline__ void run(const f32x4 (&acc)[2][2][4][2], const Unit& u, int par, int wr, int wc, int fr, int fq) const {
        typedef unsigned u32x2 __attribute__((ext_vector_type(2)));
        const int ch0 = u.pn * 128 + wc * 32 + 8 * fq; const unsigned loff = (unsigned)fr * (unsigned)(dff * 2) + (unsigned)ch0 * 2u;
        float rsv[2][4]; { const PG8_LAS unsigned long long* sl = (const PG8_LAS unsigned long long*)(side + 8192 + par * 2048) + wr * 64 + fr;
#pragma unroll
            for (int ai = 0; ai < 2; ++ai)
#pragma unroll
                for (int m = 0; m < 4; ++m) rsv[ai][m] = __builtin_amdgcn_rsqf((float)sl[ai * 128 + m * 16] * (1.0f / (4096.0f * 16777216.0f)) + 1e-5f); }
        const bool f01 = fr < 2;
#pragma unroll
        for (int n = 0; n < 2; ++n) { const int ch = ch0 + 4 * n;
            const PG8_LAS f32x4* wp = (const PG8_LAS f32x4*)(side + par * 4096) + (wc * 8 + 2 * fq + n);
            const f32x4 wg0 = wp[0], wg1 = wp[32], wg2 = wp[64], wv0 = wp[96], wv1 = wp[128], wv2 = wp[160], bg = wp[192], bv = wp[224];
#pragma unroll
            for (int ai = 0; ai < 2; ++ai) { f32x4 pg1 = {0.f, 0.f, 0.f, 0.f}, pg2 = pg1, pv1 = pg1, pv2 = pg1;
#pragma unroll
                for (int m = 0; m < 4; ++m) { const int row = u.pm * BM + ai * HALF + wr * 64 + m * 16 + fr;
                    const float rs = rsv[ai][m];
                    const f32x4 g = acc[ai][0][m][n] * rs, v = acc[ai][1][m][n] * rs; f32x4 o;
#pragma unroll
                    for (int e = 0; e < 4; ++e) { const float tg1 = eg_dpp_old<0x111>(pg1[e], g[e]), tg2 = eg_dpp_old<0x112>(pg2[e], g[e]), tv1 = eg_dpp_old<0x111>(pv1[e], v[e]), tv2 = eg_dpp_old<0x112>(pv2[e], v[e]);
                        const float a = bg[e] + wg0[e] * tg2 + wg1[e] * tg1 + wg2[e] * g[e], b = bv[e] + wv0[e] * tv2 + wv1[e] * tv1 + wv2[e] * v[e];
                        o[e] = a * __builtin_amdgcn_rcpf(1.f + __expf(-a)) * b; }
                    if (m > 0 || !f01) { u32x2 w; w.x = cvt_pk_bf16(o[0], o[1]); w.y = cvt_pk_bf16(o[2], o[3]);
                        *(__attribute__((address_space(1))) u32x2*)((__attribute__((address_space(1))) char*)GA + (size_t)(u.pm * BM + ai * HALF + wr * 64 + m * 16) * (size_t)(dff * 2) + (loff + 8u * n)) = w; }
                    if ((m == 0 && f01) || (m == 3 && fr >= 14)) { const int j = (m == 0) ? fr : fr - 12;
                        bf16_t* hp = HB + (size_t)(((row >> 6) * 4 + j) * 2) * dff + ch;
                        u32x2 wg_; wg_.x = cvt_pk_bf16(g[0], g[1]); wg_.y = cvt_pk_bf16(g[2], g[3]); *(u32x2*)hp = wg_;
                        u32x2 wv_; wv_.x = cvt_pk_bf16(v[0], v[1]); wv_.y = cvt_pk_bf16(v[2], v[3]); *(u32x2*)(hp + dff) = wv_; }
#pragma unroll
                    for (int e = 0; e < 4; ++e) { pg1[e] = EG_MIR(g[e]); pg2[e] = EG_SWP(pg1[e]); pv1[e] = EG_MIR(v[e]); pv2[e] = EG_SWP(pv1[e]); }
                } } }
    }
};
#undef EG_SHR1
#undef EG_SHR2
#undef EG_MIR
#undef EG_SWP
#undef EG_DPP
template <class T> struct epi_pf { static constexpr bool v = false; };
template <> struct epi_pf<EpiGate> { static constexpr bool v = true; };
struct EpiResN {
    static constexpr bool PERM = false, AFTER_DRAIN = false;
    const float* base; float* out; bf16_t* xb; unsigned long long* ss; int ldc;
    __device__ __forceinline__ void operator()(const f32x4 (&acc)[2][2][4][2], const Unit& u, int wr, int wc, int fr, int fq) const {
        const int col0 = u.pn * BM + wc * 32 + 4 * fq;
        int l = threadIdx.x; asm volatile("" : "+v"(l)); l &= 63;
        typedef unsigned u32x2 __attribute__((ext_vector_type(2)));
        const size_t off0 = (size_t)(u.pm * BM + wr * 64 + fr) * ldc + col0;
        const int ucol = (fq & 1) ? 12 + 4 * fq : 4 * fq;
        f32x4 bsA[2][2][2], bsB[2][2][2];
#define ERN_LOAD(dst, b_) do { _Pragma("unroll") for (int mm = 0; mm < 2; ++mm) _Pragma("unroll") for (int bj = 0; bj < 2; ++bj) _Pragma("unroll") for (int n = 0; n < 2; ++n) \
            dst[mm][bj][n] = *(const f32x4*)(base + off0 + (size_t)(((b_) >> 1) * HALF + (((b_) & 1) * 2 + mm) * 16) * ldc + bj * HALF + n * 16); } while (0)
#define ERN_DO(src, b_) do { _Pragma("unroll") for (int mm = 0; mm < 2; ++mm) { const int ai = (b_) >> 1, m = ((b_) & 1) * 2 + mm; const int row = u.pm * BM + ai * HALF + wr * 64 + m * 16 + fr; \
            const size_t off = off0 + (size_t)(ai * HALF + m * 16) * ldc; float q = 0.f; \
            _Pragma("unroll") for (int bj = 0; bj < 2; ++bj) { const f32x4 o0 = src[mm][bj][0] + acc[ai][bj][m][0], o1 = src[mm][bj][1] + acc[ai][bj][m][1]; \
                *(f32x4*)(out + off + bj * HALF) = o0; *(f32x4*)(out + off + bj * HALF + 16) = o1; \
                q += ((o0[0] * o0[0] + o0[1] * o0[1]) + (o0[2] * o0[2] + o0[3] * o0[3])) + ((o1[0] * o1[0] + o1[1] * o1[1]) + (o1[2] * o1[2] + o1[3] * o1[3])); \
                  \
                if (xb) { const auto r0 = __builtin_amdgcn_permlane16_swap(cvt_pk_bf16(o0[0], o0[1]), cvt_pk_bf16(o1[0], o1[1]), false, false);     \
                const auto r1 = __builtin_amdgcn_permlane16_swap(cvt_pk_bf16(o0[2], o0[3]), cvt_pk_bf16(o1[2], o1[3]), false, false); \
                u32x4 w; w.x = r0[0]; w.y = r1[0]; w.z = r0[1]; w.w = r1[1]; \
                *(u32x4*)(xb + off - 4 * fq + ucol + bj * HALF) = w; } } \
            q += __builtin_bit_cast(float, __builtin_amdgcn_ds_bpermute((l ^ 16) << 2, __builtin_bit_cast(int, q))); \
            q += __builtin_bit_cast(float, __builtin_amdgcn_ds_bpermute((l ^ 32) << 2, __builtin_bit_cast(int, q))); \
            if (fq == 0) atomicAdd(ss + row, (unsigned long long)__float2ll_rn(q * 16777216.0f)); } } while (0)
        ERN_LOAD(bsA, 0); ERN_LOAD(bsB, 1); asm volatile("" ::: "memory");
        ERN_DO(bsA, 0); asm volatile("" ::: "memory"); ERN_LOAD(bsA, 2); asm volatile("" ::: "memory");
        ERN_DO(bsB, 1); asm volatile("" ::: "memory"); ERN_LOAD(bsB, 3); asm volatile("" ::: "memory");
        ERN_DO(bsA, 2); asm volatile("" ::: "memory");
        ERN_DO(bsB, 3);
#undef ERN_LOAD
#undef ERN_DO
    }
};
struct EpiPart {
    static constexpr bool PERM = false, AFTER_DRAIN = false;
    float* P;
    __device__ __forceinline__ void operator()(const f32x4 (&acc)[2][2][4][2], const Unit& u, int wr, int wc, int fr, int fq) const {
#pragma unroll
        for (int ai = 0; ai < 2; ++ai)
#pragma unroll
            for (int m = 0; m < 4; ++m) { float* rowp = P + (size_t)(u.pm * BM + ai * HALF + wr * 64 + m * 16 + fr) * 128 + wc * 32 + 4 * fq;
#pragma unroll
                for (int n = 0; n < 2; ++n) *(f32x4*)(rowp + n * 16) = acc[ai][0][m][n]; }
    }
};
struct OneUnit {
    int pm, valid;
    __device__ __forceinline__ bool next(int i, Unit& u) const { if (i != 0 || !valid) return false; u.pm = pm; u.pn = 0; return true; }
    __device__ __forceinline__ void a_ready(const Unit&) const {}
    __device__ __forceinline__ void done(const Unit&) const {}
};
struct EpiNull {
    static constexpr bool PERM = true, AFTER_DRAIN = false;
    __device__ __forceinline__ void operator()(const f32x4 (&acc)[2][2][4][2], const Unit& u, int wr, int wc, int fr, int fq) const {
        float s = 0.f;
#pragma unroll
        for (int ai = 0; ai < 2; ++ai)
#pragma unroll
            for (int bj = 0; bj < 2; ++bj)
#pragma unroll
                for (int m = 0; m < 4; ++m)
#pragma unroll
                    for (int n = 0; n < 2; ++n) s += acc[ai][bj][m][n][0] + acc[ai][bj][m][n][1] + acc[ai][bj][m][n][2] + acc[ai][bj][m][n][3];
        if (s == 1.2345e-30f) asm volatile("s_nop 0" ::: "memory");
    }
};
template <class Epi, class Sched, bool ALIGN_EPI = false, bool SP2 = false>
__device__ __forceinline__ void gemm_phase(PG8_LAS unsigned char* lds, const Gemm g, const Sched& S, const Epi& E) {
    int tid_l_ = threadIdx.x; asm volatile("" : "+v"(tid_l_)); const int tid = tid_l_, wid = __builtin_amdgcn_readfirstlane(tid >> 6), lane = tid & 63, wr = wid >> 2, wc = wid & 3, fr = lane & 15, fq = lane >> 4;
    const int nt = g.K / BK, K = g.ld ? g.ld : g.K;
    unsigned voffA[2], voffB[2];
#pragma unroll
    for (int i = 0; i < 2; ++i) { int R, C; stage_rc(tid * 16 + i * 8192, R, C); const int Rb = Epi::PERM ? ((R & ~31) + perm32(R & 31)) : R;
        voffA[i] = (unsigned)(R * K + C) * 2u; voffB[i] = (unsigned)(Rb * K + C) * 2u; }
    const size_t kstep = (size_t)(BK * 2);
    const size_t hstep = (size_t)HALF * K * 2;
    const size_t tstep = 2 * hstep;
    const unsigned ldsw = (unsigned)wid * 1024u;
    const int aoff = lds_byte(wr * 64 + fr, fq * 8), boff = lds_byte(wc * 32 + fr, fq * 8);
#define PG8_SA(b, h) (((b) * 2 + (h)) * HTB)
#define PG8_SB(b, h) ((4 + (b) * 2 + (h)) * HTB)
#define PG8_STAGE(bufoff, gbase, voff) do { _Pragma("unroll") for (int _i = 0; _i < 2; ++_i) \
        __builtin_amdgcn_global_load_lds((const unsigned*)((const char*)(gbase) + (voff)[_i]), (PG8_LAS unsigned*)(lds + (bufoff) + ldsw + _i * 8192), 16, 0, 0); } while (0)
#define PG8_LDA(dst, b, h) do { _Pragma("unroll") for (int m = 0; m < 4; ++m) _Pragma("unroll") for (int k = 0; k < 2; ++k) dst[m][k] = *(const PG8_LAS bf16x8*)(lds + PG8_SA(b, h) + aoff + m * 2048 + k * 1024); } while (0)
#define PG8_LDB(dst, b, h) do { _Pragma("unroll") for (int n = 0; n < 2; ++n) _Pragma("unroll") for (int k = 0; k < 2; ++k) dst[n][k] = *(const PG8_LAS bf16x8*)(lds + PG8_SB(b, h) + boff + n * 2048 + k * 1024); } while (0)
#define PG8_MMA(ai, bj, At, Bt) do { __builtin_amdgcn_s_setprio(1); _Pragma("unroll") for (int m = 0; m < 4; ++m) _Pragma("unroll") for (int n = 0; n < 2; ++n) _Pragma("unroll") for (int k = 0; k < 2; ++k) \
        acc[ai][bj][m][n] = __builtin_amdgcn_mfma_f32_16x16x32_bf16(Bt[n][k], At[m][k], acc[ai][bj][m][n], 0, 0, 0); __builtin_amdgcn_s_setprio(0); } while (0)
#define PG8_WAIT_V(n) asm volatile("s_waitcnt vmcnt(" #n ")" ::: "memory")
#define PG8_WAIT_L(n) asm volatile("s_waitcnt lgkmcnt(" #n ")" ::: "memory")
#define PG8_BAR __builtin_amdgcn_s_barrier()
#define PG8_SCHED __builtin_amdgcn_sched_barrier(0)
    Unit cur, nxt; int ui = 0;
    if (!S.next(0, cur)) return;
    f32x4 acc[2][2][4][2];
#pragma unroll
    for (int a = 0; a < 2; ++a)
#pragma unroll
        for (int b = 0; b < 2; ++b)
#pragma unroll
            for (int m = 0; m < 4; ++m)
#pragma unroll
                for (int n = 0; n < 2; ++n) acc[a][b][m][n] = (f32x4){0.f, 0.f, 0.f, 0.f};
    bf16x8 At[4][2], B0[2][2], B1[2][2];
    const char* cA = (const char*)g.A + (size_t)cur.pm * tstep; const char* cB = (const char*)g.Bt + (size_t)cur.pn * tstep;
    if constexpr (epi_pf<Epi>::v) E.prefetch(cur, 0, wid, lane);
    S.a_ready(cur);
    if constexpr (SP2) {
        PG8_STAGE(PG8_SB(0, 0), cB, voffB); PG8_STAGE(PG8_SB(0, 1), cB + hstep, voffB); PG8_STAGE(PG8_SA(0, 0), cA, voffA); PG8_STAGE(PG8_SA(0, 1), cA + hstep, voffA);
        if (wr == 1) PG8_BAR;
        PG8_WAIT_V(2); PG8_BAR;
        PG8_STAGE(PG8_SB(1, 0), cB + kstep, voffB); PG8_STAGE(PG8_SA(1, 0), cA + kstep, voffA); PG8_STAGE(PG8_SB(1, 1), cB + hstep + kstep, voffB);
        PG8_WAIT_V(6); PG8_BAR;
    } else {
        PG8_STAGE(PG8_SB(0, 0), cB, voffB); PG8_STAGE(PG8_SA(0, 0), cA, voffA); PG8_STAGE(PG8_SB(0, 1), cB + hstep, voffB); PG8_STAGE(PG8_SA(0, 1), cA + hstep, voffA);
        if (wr == 1) PG8_BAR;
        PG8_WAIT_V(4); PG8_BAR;
        PG8_STAGE(PG8_SB(1, 0), cB + kstep, voffB); PG8_STAGE(PG8_SA(1, 0), cA + kstep, voffA); PG8_STAGE(PG8_SB(1, 1), cB + hstep + kstep, voffB);
        PG8_WAIT_V(6); PG8_BAR;
    }
    for (;;) {
        const bool has_next = S.next(ui + 1, nxt);
        const char* nA = has_next ? (const char*)g.A + (size_t)nxt.pm * tstep : cA; const char* nB = has_next ? (const char*)g.Bt + (size_t)nxt.pn * tstep : cB;
        for (int t = 0; t < nt; t += 2) {
            const bool last = (t == nt - 2);
            const char* a1 = cA + (size_t)(t + 1) * kstep;
            const char* a2 = last ? nA : cA + (size_t)(t + 2) * kstep; const char* b2 = last ? nB : cB + (size_t)(t + 2) * kstep;
            const char* a3 = a2 + kstep; const char* b3 = b2 + kstep;
            if (last && has_next) S.a_ready(nxt);
            if constexpr (SP2) {
            PG8_LDB(B0, 0, 0); PG8_LDB(B1, 0, 1); PG8_SCHED; PG8_LDA(At, 0, 0); PG8_STAGE(PG8_SA(1, 1), a1 + hstep, voffA);
            PG8_WAIT_V(8); PG8_WAIT_L(0); PG8_BAR; PG8_MMA(0, 0, At, B0); PG8_MMA(0, 1, At, B1); PG8_BAR; PG8_SCHED;
            PG8_LDA(At, 0, 1); PG8_STAGE(PG8_SB(0, 0), b2, voffB); PG8_STAGE(PG8_SB(0, 1), b2 + hstep, voffB); PG8_STAGE(PG8_SA(0, 0), a2, voffA);
            PG8_WAIT_V(8); PG8_WAIT_L(0); PG8_BAR; PG8_MMA(1, 0, At, B0); PG8_MMA(1, 1, At, B1); PG8_BAR; PG8_SCHED;
            PG8_LDB(B0, 1, 0); PG8_LDB(B1, 1, 1); PG8_SCHED; PG8_LDA(At, 1, 0); PG8_STAGE(PG8_SA(0, 1), a2 + hstep, voffA);
            PG8_WAIT_V(8); PG8_WAIT_L(0); PG8_BAR; PG8_MMA(0, 0, At, B0); PG8_MMA(0, 1, At, B1); PG8_BAR; PG8_SCHED;
            PG8_LDA(At, 1, 1); PG8_STAGE(PG8_SB(1, 0), b3, voffB); PG8_STAGE(PG8_SB(1, 1), b3 + hstep, voffB); PG8_STAGE(PG8_SA(1, 0), a3, voffA);
            PG8_WAIT_V(8); PG8_WAIT_L(0); PG8_BAR; PG8_MMA(1, 0, At, B0); PG8_MMA(1, 1, At, B1); PG8_BAR; PG8_SCHED;
            } else {
            PG8_LDB(B0, 0, 0); PG8_SCHED; PG8_LDA(At, 0, 0); PG8_STAGE(PG8_SA(1, 1), a1 + hstep, voffA);
            PG8_WAIT_L(8); PG8_BAR; PG8_WAIT_L(0); PG8_MMA(0, 0, At, B0); PG8_BAR; PG8_SCHED;
            PG8_LDB(B1, 0, 1); PG8_STAGE(PG8_SB(0, 0), b2, voffB);
            PG8_BAR; PG8_WAIT_L(0); PG8_MMA(0, 1, At, B1); PG8_BAR;
            PG8_LDA(At, 0, 1); PG8_STAGE(PG8_SA(0, 0), a2, voffA);
            PG8_BAR; PG8_WAIT_L(0); PG8_MMA(1, 0, At, B0); PG8_BAR; PG8_SCHED;
            PG8_STAGE(PG8_SB(0, 1), b2 + hstep, voffB);
            PG8_WAIT_V(6); PG8_BAR; PG8_MMA(1, 1, At, B1); PG8_BAR;
            PG8_LDB(B0, 1, 0); PG8_SCHED; PG8_LDA(At, 1, 0); PG8_STAGE(PG8_SA(0, 1), a2 + hstep, voffA);
            PG8_WAIT_L(8); PG8_BAR; PG8_WAIT_L(0); PG8_MMA(0, 0, At, B0); PG8_BAR; PG8_SCHED;
            PG8_LDB(B1, 1, 1); PG8_STAGE(PG8_SB(1, 0), b3, voffB);
            PG8_BAR; PG8_WAIT_L(0); PG8_MMA(0, 1, At, B1); PG8_BAR;
            PG8_LDA(At, 1, 1); PG8_STAGE(PG8_SA(1, 0), a3, voffA);
            PG8_BAR; PG8_WAIT_L(0); PG8_MMA(1, 0, At, B0); PG8_BAR; PG8_SCHED;
            PG8_STAGE(PG8_SB(1, 1), b3 + hstep, voffB);
            PG8_WAIT_V(6); PG8_BAR; PG8_MMA(1, 1, At, B1); PG8_BAR;
            }
        }
        if constexpr (ALIGN_EPI) { if (wr == 0) PG8_BAR; }
        if constexpr (epi_pf<Epi>::v) { if (has_next) E.prefetch(nxt, (ui + 1) & 1, wid, lane); E.run(acc, cur, ui & 1, wr, wc, fr, fq); S.done(cur); } else
        if constexpr (!Epi::AFTER_DRAIN) { E(acc, cur, wr, wc, fr, fq); S.done(cur); }
        if (!has_next) break;
#pragma unroll
        for (int a = 0; a < 2; ++a)
#pragma unroll
            for (int b = 0; b < 2; ++b)
#pragma unroll
                for (int m = 0; m < 4; ++m)
#pragma unroll
                    for (int n = 0; n < 2; ++n) acc[a][b][m][n] = (f32x4){0.f, 0.f, 0.f, 0.f};
        cur = nxt; cA = nA; cB = nB; ++ui;
        if constexpr (ALIGN_EPI) { if (wr == 1) PG8_BAR; }
    }
    PG8_WAIT_V(0);
    if constexpr (!ALIGN_EPI) { if (wr == 0) PG8_BAR; }
    PG8_BAR;
    if constexpr (Epi::AFTER_DRAIN) { E.fused(acc, cur, wr, wc, fr, fq, lds, wid, lane); S.done(cur); }
#undef PG8_SA
#undef PG8_SB
#undef PG8_STAGE
#undef PG8_LDA
#undef PG8_LDB
#undef PG8_MMA
#undef PG8_WAIT_V
#undef PG8_WAIT_L
#undef PG8_BAR
#undef PG8_SCHED
}
}

#ifndef PG8_SP2
#define PG8_SP2 true
#endif
#ifndef PG8_ALIGN
#define PG8_ALIGN true
#endif

namespace att {
constexpr int D = 128;
constexpr float SCALE = 0.08838834764831845f;
constexpr float THR = 8.f;
constexpr bool WSKIP = false;
constexpr int NW = 8, QBLK = 32, KVBLK = 64, QB = NW * QBLK;
constexpr int SHM_V = KVBLK * D * 2, SHM_K = KVBLK * D * 2;
constexpr int LDS_BYTES = 2 * SHM_V + 2 * SHM_K + NW * 64 * 4;
typedef unsigned short bf16;
typedef short bf16x8 __attribute__((ext_vector_type(8)));
typedef short s16x4 __attribute__((ext_vector_type(4)));
typedef float f32x16 __attribute__((ext_vector_type(16)));
typedef float f32x4 __attribute__((ext_vector_type(4)));
typedef unsigned u32x4 __attribute__((ext_vector_type(4)));
template <class A, class Bt> struct same_t { static constexpr bool v = false; };
template <class A> struct same_t<A, A> { static constexpr bool v = true; };

#define KSWZ(row, colB) ((row) * 256 + ((colB) ^ (((row) & 7) << 4)))
#define SBAR() __builtin_amdgcn_sched_barrier(0)
__device__ __forceinline__ int v_st(int k, int c) { const int kk = (k & ~0xC) | ((k & 4) << 1) | ((k & 8) >> 1); return ((kk >> 3) * 4 + (c >> 5)) * 512 + ((kk & 7) * 32 + (c & 31)) * 2; }
__device__ __forceinline__ int v_rd_base(int lane) { return ((lane & 3) << 3) | (((lane >> 2) & 3) << 6) | (((lane >> 4) & 1) << 5) | (((lane >> 5) & 1) << 8); }
constexpr int v_rd_off(int d0, int ks, int half) { return d0 * 512 + ks * 4096 + half * 2048; }
__device__ __forceinline__ int crow(int r, int hi) { return (r & 3) + 8 * (r >> 2) + 4 * hi; }
typedef float f32x2a __attribute__((ext_vector_type(2))); typedef __bf16 bf16x2a __attribute__((ext_vector_type(2)));
__device__ __forceinline__ unsigned cvtpk(float lo, float hi) { const f32x2a v = {lo, hi}; return __builtin_bit_cast(unsigned, __builtin_convertvector(v, bf16x2a)); }
__device__ __forceinline__ bf16x8 pack8(f32x4 a, f32x4 b) {
    u32x4 w = {cvtpk(a[0], a[1]), cvtpk(a[2], a[3]), cvtpk(b[0], b[1]), cvtpk(b[2], b[3])};
    return *reinterpret_cast<bf16x8*>(&w);
}
template <class T> __device__ __forceinline__ bf16x8 load8(const T* p) {
    if constexpr (same_t<T, float>::v) { return pack8(*(const f32x4*)p, *(const f32x4*)(p + 4)); }
    else { return *reinterpret_cast<const bf16x8*>(p); }
}
__device__ __forceinline__ void mask_tile(f32x16& p0, f32x16& p1, int dq, unsigned W) {
    const float NEG = -__builtin_inff();
#pragma unroll
    for (int r = 0; r < 16; ++r) {
        const int c = (r & 3) + 8 * (r >> 2);
        if ((unsigned)(dq - c) >= W) p0[r] = NEG;
        if ((unsigned)(dq - c - 32) >= W) p1[r] = NEG;
    }
}
__device__ __forceinline__ void partialSM(f32x16& p0, f32x16& p1, float& m_reg, float& mn, float& alpha) {
    float pmax = p0[0]; for (int r = 1; r < 16; ++r) pmax = fmaxf(pmax, p0[r]); for (int r = 0; r < 16; ++r) pmax = fmaxf(pmax, p1[r]);
    { auto rr = __builtin_amdgcn_permlane32_swap(__float_as_uint(pmax), __float_as_uint(pmax), false, false);
      pmax = fmaxf(__uint_as_float(rr[0]), __uint_as_float(rr[1])); }
    constexpr float C2 = 1.4426950408889634f * SCALE;
    if (__builtin_expect(__all((pmax - m_reg) * SCALE <= THR), 1)) { mn = m_reg; alpha = 1.f; }
    else { mn = fmaxf(m_reg, pmax); alpha = __builtin_amdgcn_exp2f((m_reg - mn) * C2); m_reg = mn; }
    const float mnL = -mn * C2;
    for (int r = 0; r < 16; ++r) p0[r] = fmaf(p0[r], C2, mnL); for (int r = 0; r < 16; ++r) p1[r] = fmaf(p1[r], C2, mnL);
    for (int r = 0; r < 16; ++r) p0[r] = __builtin_amdgcn_exp2f(p0[r]);
}
__device__ __forceinline__ void finishSM(f32x16& p0, f32x16& p1, float alpha, float& l_reg, bf16x8& pa0, bf16x8& pa1, bf16x8& pa2, bf16x8& pa3) {
    for (int r = 0; r < 16; ++r) p1[r] = __builtin_amdgcn_exp2f(p1[r]);
    float ps = 0; for (int r = 0; r < 16; ++r) ps += p0[r]; for (int r = 0; r < 16; ++r) ps += p1[r];
    { auto rr = __builtin_amdgcn_permlane32_swap(__float_as_uint(ps), __float_as_uint(ps), false, false);
      ps = __uint_as_float(rr[0]) + __uint_as_float(rr[1]); }
    l_reg = l_reg * alpha + ps;
#define PK4(P, B_, OUT) do { unsigned a0 = cvtpk(P[B_+0], P[B_+1]), a1 = cvtpk(P[B_+2], P[B_+3]);                          \
        unsigned b0 = cvtpk(P[B_+4], P[B_+5]), b1 = cvtpk(P[B_+6], P[B_+7]);                                             \
        auto r0 = __builtin_amdgcn_permlane32_swap(a0, b0, false, false); auto r1 = __builtin_amdgcn_permlane32_swap(a1, b1, false, false); \
        u32x4 w = {r0[0], r1[0], r0[1], r1[1]}; OUT = *reinterpret_cast<bf16x8*>(&w); } while (0)
    PK4(p0, 0, pa0); PK4(p0, 8, pa1); PK4(p1, 0, pa2); PK4(p1, 8, pa3);
#undef PK4
}
template <int KB, bool SK>
__device__ __forceinline__ void qkt(f32x16& p0, f32x16& p1, const char* K_lds, int r32, int hi, const bf16x8* qr, bool act) {
    if (SK && !act) { const float NEG = -__builtin_inff();
#pragma unroll
        for (int r = 0; r < 16; ++r) { p0[r] = NEG; p1[r] = NEG; } return; }
    p0 = f32x16{}; p1 = f32x16{};
    const char* kb[4];
#pragma unroll
    for (int dd = 0; dd < 4; ++dd) kb[dd] = K_lds + KB * SHM_K + KSWZ(r32, (dd * 16 + hi * 8) * 2);
#pragma unroll
    for (int d0 = 0; d0 < 8; ++d0) { const char* a = kb[d0 & 3] + (d0 >> 2) * 128;
        bf16x8 b0 = *reinterpret_cast<const bf16x8*>(a);
        bf16x8 b1 = *reinterpret_cast<const bf16x8*>(a + 32 * 256);
        p0 = __builtin_amdgcn_mfma_f32_32x32x16_bf16(b0, qr[d0], p0, 0, 0, 0);
        p1 = __builtin_amdgcn_mfma_f32_32x32x16_bf16(b1, qr[d0], p1, 0, 0, 0); }
}
template <int VB, bool SK>
__device__ __forceinline__ void pv_tile(f32x16* o, int vb0, bf16x8 pa0, bf16x8 pa1, bf16x8 pa2, bf16x8 pa3, bool act) {
    if (SK && !act) return;
#define TRRD(dst, off) asm volatile("ds_read_b64_tr_b16 %0, %1 offset:%2" : "=&v"(dst) : "v"(vb0), "i"(off) : "memory")
#define PV_D0(d0) do { s16x4 l0, l1, l2, l3, h0, h1, h2, h3; constexpr int b_ = VB * SHM_V + v_rd_off(d0, 0, 0);     \
        TRRD(l0, b_); TRRD(h0, b_ + 2048); TRRD(l1, b_ + 4096); TRRD(h1, b_ + 6144); TRRD(l2, b_ + 8192); TRRD(h2, b_ + 10240); TRRD(l3, b_ + 12288); TRRD(h3, b_ + 14336); \
        asm volatile("s_waitcnt lgkmcnt(0)" ::: "memory"); SBAR();                 \
        o[d0] = __builtin_amdgcn_mfma_f32_32x32x16_bf16(pa0, (bf16x8){l0[0], l0[1], l0[2], l0[3], h0[0], h0[1], h0[2], h0[3]}, o[d0], 0, 0, 0);   \
        o[d0] = __builtin_amdgcn_mfma_f32_32x32x16_bf16(pa1, (bf16x8){l1[0], l1[1], l1[2], l1[3], h1[0], h1[1], h1[2], h1[3]}, o[d0], 0, 0, 0);   \
        o[d0] = __builtin_amdgcn_mfma_f32_32x32x16_bf16(pa2, (bf16x8){l2[0], l2[1], l2[2], l2[3], h2[0], h2[1], h2[2], h2[3]}, o[d0], 0, 0, 0);   \
        o[d0] = __builtin_amdgcn_mfma_f32_32x32x16_bf16(pa3, (bf16x8){l3[0], l3[1], l3[2], l3[3], h3[0], h3[1], h3[2], h3[3]}, o[d0], 0, 0, 0); } while (0)
    PV_D0(0); PV_D0(1); PV_D0(2); PV_D0(3);
#undef PV_D0
#undef TRRD
}

template <class TIn, class TOut> struct BlockRef { const TIn* Q; const TIn* K; const TIn* V; TOut* O; int P0; };
template <class TIn> struct Seam {
    bf16x8 qr[8];
    bf16x8 st_v0, st_v1, st_k0, st_k1; f32x4 sf0, sf1, sf2, sf3;
    f32x4 tq[16];
};
__device__ __forceinline__ int swa_jlo(int P0, int W) { const int lowk = P0 - W + 1; return lowk > 0 ? lowk / KVBLK : 0; }
#define ROW(p, k0, rr) ((p) + (size_t)((k0) + (rr)) * D + sc)
#define VMW() asm volatile("s_waitcnt vmcnt(0)" ::: "memory")
#define VMWN(n) asm volatile("s_waitcnt vmcnt(%0)" :: "i"(n) : "memory")
#define SLOAD_H(Kp, Vp, k0) do { S.st_v0 = load8<TIn>(ROW(Vp, k0, sr)); S.st_v1 = load8<TIn>(ROW(Vp, k0, 32 + sr));              \
                         S.st_k0 = load8<TIn>(ROW(Kp, k0, sr)); S.st_k1 = load8<TIn>(ROW(Kp, k0, 32 + sr)); } while (0)
#define SWRITE_HK(bf) do { *(bf16x8*)(K_lds + (bf) * SHM_K + kws) = S.st_k0; *(bf16x8*)(K_lds + (bf) * SHM_K + kws + 32 * 256) = S.st_k1; } while (0)
#define SWRITE_HV(bf) do { *(bf16x8*)(V_lds + (bf) * SHM_V + vst0) = S.st_v0; *(bf16x8*)(V_lds + (bf) * SHM_V + vst1) = S.st_v1; } while (0)
#define SWRITE_H(bf) do { SWRITE_HV(bf); SWRITE_HK(bf); } while (0)
#define SLOAD_F(p, k0) do { S.sf0 = *(const f32x4*)ROW(p, k0, sr); S.sf1 = *(const f32x4*)(ROW(p, k0, sr) + 4);                \
                            S.sf2 = *(const f32x4*)ROW(p, k0, 32 + sr); S.sf3 = *(const f32x4*)(ROW(p, k0, 32 + sr) + 4); } while (0)
#define SWRITE_KF(bf) do { *(bf16x8*)(K_lds + (bf) * SHM_K + kws) = pack8(S.sf0, S.sf1); *(bf16x8*)(K_lds + (bf) * SHM_K + kws + 32 * 256) = pack8(S.sf2, S.sf3); } while (0)
#define SWRITE_VF(bf) do { *(bf16x8*)(V_lds + (bf) * SHM_V + vst0) = pack8(S.sf0, S.sf1); *(bf16x8*)(V_lds + (bf) * SHM_V + vst1) = pack8(S.sf2, S.sf3); } while (0)
template <class TIn, class TOut>
__device__ __forceinline__ void causal_swa_prime(const BlockRef<TIn, TOut>& cur, int W, char* lds, Seam<TIn>& S) {
    constexpr bool F32 = same_t<TIn, float>::v;
    int tid_l_ = threadIdx.x; asm volatile("" : "+v"(tid_l_)); const int tid = tid_l_, wid = __builtin_amdgcn_readfirstlane(tid >> 6), lane = tid & 63, r32 = lane & 31, hi = lane >> 5;
    const int sr = tid >> 4, sc = (tid & 15) * 8, kws = KSWZ(sr, sc * 2); char* K_lds = lds + 2 * SHM_V;
    const int kb0 = swa_jlo(cur.P0, W) * KVBLK;
    for (int d0 = 0; d0 < 8; ++d0) S.qr[d0] = load8<TIn>(cur.Q + (size_t)(wid * QBLK + r32) * D + d0 * 16 + hi * 8);
    if constexpr (F32) { SLOAD_F((const float*)cur.K, kb0); VMW(); SWRITE_KF(0); SBAR(); SLOAD_F((const float*)cur.V, kb0); }
    else { SLOAD_H(cur.K, cur.V, kb0); VMW(); SWRITE_HK(0); }
    __syncthreads();
}
template <class TIn, class TOut>
__device__ __forceinline__ void causal_swa_block(const BlockRef<TIn, TOut>& cur, const BlockRef<TIn, TOut>& nxt, int skv, int W, char* lds, Seam<TIn>& S) {
    constexpr bool F32 = same_t<TIn, float>::v;
    int tid_l_ = threadIdx.x; asm volatile("" : "+v"(tid_l_)); const int tid = tid_l_, wid = __builtin_amdgcn_readfirstlane(tid >> 6), lane = tid & 63, r32 = lane & 31, hi = lane >> 5;
    const int j_lo = swa_jlo(cur.P0, W);
    int j_hi = (cur.P0 + QB - 1) / KVBLK + 1; if (j_hi > skv / KVBLK) j_hi = skv / KVBLK;
    const int NT = j_hi - j_lo;
    const int kbn = swa_jlo(nxt.P0, W) * KVBLK;
    const int qlo = cur.P0 + wid * QBLK, qm = qlo + r32 - 4 * hi;
    char* V_lds = lds; char* K_lds = lds + 2 * SHM_V;
    float* ws = (float*)(lds + 2 * SHM_V + 2 * SHM_K) + wid * 64; float* li_l = ws, * al_l = ws + 32;
    float m_reg = -1e30f, l_reg = 0; f32x16 o[4] = {};
    const int sr = tid >> 4, sc = (tid & 15) * 8, vst0 = v_st(sr, sc), vst1 = v_st(32 + sr, sc), kws = KSWZ(sr, sc * 2);
    const int vb0 = (int)(uintptr_t)V_lds + v_rd_base(lane);
    const TIn* Kh = cur.K; const TIn* Vh = cur.V;
#define RESC(a) do { if (__any((a) < 1.f)) { if (hi == 0) al_l[r32] = (a); asm volatile("s_waitcnt lgkmcnt(0)" ::: "memory");              \
                     for (int d_ = 0; d_ < 4; ++d_) for (int r = 0; r < 16; ++r) o[d_][r] *= al_l[crow(r, hi)]; } } while (0)
#define KBASE(t) ((j_lo + (t)) * KVBLK)
#define ACT(t) (KBASE(t) <= qlo + QBLK - 1 && KBASE(t) + KVBLK - 1 >= qlo - W + 1)
#define MASKT(P0_, P1_, t) do { const int kb_ = KBASE(t); if ((!SK || ACT(t)) && (kb_ + KVBLK - 1 > qlo || kb_ <= qlo + QBLK - 1 - W)) mask_tile(P0_, P1_, qm - kb_, (unsigned)W); } while (0)
    constexpr int NQL = F32 ? 16 : 8;
    constexpr bool SK = WSKIP && !F32;
#define SEAM_K0() do { VMWN(NQL); if constexpr (F32) { SWRITE_KF(0); SBAR(); SLOAD_F((const float*)nxt.V, kbn); } else { SWRITE_HK(0); } SBAR(); } while (0)
    f32x16 pA0, pA1, pB0, pB1; float mnA, mnB, alA, alB; bf16x8 pa0, pa1, pa2, pa3;
    if constexpr (F32) { VMW(); SWRITE_VF(0); SBAR(); } else { SWRITE_HV(0); SBAR(); }
    if (NT > 1) { if constexpr (F32) SLOAD_F((const float*)Kh, KBASE(1)); else SLOAD_H(Kh, Vh, KBASE(1)); }
    SBAR(); qkt<0, SK>(pA0, pA1, K_lds, r32, hi, S.qr, ACT(0));
    if constexpr (F32) { if (NT > 1) { VMW(); SWRITE_KF(1); SBAR(); SLOAD_F((const float*)Vh, KBASE(1)); } }
    MASKT(pA0, pA1, 0); partialSM(pA0, pA1, m_reg, mnA, alA);
    if (NT > 1) { VMW(); if constexpr (F32) { SWRITE_VF(1); SBAR(); if (NT > 2) SLOAD_F((const float*)Kh, KBASE(2)); } else SWRITE_H(1); }
    __syncthreads();
#define HALF_STEP(PX0, PX1, mnX, alX, PY0, PY1, alY, t, KB, VB, SB) do {                                                      \
        SBAR(); qkt<KB, SK>(PX0, PX1, K_lds, r32, hi, S.qr, ACT(t));                                             \
        finishSM(PY0, PY1, alY, l_reg, pa0, pa1, pa2, pa3); SBAR();                                                           \
        if ((t) + 1 < NT) { if constexpr (F32) { VMW(); SWRITE_KF(SB); SBAR(); SLOAD_F((const float*)Vh, KBASE((t) + 1)); }  \
                            else { SLOAD_H(Kh, Vh, KBASE((t) + 1)); } SBAR(); }                                               \
        pv_tile<VB, SK>(o, vb0, pa0, pa1, pa2, pa3, ACT((t) - 1)); MASKT(PX0, PX1, (t)); partialSM(PX0, PX1, m_reg, mnX, alX);                                        \
        __syncthreads();                                                                                                      \
        if ((t) + 1 < NT) { VMW(); if constexpr (F32) { SWRITE_VF(SB); SBAR(); if ((t) + 2 < NT) SLOAD_F((const float*)Kh, KBASE((t) + 2)); } \
                            else { SWRITE_H(SB); } }                                                                          \
        RESC(alX); __syncthreads(); } while (0)
    for (int t = 1; t + 1 < NT; t += 2) {
        HALF_STEP(pB0, pB1, mnB, alB, pA0, pA1, alA, t, 1, 0, 0);
        HALF_STEP(pA0, pA1, mnA, alA, pB0, pB1, alB, t + 1, 0, 1, 1);
    }
    const bool even = (NT & 1) == 0;
    if (even) { SBAR(); qkt<1, SK>(pB0, pB1, K_lds, r32, hi, S.qr, ACT(NT - 1)); SBAR(); }
#define QROW(e) (nxt.Q + (size_t)(wid * QBLK + r32) * D + ((e) >> 1) * 16 + hi * 8 + ((e) & 1) * 4)
    if constexpr (F32) { SLOAD_F((const float*)nxt.K, kbn); SBAR();
#pragma unroll
        for (int e = 0; e < 8; ++e) S.tq[e] = *(const f32x4*)QROW(e); }
    else { SLOAD_H(nxt.K, nxt.V, kbn); SBAR();
#pragma unroll
        for (int d0 = 0; d0 < 8; ++d0) S.qr[d0] = load8<TIn>(nxt.Q + (size_t)(wid * QBLK + r32) * D + d0 * 16 + hi * 8); }
    SBAR();
    finishSM(pA0, pA1, alA, l_reg, pa0, pa1, pa2, pa3); SBAR();
    if constexpr (F32) {
#pragma unroll
        for (int e = 8; e < 16; ++e) S.tq[e] = *(const f32x4*)QROW(e); SBAR(); }
#undef QROW
    pv_tile<0, SK>(o, vb0, pa0, pa1, pa2, pa3, ACT(even ? NT - 2 : NT - 1));
    if (even) { MASKT(pB0, pB1, NT - 1); partialSM(pB0, pB1, m_reg, mnB, alB); __syncthreads(); RESC(alB);
        finishSM(pB0, pB1, alB, l_reg, pa0, pa1, pa2, pa3); SBAR(); pv_tile<1, SK>(o, vb0, pa0, pa1, pa2, pa3, ACT(NT - 1)); }
    SBAR(); SEAM_K0();
    if (hi == 0) li_l[r32] = l_reg; asm volatile("s_waitcnt lgkmcnt(0)" ::: "memory");
    float rli[16];
#pragma unroll
    for (int r = 0; r < 16; ++r) rli[r] = __builtin_amdgcn_rcpf(li_l[crow(r, hi)]);
    TOut* Ow = cur.O + (size_t)(wid * QBLK) * D;
#pragma unroll
    for (int r = 0; r < 16; ++r) { const int orow = crow(r, hi);
#pragma unroll
        for (int d0 = 0; d0 < 4; ++d0) { const float v = o[d0][r] * rli[r];
            if constexpr (same_t<TOut, float>::v) { Ow[(size_t)orow * D + d0 * 32 + r32] = v; }
            else { const float vn = __shfl_xor(v, 1);
                   if ((r32 & 1) == 0) *(unsigned*)(Ow + (size_t)orow * D + d0 * 32 + r32) = cvtpk(v, vn); } } }
    if constexpr (F32) {
#pragma unroll
        for (int d0 = 0; d0 < 8; ++d0) S.qr[d0] = pack8(S.tq[2 * d0], S.tq[2 * d0 + 1]); }
    __syncthreads();
#undef RESC
#undef KBASE
#undef ACT
#undef MASKT
#undef SEAM_K0
#undef HALF_STEP
}
#undef ROW
#undef VMW
#undef VMWN
#undef SLOAD_H
#undef SWRITE_HK
#undef SWRITE_HV
#undef SWRITE_H
#undef SLOAD_F
#undef SWRITE_KF
#undef SWRITE_VF
}

namespace mk {
constexpr int NWAVES = 8, NTHR = 512;
constexpr int BATCH = 2, SEQ = 4096, M = BATCH * SEQ, DM = 4096;
constexpr int DI = 8192, NHEAD = 128, HDIM = 64, NGRP = 8, NST = 128, CONVD = 10240, NCHUNK = 32;
constexpr int NZX = 18560, NZXP = 18688, ZX_XBC = 8192, ZX_DT = 18432, NZXM = 18432;
constexpr int DFF = 11008, NUP = 22016;
constexpr int NQKV = 12288, AH = 16;
constexpr float EPS = 1e-5f;

constexpr size_t MiB = 1u << 20;
constexpr size_t WS_CTL = 0, CTL_ZERO_BYTES = 1 * MiB;
constexpr size_t WS_ROPE = 2 * MiB;
constexpr size_t WS_W = 8 * MiB;
constexpr size_t WL_MAMBA = 468 * MiB, WL_ATTN = 386 * MiB;
constexpr size_t W_IN = 0, W_OUT = 146 * MiB, W_UP_M = 210 * MiB, W_DOWN_M = 382 * MiB;
constexpr size_t W_QKV = 0, W_O = 96 * MiB, W_UP_A = 128 * MiB, W_DOWN_A = 300 * MiB;
constexpr size_t WS_XR = 1716 * MiB;
constexpr size_t WS_U = 1844 * MiB;
constexpr size_t WS_BIG = 1908 * MiB;
constexpr size_t WS_ACT2 = 2252 * MiB;
constexpr size_t WS_XT = 2424 * MiB;
constexpr size_t WS_Y = 2552 * MiB;
constexpr size_t WS_BN = 2680 * MiB, WS_BT = 2696 * MiB, WS_CN = 2712 * MiB, WS_DTF = 2728 * MiB;
constexpr size_t WS_PART = 2732 * MiB;
constexpr size_t WS_END = 2764 * MiB;
constexpr int CW_TMO = 0, CW_CODE = 1, CW_BAR = 4096;
constexpr int CW_SS = 65536;
static_assert((CW_SS + 9 * M * 2) * 4 <= (int)CTL_ZERO_BYTES, "norm statistics inside the memset region");

constexpr int RING_OFF = 0, RING_BYTES = 131072 + 16384;
constexpr int TAB_OFF = 131072, TAB_TILES = 16;
constexpr int LDSCTL_OFF = RING_BYTES, MISC_OFF = LDSCTL_OFF + 320;
constexpr int SIDE_OFF = RING_BYTES + 1024, LDS_BYTES = SIDE_OFF + 12288;
static_assert(MISC_OFF + 128 <= LDS_BYTES, "LDS map");

#define GAS __attribute__((address_space(1)))
#define LAS __attribute__((address_space(3)))
typedef unsigned short bf16;
typedef unsigned v4u __attribute__((ext_vector_type(4)));
typedef unsigned v2u __attribute__((ext_vector_type(2)));
typedef float f32x4 __attribute__((ext_vector_type(4)));
typedef float f32x2 __attribute__((ext_vector_type(2)));
typedef float f32x16 __attribute__((ext_vector_type(16)));
typedef short bf16x8 __attribute__((ext_vector_type(8)));
typedef GAS unsigned gu32;
#define RLX_AGENT __ATOMIC_RELAXED, __HIP_MEMORY_SCOPE_AGENT
#define LDS_WAIT() asm volatile("s_waitcnt lgkmcnt(0)" ::: "memory")
#define VM_WAIT() asm volatile("s_waitcnt vmcnt(0)" ::: "memory")
__device__ __forceinline__ unsigned f2bf(float f) { unsigned u = __builtin_bit_cast(unsigned, f); return (u + 0x7fffu + ((u >> 16) & 1u)) >> 16; }
typedef __bf16 bf16x2_t __attribute__((ext_vector_type(2)));
__device__ __forceinline__ unsigned pk2(float lo, float hi) { const f32x2 v = {lo, hi}; return __builtin_bit_cast(unsigned, __builtin_convertvector(v, bf16x2_t)); }
__device__ __forceinline__ float bf_lo(unsigned w) { return __builtin_bit_cast(float, w << 16); }
__device__ __forceinline__ float bf_hi(unsigned w) { return __builtin_bit_cast(float, w & 0xffff0000u); }
__device__ __forceinline__ float bf1(bf16 h) { return __builtin_bit_cast(float, (unsigned)h << 16); }
__device__ __forceinline__ float silu_f(float a) { return a * __builtin_amdgcn_rcpf(1.f + __expf(-a)); }

#define XB_TMO      128
#define XB_XCNT(j)  (256  + 64 * (j))
#define XB_XSUB(j)  (1280 + 64 * (j))
#define XB_XGEN(j)  (2304 + 64 * (j))
#define XB_TOP      3328
#define XB_TOPGEN   3392
#define XCD_BAR_WORDS 3456
#define XB_SPIN_CAP (1u << 18)
__device__ __forceinline__ unsigned xb_ld(unsigned* p)              { return __hip_atomic_load(p, __ATOMIC_RELAXED, __HIP_MEMORY_SCOPE_AGENT); }
__device__ __forceinline__ unsigned xb_add(unsigned* p, unsigned v) { return __hip_atomic_fetch_add(p, v, __ATOMIC_RELAXED, __HIP_MEMORY_SCOPE_AGENT); }
__device__ __forceinline__ unsigned xb_xcc_id() { return (unsigned)__builtin_amdgcn_s_getreg((3 << 11) | 20) & 0xFu; }
#define XB_SPIN(cond, bar) do { unsigned _sp = 0; while (cond) { __builtin_amdgcn_s_sleep(1); \
    if ((++_sp & 255u) == 0u) { if (xb_ld(&(bar)[XB_TMO])) break; if (_sp > XB_SPIN_CAP) { atomicAdd(&(bar)[XB_TMO], 1u); break; } } } } while (0)
struct XcdBarrier { unsigned* bar; unsigned x; volatile LAS unsigned* st; };
__device__ __forceinline__ XcdBarrier xcd_barrier_post(unsigned* bar, volatile LAS unsigned* st) {
    XcdBarrier b; b.bar = bar; b.x = xb_xcc_id(); b.st = st;
    if (threadIdx.x == 0) (void)xb_add(&bar[XB_XCNT(b.x)], 1u);
    return b;
}
__device__ __forceinline__ void xcd_barrier_complete(unsigned* bar, unsigned x, unsigned& nloc, unsigned& nx) {
    const unsigned G = gridDim.x * gridDim.y * gridDim.z;
    unsigned sum, cnt, mine, sp = 0u;
    for (;;) {
        sum = 0u; cnt = 0u; mine = 0u;
#pragma unroll
        for (unsigned j = 0; j < 16; ++j) { const unsigned c = xb_ld(&bar[XB_XCNT(j)]); sum += c; cnt += (c > 0u) ? 1u : 0u; mine = (j == x) ? c : mine; }
        if (sum == G) break;
        __builtin_amdgcn_s_sleep(1);
        if ((++sp & 255u) == 0u) { if (xb_ld(&bar[XB_TMO])) break; if (sp > XB_SPIN_CAP) { atomicAdd(&bar[XB_TMO], 1u); break; } }
    }
    nloc = mine > 0u ? mine : 1u; nx = cnt > 0u ? cnt : 1u;
}
__device__ __forceinline__ void xcd_barrier(const XcdBarrier& b) {
    asm volatile("s_waitcnt vmcnt(0)" ::: "memory");
    __syncthreads();
    if (threadIdx.x == 0) {
        unsigned long long bar_l_ = (unsigned long long)b.bar; asm volatile("" : "+s"(bar_l_));
        unsigned* bar = (unsigned*)bar_l_;
        __builtin_amdgcn_s_waitcnt(0);
        unsigned bx_l_ = b.x; asm volatile("" : "+s"(bx_l_));
        unsigned nloc = b.st[0], nx = b.st[1];
        if (nloc == 0u) { xcd_barrier_complete(bar, bx_l_, nloc, nx); b.st[0] = nloc; b.st[1] = nx; }
        const unsigned old = xb_add(&bar[XB_XSUB(bx_l_)], 1u);
        const unsigned gen = old / nloc;
        if (old + 1u == (gen + 1u) * nloc) {
            __builtin_amdgcn_fence(__ATOMIC_RELEASE, "agent");
            asm volatile("s_waitcnt vmcnt(0)" ::: "memory");
            const unsigned og = xb_add(&bar[XB_TOP], 1u);
            const unsigned tg = og / nx;
            if (og + 1u == (tg + 1u) * nx) xb_add(&bar[XB_TOPGEN], 1u);
            else XB_SPIN(xb_ld(&bar[XB_TOPGEN]) == tg, bar);
            __builtin_amdgcn_fence(__ATOMIC_ACQUIRE, "agent");
            xb_add(&bar[XB_XGEN(bx_l_)], 1u);
            asm volatile("s_waitcnt vmcnt(0)" ::: "memory");
        } else {
            XB_SPIN(xb_ld(&bar[XB_XGEN(bx_l_)]) == gen, bar);
            __builtin_amdgcn_fence(__ATOMIC_ACQUIRE, "agent");
            asm volatile("s_waitcnt vmcnt(0)" ::: "memory");
        }
    }
    __syncthreads();
}

struct Frame {
    LAS unsigned char* lds;
    unsigned char* ws;
    int tid, lane, wave;
    int vcu, G, bx;
};

__device__ __forceinline__ void relaunder(Frame& F, unsigned char* ws0) { int t = threadIdx.x; asm volatile("" : "+v"(t)); F.tid = t; F.lane = t & 63; F.wave = __builtin_amdgcn_readfirstlane(t >> 6);
    unsigned long long w = (unsigned long long)ws0; asm volatile("" : "+s"(w)); F.ws = (unsigned char*)w;
    int g = gridDim.x; asm volatile("" : "+s"(g)); F.G = g; int bx = blockIdx.x; asm volatile("" : "+s"(bx)); F.bx = bx; F.vcu = (g % 8 == 0) ? (bx % 8) * (g / 8) + bx / 8 : bx; }
__device__ __forceinline__ float wave_sum(float v) {
    int l = threadIdx.x; asm volatile("" : "+v"(l)); l &= 63;
#pragma unroll
    for (int o = 1; o < 64; o <<= 1) v += __builtin_bit_cast(float, __builtin_amdgcn_ds_bpermute((l ^ o) << 2, __builtin_bit_cast(int, v)));
    return v;
}

constexpr int TAIL_TILES = 64 * 12;
__device__ __forceinline__ void p0_matrix(Frame& F, const float* W, int K, int N, int NP, bf16* WT, int& prefix, int perm_limit = 0, const float* gain = nullptr, int gv_tiles = 0, int ov_t0 = -1, int ov_stride = 0, int t_lo = 0, int t_hi = -1) {
    const int nnt = NP / 256, nkt = K / 128, ntiles = nkt * nnt, G = F.G, w = F.wave, lane = F.lane;
    const int stride = ov_t0 >= 0 ? ov_stride : G; int t;
    const int nhi = t_hi >= 0 ? t_hi : ntiles;
    if (ov_t0 >= 0) t = t_lo + ov_t0; else { t = (F.vcu - prefix) % G; if (t < 0) t += G; t += t_lo; prefix = (prefix + (nhi - t_lo)) % G; }
    LAS unsigned char* L = F.lds;
    f32x4 v[16];
#define P0_TILE(tt, kt_, nt_) const int blk_ = (tt) / (16 * nnt), rem_ = (tt) - blk_ * 16 * nnt, bh_ = (nkt - 16 * blk_) < 16 ? (nkt - 16 * blk_) : 16, nt_ = rem_ / bh_, kt_ = 16 * blk_ + (rem_ - nt_ * bh_)
#define P0_LOAD(tt) do { P0_TILE(tt, kt_, nt_); const int n_ = nt_ * 256 + 4 * lane; \
        const GAS float* s_ = (const GAS float*)W + (size_t)(kt_ * 128 + 16 * w) * N + n_; \
        if (n_ < N) { _Pragma("unroll") for (int jj = 0; jj < 16; ++jj) v[jj] = *(const GAS f32x4*)(s_ + (size_t)jj * N); \
            if (gain) { _Pragma("unroll") for (int jj = 0; jj < 16; ++jj) v[jj] = v[jj] * gain[kt_ * 128 + 16 * w + jj]; } } \
        else { _Pragma("unroll") for (int jj = 0; jj < 16; ++jj) v[jj] = (f32x4){0.f, 0.f, 0.f, 0.f}; } } while (0)
    if (t < nhi) P0_LOAD(t);
    while (t < nhi) {
#pragma unroll
        for (int i = 0; i < 4; ++i)
#pragma unroll
            for (int h = 0; h < 2; ++h) {
                v4u o; o.x = pk2(v[8 * h + 0][i], v[8 * h + 1][i]); o.y = pk2(v[8 * h + 2][i], v[8 * h + 3][i]); o.z = pk2(v[8 * h + 4][i], v[8 * h + 5][i]); o.w = pk2(v[8 * h + 6][i], v[8 * h + 7][i]);
                *(LAS v4u*)(L + (4 * lane + i) * 256 + (((2 * w + h) ^ (lane & 15)) << 4)) = o;
            }
        P0_TILE(t, kt, nt); const int tn = t + stride;
        if (tn < nhi) P0_LOAD(tn);
        __syncthreads();
        const int nb = gv_tiles ? ((nt < gv_tiles ? 2 * nt : 2 * (nt - gv_tiles)) * 256 + (nt < gv_tiles ? 0 : 128)) : nt * 256;
        GAS bf16* dst = (GAS bf16*)WT + kt * 128 + 8 * (lane & 15);
        const bool perm = nt * 256 < perm_limit;
#pragma unroll
        for (int jj = 0; jj < 8; ++jj) { const int r = w * 32 + jj * 4 + (lane >> 4);
            const v4u o = *(LAS const v4u*)(L + r * 256 + (((lane & 15) ^ ((r >> 2) & 15)) << 4));
            const int d = r & 127, ro = perm ? ((r & 128) | (d < 64 ? 2 * d : 2 * (d - 64) + 1)) : r;
            const int rr = gv_tiles ? ((ro >> 7) * 256 + (ro & 127)) : ro;
            *(GAS v4u*)(dst + (size_t)(nb + rr) * K) = o; }
        __syncthreads();
        t = tn;
    }
#undef P0_LOAD
#undef P0_TILE
}

__device__ __forceinline__ void rms_row_bf16(const float* xrow, const float* w, bf16* orow, int lane) {
    const GAS f32x4* xr = (const GAS f32x4*)xrow + lane; const GAS f32x4* wr = (const GAS f32x4*)w + lane;
    f32x4 v[16]; float s = 0.f;
#pragma unroll
    for (int j = 0; j < 16; ++j) { v[j] = xr[64 * j]; s += (v[j].x * v[j].x + v[j].y * v[j].y) + (v[j].z * v[j].z + v[j].w * v[j].w); }
    const float rstd = 1.0f / sqrtf(wave_sum(s) * (1.f / DM) + EPS);
    GAS v2u* o8 = (GAS v2u*)orow + lane;
#pragma unroll
    for (int j = 0; j < 16; ++j) { const f32x4 g = wr[64 * j]; v2u o; o.x = pk2(v[j].x * rstd * g.x, v[j].y * rstd * g.y); o.y = pk2(v[j].z * rstd * g.z, v[j].w * rstd * g.w); o8[64 * j] = o; }
}
__device__ __forceinline__ void rms_row_f32(const float* xrow, const float* w, float* orow, int lane) {
    const GAS f32x4* xr = (const GAS f32x4*)xrow + lane; const GAS f32x4* wr = (const GAS f32x4*)w + lane;
    f32x4 v[16]; float s = 0.f;
#pragma unroll
    for (int j = 0; j < 16; ++j) { v[j] = xr[64 * j]; s += (v[j].x * v[j].x + v[j].y * v[j].y) + (v[j].z * v[j].z + v[j].w * v[j].w); }
    const float rstd = 1.0f / sqrtf(wave_sum(s) * (1.f / DM) + EPS);
    GAS f32x4* o = (GAS f32x4*)orow + lane;
#pragma unroll
    for (int j = 0; j < 16; ++j) { const f32x4 g = wr[64 * j]; o[64 * j] = v[j] * rstd * g; }
}
__device__ __forceinline__ void x_row_prep(const float* xrow, bf16* orow, unsigned long long* ssq, int lane) {
    const GAS f32x4* xr = (const GAS f32x4*)xrow + lane;
    f32x4 v[16]; float s = 0.f;
#pragma unroll
    for (int j = 0; j < 16; ++j) { v[j] = xr[64 * j]; s += (v[j].x * v[j].x + v[j].y * v[j].y) + (v[j].z * v[j].z + v[j].w * v[j].w); }
    s = wave_sum(s);
    GAS v2u* o8 = (GAS v2u*)orow + lane;
#pragma unroll
    for (int j = 0; j < 16; ++j) { v2u o; o.x = pk2(v[j].x, v[j].y); o.y = pk2(v[j].z, v[j].w); o8[64 * j] = o; }
    if (lane == 0) *ssq = (unsigned long long)__float2ll_rn(s * 16777216.0f);
}
__device__ __forceinline__ void rmsnorm_phase(Frame& F, const float* x, const float* w, bf16* U) {
    const int gw = F.vcu * NWAVES + F.wave, NGW = F.G * NWAVES;
    for (int m = gw; m < M; m += NGW) rms_row_bf16(x + (size_t)m * DM, w, U + (size_t)m * DM, F.lane);
}

template <class Sched>
__device__ __forceinline__ void rstd_table(Frame& F, const Sched& S, const unsigned long long* ss, int& pm0, int& ntab) {
    int lo = 1 << 30, hi = -1; pg8::Unit u;
    for (int i = 0; S.next(i, u); ++i) { lo = u.pm < lo ? u.pm : lo; hi = u.pm > hi ? u.pm : hi; }
    if (hi < 0) { pm0 = 0; ntab = 0; return; }
    pm0 = lo; ntab = (hi - lo + 1) < TAB_TILES ? (hi - lo + 1) : TAB_TILES;
    LAS float* tab = (LAS float*)(F.lds + TAB_OFF);
    for (int r = F.tid; r < ntab * 256; r += NTHR) tab[r] = 1.0f / sqrtf((float)ss[pm0 * 256 + r] * (1.0f / (4096.0f * 16777216.0f)) + 1e-5f);
    __syncthreads();
}

__device__ __forceinline__ void llc_touch(Frame& F, const void* p, size_t bytes) {
    const GAS v4u* q = (const GAS v4u*)p; const size_t n16 = bytes / 16, st = (size_t)F.G * NTHR; unsigned acc = 0u;
    for (size_t i = (size_t)F.vcu * NTHR + F.tid; i + 3 * st < n16; i += 4 * st) { const v4u a = q[i], b = q[i + st], c = q[i + 2 * st], d = q[i + 3 * st]; acc += (a.x ^ b.y) + (c.z ^ d.w); }
    if (acc == 0x12345677u) ((unsigned*)(F.ws + WS_CTL))[300] = acc;
}
__device__ __forceinline__ void unpack8(const v4u w, float (&o)[8]) { o[0] = bf_lo(w.x); o[1] = bf_hi(w.x); o[2] = bf_lo(w.y); o[3] = bf_hi(w.y); o[4] = bf_lo(w.z); o[5] = bf_hi(w.z); o[6] = bf_lo(w.w); o[7] = bf_hi(w.w); }
__device__ __forceinline__ void ffn_gate_phase(Frame& F, const bf16* H, const float* cw, const float* cb, bf16* GA) {
    constexpr int R = 32, NCHK = DFF / 8, NRB = M / R;
    const int total = NCHK * NRB;
    for (int it = F.vcu * NTHR + F.tid; it < total; it += F.G * NTHR) {
        const int ch = it % NCHK, rb = it / NCHK, c0 = ch * 8, t0 = rb * R;
        float wg[3][8], wv[3][8], bg[8], bv[8];
#pragma unroll
        for (int k = 0; k < 3; ++k) {
            const f32x4 a0 = *(const GAS f32x4*)(cw + (size_t)k * NUP + c0), a1 = *(const GAS f32x4*)(cw + (size_t)k * NUP + c0 + 4);
            const f32x4 b0 = *(const GAS f32x4*)(cw + (size_t)k * NUP + DFF + c0), b1 = *(const GAS f32x4*)(cw + (size_t)k * NUP + DFF + c0 + 4);
#pragma unroll
            for (int j = 0; j < 4; ++j) { wg[k][j] = a0[j]; wg[k][4 + j] = a1[j]; wv[k][j] = b0[j]; wv[k][4 + j] = b1[j]; }
        }
        { const f32x4 a0 = *(const GAS f32x4*)(cb + c0), a1 = *(const GAS f32x4*)(cb + c0 + 4), b0 = *(const GAS f32x4*)(cb + DFF + c0), b1 = *(const GAS f32x4*)(cb + DFF + c0 + 4);
#pragma unroll
          for (int j = 0; j < 4; ++j) { bg[j] = a0[j]; bg[4 + j] = a1[j]; bv[j] = b0[j]; bv[4 + j] = b1[j]; } }
        float g2[8], g1[8], v2[8], v1[8];
        if ((t0 & (SEQ - 1)) == 0) {
#pragma unroll
            for (int j = 0; j < 8; ++j) { g2[j] = 0.f; g1[j] = 0.f; v2[j] = 0.f; v1[j] = 0.f; }
        } else {
            const GAS bf16* r2 = (const GAS bf16*)H + (size_t)(t0 - 2) * NUP + c0; const GAS bf16* r1 = r2 + NUP;
            unpack8(*(const GAS v4u*)r2, g2); unpack8(*(const GAS v4u*)(r2 + DFF), v2); unpack8(*(const GAS v4u*)r1, g1); unpack8(*(const GAS v4u*)(r1 + DFF), v1);
        }
        const GAS bf16* hp = (const GAS bf16*)H + (size_t)t0 * NUP + c0; GAS bf16* op = (GAS bf16*)GA + (size_t)t0 * DFF + c0;
#pragma unroll 8
        for (int r = 0; r < R; ++r) {
            float g0[8], v0[8], o[8];
            unpack8(*(const GAS v4u*)(hp + (size_t)r * NUP), g0); unpack8(*(const GAS v4u*)(hp + (size_t)r * NUP + DFF), v0);
#pragma unroll
            for (int j = 0; j < 8; ++j) {
                const float a = bg[j] + wg[0][j] * g2[j] + wg[1][j] * g1[j] + wg[2][j] * g0[j];
                const float b = bv[j] + wv[0][j] * v2[j] + wv[1][j] * v1[j] + wv[2][j] * v0[j];
                o[j] = silu_f(a) * b; g2[j] = g1[j]; g1[j] = g0[j]; v2[j] = v1[j]; v1[j] = v0[j];
            }
            v4u w; w.x = pk2(o[0], o[1]); w.y = pk2(o[2], o[3]); w.z = pk2(o[4], o[5]); w.w = pk2(o[6], o[7]);
            *(GAS v4u*)(op + (size_t)r * DFF) = w;
        }
    }
}

__device__ __forceinline__ void ffn_fix_phase(Frame& F, const bf16* HB, const float* cw, const float* cb, bf16* GA) {
    constexpr int NCHK = DFF / 8, NSPAN = M / 64;
    for (int it = F.vcu * NTHR + F.tid; it < NCHK * NSPAN; it += F.G * NTHR) {
        const int ch = it % NCHK, s = it / NCHK, c0 = ch * 8, t0 = s * 64;
        float wg[3][8], wv[3][8], bg[8], bv[8];
#pragma unroll
        for (int k = 0; k < 3; ++k) {
            const f32x4 a0 = *(const GAS f32x4*)(cw + (size_t)k * NUP + c0), a1 = *(const GAS f32x4*)(cw + (size_t)k * NUP + c0 + 4);
            const f32x4 b0 = *(const GAS f32x4*)(cw + (size_t)k * NUP + DFF + c0), b1 = *(const GAS f32x4*)(cw + (size_t)k * NUP + DFF + c0 + 4);
#pragma unroll
            for (int j = 0; j < 4; ++j) { wg[k][j] = a0[j]; wg[k][4 + j] = a1[j]; wv[k][j] = b0[j]; wv[k][4 + j] = b1[j]; }
        }
        { const f32x4 a0 = *(const GAS f32x4*)(cb + c0), a1 = *(const GAS f32x4*)(cb + c0 + 4), b0 = *(const GAS f32x4*)(cb + DFF + c0), b1 = *(const GAS f32x4*)(cb + DFF + c0 + 4);
#pragma unroll
          for (int j = 0; j < 4; ++j) { bg[j] = a0[j]; bg[4 + j] = a1[j]; bv[j] = b0[j]; bv[4 + j] = b1[j]; } }
        float g2[8], g1[8], v2[8], v1[8];
        if ((t0 & (SEQ - 1)) == 0) {
#pragma unroll
            for (int j = 0; j < 8; ++j) { g2[j] = 0.f; g1[j] = 0.f; v2[j] = 0.f; v1[j] = 0.f; }
        } else {
            const GAS bf16* pr = (const GAS bf16*)HB + (size_t)(((s - 1) * 4 + 2) * 2) * DFF + c0;
            unpack8(*(const GAS v4u*)pr, g2); unpack8(*(const GAS v4u*)(pr + DFF), v2); unpack8(*(const GAS v4u*)(pr + 2 * DFF), g1); unpack8(*(const GAS v4u*)(pr + 3 * DFF), v1);
        }
        const GAS bf16* cp = (const GAS bf16*)HB + (size_t)((s * 4) * 2) * DFF + c0; GAS bf16* op = (GAS bf16*)GA + (size_t)t0 * DFF + c0;
#pragma unroll
        for (int r = 0; r < 2; ++r) {
            float g0[8], v0[8], o[8];
            unpack8(*(const GAS v4u*)(cp + (size_t)(2 * r) * DFF), g0); unpack8(*(const GAS v4u*)(cp + (size_t)(2 * r + 1) * DFF), v0);
#pragma unroll
            for (int j = 0; j < 8; ++j) {
                const float a = bg[j] + wg[0][j] * g2[j] + wg[1][j] * g1[j] + wg[2][j] * g0[j];
                const float b = bv[j] + wv[0][j] * v2[j] + wv[1][j] * v1[j] + wv[2][j] * v0[j];
                o[j] = silu_f(a) * b; g2[j] = g1[j]; g1[j] = g0[j]; v2[j] = v1[j]; v1[j] = v0[j];
            }
            v4u w; w.x = pk2(o[0], o[1]); w.y = pk2(o[2], o[3]); w.z = pk2(o[4], o[5]); w.w = pk2(o[6], o[7]);
            *(GAS v4u*)(op + (size_t)r * DFF) = w;
        }
    }
}

__device__ __forceinline__ void ssd_prep_phase(Frame& F, const bf16* ZX, const float* cw, const float* cb, const float* dt_bias, bf16* XT, bf16* Bn, bf16* BT, bf16* Cn, float* DTF, const float* part, const unsigned long long* ssq) {
    const int gw = F.vcu * NWAVES + F.wave, NGW = F.G * NWAVES, lane = F.lane, c8 = lane & 7, rg = lane >> 3;
    for (int it = gw; it < 64 * 160; it += NGW) {
        const int cg = it % 160, bc = it / 160;
        const int ch0 = cg * 64 + 8 * c8, m0 = bc * 128;
        const GAS bf16* src = (const GAS bf16*)ZX + (size_t)(m0 + 16 * rg - 3) * NZXP + ZX_XBC + ch0;
        v4u raw[19];
        const bool hist = (rg != 0) || ((bc & 31) != 0);
#pragma unroll
        for (int jj = 0; jj < 19; ++jj) raw[jj] = (jj >= 3 || hist) ? *(const GAS v4u*)(src + (size_t)jj * NZXP) : (v4u){0u, 0u, 0u, 0u};
        float wt[4][8], bb[8];
#pragma unroll
        for (int k = 0; k < 4; ++k) { const f32x4 a = *(const GAS f32x4*)(cw + (size_t)k * CONVD + ch0), b = *(const GAS f32x4*)(cw + (size_t)k * CONVD + ch0 + 4);
#pragma unroll
            for (int e = 0; e < 4; ++e) { wt[k][e] = a[e]; wt[k][4 + e] = b[e]; } }
        { const f32x4 a = *(const GAS f32x4*)(cb + ch0), b = *(const GAS f32x4*)(cb + ch0 + 4);
#pragma unroll
          for (int e = 0; e < 4; ++e) { bb[e] = a[e]; bb[4 + e] = b[e]; } }
        GAS bf16* tdst = nullptr; GAS bf16* ndst = nullptr;
        if (cg < 128) { tdst = (GAS bf16*)XT + ((size_t)(bc * 128 + cg) * 64 + 8 * c8) * 128 + 16 * rg; }
        else if (cg < 144) { const int g = (cg - 128) >> 1, n0 = ((cg - 128) & 1) * 64 + 8 * c8; tdst = (GAS bf16*)BT + ((size_t)(bc * 8 + g) * 128 + n0) * 128 + 16 * rg; ndst = (GAS bf16*)Bn + ((size_t)(bc * 8 + g) * 128 + 16 * rg) * 128 + n0; }
        else { const int g = (cg - 144) >> 1, n0 = ((cg - 144) & 1) * 64 + 8 * c8; ndst = (GAS bf16*)Cn + ((size_t)(bc * 8 + g) * 128 + 16 * rg) * 128 + n0; }
#pragma unroll
        for (int hf = 0; hf < 2; ++hf) {
            unsigned nw[8][4];
#pragma unroll
            for (int ep = 0; ep < 4; ++ep) {
                float oa[8], ob[8];
                float a3 = bf_lo(raw[8 * hf][ep]), a2 = bf_lo(raw[8 * hf + 1][ep]), a1 = bf_lo(raw[8 * hf + 2][ep]), b3 = bf_hi(raw[8 * hf][ep]), b2 = bf_hi(raw[8 * hf + 1][ep]), b1 = bf_hi(raw[8 * hf + 2][ep]);
#pragma unroll
                for (int r = 0; r < 8; ++r) { const float a0 = bf_lo(raw[8 * hf + 3 + r][ep]), b0 = bf_hi(raw[8 * hf + 3 + r][ep]);
                    oa[r] = silu_f(bb[2 * ep] + wt[0][2 * ep] * a3 + wt[1][2 * ep] * a2 + wt[2][2 * ep] * a1 + wt[3][2 * ep] * a0);
                    ob[r] = silu_f(bb[2 * ep + 1] + wt[0][2 * ep + 1] * b3 + wt[1][2 * ep + 1] * b2 + wt[2][2 * ep + 1] * b1 + wt[3][2 * ep + 1] * b0);
                    a3 = a2; a2 = a1; a1 = a0; b3 = b2; b2 = b1; b1 = b0; }
                if (tdst) {
                    v4u t0; t0.x = pk2(oa[0], oa[1]); t0.y = pk2(oa[2], oa[3]); t0.z = pk2(oa[4], oa[5]); t0.w = pk2(oa[6], oa[7]);
                    *(GAS v4u*)(tdst + (size_t)(2 * ep) * 128 + 8 * hf) = t0;
                    t0.x = pk2(ob[0], ob[1]); t0.y = pk2(ob[2], ob[3]); t0.z = pk2(ob[4], ob[5]); t0.w = pk2(ob[6], ob[7]);
                    *(GAS v4u*)(tdst + (size_t)(2 * ep + 1) * 128 + 8 * hf) = t0;
                }
                if (ndst) {
#pragma unroll
                    for (int r = 0; r < 8; ++r) nw[r][ep] = pk2(oa[r], ob[r]);
                }
            }
            if (ndst) {
#pragma unroll
                for (int r = 0; r < 8; ++r) { v4u o; o.x = nw[r][0]; o.y = nw[r][1]; o.z = nw[r][2]; o.w = nw[r][3]; *(GAS v4u*)(ndst + (size_t)(8 * hf + r) * 128) = o; }
            }
        }
    }
    for (int i = F.vcu * NTHR + F.tid; i < M * NHEAD; i += F.G * NTHR) {
        const int h = i & 127, m = i >> 7;
        float raw;
        if (part) { float s = 0.f;
#pragma unroll
            for (int ks = 0; ks < 8; ++ks) s += ((const GAS float*)part)[((size_t)ks * M + m) * 128 + h];
            raw = s * (1.0f / sqrtf((float)ssq[m] * (1.0f / (4096.0f * 16777216.0f)) + 1e-5f)) + dt_bias[h]; }
        else raw = bf1(((const GAS bf16*)ZX)[(size_t)m * NZXP + ZX_DT + h]) + dt_bias[h];
        const float sp = raw > 20.f ? raw : log1pf(__expf(raw));
        ((GAS float*)DTF)[(size_t)((m >> 12) * NHEAD + h) * SEQ + (m & (SEQ - 1))] = sp;
    }
}

#define LDS_BAR() do { asm volatile("s_waitcnt lgkmcnt(0)" ::: "memory"); __builtin_amdgcn_s_barrier(); asm volatile("" ::: "memory"); } while (0)
__device__ __forceinline__ int swz(int r, int q) { return r * 256 + ((q ^ (r & 15)) << 4); }
__device__ __forceinline__ bf16x8 ldfrag(LAS const unsigned char* base, int row, int q) { return *(LAS const bf16x8*)(base + swz(row, q)); }
__device__ __forceinline__ void ssd_phase(Frame& F, const bf16* XT, const bf16* Bn, const bf16* BT, const bf16* Cn, const float* DTF, const float* a_log, const float* d_skip, bf16* Y) {
    constexpr int SC = 0, SB = 32768, SBT = 65536, SXT = 98304, SS = 114688, SM = 131072;
    LAS unsigned char* L = F.lds;
    LAS float* dtv = (LAS float*)(L + SM); LAS float* acs = dtv + 128; LAS float* w2 = dtv + 256;
    const int tid = F.tid, wave = F.wave, lane = F.lane, c = lane & 31, hi = lane >> 5;
    const int lb = wave >> 1, pb = wave & 1, nb = wave >> 1, sb0 = 2 * (wave & 1);
    for (int id = F.vcu; id < BATCH * NHEAD; id += F.G) {
        const int b = id >> 7, h = id & 127, g = h >> 4;
        const float A = -__expf(a_log[h]), Dh = d_skip[h];
        for (int i = tid; i < 1024; i += NTHR) *(LAS v4u*)(L + SS + i * 16) = (v4u){0u, 0u, 0u, 0u};
        f32x16 sacc;
#pragma unroll
        for (int r = 0; r < 16; ++r) sacc[r] = 0.f;
        v4u stC[4], stB[4], stBT[4], stX[2]; f32x2 stdt;
#define SSD_LOAD(cc_) do { const int cidx_ = b * NCHUNK + (cc_); \
            const GAS v4u* pc_ = (const GAS v4u*)(Cn + (size_t)(cidx_ * 8 + g) * 16384); const GAS v4u* pb_ = (const GAS v4u*)(Bn + (size_t)(cidx_ * 8 + g) * 16384); \
            const GAS v4u* pt_ = (const GAS v4u*)(BT + (size_t)(cidx_ * 8 + g) * 16384); const GAS v4u* px_ = (const GAS v4u*)(XT + (size_t)(cidx_ * 128 + h) * 8192); \
            _Pragma("unroll") for (int j_ = 0; j_ < 4; ++j_) { stC[j_] = pc_[tid + 512 * j_]; stB[j_] = pb_[tid + 512 * j_]; stBT[j_] = pt_[tid + 512 * j_]; } \
            _Pragma("unroll") for (int j_ = 0; j_ < 2; ++j_) stX[j_] = px_[tid + 512 * j_]; \
            stdt = *(const GAS f32x2*)(DTF + (size_t)(b * NHEAD + h) * SEQ + (cc_) * 128 + 2 * lane); } while (0)
        SSD_LOAD(0);
        for (int cc = 0; cc < NCHUNK; ++cc) {
#pragma unroll
            for (int j = 0; j < 4; ++j) { const int i = tid + 512 * j, o = swz(i >> 4, i & 15); *(LAS v4u*)(L + SC + o) = stC[j]; *(LAS v4u*)(L + SB + o) = stB[j]; *(LAS v4u*)(L + SBT + o) = stBT[j]; }
#pragma unroll
            for (int j = 0; j < 2; ++j) { const int i = tid + 512 * j; *(LAS v4u*)(L + SXT + swz(i >> 4, i & 15)) = stX[j]; }
            if (wave == 0) {
                const float a0 = stdt.x * A, a1 = stdt.y * A; float p = a0 + a1;
#pragma unroll
                for (int o = 1; o < 64; o <<= 1) { const float t = __shfl_up(p, o); if (lane >= o) p += t; }
                const float tot = __shfl(p, 63);
                acs[2 * lane] = p - a1; acs[2 * lane + 1] = p; dtv[2 * lane] = stdt.x; dtv[2 * lane + 1] = stdt.y;
                w2[2 * lane] = stdt.x * __expf(tot - (p - a1)); w2[2 * lane + 1] = stdt.y * __expf(tot - p);
            }
            LDS_BAR();
            if (cc + 1 < NCHUNK) SSD_LOAD(cc + 1);
            bf16x8 cf[8];
#pragma unroll
            for (int ks = 0; ks < 8; ++ks) cf[ks] = ldfrag(L + SC, 32 * lb + c, 2 * ks + hi);
            f32x16 yacc;
#pragma unroll
            for (int r = 0; r < 16; ++r) yacc[r] = 0.f;
#pragma unroll
            for (int ks = 0; ks < 8; ++ks) yacc = __builtin_amdgcn_mfma_f32_32x32x16_bf16(ldfrag(L + SS, 32 * pb + c, 2 * ks + hi), cf[ks], yacc, 0, 0, 0);
            const float acl = acs[32 * lb + c]; const float el = __expf(acl);
#pragma unroll
            for (int r = 0; r < 16; ++r) yacc[r] *= el;
            f32x16 cb0, cb1;
#pragma unroll
            for (int r = 0; r < 16; ++r) { cb0[r] = 0.f; cb1[r] = 0.f; }
            if (sb0 <= lb) {
#pragma unroll
                for (int ks = 0; ks < 8; ++ks) cb0 = __builtin_amdgcn_mfma_f32_32x32x16_bf16(ldfrag(L + SB, 32 * sb0 + c, 2 * ks + hi), cf[ks], cb0, 0, 0, 0);
            }
            if (sb0 + 1 <= lb) {
#pragma unroll
                for (int ks = 0; ks < 8; ++ks) cb1 = __builtin_amdgcn_mfma_f32_32x32x16_bf16(ldfrag(L + SB, 32 * (sb0 + 1) + c, 2 * ks + hi), cf[ks], cb1, 0, 0, 0);
            }
            const int lrow = 32 * lb + c;
#pragma unroll
            for (int q = 0; q < 4; ++q) {
                const int s0a = 32 * sb0 + 8 * q + 4 * hi, s0b = s0a + 32;
                const f32x4 aa = *(LAS const f32x4*)(acs + s0a), da = *(LAS const f32x4*)(dtv + s0a), ab = *(LAS const f32x4*)(acs + s0b), db = *(LAS const f32x4*)(dtv + s0b);
#pragma unroll
                for (int j = 0; j < 4; ++j) {
                    cb0[4 * q + j] = (s0a + j <= lrow) ? cb0[4 * q + j] * __expf(acl - aa[j]) * da[j] : 0.f;
                    cb1[4 * q + j] = (s0b + j <= lrow) ? cb1[4 * q + j] * __expf(acl - ab[j]) * db[j] : 0.f;
                }
            }
            LDS_BAR();
#pragma unroll
            for (int q = 0; q < 4; ++q) {
                v2u wa, wb; wa.x = pk2(cb0[4 * q], cb0[4 * q + 1]); wa.y = pk2(cb0[4 * q + 2], cb0[4 * q + 3]); wb.x = pk2(cb1[4 * q], cb1[4 * q + 1]); wb.y = pk2(cb1[4 * q + 2], cb1[4 * q + 3]);
                *(LAS v2u*)(L + SB + swz(lrow, 4 * sb0 + q) + 8 * hi) = wa; *(LAS v2u*)(L + SB + swz(lrow, 4 * (sb0 + 1) + q) + 8 * hi) = wb;
            }
            LDS_BAR();
            const int nks = 2 * (lb + 1);
            for (int ks = 0; ks < nks; ++ks) yacc = __builtin_amdgcn_mfma_f32_32x32x16_bf16(ldfrag(L + SXT, 32 * pb + c, 2 * ks + hi), ldfrag(L + SB, lrow, 2 * ks + hi), yacc, 0, 0, 0);
            {
                GAS bf16* yrow = (GAS bf16*)Y + (size_t)(b * SEQ + cc * 128 + lrow) * DI + h * 64 + 32 * pb + 4 * hi;
#pragma unroll
                for (int q = 0; q < 4; ++q) {
                    float yv[4];
#pragma unroll
                    for (int j = 0; j < 4; ++j) { const int p = 32 * pb + 8 * q + 4 * hi + j; const float xv = bf1(*(LAS const bf16*)(L + SXT + swz(p, lrow >> 3) + (lrow & 7) * 2)); yv[j] = yacc[4 * q + j] + Dh * xv; }
                    v2u w; w.x = pk2(yv[0], yv[1]); w.y = pk2(yv[2], yv[3]); *(GAS v2u*)(yrow + 8 * q) = w;
                }
            }
            {
                const float etot = __expf(acs[127]);
#pragma unroll
                for (int r = 0; r < 16; ++r) sacc[r] *= etot;
#pragma unroll
                for (int ks = 0; ks < 8; ++ks) {
                    const bf16x8 xa = ldfrag(L + SXT, 32 * pb + c, 2 * ks + hi);
                    const f32x4 wA = *(LAS const f32x4*)(w2 + 16 * ks + 8 * hi), wB = *(LAS const f32x4*)(w2 + 16 * ks + 8 * hi + 4);
                    const v4u xu = __builtin_bit_cast(v4u, xa);
                    v4u xs; xs.x = pk2(bf_lo(xu.x) * wA[0], bf_hi(xu.x) * wA[1]); xs.y = pk2(bf_lo(xu.y) * wA[2], bf_hi(xu.y) * wA[3]);
                    xs.z = pk2(bf_lo(xu.z) * wB[0], bf_hi(xu.z) * wB[1]); xs.w = pk2(bf_lo(xu.w) * wB[2], bf_hi(xu.w) * wB[3]);
                    sacc = __builtin_amdgcn_mfma_f32_32x32x16_bf16(ldfrag(L + SBT, 32 * nb + c, 2 * ks + hi), __builtin_bit_cast(bf16x8, xs), sacc, 0, 0, 0);
                }
                const int prow = 32 * pb + c;
#pragma unroll
                for (int q = 0; q < 4; ++q) { v2u w; w.x = pk2(sacc[4 * q], sacc[4 * q + 1]); w.y = pk2(sacc[4 * q + 2], sacc[4 * q + 3]); *(LAS v2u*)(L + SS + swz(prow, 4 * nb + q) + 8 * hi) = w; }
            }
            LDS_BAR();
        }
#undef SSD_LOAD
    }
}

__device__ __forceinline__ void gated_norm_phase(Frame& F, const bf16* Y, const bf16* ZX, const float* nw, bf16* G) {
    const int gw = F.vcu * NWAVES + F.wave, NGW = F.G * NWAVES, lane = F.lane;
    constexpr int UN = 8;
    for (int it0 = gw; it0 < M * NGRP; it0 += UN * NGW) {
        v4u yr[UN][2], zr[UN][2];
#pragma unroll
        for (int u = 0; u < UN; ++u) { const int it = it0 + u * NGW, m = it >> 3, g = it & 7;
#pragma unroll
            for (int j = 0; j < 2; ++j) { const int col = g * 1024 + j * 512 + lane * 8;
                if (it < M * NGRP) { yr[u][j] = *(const GAS v4u*)((const GAS bf16*)Y + (size_t)m * DI + col); zr[u][j] = *(const GAS v4u*)((const GAS bf16*)ZX + (size_t)m * NZXP + col); } } }
#pragma unroll
        for (int u = 0; u < UN; ++u) { const int it = it0 + u * NGW, m = it >> 3, g = it & 7;
            if (it >= M * NGRP) break;
            float gv[16]; float ss = 0.f;
#pragma unroll
            for (int j = 0; j < 2; ++j) { float yv[8], zv[8]; unpack8(yr[u][j], yv); unpack8(zr[u][j], zv);
#pragma unroll
                for (int e = 0; e < 8; ++e) { const float t = yv[e] * silu_f(zv[e]); gv[8 * j + e] = t; ss += t * t; } }
            const float rstd = 1.0f / sqrtf(wave_sum(ss) * (1.f / 1024.f) + EPS);
#pragma unroll
            for (int j = 0; j < 2; ++j) {
                const int col = g * 1024 + j * 512 + lane * 8;
                const f32x4 wa = *(const GAS f32x4*)(nw + col), wb = *(const GAS f32x4*)(nw + col + 4);
                v4u o; o.x = pk2(gv[8 * j] * rstd * wa[0], gv[8 * j + 1] * rstd * wa[1]); o.y = pk2(gv[8 * j + 2] * rstd * wa[2], gv[8 * j + 3] * rstd * wa[3]);
                o.z = pk2(gv[8 * j + 4] * rstd * wb[0], gv[8 * j + 5] * rstd * wb[1]); o.w = pk2(gv[8 * j + 6] * rstd * wb[2], gv[8 * j + 7] * rstd * wb[3]);
                *(GAS v4u*)((GAS bf16*)G + (size_t)m * DI + col) = o;
            }
        }
    }
}

__device__ __forceinline__ void rope_table_phase(Frame& F, const int* positions, float* cs, float* sn) {
    for (int i = F.vcu * NTHR + F.tid; i < M * 64; i += F.G * NTHR) {
        const int d = i & 63, m = i >> 6;
        const float inv = 1.0f / powf(10000.0f, (float)(2 * d) * (1.0f / 128.0f));
        const float ang = (float)positions[m] * inv;
        const float k = rintf(ang * 0.15915494309189535f);
        float r = fmaf(-k, 6.28125f, ang); r = fmaf(-k, 1.9353071795864769e-3f, r);
        const float rev = r * 0.15915494309189535f;
        cs[i] = __builtin_amdgcn_cosf(rev); sn[i] = __builtin_amdgcn_sinf(rev);
    }
}
__device__ __forceinline__ void rope_phase(Frame& F, bf16* QKVH, const float* cs, const float* sn) {
    const int total = 64 * M * 8;
    for (int i = F.vcu * NTHR + F.tid; i < total; i += F.G * NTHR) {
        const int d8 = i & 7, m = (i >> 3) & (M - 1), cg = i >> 16;
        GAS bf16* row = (GAS bf16*)QKVH + ((size_t)cg * M + m) * 128 + d8 * 8;
        float a[8], b[8];
        unpack8(*(const GAS v4u*)row, a); unpack8(*(const GAS v4u*)(row + 64), b);
        const f32x4 c0 = *(const GAS f32x4*)(cs + (size_t)m * 64 + d8 * 8), c1 = *(const GAS f32x4*)(cs + (size_t)m * 64 + d8 * 8 + 4);
        const f32x4 s0 = *(const GAS f32x4*)(sn + (size_t)m * 64 + d8 * 8), s1 = *(const GAS f32x4*)(sn + (size_t)m * 64 + d8 * 8 + 4);
        float oa[8], ob[8];
#pragma unroll
        for (int j = 0; j < 8; ++j) { const float cc = j < 4 ? c0[j & 3] : c1[j & 3], ss = j < 4 ? s0[j & 3] : s1[j & 3]; oa[j] = a[j] * cc - b[j] * ss; ob[j] = b[j] * cc + a[j] * ss; }
        v4u wa, wb; wa.x = pk2(oa[0], oa[1]); wa.y = pk2(oa[2], oa[3]); wa.z = pk2(oa[4], oa[5]); wa.w = pk2(oa[6], oa[7]);
        wb.x = pk2(ob[0], ob[1]); wb.y = pk2(ob[2], ob[3]); wb.z = pk2(ob[4], ob[5]); wb.w = pk2(ob[6], ob[7]);
        *(GAS v4u*)row = wa; *(GAS v4u*)(row + 64) = wb;
    }
}
typedef att::BlockRef<att::bf16, float> AttRef;
__device__ __forceinline__ AttRef att_ref(const bf16* QKVH, float* OP, int L, int pass) {
    const int combo = L >> 3, x = L & 7;
    const int vh = combo & 1, c = (combo >> 1) & 1, h = (combo >> 2) & 15, b = combo >> 6;
    const int qb = pass ? 15 - x : x;
    const size_t GS = (size_t)M * 128;
    AttRef r;
    r.Q = QKVH + (size_t)(2 * h + c) * GS + (size_t)(b * SEQ + qb * 256) * 128;
    r.K = QKVH + (size_t)(32 + 2 * h + c) * GS + (size_t)(b * SEQ) * 128;
    r.V = QKVH + (size_t)(64 + 2 * h + vh) * GS + (size_t)(b * SEQ) * 128;
    r.O = OP + (size_t)((2 * h + c) * 2 + vh) * GS + (size_t)(b * SEQ + qb * 256) * 128;
    r.P0 = qb * 256;
    return r;
}
__device__ __forceinline__ void attn_phase(Frame& F, const bf16* QKVH, float* OP, char* lds) {
    constexpr int TOTAL = 1024;
    int L = F.vcu; if (L >= TOTAL) return;
    const int stride = F.G; int pass = 0;
    AttRef cur = att_ref(QKVH, OP, L, 0);
    att::Seam<att::bf16> S;
    att::causal_swa_prime<att::bf16, float>(cur, SEQ, lds, S);
    for (;;) {
        const bool more_pass = pass == 0, more_item = L + stride < TOTAL, last = !more_pass && !more_item;
        int passn = pass + 1, Ln = L;
        if (!more_pass) { passn = 0; Ln = more_item ? L + stride : L; }
        const AttRef nxt = last ? cur : att_ref(QKVH, OP, Ln, passn);
        att::causal_swa_block<att::bf16, float>(cur, nxt, SEQ, SEQ, lds, S);
        if (last) break;
        cur = nxt; pass = passn; L = Ln;
    }
}
namespace att2 {
using att::bf16x8; using att::s16x4; using att::f32x16; using att::f32x4;
constexpr int QROWS = 128, KT = 64, K_BYTES = 16384, V_BYTES = 32768;
constexpr int OFF_K = 0, OFF_V = 2 * K_BYTES, OFF_P = OFF_V + 2 * V_BYTES, OFF_AL = OFF_P + 2 * 4 * 4096, OFF_LL = OFF_AL + 2 * 4 * 32 * 4, LDS_NEED = OFF_LL + 4 * 32 * 4;
__device__ __forceinline__ int v_st2(int k, int c) { const int kk = (k & ~0xC) | ((k & 4) << 1) | ((k & 8) >> 1); return ((kk >> 3) * 8 + (c >> 5)) * 512 + ((kk & 7) * 32 + (c & 31)) * 2; }
struct Blk { const unsigned short* Q; const unsigned short* K; const unsigned short* V0; const unsigned short* V1; float* O; int P0; unsigned short* AO; const float* subln; float lam, post; };
typedef att::u32x4 u4;

template <int PAR>
__device__ __forceinline__ void stageK(const Blk& B, char* lds, int t, int NT, int tid, u4 (&stK)[4]) {
    if (t + 1 < NT) {
#pragma unroll
        for (int j = 0; j < 4; ++j) { const int id = tid + 256 * j, key = id >> 4, col = (id & 15) * 8; *(u4*)(lds + OFF_K + (PAR ^ 1) * K_BYTES + KSWZ(key, col * 2)) = stK[j]; }
    }
    if (t + 2 < NT) {
        { const unsigned voff = (unsigned)(tid >> 4) * 256u + (unsigned)(tid & 15) * 16u;
          const __attribute__((address_space(1))) char* kb = (const __attribute__((address_space(1))) char*)B.K + (size_t)(t + 2) * (KT * 256);
#pragma unroll
          for (int j = 0; j < 4; ++j) stK[j] = *(const __attribute__((address_space(1))) u4*)(kb + 4096 * j + voff); }
    }
}
template <int PAR>
__device__ __forceinline__ void stageV(const Blk& B, char* lds, int t, int NT, int tid, u4 (&stV)[8]) {
    if (t < NT) {
#pragma unroll
        for (int j = 0; j < 8; ++j) { const int id = tid + 256 * j, key = id >> 5, col = (id & 31) * 8; *(u4*)(lds + OFF_V + PAR * V_BYTES + v_st2(key, col)) = stV[j]; }
    }
    if (t + 1 < NT) {
        { const unsigned dV = (unsigned)((const char*)B.V1 - (const char*)B.V0), lc = (unsigned)tid & 31u, voff = (unsigned)(tid >> 5) * 256u + (lc < 16u ? lc * 16u : dV + (lc - 16u) * 16u);
          const __attribute__((address_space(1))) char* vb = (const __attribute__((address_space(1))) char*)B.V0 + (size_t)(t + 1) * (KT * 256);
#pragma unroll
          for (int j = 0; j < 8; ++j) stV[j] = *(const __attribute__((address_space(1))) u4*)(vb + 2048 * j + voff); }
    }
}
template <int PAR>
__device__ __forceinline__ void step_prod(const Blk& B, char* lds, int t, int NT, int tid, int wid, int lane, int r32, int hi, const bf16x8 (&qr)[8], float& m_reg, float& l_reg, u4 (&stV)[8]) {
    stageV<PAR>(B, lds, t, NT, tid, stV);
    if (t < NT) {
        f32x16 p0, p1; float mn, al; bf16x8 pa0, pa1, pa2, pa3;
        __builtin_amdgcn_s_setprio(2);
        att::qkt<PAR, false>(p0, p1, lds + OFF_K, r32, hi, qr, true);
        __builtin_amdgcn_s_setprio(0);
        const int kb = t * KT, qlo = B.P0 + wid * 32;
        if (kb + KT - 1 > qlo) att::mask_tile(p0, p1, qlo + r32 - 4 * hi - kb, (unsigned)0x7fffffff);
        att::partialSM(p0, p1, m_reg, mn, al);
        att::finishSM(p0, p1, al, l_reg, pa0, pa1, pa2, pa3);
        char* pb = lds + OFF_P + (PAR * 4 + wid) * 4096 + lane * 16;
        *(bf16x8*)(pb) = pa0; *(bf16x8*)(pb + 1024) = pa1; *(bf16x8*)(pb + 2048) = pa2; *(bf16x8*)(pb + 3072) = pa3;
        if (hi == 0) ((float*)(lds + OFF_AL))[(PAR * 4 + wid) * 32 + r32] = al;
    }
    __syncthreads();
}
template <int PAR>
__device__ __forceinline__ void step_cons(const Blk& B, char* lds, int t, int NT, int tid, int p, int lane, int r32, int hi, f32x16 (&o)[8], u4 (&stK)[4]) {
    stageK<PAR>(B, lds, t, NT, tid - 256, stK);
    if (t >= 1) {
        constexpr int UP = PAR ^ 1;
        const float* alp = (const float*)(lds + OFF_AL) + (UP * 4 + p) * 32;
        const float a = alp[r32];
        if (__any(a < 1.f)) {
#pragma unroll
            for (int r = 0; r < 16; ++r) { const float ar = alp[att::crow(r, hi)];
#pragma unroll
                for (int d = 0; d < 8; ++d) o[d][r] *= ar; }
        }
        const char* pb = lds + OFF_P + (UP * 4 + p) * 4096 + lane * 16;
        const bf16x8 pa0 = *(const bf16x8*)(pb), pa1 = *(const bf16x8*)(pb + 1024), pa2 = *(const bf16x8*)(pb + 2048), pa3 = *(const bf16x8*)(pb + 3072);
        const int vb0 = (int)(uintptr_t)(lds + OFF_V) + att::v_rd_base(lane);
#define A2_TRRD(dst, off) asm volatile("ds_read_b64_tr_b16 %0, %1 offset:%2" : "=&v"(dst) : "v"(vb0), "i"(off) : "memory")
#define A2_LDG(L, H, ks, dh) do { constexpr int b_ = UP * V_BYTES + (ks) * 8192 + (dh) * 2048; \
        A2_TRRD(L[0], b_); A2_TRRD(H[0], b_ + 4096); A2_TRRD(L[1], b_ + 512); A2_TRRD(H[1], b_ + 512 + 4096); A2_TRRD(L[2], b_ + 1024); A2_TRRD(H[2], b_ + 1024 + 4096); A2_TRRD(L[3], b_ + 1536); A2_TRRD(H[3], b_ + 1536 + 4096); } while (0)
#define A2_MMA(L, H, pa, dh) do { _Pragma("unroll") for (int d = 0; d < 4; ++d) \
        o[4 * (dh) + d] = __builtin_amdgcn_mfma_f32_32x32x16_bf16(pa, (bf16x8){L[d][0], L[d][1], L[d][2], L[d][3], H[d][0], H[d][1], H[d][2], H[d][3]}, o[4 * (dh) + d], 0, 0, 0); } while (0)
#define A2_W8() do { asm volatile("s_waitcnt lgkmcnt(8)" ::: "memory"); SBAR(); } while (0)
        {
            s16x4 La[4], Ha[4], Lb[4], Hb[4];
            asm volatile("s_waitcnt lgkmcnt(0)" ::: "memory"); SBAR();
            A2_LDG(La, Ha, 0, 0); A2_LDG(Lb, Hb, 0, 1);
            A2_W8(); A2_MMA(La, Ha, pa0, 0); SBAR(); A2_LDG(La, Ha, 1, 0);
            A2_W8(); A2_MMA(Lb, Hb, pa0, 1); SBAR(); A2_LDG(Lb, Hb, 1, 1);
            A2_W8(); A2_MMA(La, Ha, pa1, 0); SBAR(); A2_LDG(La, Ha, 2, 0);
            A2_W8(); A2_MMA(Lb, Hb, pa1, 1); SBAR(); A2_LDG(Lb, Hb, 2, 1);
            A2_W8(); A2_MMA(La, Ha, pa2, 0); SBAR(); A2_LDG(La, Ha, 3, 0);
            A2_W8(); A2_MMA(Lb, Hb, pa2, 1); SBAR(); A2_LDG(Lb, Hb, 3, 1);
            A2_W8(); A2_MMA(La, Ha, pa3, 0); SBAR();
            asm volatile("s_waitcnt lgkmcnt(0)" ::: "memory"); SBAR(); A2_MMA(Lb, Hb, pa3, 1); SBAR();
        }
#undef A2_W8
#undef A2_MMA
#undef A2_LDG
#undef A2_TRRD
    }
    __syncthreads();
}

template <int MODE>
__device__ __forceinline__ void block(const Blk& B, char* lds) {
    int tl = threadIdx.x; asm volatile("" : "+v"(tl));
    const int tid = tl, wid = __builtin_amdgcn_readfirstlane(tid >> 6), lane = tid & 63, r32 = lane & 31, hi = lane >> 5;
    const int NT = (B.P0 + QROWS - 1) / KT + 1;
    if (wid < 4) {
        bf16x8 qr[8]; float m_reg = -1e30f, l_reg = 0.f; u4 stV[8];
#pragma unroll
        for (int j = 0; j < 8; ++j) { const int id = tid + 256 * j, key = id >> 5, col = (id & 31) * 8; stV[j] = *(const __attribute__((address_space(1))) u4*)((col < 128 ? B.V0 + col : B.V1 + (col - 128)) + (size_t)key * 128); }
#pragma unroll
        for (int d0 = 0; d0 < 8; ++d0) qr[d0] = *(const __attribute__((address_space(1))) bf16x8*)(B.Q + (size_t)(wid * 32 + r32) * 128 + d0 * 16 + hi * 8);
        __syncthreads();
        for (int t = 0; t <= NT; t += 2) {
            step_prod<0>(B, lds, t, NT, tid, wid, lane, r32, hi, qr, m_reg, l_reg, stV);
            if (t + 1 <= NT) step_prod<1>(B, lds, t + 1, NT, tid, wid, lane, r32, hi, qr, m_reg, l_reg, stV);
        }
        if (hi == 0) ((float*)(lds + OFF_LL))[wid * 32 + r32] = l_reg;
        __syncthreads();
    } else {
        f32x16 o[8]; const int p = wid - 4; u4 stK[4];
#pragma unroll
        for (int j = 0; j < 4; ++j) { const int id = (tid - 256) + 256 * j, key = id >> 4, col = (id & 15) * 8; const u4 k0 = *(const __attribute__((address_space(1))) u4*)(B.K + (size_t)key * 128 + col); *(u4*)(lds + OFF_K + KSWZ(key, col * 2)) = k0; }
        if (NT > 1) {
#pragma unroll
            for (int j = 0; j < 4; ++j) { const int id = (tid - 256) + 256 * j, key = id >> 4, col = (id & 15) * 8; stK[j] = *(const __attribute__((address_space(1))) u4*)(B.K + (size_t)(KT + key) * 128 + col); }
        }
#pragma unroll
        for (int d = 0; d < 8; ++d)
#pragma unroll
            for (int r = 0; r < 16; ++r) o[d][r] = 0.f;
        __syncthreads();
        for (int t = 0; t <= NT; t += 2) {
            step_cons<0>(B, lds, t, NT, tid, p, lane, r32, hi, o, stK);
            if (t + 1 <= NT) step_cons<1>(B, lds, t + 1, NT, tid, p, lane, r32, hi, o, stK);
        }
        __syncthreads();
        const float* llp = (const float*)(lds + OFF_LL) + p * 32;
        float* Ow = B.O + (size_t)(p * 32) * 256;
        if constexpr (MODE == 0) {
#pragma unroll
            for (int r = 0; r < 16; ++r) { const int orow = att::crow(r, hi); const float rl = __builtin_amdgcn_rcpf(llp[orow]);
#pragma unroll
                for (int d = 0; d < 8; ++d) ((__attribute__((address_space(1))) float*)Ow)[(size_t)orow * 256 + d * 32 + r32] = o[d][r] * rl; }
        } else {
            asm volatile("s_waitcnt vmcnt(0)" ::: "memory");
            int ll_ = threadIdx.x; asm volatile("" : "+v"(ll_)); ll_ &= 63;
            f32x4 sw0 = {B.subln[r32], B.subln[32 + r32], B.subln[64 + r32], B.subln[96 + r32]}, sw1 = {B.subln[128 + r32], B.subln[160 + r32], B.subln[192 + r32], B.subln[224 + r32]};
#pragma unroll
            for (int r = 0; r < 16; ++r) { const int orow = att::crow(r, hi); const float rl = __builtin_amdgcn_rcpf(llp[orow]) * B.lam; float q = 0.f; float dv[8];
#pragma unroll
                for (int d = 0; d < 8; ++d) { const float o0 = ((const __attribute__((address_space(1))) float*)Ow)[(size_t)orow * 256 + d * 32 + r32]; dv[d] = o0 - o[d][r] * rl; q += dv[d] * dv[d]; }
#pragma unroll
                for (int sft = 1; sft < 32; sft <<= 1) q += __builtin_bit_cast(float, __builtin_amdgcn_ds_bpermute((ll_ ^ sft) << 2, __builtin_bit_cast(int, q)));
                const float rs = B.post / sqrtf(q * (1.f / 256.f) + 1e-5f);
                __attribute__((address_space(1))) unsigned short* arow = (__attribute__((address_space(1))) unsigned short*)B.AO + (size_t)(p * 32 + orow) * 4096 + r32;
#pragma unroll
                for (int d = 0; d < 8; ++d) { const float v = dv[d] * rs * (d < 4 ? sw0[d & 3] : sw1[d & 3]);
                    const float vn = __builtin_bit_cast(float, __builtin_amdgcn_update_dpp(0, __builtin_bit_cast(int, v), 0xB1, 0xf, 0xf, true));
                    if ((r32 & 1) == 0) *(__attribute__((address_space(1))) unsigned*)(arow + d * 32) = att::cvtpk(v, vn); }
            }
        }
    }
    __syncthreads();
}
}

__device__ __forceinline__ att2::Blk att2_ref(const bf16* QKVH, float* OP2, bf16* AO, const float* subln, float lam, float post, int L, int c, int pass) {
    const int bh = L >> 4, y = L & 15; const int h = bh & 15, b = bh >> 4; const int qb = pass ? 31 - y : y;
    const size_t GS = (size_t)M * 128;
    att2::Blk r;
    r.Q = QKVH + (size_t)(2 * h + c) * GS + (size_t)(b * SEQ + qb * 128) * 128;
    r.K = QKVH + (size_t)(32 + 2 * h + c) * GS + (size_t)(b * SEQ) * 128;
    r.V0 = QKVH + (size_t)(64 + 2 * h) * GS + (size_t)(b * SEQ) * 128;
    r.V1 = QKVH + (size_t)(65 + 2 * h) * GS + (size_t)(b * SEQ) * 128;
    r.O = OP2 + (size_t)h * M * 256 + (size_t)(b * SEQ + qb * 128) * 256;
    r.P0 = qb * 128;
    r.AO = AO + (size_t)(b * SEQ + qb * 128) * DM + h * 256; r.subln = subln; r.lam = lam; r.post = post;
    return r;
}
__device__ __forceinline__ void attn2_phase(Frame& F, const bf16* QKVH, float* OP2, char* lds, const float* lq1, const float* lk1, const float* lq2, const float* lk2, const float* subln, float lambda_init, bf16* AO) {
    const int lane = F.lane;
    const float d1 = wave_sum(lq1[lane] * lk1[lane] + lq1[lane + 64] * lk1[lane + 64]), d2 = wave_sum(lq2[lane] * lk2[lane] + lq2[lane + 64] * lk2[lane + 64]);
    const float lam = expf(d1) - expf(d2) + lambda_init, post = 1.0f - lambda_init;
    for (int L = F.vcu; L < 512; L += F.G) {
#pragma unroll 1
        for (int pass = 0; pass < 2; ++pass) {
            { const att2::Blk B = att2_ref(QKVH, OP2, AO, subln, lam, post, L, 0, pass); att2::block<0>(B, lds); }
            { const att2::Blk B = att2_ref(QKVH, OP2, AO, subln, lam, post, L, 1, pass); att2::block<1>(B, lds); }
        }
    }
}
__device__ __forceinline__ void attn_combine_phase(Frame& F, const float* OP, const float* lq1, const float* lk1, const float* lq2, const float* lk2, const float* subln, float lambda_init, bf16* AO) {
    const int gw = F.vcu * NWAVES + F.wave, NGW = F.G * NWAVES, lane = F.lane;
    const float d1 = wave_sum(lq1[lane] * lk1[lane] + lq1[lane + 64] * lk1[lane + 64]), d2 = wave_sum(lq2[lane] * lk2[lane] + lq2[lane + 64] * lk2[lane + 64]);
    const float lam = expf(d1) - expf(d2) + lambda_init, post = 1.0f - lambda_init;
    const int vh = lane >> 5, d = (lane & 31) * 4;
    const f32x4 sw = *(const GAS f32x4*)(subln + vh * 128 + d);
    const size_t GS = (size_t)M * 128;
    constexpr int UN = 8;
    for (int it0 = gw; it0 < M * AH; it0 += UN * NGW) {
        f32x4 o1[UN], o2[UN];
#pragma unroll
        for (int u = 0; u < UN; ++u) { const int it = it0 + u * NGW, m = it >> 4, h = it & 15;
            if (it < M * AH) { o1[u] = *(const GAS f32x4*)(OP + (size_t)(2 * h) * M * 256 + (size_t)m * 256 + vh * 128 + d); o2[u] = *(const GAS f32x4*)(OP + (size_t)(2 * h + 1) * M * 256 + (size_t)m * 256 + vh * 128 + d); } }
#pragma unroll
        for (int u = 0; u < UN; ++u) { const int it = it0 + u * NGW, m = it >> 4, h = it & 15;
            if (it >= M * AH) break;
            const f32x4 o = o1[u] - lam * o2[u];
            const float ss = wave_sum((o.x * o.x + o.y * o.y) + (o.z * o.z + o.w * o.w));
            const float rs = post / sqrtf(ss * (1.f / 256.f) + EPS);
            v2u w; w.x = pk2(o.x * rs * sw.x, o.y * rs * sw.y); w.y = pk2(o.z * rs * sw.z, o.w * rs * sw.w);
            *(GAS v2u*)((GAS bf16*)AO + (size_t)m * DM + h * 256 + vh * 128 + d) = w;
        }
    }
}


struct Args { const float* in[57]; float* out; unsigned char* ws; };
__global__ void __launch_bounds__(NTHR, 2) trunk_fwd(Args args) {
    extern __shared__ __attribute__((aligned(16))) unsigned char lds[];
    Frame F;
    F.lds = (LAS unsigned char*)lds;
    F.tid = threadIdx.x; F.lane = F.tid & 63; F.wave = __builtin_amdgcn_readfirstlane(F.tid >> 6);
    gu32* ctl = (gu32*)(args.ws + WS_CTL);
    for (int u = F.tid; u < (LDS_BYTES - LDSCTL_OFF) / 4; u += NTHR) ((LAS unsigned*)(F.lds + LDSCTL_OFF))[u] = 0u;
    __syncthreads();
    volatile LAS unsigned* MISC = (volatile LAS unsigned*)(F.lds + MISC_OFF);
    XcdBarrier bar = xcd_barrier_post((unsigned*)(ctl + CW_BAR), MISC + 8);
#define GRID_BAR() do { xcd_barrier(bar); relaunder(F, args.ws); } while (0)

#define XR ((float*)(F.ws + WS_XR))
#define U ((bf16*)(F.ws + WS_U))
#define BIG ((bf16*)(F.ws + WS_BIG))
#define ACT2 ((bf16*)(F.ws + WS_ACT2))
#define XT ((bf16*)(F.ws + WS_XT))
#define Yb ((bf16*)(F.ws + WS_Y))
#define Bn ((bf16*)(F.ws + WS_BN))
#define BT ((bf16*)(F.ws + WS_BT))
#define Cn ((bf16*)(F.ws + WS_CN))
#define DTF ((float*)(F.ws + WS_DTF))
#define PART ((float*)(F.ws + WS_PART))
#define OP ((float*)(F.ws + WS_XT))
#define SSQ(k) ((unsigned long long*)((unsigned*)(F.ws + WS_CTL) + CW_SS) + (k) * M)
#define ropec ((float*)(F.ws + WS_ROPE))
#define ropes ((float*)(F.ws + WS_ROPE) + (size_t)M * 64)
    relaunder(F, args.ws);

    {
        int p0_prefix = 0;
#pragma unroll 1
        for (int layer = 0; layer < 4; ++layer) {
            const bool mamba = (layer & 1) == 0;
            const int ib = layer == 0 ? 2 : layer == 1 ? 16 : layer == 2 ? 29 : 43;
            const size_t wlo = WS_W + (layer == 0 ? 0 : layer == 1 ? WL_MAMBA : layer == 2 ? WL_MAMBA + WL_ATTN : 2 * WL_MAMBA + WL_ATTN);
            if (mamba) {
                p0_matrix(F, args.in[ib + 1], DM, NZX, NZXP, (bf16*)(F.ws + wlo + W_IN), p0_prefix, 0, args.in[ib + 0]);
                p0_matrix(F, args.in[ib + 8], DI, DM, DM, (bf16*)(F.ws + wlo + W_OUT), p0_prefix);
                p0_matrix(F, args.in[ib + 10], DM, NUP, NUP, (bf16*)(F.ws + wlo + W_UP_M), p0_prefix, 0, args.in[ib + 9], DFF / 256);
                p0_matrix(F, args.in[ib + 13], DFF, DM, DM, (bf16*)(F.ws + wlo + W_DOWN_M), p0_prefix, 0, nullptr, 0, -1, 0, (layer == 0 || F.G != 256) ? 0 : TAIL_TILES);
            } else {
                p0_matrix(F, args.in[ib + 1], DM, NQKV, NQKV, (bf16*)(F.ws + wlo + W_QKV), p0_prefix, 2 * DM, args.in[ib + 0]);
                p0_matrix(F, args.in[ib + 7], DM, DM, DM, (bf16*)(F.ws + wlo + W_O), p0_prefix);
                p0_matrix(F, args.in[ib + 9], DM, NUP, NUP, (bf16*)(F.ws + wlo + W_UP_A), p0_prefix, 0, args.in[ib + 8], DFF / 256);
                p0_matrix(F, args.in[ib + 12], DFF, DM, DM, (bf16*)(F.ws + wlo + W_DOWN_A), p0_prefix, 0, nullptr, 0, -1, 0, (layer == 0 || F.G != 256) ? 0 : TAIL_TILES);
            }
        }
        rope_table_phase(F, (const int*)args.in[1], ropec, ropes);
        { const int gw = F.vcu * NWAVES + F.wave, NGW = F.G * NWAVES;
          for (int m = gw; m < M; m += NGW) x_row_prep(args.in[0] + (size_t)m * DM, U + (size_t)m * DM, SSQ(0) + m, F.lane); }
        GRID_BAR();
    }

    {
        constexpr int layer = 0;
        constexpr bool mamba = (layer & 1) == 0;
        constexpr int ib = layer == 0 ? 2 : layer == 1 ? 16 : layer == 2 ? 29 : 43;
        constexpr size_t wlo = WS_W + (layer == 0 ? 0 : layer == 1 ? WL_MAMBA : layer == 2 ? WL_MAMBA + WL_ATTN : 2 * WL_MAMBA + WL_ATTN);
        const float* xin = layer == 0 ? args.in[0] : XR;
        if constexpr (mamba) {
            const bool splitdt = F.G == 256;
            if (splitdt) {
                { pg8::Gemm g{U, (const bf16*)(F.ws + wlo + W_IN), M, NZXM, DM}; pg8::StaticOrder S; S.init(M, NZXM, F.G, F.bx);
                  int pm0, ntab; rstd_table(F, S, SSQ(2 * layer), pm0, ntab);
                  pg8::EpiBf16S E{BIG, NZXP, SSQ(2 * layer), (const LAS float*)(F.lds + TAB_OFF), pm0, ntab};
                  pg8::gemm_phase<pg8::EpiBf16S, pg8::StaticOrder, PG8_ALIGN, PG8_SP2>(F.lds + RING_OFF, g, S, E); }
                { const int ks = F.vcu & 7; pg8::Gemm g{U + ks * 512, (const bf16*)(F.ws + wlo + W_IN) + (size_t)NZXM * DM + ks * 512, M, 256, 512, DM};
                  pg8::OneUnit S{F.vcu >> 3, 1}; pg8::EpiPart E{PART + (size_t)ks * M * 128};
                  pg8::gemm_phase<pg8::EpiPart, pg8::OneUnit, false, PG8_SP2>(F.lds + RING_OFF, g, S, E); }
            } else {
                { pg8::Gemm g{U, (const bf16*)(F.ws + wlo + W_IN), M, NZXP, DM}; pg8::StaticOrder S; S.init(M, NZXP, F.G, F.bx);
                  int pm0, ntab; rstd_table(F, S, SSQ(2 * layer), pm0, ntab);
                  pg8::EpiBf16S E{BIG, NZXP, SSQ(2 * layer), (const LAS float*)(F.lds + TAB_OFF), pm0, ntab};
                  pg8::gemm_phase<pg8::EpiBf16S, pg8::StaticOrder, PG8_ALIGN, PG8_SP2>(F.lds + RING_OFF, g, S, E); }
            }
            GRID_BAR();
            ssd_prep_phase(F, BIG, args.in[ib + 2], args.in[ib + 3], args.in[ib + 4], XT, Bn, BT, Cn, DTF, splitdt ? PART : nullptr, SSQ(2 * layer));
            GRID_BAR();
            ssd_phase(F, XT, Bn, BT, Cn, DTF, args.in[ib + 5], args.in[ib + 6], Yb);
            GRID_BAR();
            gated_norm_phase(F, Yb, BIG, args.in[ib + 7], ACT2);
            GRID_BAR();
            { pg8::Gemm g{ACT2, (const bf16*)(F.ws + wlo + W_OUT), M, DM, DI}; pg8::StaticOrder S; S.init(M, DM, F.G, F.bx);
              pg8::EpiResN E{xin, XR, U, SSQ(2 * layer + 1), DM};
              pg8::gemm_phase<pg8::EpiResN, pg8::StaticOrder, PG8_ALIGN, PG8_SP2>(F.lds + RING_OFF, g, S, E); }
            GRID_BAR();
        } else {
            { pg8::Gemm g{U, (const bf16*)(F.ws + wlo + W_QKV), M, NQKV, DM}; pg8::StaticOrder S; S.init(M, NQKV, F.G, F.bx);
              int pm0, ntab; rstd_table(F, S, SSQ(2 * layer), pm0, ntab);
              pg8::EpiHeadMajor E{BIG, (size_t)M * 128, ropec, ropes, SSQ(2 * layer), (const LAS float*)(F.lds + TAB_OFF), pm0, ntab};
              pg8::gemm_phase<pg8::EpiHeadMajor, pg8::StaticOrder, PG8_ALIGN, PG8_SP2>(F.lds + RING_OFF, g, S, E); }
            GRID_BAR();
            attn2_phase(F, BIG, OP, (char*)lds + RING_OFF, args.in[ib + 2], args.in[ib + 3], args.in[ib + 4], args.in[ib + 5], args.in[ib + 6], 0.8f - 0.6f * expf(-0.3f * (float)layer), ACT2);
            GRID_BAR();
            { pg8::Gemm g{ACT2, (const bf16*)(F.ws + wlo + W_O), M, DM, DM}; pg8::StaticOrder S; S.init(M, DM, F.G, F.bx);
              pg8::EpiResN E{xin, XR, U, SSQ(2 * layer + 1), DM};
              pg8::gemm_phase<pg8::EpiResN, pg8::StaticOrder, PG8_ALIGN, PG8_SP2>(F.lds + RING_OFF, g, S, E); }
            GRID_BAR();
        }
        constexpr int fb = mamba ? ib + 9 : ib + 8;
        { pg8::Gemm g{U, (const bf16*)(F.ws + wlo + (mamba ? W_UP_M : W_UP_A)), M, NUP, DM}; pg8::StaticOrder S; S.init(M, NUP, F.G, F.bx);

          { pg8::EpiGate E{ACT2, BIG, args.in[fb + 2], args.in[fb + 3], NUP, DFF, SSQ(2 * layer + 1), F.lds + SIDE_OFF};
          pg8::gemm_phase<pg8::EpiGate, pg8::StaticOrder, PG8_ALIGN, PG8_SP2>(F.lds + RING_OFF, g, S, E); } }
        if constexpr (layer < 3) { if (F.G == 256 && F.bx >= 192) {
            constexpr bool nm = ((layer + 1) & 1) == 0; constexpr int nib = layer + 1 == 1 ? 16 : layer + 1 == 2 ? 29 : 43;
            constexpr size_t nwlo = WS_W + (layer + 1 == 1 ? WL_MAMBA : layer + 1 == 2 ? WL_MAMBA + WL_ATTN : 2 * WL_MAMBA + WL_ATTN);
            int nopfx = 0; p0_matrix(F, args.in[nib + (nm ? 13 : 12)], DFF, DM, DM, (bf16*)(F.ws + nwlo + (nm ? W_DOWN_M : W_DOWN_A)), nopfx, 0, nullptr, 0, F.bx - 192, 64, 0, TAIL_TILES); } }
        GRID_BAR();
        ffn_fix_phase(F, BIG, args.in[fb + 2], args.in[fb + 3], ACT2);
        GRID_BAR();
        { pg8::Gemm g{ACT2, (const bf16*)(F.ws + wlo + (mamba ? W_DOWN_M : W_DOWN_A)), M, DM, DFF}; pg8::StaticOrder S; S.init(M, DM, F.G, F.bx);
          pg8::EpiResN E{XR, XR, layer == 3 ? (bf16*)nullptr : U, SSQ(2 * layer + 2), DM};
          pg8::gemm_phase<pg8::EpiResN, pg8::StaticOrder, PG8_ALIGN, PG8_SP2>(F.lds + RING_OFF, g, S, E); }
        GRID_BAR();
    }
    {
        constexpr int layer = 1;
        constexpr bool mamba = (layer & 1) == 0;
        constexpr int ib = layer == 0 ? 2 : layer == 1 ? 16 : layer == 2 ? 29 : 43;
        constexpr size_t wlo = WS_W + (layer == 0 ? 0 : layer == 1 ? WL_MAMBA : layer == 2 ? WL_MAMBA + WL_ATTN : 2 * WL_MAMBA + WL_ATTN);
        const float* xin = layer == 0 ? args.in[0] : XR;
        if constexpr (mamba) {
            const bool splitdt = F.G == 256;
            if (splitdt) {
                { pg8::Gemm g{U, (const bf16*)(F.ws + wlo + W_IN), M, NZXM, DM}; pg8::StaticOrder S; S.init(M, NZXM, F.G, F.bx);
                  int pm0, ntab; rstd_table(F, S, SSQ(2 * layer), pm0, ntab);
                  pg8::EpiBf16S E{BIG, NZXP, SSQ(2 * layer), (const LAS float*)(F.lds + TAB_OFF), pm0, ntab};
                  pg8::gemm_phase<pg8::EpiBf16S, pg8::StaticOrder, PG8_ALIGN, PG8_SP2>(F.lds + RING_OFF, g, S, E); }
                { const int ks = F.vcu & 7; pg8::Gemm g{U + ks * 512, (const bf16*)(F.ws + wlo + W_IN) + (size_t)NZXM * DM + ks * 512, M, 256, 512, DM};
                  pg8::OneUnit S{F.vcu >> 3, 1}; pg8::EpiPart E{PART + (size_t)ks * M * 128};
                  pg8::gemm_phase<pg8::EpiPart, pg8::OneUnit, false, PG8_SP2>(F.lds + RING_OFF, g, S, E); }
            } else {
                { pg8::Gemm g{U, (const bf16*)(F.ws + wlo + W_IN), M, NZXP, DM}; pg8::StaticOrder S; S.init(M, NZXP, F.G, F.bx);
                  int pm0, ntab; rstd_table(F, S, SSQ(2 * layer), pm0, ntab);
                  pg8::EpiBf16S E{BIG, NZXP, SSQ(2 * layer), (const LAS float*)(F.lds + TAB_OFF), pm0, ntab};
                  pg8::gemm_phase<pg8::EpiBf16S, pg8::StaticOrder, PG8_ALIGN, PG8_SP2>(F.lds + RING_OFF, g, S, E); }
            }
            GRID_BAR();
            ssd_prep_phase(F, BIG, args.in[ib + 2], args.in[ib + 3], args.in[ib + 4], XT, Bn, BT, Cn, DTF, splitdt ? PART : nullptr, SSQ(2 * layer));
            GRID_BAR();
            ssd_phase(F, XT, Bn, BT, Cn, DTF, args.in[ib + 5], args.in[ib + 6], Yb);
            GRID_BAR();
            gated_norm_phase(F, Yb, BIG, args.in[ib + 7], ACT2);
            GRID_BAR();
            { pg8::Gemm g{ACT2, (const bf16*)(F.ws + wlo + W_OUT), M, DM, DI}; pg8::StaticOrder S; S.init(M, DM, F.G, F.bx);
              pg8::EpiResN E{xin, XR, U, SSQ(2 * layer + 1), DM};
              pg8::gemm_phase<pg8::EpiResN, pg8::StaticOrder, PG8_ALIGN, PG8_SP2>(F.lds + RING_OFF, g, S, E); }
            GRID_BAR();
        } else {
            { pg8::Gemm g{U, (const bf16*)(F.ws + wlo + W_QKV), M, NQKV, DM}; pg8::StaticOrder S; S.init(M, NQKV, F.G, F.bx);
              int pm0, ntab; rstd_table(F, S, SSQ(2 * layer), pm0, ntab);
              pg8::EpiHeadMajor E{BIG, (size_t)M * 128, ropec, ropes, SSQ(2 * layer), (const LAS float*)(F.lds + TAB_OFF), pm0, ntab};
              pg8::gemm_phase<pg8::EpiHeadMajor, pg8::StaticOrder, PG8_ALIGN, PG8_SP2>(F.lds + RING_OFF, g, S, E); }
            GRID_BAR();
            attn2_phase(F, BIG, OP, (char*)lds + RING_OFF, args.in[ib + 2], args.in[ib + 3], args.in[ib + 4], args.in[ib + 5], args.in[ib + 6], 0.8f - 0.6f * expf(-0.3f * (float)layer), ACT2);
            GRID_BAR();
            { pg8::Gemm g{ACT2, (const bf16*)(F.ws + wlo + W_O), M, DM, DM}; pg8::StaticOrder S; S.init(M, DM, F.G, F.bx);
              pg8::EpiResN E{xin, XR, U, SSQ(2 * layer + 1), DM};
              pg8::gemm_phase<pg8::EpiResN, pg8::StaticOrder, PG8_ALIGN, PG8_SP2>(F.lds + RING_OFF, g, S, E); }
            GRID_BAR();
        }
        constexpr int fb = mamba ? ib + 9 : ib + 8;
        { pg8::Gemm g{U, (const bf16*)(F.ws + wlo + (mamba ? W_UP_M : W_UP_A)), M, NUP, DM}; pg8::StaticOrder S; S.init(M, NUP, F.G, F.bx);

          { pg8::EpiGate E{ACT2, BIG, args.in[fb + 2], args.in[fb + 3], NUP, DFF, SSQ(2 * layer + 1), F.lds + SIDE_OFF};
          pg8::gemm_phase<pg8::EpiGate, pg8::StaticOrder, PG8_ALIGN, PG8_SP2>(F.lds + RING_OFF, g, S, E); } }
        if constexpr (layer < 3) { if (F.G == 256 && F.bx >= 192) {
            constexpr bool nm = ((layer + 1) & 1) == 0; constexpr int nib = layer + 1 == 1 ? 16 : layer + 1 == 2 ? 29 : 43;
            constexpr size_t nwlo = WS_W + (layer + 1 == 1 ? WL_MAMBA : layer + 1 == 2 ? WL_MAMBA + WL_ATTN : 2 * WL_MAMBA + WL_ATTN);
            int nopfx = 0; p0_matrix(F, args.in[nib + (nm ? 13 : 12)], DFF, DM, DM, (bf16*)(F.ws + nwlo + (nm ? W_DOWN_M : W_DOWN_A)), nopfx, 0, nullptr, 0, F.bx - 192, 64, 0, TAIL_TILES); } }
        GRID_BAR();
        ffn_fix_phase(F, BIG, args.in[fb + 2], args.in[fb + 3], ACT2);
        GRID_BAR();
        { pg8::Gemm g{ACT2, (const bf16*)(F.ws + wlo + (mamba ? W_DOWN_M : W_DOWN_A)), M, DM, DFF}; pg8::StaticOrder S; S.init(M, DM, F.G, F.bx);
          pg8::EpiResN E{XR, XR, layer == 3 ? (bf16*)nullptr : U, SSQ(2 * layer + 2), DM};
          pg8::gemm_phase<pg8::EpiResN, pg8::StaticOrder, PG8_ALIGN, PG8_SP2>(F.lds + RING_OFF, g, S, E); }
        GRID_BAR();
    }
    {
        constexpr int layer = 2;
        constexpr bool mamba = (layer & 1) == 0;
        constexpr int ib = layer == 0 ? 2 : layer == 1 ? 16 : layer == 2 ? 29 : 43;
        constexpr size_t wlo = WS_W + (layer == 0 ? 0 : layer == 1 ? WL_MAMBA : layer == 2 ? WL_MAMBA + WL_ATTN : 2 * WL_MAMBA + WL_ATTN);
        const float* xin = layer == 0 ? args.in[0] : XR;
        if constexpr (mamba) {
            const bool splitdt = F.G == 256;
            if (splitdt) {
                { pg8::Gemm g{U, (const bf16*)(F.ws + wlo + W_IN), M, NZXM, DM}; pg8::StaticOrder S; S.init(M, NZXM, F.G, F.bx);
                  int pm0, ntab; rstd_table(F, S, SSQ(2 * layer), pm0, ntab);
                  pg8::EpiBf16S E{BIG, NZXP, SSQ(2 * layer), (const LAS float*)(F.lds + TAB_OFF), pm0, ntab};
                  pg8::gemm_phase<pg8::EpiBf16S, pg8::StaticOrder, PG8_ALIGN, PG8_SP2>(F.lds + RING_OFF, g, S, E); }
                { const int ks = F.vcu & 7; pg8::Gemm g{U + ks * 512, (const bf16*)(F.ws + wlo + W_IN) + (size_t)NZXM * DM + ks * 512, M, 256, 512, DM};
                  pg8::OneUnit S{F.vcu >> 3, 1}; pg8::EpiPart E{PART + (size_t)ks * M * 128};
                  pg8::gemm_phase<pg8::EpiPart, pg8::OneUnit, false, PG8_SP2>(F.lds + RING_OFF, g, S, E); }
            } else {
                { pg8::Gemm g{U, (const bf16*)(F.ws + wlo + W_IN), M, NZXP, DM}; pg8::StaticOrder S; S.init(M, NZXP, F.G, F.bx);
                  int pm0, ntab; rstd_table(F, S, SSQ(2 * layer), pm0, ntab);
                  pg8::EpiBf16S E{BIG, NZXP, SSQ(2 * layer), (const LAS float*)(F.lds + TAB_OFF), pm0, ntab};
                  pg8::gemm_phase<pg8::EpiBf16S, pg8::StaticOrder, PG8_ALIGN, PG8_SP2>(F.lds + RING_OFF, g, S, E); }
            }
            GRID_BAR();
            ssd_prep_phase(F, BIG, args.in[ib + 2], args.in[ib + 3], args.in[ib + 4], XT, Bn, BT, Cn, DTF, splitdt ? PART : nullptr, SSQ(2 * layer));
            GRID_BAR();
            ssd_phase(F, XT, Bn, BT, Cn, DTF, args.in[ib + 5], args.in[ib + 6], Yb);
            GRID_BAR();
            gated_norm_phase(F, Yb, BIG, args.in[ib + 7], ACT2);
            GRID_BAR();
            { pg8::Gemm g{ACT2, (const bf16*)(F.ws + wlo + W_OUT), M, DM, DI}; pg8::StaticOrder S; S.init(M, DM, F.G, F.bx);
              pg8::EpiResN E{xin, XR, U, SSQ(2 * layer + 1), DM};
              pg8::gemm_phase<pg8::EpiResN, pg8::StaticOrder, PG8_ALIGN, PG8_SP2>(F.lds + RING_OFF, g, S, E); }
            GRID_BAR();
        } else {
            { pg8::Gemm g{U, (const bf16*)(F.ws + wlo + W_QKV), M, NQKV, DM}; pg8::StaticOrder S; S.init(M, NQKV, F.G, F.bx);
              int pm0, ntab; rstd_table(F, S, SSQ(2 * layer), pm0, ntab);
              pg8::EpiHeadMajor E{BIG, (size_t)M * 128, ropec, ropes, SSQ(2 * layer), (const LAS float*)(F.lds + TAB_OFF), pm0, ntab};
              pg8::gemm_phase<pg8::EpiHeadMajor, pg8::StaticOrder, PG8_ALIGN, PG8_SP2>(F.lds + RING_OFF, g, S, E); }
            GRID_BAR();
            attn2_phase(F, BIG, OP, (char*)lds + RING_OFF, args.in[ib + 2], args.in[ib + 3], args.in[ib + 4], args.in[ib + 5], args.in[ib + 6], 0.8f - 0.6f * expf(-0.3f * (float)layer), ACT2);
            GRID_BAR();
            { pg8::Gemm g{ACT2, (const bf16*)(F.ws + wlo + W_O), M, DM, DM}; pg8::StaticOrder S; S.init(M, DM, F.G, F.bx);
              pg8::EpiResN E{xin, XR, U, SSQ(2 * layer + 1), DM};
              pg8::gemm_phase<pg8::EpiResN, pg8::StaticOrder, PG8_ALIGN, PG8_SP2>(F.lds + RING_OFF, g, S, E); }
            GRID_BAR();
        }
        constexpr int fb = mamba ? ib + 9 : ib + 8;
        { pg8::Gemm g{U, (const bf16*)(F.ws + wlo + (mamba ? W_UP_M : W_UP_A)), M, NUP, DM}; pg8::StaticOrder S; S.init(M, NUP, F.G, F.bx);

          { pg8::EpiGate E{ACT2, BIG, args.in[fb + 2], args.in[fb + 3], NUP, DFF, SSQ(2 * layer + 1), F.lds + SIDE_OFF};
          pg8::gemm_phase<pg8::EpiGate, pg8::StaticOrder, PG8_ALIGN, PG8_SP2>(F.lds + RING_OFF, g, S, E); } }
        if constexpr (layer < 3) { if (F.G == 256 && F.bx >= 192) {
            constexpr bool nm = ((layer + 1) & 1) == 0; constexpr int nib = layer + 1 == 1 ? 16 : layer + 1 == 2 ? 29 : 43;
            constexpr size_t nwlo = WS_W + (layer + 1 == 1 ? WL_MAMBA : layer + 1 == 2 ? WL_MAMBA + WL_ATTN : 2 * WL_MAMBA + WL_ATTN);
            int nopfx = 0; p0_matrix(F, args.in[nib + (nm ? 13 : 12)], DFF, DM, DM, (bf16*)(F.ws + nwlo + (nm ? W_DOWN_M : W_DOWN_A)), nopfx, 0, nullptr, 0, F.bx - 192, 64, 0, TAIL_TILES); } }
        GRID_BAR();
        ffn_fix_phase(F, BIG, args.in[fb + 2], args.in[fb + 3], ACT2);
        GRID_BAR();
        { pg8::Gemm g{ACT2, (const bf16*)(F.ws + wlo + (mamba ? W_DOWN_M : W_DOWN_A)), M, DM, DFF}; pg8::StaticOrder S; S.init(M, DM, F.G, F.bx);
          pg8::EpiResN E{XR, XR, layer == 3 ? (bf16*)nullptr : U, SSQ(2 * layer + 2), DM};
          pg8::gemm_phase<pg8::EpiResN, pg8::StaticOrder, PG8_ALIGN, PG8_SP2>(F.lds + RING_OFF, g, S, E); }
        GRID_BAR();
    }
    {
        constexpr int layer = 3;
        constexpr bool mamba = (layer & 1) == 0;
        constexpr int ib = layer == 0 ? 2 : layer == 1 ? 16 : layer == 2 ? 29 : 43;
        constexpr size_t wlo = WS_W + (layer == 0 ? 0 : layer == 1 ? WL_MAMBA : layer == 2 ? WL_MAMBA + WL_ATTN : 2 * WL_MAMBA + WL_ATTN);
        const float* xin = layer == 0 ? args.in[0] : XR;
        if constexpr (mamba) {
            const bool splitdt = F.G == 256;
            if (splitdt) {
                { pg8::Gemm g{U, (const bf16*)(F.ws + wlo + W_IN), M, NZXM, DM}; pg8::StaticOrder S; S.init(M, NZXM, F.G, F.bx);
                  int pm0, ntab; rstd_table(F, S, SSQ(2 * layer), pm0, ntab);
                  pg8::EpiBf16S E{BIG, NZXP, SSQ(2 * layer), (const LAS float*)(F.lds + TAB_OFF), pm0, ntab};
                  pg8::gemm_phase<pg8::EpiBf16S, pg8::StaticOrder, PG8_ALIGN, PG8_SP2>(F.lds + RING_OFF, g, S, E); }
                { const int ks = F.vcu & 7; pg8::Gemm g{U + ks * 512, (const bf16*)(F.ws + wlo + W_IN) + (size_t)NZXM * DM + ks * 512, M, 256, 512, DM};
                  pg8::OneUnit S{F.vcu >> 3, 1}; pg8::EpiPart E{PART + (size_t)ks * M * 128};
                  pg8::gemm_phase<pg8::EpiPart, pg8::OneUnit, false, PG8_SP2>(F.lds + RING_OFF, g, S, E); }
            } else {
                { pg8::Gemm g{U, (const bf16*)(F.ws + wlo + W_IN), M, NZXP, DM}; pg8::StaticOrder S; S.init(M, NZXP, F.G, F.bx);
                  int pm0, ntab; rstd_table(F, S, SSQ(2 * layer), pm0, ntab);
                  pg8::EpiBf16S E{BIG, NZXP, SSQ(2 * layer), (const LAS float*)(F.lds + TAB_OFF), pm0, ntab};
                  pg8::gemm_phase<pg8::EpiBf16S, pg8::StaticOrder, PG8_ALIGN, PG8_SP2>(F.lds + RING_OFF, g, S, E); }
            }
            GRID_BAR();
            ssd_prep_phase(F, BIG, args.in[ib + 2], args.in[ib + 3], args.in[ib + 4], XT, Bn, BT, Cn, DTF, splitdt ? PART : nullptr, SSQ(2 * layer));
            GRID_BAR();
            ssd_phase(F, XT, Bn, BT, Cn, DTF, args.in[ib + 5], args.in[ib + 6], Yb);
            GRID_BAR();
            gated_norm_phase(F, Yb, BIG, args.in[ib + 7], ACT2);
            GRID_BAR();
            { pg8::Gemm g{ACT2, (const bf16*)(F.ws + wlo + W_OUT), M, DM, DI}; pg8::StaticOrder S; S.init(M, DM, F.G, F.bx);
              pg8::EpiResN E{xin, XR, U, SSQ(2 * layer + 1), DM};
              pg8::gemm_phase<pg8::EpiResN, pg8::StaticOrder, PG8_ALIGN, PG8_SP2>(F.lds + RING_OFF, g, S, E); }
            GRID_BAR();
        } else {
            { pg8::Gemm g{U, (const bf16*)(F.ws + wlo + W_QKV), M, NQKV, DM}; pg8::StaticOrder S; S.init(M, NQKV, F.G, F.bx);
              int pm0, ntab; rstd_table(F, S, SSQ(2 * layer), pm0, ntab);
              pg8::EpiHeadMajor E{BIG, (size_t)M * 128, ropec, ropes, SSQ(2 * layer), (const LAS float*)(F.lds + TAB_OFF), pm0, ntab};
              pg8::gemm_phase<pg8::EpiHeadMajor, pg8::StaticOrder, PG8_ALIGN, PG8_SP2>(F.lds + RING_OFF, g, S, E); }
            GRID_BAR();
            attn2_phase(F, BIG, OP, (char*)lds + RING_OFF, args.in[ib + 2], args.in[ib + 3], args.in[ib + 4], args.in[ib + 5], args.in[ib + 6], 0.8f - 0.6f * expf(-0.3f * (float)layer), ACT2);
            GRID_BAR();
            { pg8::Gemm g{ACT2, (const bf16*)(F.ws + wlo + W_O), M, DM, DM}; pg8::StaticOrder S; S.init(M, DM, F.G, F.bx);
              pg8::EpiResN E{xin, XR, U, SSQ(2 * layer + 1), DM};
              pg8::gemm_phase<pg8::EpiResN, pg8::StaticOrder, PG8_ALIGN, PG8_SP2>(F.lds + RING_OFF, g, S, E); }
            GRID_BAR();
        }
        constexpr int fb = mamba ? ib + 9 : ib + 8;
        { pg8::Gemm g{U, (const bf16*)(F.ws + wlo + (mamba ? W_UP_M : W_UP_A)), M, NUP, DM}; pg8::StaticOrder S; S.init(M, NUP, F.G, F.bx);

          { pg8::EpiGate E{ACT2, BIG, args.in[fb + 2], args.in[fb + 3], NUP, DFF, SSQ(2 * layer + 1), F.lds + SIDE_OFF};
          pg8::gemm_phase<pg8::EpiGate, pg8::StaticOrder, PG8_ALIGN, PG8_SP2>(F.lds + RING_OFF, g, S, E); } }
        if constexpr (layer < 3) { if (F.G == 256 && F.bx >= 192) {
            constexpr bool nm = ((layer + 1) & 1) == 0; constexpr int nib = layer + 1 == 1 ? 16 : layer + 1 == 2 ? 29 : 43;
            constexpr size_t nwlo = WS_W + (layer + 1 == 1 ? WL_MAMBA : layer + 1 == 2 ? WL_MAMBA + WL_ATTN : 2 * WL_MAMBA + WL_ATTN);
            int nopfx = 0; p0_matrix(F, args.in[nib + (nm ? 13 : 12)], DFF, DM, DM, (bf16*)(F.ws + nwlo + (nm ? W_DOWN_M : W_DOWN_A)), nopfx, 0, nullptr, 0, F.bx - 192, 64, 0, TAIL_TILES); } }
        GRID_BAR();
        ffn_fix_phase(F, BIG, args.in[fb + 2], args.in[fb + 3], ACT2);
        GRID_BAR();
        { pg8::Gemm g{ACT2, (const bf16*)(F.ws + wlo + (mamba ? W_DOWN_M : W_DOWN_A)), M, DM, DFF}; pg8::StaticOrder S; S.init(M, DM, F.G, F.bx);
          pg8::EpiResN E{XR, XR, layer == 3 ? (bf16*)nullptr : U, SSQ(2 * layer + 2), DM};
          pg8::gemm_phase<pg8::EpiResN, pg8::StaticOrder, PG8_ALIGN, PG8_SP2>(F.lds + RING_OFF, g, S, E); }
        GRID_BAR();
    }
    {
        const int gw = F.vcu * NWAVES + F.wave, NGW = F.G * NWAVES;
        for (int m = gw; m < M; m += NGW) rms_row_f32(XR + (size_t)m * DM, args.in[56], args.out + (size_t)m * DM, F.lane);
    }
#undef GRID_BAR
#undef XR
#undef U
#undef BIG
#undef ACT2
#undef XT
#undef Yb
#undef Bn
#undef BT
#undef Cn
#undef DTF
#undef PART
#undef OP
#undef SSQ
#undef ropec
#undef ropes
}
}

extern "C" void kernel_launch(void* const* d_in, const int* in_sizes, int n_in, void* d_out, int out_size, void* d_ws, size_t ws_size, hipStream_t stream) {
    using namespace mk;
    static int grid = 0;
    if (grid == 0) {
        if (n_in != 57 || out_size != M * DM || ws_size < WS_END) { fprintf(stderr, "kernel_launch: built for 57 inputs, out of %d floats, >= %zu bytes of workspace; got n_in %d, out %d, ws %zu; nothing launched\n", M * DM, (size_t)WS_END, n_in, out_size, ws_size); grid = -1; return; }
        int dev = 0, cus = 0, per_cu = 0;
        if (hipGetDevice(&dev) != hipSuccess || hipDeviceGetAttribute(&cus, hipDeviceAttributeMultiprocessorCount, dev) != hipSuccess) { fprintf(stderr, "kernel_launch: device query failed\n"); grid = -1; return; }
        if (hipFuncSetAttribute((const void*)trunk_fwd, hipFuncAttributeMaxDynamicSharedMemorySize, LDS_BYTES) != hipSuccess) { fprintf(stderr, "kernel_launch: hipFuncSetAttribute failed\n"); grid = -1; return; }
        if (hipOccupancyMaxActiveBlocksPerMultiprocessor(&per_cu, (const void*)trunk_fwd, NTHR, LDS_BYTES) != hipSuccess || per_cu < 1)
            fprintf(stderr, "kernel_launch: note: occupancy query reports %d workgroups per CU\n", per_cu);
        (void)hipGetLastError();
        grid = cus;
    }
    if (grid < 0) return;
    if (hipMemsetAsync((char*)d_ws + WS_CTL, 0, CTL_ZERO_BYTES, stream) != hipSuccess) { fprintf(stderr, "kernel_launch: memset failed\n"); return; }
    Args a{};
    for (int i = 0; i < 57; ++i) a.in[i] = (const float*)d_in[i];
    a.out = (float*)d_out; a.ws = (unsigned char*)d_ws;
    hipLaunchKernelGGL(trunk_fwd, dim3(grid), dim3(NTHR), LDS_BYTES, stream, a);
    const hipError_t le = hipPeekAtLastError();
    if (le != hipSuccess) fprintf(stderr, "kernel_launch: launch failed: %s\n", hipGetErrorName(le));
}
```
